# Optimizing an MI355X kernel written in HIP

```python
import math
import jax, jax.numpy as jnp
from jax import lax
import numpy as np

D_MODEL = 1024
BATCH = 8
SEQ = 2048
DEPTH = 2
DEC_BATCH = 128
DEC_SEQ = 8
PAST_LEN = 16384
PAGE_SIZE = 128

N_MIXERS = 2
N_RET_LAYERS = (DEPTH + 1) // 2
N_SSM_LAYERS = DEPTH // 2
RET_HEADS = 4
RET_DK = D_MODEL // RET_HEADS
RET_DV = 2 * RET_DK
RET_VW = RET_HEADS * RET_DV
RET_IN = 2 * RET_HEADS * RET_DK + 2 * RET_VW
SSM_DINNER = 2 * D_MODEL
SSM_HEADDIM = 64
SSM_HEADS = SSM_DINNER // SSM_HEADDIM
SSM_GROUPS = 8
SSM_DSTATE = 128
SSM_CONV = 4
SSM_CONVDIM = SSM_DINNER + 2 * SSM_GROUPS * SSM_DSTATE
SSM_IN = 2 * SSM_DINNER + 2 * SSM_GROUPS * SSM_DSTATE + SSM_HEADS
CHUNK = 128
ROPE_BASE = 10000.0
EPS = 1e-6

kernel_name = "retnet_mamba2_interleaved_decode_step"


def _rms(x, axis=-1):
    xf = x.astype(jnp.float32)
    return xf * lax.rsqrt(jnp.mean(xf * xf, axis=axis, keepdims=True) + EPS)


def rmsnorm(x, g):
    return (_rms(x) * g.astype(jnp.float32)).astype(x.dtype)


def rope(x, pos):
    half = x.shape[-1] // 2
    freqs = ROPE_BASE ** (-jnp.arange(half, dtype=jnp.float32) / half)
    ang = pos.astype(jnp.float32)[:, None] * freqs[None, :]
    cos = jnp.cos(ang)[None, :, None, :]
    sin = jnp.sin(ang)[None, :, None, :]
    xf = x.astype(jnp.float32)
    x1, x2 = xf[..., :half], xf[..., half:]
    return jnp.concatenate([x1 * cos - x2 * sin, x1 * sin + x2 * cos], axis=-1).astype(x.dtype)


def chunked_linear_recurrence(q, k, v, log_a, s0):
    b, L, h, dk = q.shape
    dv = v.shape[-1]
    c = CHUNK if L % CHUNK == 0 else L
    n = L // c

    def to_chunks(t):
        return jnp.moveaxis(t.astype(jnp.float32).reshape((b, n, c) + t.shape[2:]), 1, 0)

    qs, ks, vs, las = to_chunks(q), to_chunks(k), to_chunks(v), to_chunks(log_a)
    mask = jnp.tril(jnp.ones((c, c), dtype=bool))

    def step(s, inp):
        qc, kc, vc, lac = inp
        cum = jnp.cumsum(lac, axis=1)
        cum_t = jnp.moveaxis(cum, 1, 2)
        diff = cum_t[..., :, None] - cum_t[..., None, :]
        decay = jnp.exp(jnp.where(mask, diff, -jnp.inf))
        scores = jnp.einsum('bihd,bjhd->bhij', qc, kc) * decay
        intra = jnp.einsum('bhij,bjhe->bihe', scores, vc)
        cross = jnp.einsum('bihd,bhde->bihe', qc, s) * jnp.exp(cum)[..., None]
        tail = jnp.exp(cum[:, -1:, :] - cum)
        s_new = jnp.exp(cum[:, -1, :])[..., None, None] * s + jnp.einsum('bjhd,bjh,bjhe->bhde', kc, tail, vc)
        return s_new, intra + cross

    s_fin, out = lax.scan(step, s0.astype(jnp.float32), (qs, ks, vs, las))
    out = jnp.moveaxis(out, 0, 1).reshape(b, L, h, dv)
    return out.astype(v.dtype), s_fin.astype(s0.dtype)


def retention_layer(h, s0, pos, w_in, head_norm, w_out):
    b, L, _ = h.shape
    proj = h @ w_in
    qk = RET_HEADS * RET_DK
    q = proj[..., :qk].reshape(b, L, RET_HEADS, RET_DK)
    k = proj[..., qk:2 * qk].reshape(b, L, RET_HEADS, RET_DK)
    v = proj[..., 2 * qk:2 * qk + RET_VW].reshape(b, L, RET_HEADS, RET_DV)
    gate = proj[..., 2 * qk + RET_VW:]
    q = rope(q, pos)
    k = rope(k, pos) * (RET_DK ** -0.5)
    log_gamma = jnp.log(1.0 - 2.0 ** (-5.0 - jnp.arange(RET_HEADS, dtype=jnp.float32)))
    log_a = jnp.broadcast_to(log_gamma, (b, L, RET_HEADS))
    o, s_new = chunked_linear_recurrence(q, k, v, log_a, s0)
    o = (_rms(o).reshape(b, L, RET_VW) * head_norm.astype(jnp.float32)).astype(h.dtype)
    return (o * jax.nn.silu(gate)) @ w_out, s_new


def ssd_layer(h, s0, conv0, w_in, conv_w, conv_b, dt_bias, a_log, d_skip, gate_norm, w_out):
    b, L, _ = h.shape
    proj = h @ w_in
    z = proj[..., :SSM_DINNER]
    xbc = proj[..., SSM_DINNER:SSM_DINNER + SSM_CONVDIM]
    dt_raw = proj[..., SSM_DINNER + SSM_CONVDIM:]
    xpad = jnp.concatenate([conv0.astype(xbc.dtype), xbc], axis=1)
    conv = conv_b
    for w in range(SSM_CONV):
        conv = conv + xpad[:, w:w + L] * conv_w[w]
    xbc_c = jax.nn.silu(conv)
    new_conv = xpad[:, L:]
    gn = SSM_GROUPS * SSM_DSTATE
    xs = xbc_c[..., :SSM_DINNER].reshape(b, L, SSM_HEADS, SSM_HEADDIM)
    rep = SSM_HEADS // SSM_GROUPS
    bm = jnp.repeat(xbc_c[..., SSM_DINNER:SSM_DINNER + gn].reshape(b, L, SSM_GROUPS, SSM_DSTATE), rep, axis=2)
    cm = jnp.repeat(xbc_c[..., SSM_DINNER + gn:].reshape(b, L, SSM_GROUPS, SSM_DSTATE), rep, axis=2)
    dt = jax.nn.softplus(dt_raw.astype(jnp.float32) + dt_bias.astype(jnp.float32))
    a = -jnp.exp(a_log.astype(jnp.float32))
    log_a = dt * a
    v = xs * dt[..., None].astype(xs.dtype)
    y, s_new = chunked_linear_recurrence(cm, bm, v, log_a, s0)
    y = (y + xs * d_skip[:, None]).reshape(b, L, SSM_DINNER)
    g = y * jax.nn.silu(z)
    g = _rms(g.reshape(b, L, SSM_GROUPS, SSM_DINNER // SSM_GROUPS)).reshape(b, L, SSM_DINNER)
    g = (g * gate_norm.astype(jnp.float32)).astype(h.dtype)
    return g @ w_out, new_conv


def trunk(x, ret_states, ssm_states, conv_states, pos, ret_norm, ret_w_in, ret_head_norm, ret_w_out,
          ssm_norm, ssm_w_in, ssm_conv_w, ssm_conv_b, ssm_dt_bias, ssm_a_log, ssm_d, ssm_gate_norm,
          ssm_w_out, final_norm):
    h = x
    ret_new, ssm_new, conv_new = [], [], []
    for i in range(DEPTH):
        j = i // N_MIXERS
        if i % N_MIXERS == 0:
            out, s = retention_layer(rmsnorm(h, ret_norm[j]), ret_states[j], pos,
                                     ret_w_in[j], ret_head_norm[j], ret_w_out[j])
            ret_new.append(s)
        else:
            out, s, cv = ssd_layer_full(rmsnorm(h, ssm_norm[j]), ssm_states[j], conv_states[j],
                                        ssm_w_in[j], ssm_conv_w[j], ssm_conv_b[j], ssm_dt_bias[j],
                                        ssm_a_log[j], ssm_d[j], ssm_gate_norm[j], ssm_w_out[j])
            ssm_new.append(s)
            conv_new.append(cv)
        h = h + out
    return rmsnorm(h, final_norm), jnp.stack(ret_new), jnp.stack(ssm_new), jnp.stack(conv_new)


def ssd_layer_full(h, s0, conv0, w_in, conv_w, conv_b, dt_bias, a_log, d_skip, gate_norm, w_out):
    b, L, _ = h.shape
    proj = h @ w_in
    z = proj[..., :SSM_DINNER]
    xbc = proj[..., SSM_DINNER:SSM_DINNER + SSM_CONVDIM]
    dt_raw = proj[..., SSM_DINNER + SSM_CONVDIM:]
    xpad = jnp.concatenate([conv0.astype(xbc.dtype), xbc], axis=1)
    conv = conv_b
    for w in range(SSM_CONV):
        conv = conv + xpad[:, w:w + L] * conv_w[w]
    xbc_c = jax.nn.silu(conv)
    new_conv = xpad[:, L:]
    gn = SSM_GROUPS * SSM_DSTATE
    rep = SSM_HEADS // SSM_GROUPS
    xs = xbc_c[..., :SSM_DINNER].reshape(b, L, SSM_HEADS, SSM_HEADDIM)
    bm = jnp.repeat(xbc_c[..., SSM_DINNER:SSM_DINNER + gn].reshape(b, L, SSM_GROUPS, SSM_DSTATE), rep, axis=2)
    cm = jnp.repeat(xbc_c[..., SSM_DINNER + gn:].reshape(b, L, SSM_GROUPS, SSM_DSTATE), rep, axis=2)
    dt = jax.nn.softplus(dt_raw.astype(jnp.float32) + dt_bias.astype(jnp.float32))
    log_a = dt * (-jnp.exp(a_log.astype(jnp.float32)))
    v = xs * dt[..., None].astype(xs.dtype)
    y, s_new = chunked_linear_recurrence(cm, bm, v, log_a, s0)
    y = (y + xs * d_skip[:, None]).reshape(b, L, SSM_DINNER)
    g = y * jax.nn.silu(z)
    g = _rms(g.reshape(b, L, SSM_GROUPS, SSM_DINNER // SSM_GROUPS)).reshape(b, L, SSM_DINNER)
    g = (g * gate_norm.astype(jnp.float32)).astype(h.dtype)
    return g @ w_out, s_new, new_conv


def setup_inputs(seed: int = 0) -> dict:
    key = jax.random.key(seed)
    ks = jax.random.split(key, 24)
    nr, ns = N_RET_LAYERS, N_SSM_LAYERS
    f32 = jnp.float32
    dt0 = jnp.exp(jax.random.uniform(ks[17], (ns, SSM_HEADS), f32) * (math.log(0.1) - math.log(0.001)) + math.log(0.001))
    return {
        "x_prompt": jax.random.normal(ks[0], (BATCH, SEQ, D_MODEL), f32),
        "x_sample": jax.random.normal(ks[1], (DEC_BATCH, DEC_SEQ, D_MODEL), f32),
        "state_ret": 0.1 * jax.random.normal(ks[2], (nr, DEC_BATCH, RET_HEADS, RET_DK, RET_DV), f32),
        "state_ssm": 0.1 * jax.random.normal(ks[3], (ns, DEC_BATCH, SSM_HEADS, SSM_DSTATE, SSM_HEADDIM), f32),
        "state_conv": jax.random.normal(ks[4], (ns, DEC_BATCH, SSM_CONV - 1, SSM_CONVDIM), f32),
        "ret_norm": 1.0 + 0.02 * jax.random.normal(ks[5], (nr, D_MODEL), f32),
        "ret_w_in": jax.random.normal(ks[6], (nr, D_MODEL, RET_IN), f32) * D_MODEL ** -0.5,
        "ret_head_norm": 1.0 + 0.02 * jax.random.normal(ks[7], (nr, RET_VW), f32),
        "ret_w_out": jax.random.normal(ks[8], (nr, RET_VW, D_MODEL), f32) * RET_VW ** -0.5,
        "ssm_norm": 1.0 + 0.02 * jax.random.normal(ks[9], (ns, D_MODEL), f32),
        "ssm_w_in": jax.random.normal(ks[10], (ns, D_MODEL, SSM_IN), f32) * D_MODEL ** -0.5,
        "ssm_conv_w": jax.random.normal(ks[11], (ns, SSM_CONV, SSM_CONVDIM), f32) * SSM_CONV ** -0.5,
        "ssm_conv_b": 0.01 * jax.random.normal(ks[12], (ns, SSM_CONVDIM), f32),
        "ssm_dt_bias": dt0 + jnp.log(-jnp.expm1(-dt0)),
        "ssm_a_log": jnp.log(jax.random.uniform(ks[13], (ns, SSM_HEADS), f32, 1.0, 16.0)),
        "ssm_d": 1.0 + 0.02 * jax.random.normal(ks[14], (ns, SSM_HEADS), f32),
        "ssm_gate_norm": 1.0 + 0.02 * jax.random.normal(ks[15], (ns, SSM_DINNER), f32),
        "ssm_w_out": jax.random.normal(ks[16], (ns, SSM_DINNER, D_MODEL), f32) * SSM_DINNER ** -0.5,
        "final_norm": 1.0 + 0.02 * jax.random.normal(ks[18], (D_MODEL,), f32),
    }


def reference(x_prompt, x_sample, state_ret, state_ssm, state_conv, ret_norm, ret_w_in, ret_head_norm,
              ret_w_out, ssm_norm, ssm_w_in, ssm_conv_w, ssm_conv_b, ssm_dt_bias, ssm_a_log, ssm_d,
              ssm_gate_norm, ssm_w_out, final_norm):
    weights = (ret_norm, ret_w_in, ret_head_norm, ret_w_out, ssm_norm, ssm_w_in, ssm_conv_w, ssm_conv_b,
               ssm_dt_bias, ssm_a_log, ssm_d, ssm_gate_norm, ssm_w_out, final_norm)
    bp = x_prompt.shape[0]
    dt = x_prompt.dtype
    ret0 = jnp.zeros((N_RET_LAYERS, bp, RET_HEADS, RET_DK, RET_DV), dt)
    ssm0 = jnp.zeros((N_SSM_LAYERS, bp, SSM_HEADS, SSM_DSTATE, SSM_HEADDIM), dt)
    conv0 = jnp.zeros((N_SSM_LAYERS, bp, SSM_CONV - 1, SSM_CONVDIM), dt)
    pos_p = jnp.arange(x_prompt.shape[1], dtype=jnp.int32)
    pos_s = PAST_LEN + jnp.arange(x_sample.shape[1], dtype=jnp.int32)
    y_prompt, ret_p, ssm_p, conv_p = trunk(x_prompt, ret0, ssm0, conv0, pos_p, *weights)
    y_sample, ret_s, ssm_s, conv_s = trunk(x_sample, state_ret, state_ssm, state_conv, pos_s, *weights)
    return (y_prompt, y_sample, ret_p, ret_s, ssm_p, ssm_s, conv_p, conv_s)
```

```cpp
#include <hip/hip_runtime.h>
#include <hip/hip_cooperative_groups.h>
#include <stdint.h>
#include <stdio.h>
namespace cg = cooperative_groups;

typedef __attribute__((ext_vector_type(8))) short bf16x8;
typedef __attribute__((ext_vector_type(4))) short s16x4;
typedef __attribute__((ext_vector_type(4))) float f32x4;
typedef unsigned short u16;
typedef __attribute__((ext_vector_type(4))) unsigned int u32x4;
typedef __attribute__((ext_vector_type(2))) unsigned int u32x2;

#define NTHR 512
#define T_TOK 17408
#define NPROMPT 16384
#define LDS_BYTES 143360

constexpr size_t OFF_WT0 = 0;
constexpr size_t OFF_WT1 = OFF_WT0 + (size_t)6144 * 1024 * 2;
constexpr size_t OFF_WT2 = OFF_WT1 + (size_t)1024 * 2048 * 2;
constexpr size_t OFF_WT3 = OFF_WT2 + (size_t)6272 * 1024 * 2;
constexpr size_t OFF_ROPE = OFF_WT3 + (size_t)1024 * 2048 * 2;
constexpr size_t OFF_H = OFF_ROPE + (size_t)2056 * 128 * 8;
constexpr size_t OFF_PROJ = OFF_H + (size_t)T_TOK * 1024 * 2;
constexpr size_t OFF_A2 = OFF_PROJ + (size_t)T_TOK * 6144 * 2;
constexpr size_t OFF_PARTS = OFF_A2 + (size_t)T_TOK * 2048 * 2;
constexpr size_t OFF_X1 = OFF_PARTS + (size_t)T_TOK * 64 * 4;
constexpr size_t OFF_X2 = OFF_X1 + (size_t)T_TOK * 1024 * 4;
constexpr size_t OFF_XBCC = OFF_X2 + (size_t)T_TOK * 1024 * 4;
constexpr size_t OFF_DTRAW = OFF_XBCC + (size_t)T_TOK * 4096 * 2;
constexpr size_t OFF_DT = OFF_DTRAW + (size_t)T_TOK * 32 * 4;
constexpr size_t OFF_CUM = OFF_DT + (size_t)T_TOK * 32 * 4;

constexpr size_t OUT_Y = 0;
constexpr size_t OUT_RETP = 17825792;
constexpr size_t OUT_RETS = 22020096;
constexpr size_t OUT_SSMP = 89128960;
constexpr size_t OUT_SSMS = 91226112;
constexpr size_t OUT_CONVP = 124780544;
constexpr size_t OUT_CONVS = 124878848;

struct Params {
  const float *x_prompt, *x_sample, *state_ret, *state_ssm, *state_conv, *ret_norm, *ret_w_in, *ret_head_norm,
      *ret_w_out, *ssm_norm, *ssm_w_in, *ssm_conv_w, *ssm_conv_b, *ssm_dt_bias, *ssm_a_log, *ssm_d, *ssm_gate_norm,
      *ssm_w_out, *final_norm;
  float* out;
  unsigned char* ws;
  long long phase_lo, phase_hi;
};

__device__ __forceinline__ u16 f2bf(float f) {
  uint32_t u = __float_as_uint(f);
  u += 0x7fffu + ((u >> 16) & 1u);
  return (u16)(u >> 16);
}
__device__ __forceinline__ float bf2f(u16 h) { return __uint_as_float(((uint32_t)h) << 16); }
__device__ __forceinline__ uint32_t pack2(float a, float b) { return (uint32_t)f2bf(a) | ((uint32_t)f2bf(b) << 16); }
__device__ __forceinline__ float silu(float x) { return x / (1.0f + __expf(-x)); }
__device__ __forceinline__ float wave_sum(float v) {
#pragma unroll
  for (int o = 32; o > 0; o >>= 1) v += __shfl_xor(v, o);
  return v;
}
__device__ __forceinline__ const float* xrow(const Params& p, int r) {
  return r < NPROMPT ? p.x_prompt + (size_t)r * 1024 : p.x_sample + (size_t)(r - NPROMPT) * 1024;
}
__device__ __forceinline__ s16x4 trread(const unsigned char* ptr) {
  return __builtin_amdgcn_ds_read_tr16_b64_v4i16((s16x4 __attribute__((address_space(3)))*)ptr);
}
__device__ __forceinline__ bf16x8 cat8(s16x4 a, s16x4 b) {
  bf16x8 r;
  r[0] = a[0]; r[1] = a[1]; r[2] = a[2]; r[3] = a[3];
  r[4] = b[0]; r[5] = b[1]; r[6] = b[2]; r[7] = b[3];
  return r;
}
__device__ __forceinline__ bf16x8 trfrag(const unsigned char* img, int rs, int kbase, int nbase, int lane) {
  const int g = lane >> 4, q = (lane & 15) >> 2, pp = lane & 3;
  const unsigned char* a = img + (kbase + 8 * g + q) * rs + (nbase + 4 * pp) * 2;
  s16x4 t0 = trread(a);
  s16x4 t1 = trread(a + 4 * rs);
  return cat8(t0, t1);
}

__device__ __forceinline__ int colmap_retin(int p) {
  if (p < 2048) {
    int hb = p & ~255, pp = p & 255;
    int gi = pp >> 5, half = (pp >> 4) & 1, c = pp & 15;
    return hb + half * 128 + gi * 16 + c;
  }
  return p;
}

__device__ void transpose_tile(const float* __restrict__ W, u16* __restrict__ Wt, int K, int N, int mode, int nt, int kt,
                               unsigned char* smem) {
  float* tile = (float*)smem;
  const int tid = threadIdx.x;
#pragma unroll
  for (int i = 0; i < 8; ++i) {
    int idx = tid + NTHR * i;
    int kk = idx >> 6, nn = idx & 63;
    int n = nt * 64 + nn;
    int src = (mode == 1) ? colmap_retin(n) : n;
    float v = 0.f;
    if (src < N) v = W[(size_t)(kt * 64 + kk) * N + src];
    tile[kk * 65 + nn] = v;
  }
  __syncthreads();
  {
    int n = tid >> 3, kc = tid & 7;
    float v[8];
#pragma unroll
    for (int j = 0; j < 8; ++j) v[j] = tile[(kc * 8 + j) * 65 + n];
    u32x4 o;
    o.x = pack2(v[0], v[1]); o.y = pack2(v[2], v[3]); o.z = pack2(v[4], v[5]); o.w = pack2(v[6], v[7]);
    *(u32x4*)(Wt + (size_t)(nt * 64 + n) * K + kt * 64 + kc * 8) = o;
  }
  __syncthreads();
}

__device__ void phase_prep(const Params& p, unsigned char* smem) {
  const int tid = threadIdx.x;
  u16* Wt0 = (u16*)(p.ws + OFF_WT0);
  u16* Wt1 = (u16*)(p.ws + OFF_WT1);
  u16* Wt2 = (u16*)(p.ws + OFF_WT2);
  u16* Wt3 = (u16*)(p.ws + OFF_WT3);
  const int n0 = 1536, n1 = 512, n2 = 1568, n3 = 512;
  for (int t = blockIdx.x; t < n0 + n1 + n2 + n3; t += gridDim.x) {
    if (t < n0) {
      transpose_tile(p.ret_w_in, Wt0, 1024, 6144, 1, t >> 4, t & 15, smem);
    } else if (t < n0 + n1) {
      int u = t - n0;
      transpose_tile(p.ret_w_out, Wt1, 2048, 1024, 0, u >> 5, u & 31, smem);
    } else if (t < n0 + n1 + n2) {
      int u = t - n0 - n1;
      transpose_tile(p.ssm_w_in, Wt2, 1024, 6176, 0, u >> 4, u & 15, smem);
    } else {
      int u = t - n0 - n1 - n2;
      transpose_tile(p.ssm_w_out, Wt3, 2048, 1024, 0, u >> 5, u & 31, smem);
    }
  }
  float2* rope = (float2*)(p.ws + OFF_ROPE);
  const int gtid = blockIdx.x * NTHR + tid, gn = gridDim.x * NTHR;
  for (int idx = gtid; idx < 2056 * 128; idx += gn) {
    int pi = idx >> 7, i = idx & 127;
    int pos = pi < 2048 ? pi : 16384 + (pi - 2048);
    float freq = (float)exp2(-(double)i * (13.287712379549449 / 128.0));
    float ang = (float)pos * freq;
    float sn, cs;
    sincosf(ang, &sn, &cs);
    rope[idx] = make_float2(cs, sn);
  }
  u16* H = (u16*)(p.ws + OFF_H);
  const int lane = tid & 63, w = tid >> 6;
  for (int row = blockIdx.x * 8 + w; row < T_TOK; row += gridDim.x * 8) {
    const float* xr = xrow(p, row);
    float4 v[4];
    float ss = 0.f;
#pragma unroll
    for (int i = 0; i < 4; ++i) {
      v[i] = *(const float4*)(xr + i * 256 + lane * 4);
      ss += v[i].x * v[i].x + v[i].y * v[i].y + v[i].z * v[i].z + v[i].w * v[i].w;
    }
    ss = wave_sum(ss);
    float rstd = rsqrtf(ss * (1.0f / 1024.0f) + 1e-6f);
#pragma unroll
    for (int i = 0; i < 4; ++i) {
      float4 gg = *(const float4*)(p.ret_norm + i * 256 + lane * 4);
      u32x2 o;
      o.x = pack2(v[i].x * rstd * gg.x, v[i].y * rstd * gg.y);
      o.y = pack2(v[i].z * rstd * gg.z, v[i].w * rstd * gg.w);
      *(u32x2*)(H + (size_t)row * 1024 + i * 256 + lane * 4) = o;
    }
  }
}

template <int MODE>
__device__ void phase_norm(const Params& p, const float* __restrict__ X, const float* __restrict__ gain) {
  const int tid = threadIdx.x, lane = tid & 63, w = tid >> 6;
  u16* H = (u16*)(p.ws + OFF_H);
  for (int row = blockIdx.x * 8 + w; row < T_TOK; row += gridDim.x * 8) {
    const float* xr = X + (size_t)row * 1024;
    float4 v[4];
    float ss = 0.f;
#pragma unroll
    for (int i = 0; i < 4; ++i) {
      v[i] = *(const float4*)(xr + i * 256 + lane * 4);
      ss += v[i].x * v[i].x + v[i].y * v[i].y + v[i].z * v[i].z + v[i].w * v[i].w;
    }
    ss = wave_sum(ss);
    float rstd = rsqrtf(ss * (1.0f / 1024.0f) + 1e-6f);
#pragma unroll
    for (int i = 0; i < 4; ++i) {
      float4 gg = *(const float4*)(gain + i * 256 + lane * 4);
      if (MODE == 0) {
        u32x2 o;
        o.x = pack2(v[i].x * rstd * gg.x, v[i].y * rstd * gg.y);
        o.y = pack2(v[i].z * rstd * gg.z, v[i].w * rstd * gg.w);
        *(u32x2*)(H + (size_t)row * 1024 + i * 256 + lane * 4) = o;
      } else {
        float4 o = make_float4(v[i].x * rstd * gg.x, v[i].y * rstd * gg.y, v[i].z * rstd * gg.z, v[i].w * rstd * gg.w);
        *(float4*)(p.out + OUT_Y + (size_t)row * 1024 + i * 256 + lane * 4) = o;
      }
    }
  }
}

template <int EPI, int NH>
__device__ void gemm_phase(const Params& p, const u16* __restrict__ A, const u16* __restrict__ Bt, const int K, const int NT,
                           const float* __restrict__ resid, float* __restrict__ outf, unsigned char* smem) {
  constexpr int BM = 256, BN = 128, BK = 64, LR = 144;
  constexpr int BUFB = (BM + BN) * LR;
  float* rstdS = (float*)(smem + 2 * BUFB);
  const int tid = threadIdx.x, lane = tid & 63, w = tid >> 6;
  const int wm = w >> 1, wn = w & 1, l15 = lane & 15, g = lane >> 4;
  const int KT = K / BK;
  const int ntiles = (T_TOK / BM) * NT;
  const float* parts = (const float*)(p.ws + OFF_PARTS);
  const int srow = tid >> 3, skc = tid & 7;

  for (int tile = blockIdx.x; tile < ntiles; tile += gridDim.x) {
    const int mt = tile / NT, nt = tile - mt * NT;
    const int m0 = mt * BM, n0 = nt * BN;
    if (NH > 0) {
      for (int idx = tid; idx < BM * NH; idx += NTHR) {
        int row = idx / NH, h = idx % NH;
        const float* pp = parts + (size_t)(m0 + row) * 64 + h * (64 / NH);
        float s = 0.f;
#pragma unroll
        for (int q = 0; q < 64 / NH; ++q) s += pp[q];
        rstdS[idx] = rsqrtf(s / (float)(K / NH) + 1e-6f);
      }
    }
    u32x4 ra[4], rb[2];
    const u16* ap = A + (size_t)(m0 + srow) * K + skc * 8;
    const u16* bp = Bt + (size_t)(n0 + srow) * K + skc * 8;
#pragma unroll
    for (int i = 0; i < 4; ++i) ra[i] = *(const u32x4*)(ap + (size_t)(64 * i) * K);
#pragma unroll
    for (int i = 0; i < 2; ++i) rb[i] = *(const u32x4*)(bp + (size_t)(64 * i) * K);
    {
      unsigned char* base = smem;
#pragma unroll
      for (int i = 0; i < 4; ++i) *(u32x4*)(base + (srow + 64 * i) * LR + skc * 16) = ra[i];
#pragma unroll
      for (int i = 0; i < 2; ++i) *(u32x4*)(base + BM * LR + (srow + 64 * i) * LR + skc * 16) = rb[i];
    }
    __syncthreads();

    f32x4 acc[4][4];
    f32x4 accT[4][4];
#pragma unroll
    for (int i = 0; i < 4; ++i)
#pragma unroll
      for (int j = 0; j < 4; ++j) {
        acc[i][j] = (f32x4){0.f, 0.f, 0.f, 0.f};
        accT[i][j] = (f32x4){0.f, 0.f, 0.f, 0.f};
      }

    for (int kt = 0; kt < KT; ++kt) {
      const bool more = (kt + 1 < KT);
      if (more) {
#pragma unroll
        for (int i = 0; i < 4; ++i) ra[i] = *(const u32x4*)(ap + (size_t)(64 * i) * K + (kt + 1) * BK);
#pragma unroll
        for (int i = 0; i < 2; ++i) rb[i] = *(const u32x4*)(bp + (size_t)(64 * i) * K + (kt + 1) * BK);
      }
      const unsigned char* abase = smem + (kt & 1) * BUFB + (wm * 64 + l15) * LR + g * 16;
      const unsigned char* bbase = smem + (kt & 1) * BUFB + BM * LR + (wn * 64 + l15) * LR + g * 16;
#pragma unroll
      for (int ks = 0; ks < 2; ++ks) {
        bf16x8 af[4], bfr[4];
#pragma unroll
        for (int mf = 0; mf < 4; ++mf) af[mf] = *(const bf16x8*)(abase + mf * 16 * LR + ks * 64);
#pragma unroll
        for (int nf = 0; nf < 4; ++nf) bfr[nf] = *(const bf16x8*)(bbase + nf * 16 * LR + ks * 64);
#pragma unroll
        for (int mf = 0; mf < 4; ++mf)
#pragma unroll
          for (int nf = 0; nf < 4; ++nf)
            acc[mf][nf] = __builtin_amdgcn_mfma_f32_16x16x32_bf16(af[mf], bfr[nf], acc[mf][nf], 0, 0, 0);
      }
      if (NH > 0) {
        const int per = KT / NH;
        if (((kt + 1) % per) == 0) {
          const int h = (kt + 1) / per - 1;
#pragma unroll
          for (int mf = 0; mf < 4; ++mf)
#pragma unroll
            for (int r = 0; r < 4; ++r) {
              float s = rstdS[(wm * 64 + mf * 16 + 4 * g + r) * NH + h];
#pragma unroll
              for (int nf = 0; nf < 4; ++nf) {
                accT[mf][nf][r] += s * acc[mf][nf][r];
                acc[mf][nf][r] = 0.f;
              }
            }
        }
      }
      if (more) {
        unsigned char* base = smem + ((kt + 1) & 1) * BUFB;
#pragma unroll
        for (int i = 0; i < 4; ++i) *(u32x4*)(base + (srow + 64 * i) * LR + skc * 16) = ra[i];
#pragma unroll
        for (int i = 0; i < 2; ++i) *(u32x4*)(base + BM * LR + (srow + 64 * i) * LR + skc * 16) = rb[i];
      }
      __syncthreads();
    }

#pragma unroll
    for (int mf = 0; mf < 4; ++mf) {
#pragma unroll
      for (int r = 0; r < 4; ++r) {
        const int row = m0 + wm * 64 + mf * 16 + 4 * g + r;
        if (EPI == 0) {
          u16* proj = (u16*)(p.ws + OFF_PROJ) + (size_t)row * 6144;
          if (n0 < 2048) {
            const float2* rope = (const float2*)(p.ws + OFF_ROPE);
            const int pi = row < NPROMPT ? (row & 2047) : 2048 + ((row - NPROMPT) & 7);
#pragma unroll
            for (int np = 0; np < 2; ++np) {
              const int pc = n0 + wn * 64 + np * 32;
              const int i = ((pc & 255) >> 5) * 16 + l15;
              const float2 cs = rope[pi * 128 + i];
              const float x1 = acc[mf][2 * np][r], x2 = acc[mf][2 * np + 1][r];
              float y1 = x1 * cs.x - x2 * cs.y, y2 = x1 * cs.y + x2 * cs.x;
              if (pc >= 1024) { y1 *= 0.0625f; y2 *= 0.0625f; }
              const int f1 = (pc & ~255) + i;
              proj[f1] = f2bf(y1);
              proj[f1 + 128] = f2bf(y2);
            }
          } else {
#pragma unroll
            for (int nf = 0; nf < 4; ++nf) proj[n0 + wn * 64 + nf * 16 + l15] = f2bf(acc[mf][nf][r]);
          }
        } else if (EPI == 1) {
#pragma unroll
          for (int nf = 0; nf < 4; ++nf) {
            const int col = n0 + wn * 64 + nf * 16 + l15;
            const float rv = resid ? resid[(size_t)row * 1024 + col] : xrow(p, row)[col];
            const float a = (NH > 0) ? accT[mf][nf][r] : acc[mf][nf][r];
            outf[(size_t)row * 1024 + col] = rv + a;
          }
        } else {
          u16* proj = (u16*)(p.ws + OFF_PROJ) + (size_t)row * 6144;
          float* dtraw = (float*)(p.ws + OFF_DTRAW) + (size_t)row * 32;
          float* cvo = nullptr;
          if (row < NPROMPT) {
            const int t = row & 2047;
            if (t >= 2045) cvo = p.out + OUT_CONVP + ((size_t)(row >> 11) * 3 + (t - 2045)) * 4096;
          } else {
            const int rs = row - NPROMPT, t = rs & 7;
            if (t >= 5) cvo = p.out + OUT_CONVS + ((size_t)(rs >> 3) * 3 + (t - 5)) * 4096;
          }
#pragma unroll
          for (int nf = 0; nf < 4; ++nf) {
            const int col = n0 + wn * 64 + nf * 16 + l15;
            const float a = acc[mf][nf][r];
            if (col < 6144) {
              proj[col] = f2bf(a);
              if (col >= 2048 && cvo) cvo[col - 2048] = a;
            } else if (col < 6176) {
              dtraw[col - 6144] = a;
            }
          }
        }
      }
    }
  }
}

__device__ void phase_conv(const Params& p) {
  const int gtid = blockIdx.x * NTHR + threadIdx.x, gn = gridDim.x * NTHR;
  const float* dtraw = (const float*)(p.ws + OFF_DTRAW);
  float* dtv = (float*)(p.ws + OFF_DT);
  float* cumv = (float*)(p.ws + OFF_CUM);
  for (int idx = gtid; idx < (256 + 128) * 32; idx += gn) {
    const int sc = idx >> 5, h = idx & 31;
    int row0, len;
    if (sc < 256) { row0 = sc * 64; len = 64; } else { row0 = NPROMPT + (sc - 256) * 8; len = 8; }
    const float a = -expf(p.ssm_a_log[h]);
    const float bias = p.ssm_dt_bias[h];
    float cum = 0.f;
    for (int t = 0; t < len; ++t) {
      float x = dtraw[(size_t)(row0 + t) * 32 + h] + bias;
      float dt = x > 20.f ? x : log1pf(expf(x));
      cum += dt * a;
      dtv[(size_t)(row0 + t) * 32 + h] = dt;
      cumv[(size_t)(row0 + t) * 32 + h] = cum;
    }
  }
  const u16* proj = (const u16*)(p.ws + OFF_PROJ);
  u16* xbcc = (u16*)(p.ws + OFF_XBCC);
  for (int idx = gtid; idx < T_TOK * 512; idx += gn) {
    const int row = idx >> 9, ch0 = (idx & 511) * 8;
    int t, b;
    const bool samp = row >= NPROMPT;
    if (!samp) { t = row & 2047; b = row >> 11; } else { t = (row - NPROMPT) & 7; b = (row - NPROMPT) >> 3; }
    float acc[8];
    {
      float4 b0 = *(const float4*)(p.ssm_conv_b + ch0), b1 = *(const float4*)(p.ssm_conv_b + ch0 + 4);
      acc[0] = b0.x; acc[1] = b0.y; acc[2] = b0.z; acc[3] = b0.w;
      acc[4] = b1.x; acc[5] = b1.y; acc[6] = b1.z; acc[7] = b1.w;
    }
#pragma unroll
    for (int wv = 0; wv < 4; ++wv) {
      const int tt = t - 3 + wv;
      float xv[8];
      if (tt >= 0) {
        u32x4 u = *(const u32x4*)(proj + (size_t)(row - 3 + wv) * 6144 + 2048 + ch0);
        xv[0] = bf2f((u16)(u.x & 0xffff)); xv[1] = bf2f((u16)(u.x >> 16));
        xv[2] = bf2f((u16)(u.y & 0xffff)); xv[3] = bf2f((u16)(u.y >> 16));
        xv[4] = bf2f((u16)(u.z & 0xffff)); xv[5] = bf2f((u16)(u.z >> 16));
        xv[6] = bf2f((u16)(u.w & 0xffff)); xv[7] = bf2f((u16)(u.w >> 16));
      } else if (samp) {
        const float* sp = p.state_conv + ((size_t)b * 3 + (tt + 3)) * 4096 + ch0;
        float4 s0 = *(const float4*)sp, s1 = *(const float4*)(sp + 4);
        xv[0] = s0.x; xv[1] = s0.y; xv[2] = s0.z; xv[3] = s0.w;
        xv[4] = s1.x; xv[5] = s1.y; xv[6] = s1.z; xv[7] = s1.w;
      } else {
#pragma unroll
        for (int j = 0; j < 8; ++j) xv[j] = 0.f;
      }
      float4 w0 = *(const float4*)(p.ssm_conv_w + (size_t)wv * 4096 + ch0);
      float4 w1 = *(const float4*)(p.ssm_conv_w + (size_t)wv * 4096 + ch0 + 4);
      acc[0] += xv[0] * w0.x; acc[1] += xv[1] * w0.y; acc[2] += xv[2] * w0.z; acc[3] += xv[3] * w0.w;
      acc[4] += xv[4] * w1.x; acc[5] += xv[5] * w1.y; acc[6] += xv[6] * w1.z; acc[7] += xv[7] * w1.w;
    }
    u32x4 o;
    o.x = pack2(silu(acc[0]), silu(acc[1]));
    o.y = pack2(silu(acc[2]), silu(acc[3]));
    o.z = pack2(silu(acc[4]), silu(acc[5]));
    o.w = pack2(silu(acc[6]), silu(acc[7]));
    *(u32x4*)(xbcc + (size_t)row * 4096 + ch0) = o;
  }
}

template <int DK, int MODE>
__device__ void rec_prompt_item(const Params& p, const int item, unsigned char* smem) {
  constexpr int QS = (DK + 16) * 2;
  constexpr int VS = 160, PS = 144;
  constexpr int MF = DK / 128;
  constexpr int KS = DK / 32;
  constexpr int NQ = DK / 64;
  constexpr int CPR = DK / 8;
  unsigned char* Qs = smem;
  unsigned char* Ks = Qs + 64 * QS;
  unsigned char* STs = Ks + 64 * QS;
  unsigned char* Vs = STs + 64 * QS;
  unsigned char* Vts = Vs + 64 * VS;
  unsigned char* Ps = Vts + 64 * VS;
  float* cumS = (float*)(Ps + 64 * PS);
  float* uS = cumS + 64;

  const int tid = threadIdx.x, lane = tid & 63, w = tid >> 6;
  const int l15 = lane & 15, g = lane >> 4;
  const int b = item >> 5;
  const int h = (MODE == 0) ? ((item >> 3) & 3) : (item & 31);
  const int s = (MODE == 0) ? (item & 7) : 0;
  const int row0 = b * 2048;

  const u16* src;
  int sstride, qcol, kcol, vcol;
  if (MODE == 0) {
    src = (const u16*)(p.ws + OFF_PROJ); sstride = 6144;
    qcol = h * 256; kcol = 1024 + h * 256; vcol = 2048 + h * 512 + s * 64;
  } else {
    src = (const u16*)(p.ws + OFF_XBCC); sstride = 4096;
    qcol = 3072 + (h >> 2) * 128; kcol = 2048 + (h >> 2) * 128; vcol = h * 64;
  }
  const float* dtv = (const float*)(p.ws + OFF_DT);
  const float* cumv = (const float*)(p.ws + OFF_CUM);
  const float lg = (MODE == 0) ? logf(1.0f - exp2f(-5.0f - (float)h)) : 0.f;

  const int vrow = tid >> 3, vkc = tid & 7;
  const int jt = tid & 63;

  u32x4 rq[NQ], rk[NQ], rv;
  float pcj = 0.f, puj = 1.f, pclast = 0.f, pct = 0.f, put = 1.f;

  f32x4 S[MF][4];
#pragma unroll
  for (int i = 0; i < MF; ++i)
#pragma unroll
    for (int j = 0; j < 4; ++j) S[i][j] = (f32x4){0.f, 0.f, 0.f, 0.f};

  {
    const int r0 = row0;
#pragma unroll
    for (int i = 0; i < NQ; ++i) {
      int c = tid + NTHR * i, rr = c / CPR, kc = c % CPR;
      rq[i] = *(const u32x4*)(src + (size_t)(r0 + rr) * sstride + qcol + kc * 8);
      rk[i] = *(const u32x4*)(src + (size_t)(r0 + rr) * sstride + kcol + kc * 8);
    }
    rv = *(const u32x4*)(src + (size_t)(r0 + vrow) * sstride + vcol + vkc * 8);
    if (MODE == 1) {
      pcj = cumv[(size_t)(r0 + vrow) * 32 + h]; puj = dtv[(size_t)(r0 + vrow) * 32 + h];
      pclast = cumv[(size_t)(r0 + 63) * 32 + h];
      pct = cumv[(size_t)(r0 + jt) * 32 + h]; put = dtv[(size_t)(r0 + jt) * 32 + h];
    }
  }

  const int fi = w >> 1, fe0 = 2 * (w & 1);
  const int dw = w * (DK / 8);

  for (int c = 0; c < 32; ++c) {
    const int r0 = row0 + c * 64;
#pragma unroll
    for (int i = 0; i < NQ; ++i) {
      int cc = tid + NTHR * i, rr = cc / CPR, kc = cc % CPR;
      *(u32x4*)(Qs + rr * QS + kc * 16) = rq[i];
      *(u32x4*)(Ks + rr * QS + kc * 16) = rk[i];
    }
    {
      *(u32x4*)(Vs + vrow * VS + vkc * 16) = rv;
      float cj, uj, cl;
      if (MODE == 0) { cj = (float)(vrow + 1) * lg; uj = 1.f; cl = 64.f * lg; } else { cj = pcj; uj = puj; cl = pclast; }
      const float wj = uj * __expf(cl - cj);
      u32x4 o;
      o.x = pack2(bf2f((u16)(rv.x & 0xffff)) * wj, bf2f((u16)(rv.x >> 16)) * wj);
      o.y = pack2(bf2f((u16)(rv.y & 0xffff)) * wj, bf2f((u16)(rv.y >> 16)) * wj);
      o.z = pack2(bf2f((u16)(rv.z & 0xffff)) * wj, bf2f((u16)(rv.z >> 16)) * wj);
      o.w = pack2(bf2f((u16)(rv.w & 0xffff)) * wj, bf2f((u16)(rv.w >> 16)) * wj);
      *(u32x4*)(Vts + vrow * VS + vkc * 16) = o;
    }
    if (tid < 64) {
      if (MODE == 0) { cumS[tid] = (float)(tid + 1) * lg; uS[tid] = 1.f; } else { cumS[tid] = pct; uS[tid] = put; }
    }
#pragma unroll
    for (int mf = 0; mf < MF; ++mf)
#pragma unroll
      for (int nf = 0; nf < 4; ++nf) {
        u32x2 o;
        o.x = pack2(S[mf][nf][0], S[mf][nf][1]);
        o.y = pack2(S[mf][nf][2], S[mf][nf][3]);
        *(u32x2*)(STs + (16 * nf + l15) * QS + (dw + 16 * mf + 4 * g) * 2) = o;
      }
    __syncthreads();
    if (c + 1 < 32) {
      const int r1 = r0 + 64;
#pragma unroll
      for (int i = 0; i < NQ; ++i) {
        int cc = tid + NTHR * i, rr = cc / CPR, kc = cc % CPR;
        rq[i] = *(const u32x4*)(src + (size_t)(r1 + rr) * sstride + qcol + kc * 8);
        rk[i] = *(const u32x4*)(src + (size_t)(r1 + rr) * sstride + kcol + kc * 8);
      }
      rv = *(const u32x4*)(src + (size_t)(r1 + vrow) * sstride + vcol + vkc * 8);
      if (MODE == 1) {
        pcj = cumv[(size_t)(r1 + vrow) * 32 + h]; puj = dtv[(size_t)(r1 + vrow) * 32 + h];
        pclast = cumv[(size_t)(r1 + 63) * 32 + h];
        pct = cumv[(size_t)(r1 + jt) * 32 + h]; put = dtv[(size_t)(r1 + jt) * 32 + h];
      }
    }
    u16 gz[2][4];
    {
      const u16* gsrc = (const u16*)(p.ws + OFF_PROJ);
      const int gcol = (MODE == 0) ? (4096 + h * 512 + s * 64) : (h * 64);
#pragma unroll
      for (int x = 0; x < 2; ++x)
#pragma unroll
        for (int r = 0; r < 4; ++r)
          gz[x][r] = gsrc[(size_t)(r0 + 16 * fi + 4 * g + r) * 6144 + gcol + 16 * (fe0 + x) + l15];
    }
    f32x4 sc[2], cr[2];
#pragma unroll
    for (int x = 0; x < 2; ++x) { sc[x] = (f32x4){0.f, 0.f, 0.f, 0.f}; cr[x] = (f32x4){0.f, 0.f, 0.f, 0.f}; }
#pragma unroll 2
    for (int ks = 0; ks < KS; ++ks) {
      const bf16x8 a = *(const bf16x8*)(Qs + (16 * fi + l15) * QS + ks * 64 + g * 16);
#pragma unroll
      for (int x = 0; x < 2; ++x) {
        const int fj = fe0 + x;
        if (fj <= fi) {
          const bf16x8 bk = *(const bf16x8*)(Ks + (16 * fj + l15) * QS + ks * 64 + g * 16);
          sc[x] = __builtin_amdgcn_mfma_f32_16x16x32_bf16(a, bk, sc[x], 0, 0, 0);
        }
        const bf16x8 bs = *(const bf16x8*)(STs + (16 * (fe0 + x) + l15) * QS + ks * 64 + g * 16);
        cr[x] = __builtin_amdgcn_mfma_f32_16x16x32_bf16(a, bs, cr[x], 0, 0, 0);
      }
    }
    float ci[4];
#pragma unroll
    for (int r = 0; r < 4; ++r) ci[r] = cumS[16 * fi + 4 * g + r];
#pragma unroll
    for (int x = 0; x < 2; ++x) {
      const int fj = fe0 + x;
      const int j = 16 * fj + l15;
      const float cj = cumS[j], uj = uS[j];
#pragma unroll
      for (int r = 0; r < 4; ++r) {
        const int i = 16 * fi + 4 * g + r;
        float v = 0.f;
        if (fj <= fi && j <= i) v = sc[x][r] * __expf(ci[r] - cj) * uj;
        *(u16*)(Ps + i * PS + j * 2) = f2bf(v);
      }
    }
    {
      const float atot = __expf(cumS[63]);
#pragma unroll
      for (int mf = 0; mf < MF; ++mf)
#pragma unroll
        for (int nf = 0; nf < 4; ++nf)
#pragma unroll
          for (int r = 0; r < 4; ++r) S[mf][nf][r] *= atot;
#pragma unroll
      for (int ks = 0; ks < 2; ++ks) {
        bf16x8 af[MF], bfv[4];
#pragma unroll
        for (int mf = 0; mf < MF; ++mf) af[mf] = trfrag(Ks, QS, 32 * ks, dw + 16 * mf, lane);
#pragma unroll
        for (int nf = 0; nf < 4; ++nf) bfv[nf] = trfrag(Vts, VS, 32 * ks, 16 * nf, lane);
#pragma unroll
        for (int mf = 0; mf < MF; ++mf)
#pragma unroll
          for (int nf = 0; nf < 4; ++nf)
            S[mf][nf] = __builtin_amdgcn_mfma_f32_16x16x32_bf16(af[mf], bfv[nf], S[mf][nf], 0, 0, 0);
      }
    }
    __syncthreads();
    f32x4 in[2];
#pragma unroll
    for (int x = 0; x < 2; ++x) in[x] = (f32x4){0.f, 0.f, 0.f, 0.f};
#pragma unroll
    for (int ks = 0; ks < 2; ++ks) {
      if (2 * ks <= fi) {
        const bf16x8 a = *(const bf16x8*)(Ps + (16 * fi + l15) * PS + ks * 64 + g * 16);
#pragma unroll
        for (int x = 0; x < 2; ++x) {
          const bf16x8 bv = trfrag(Vs, VS, 32 * ks, 16 * (fe0 + x), lane);
          in[x] = __builtin_amdgcn_mfma_f32_16x16x32_bf16(a, bv, in[x], 0, 0, 0);
        }
      }
    }
    {
      float ss[4] = {0.f, 0.f, 0.f, 0.f};
      u16* aout = (u16*)(p.ws + OFF_A2);
      float* parts = (float*)(p.ws + OFF_PARTS);
#pragma unroll
      for (int x = 0; x < 2; ++x) {
        const int e = 16 * (fe0 + x) + l15;
        float gn, dsk = 0.f;
        int ocol;
        if (MODE == 0) { gn = p.ret_head_norm[h * 512 + s * 64 + e]; ocol = h * 512 + s * 64 + e; }
        else { gn = p.ssm_gate_norm[h * 64 + e]; dsk = p.ssm_d[h]; ocol = h * 64 + e; }
#pragma unroll
        for (int r = 0; r < 4; ++r) {
          const int i = 16 * fi + 4 * g + r;
          float o = in[x][r] + cr[x][r] * __expf(ci[r]);
          const float gv = bf2f(gz[x][r]);
          float val;
          if (MODE == 0) {
            ss[r] += o * o;
            val = o * gn * silu(gv);
          } else {
            const float xs = bf2f(*(const u16*)(Vs + i * VS + e * 2));
            const float y = o + xs * dsk;
            const float gg = y * silu(gv);
            ss[r] += gg * gg;
            val = gg * gn;
          }
          aout[(size_t)(r0 + i) * 2048 + ocol] = f2bf(val);
        }
      }
#pragma unroll
      for (int r = 0; r < 4; ++r) {
        float v = ss[r];
        v += __shfl_xor(v, 1); v += __shfl_xor(v, 2); v += __shfl_xor(v, 4); v += __shfl_xor(v, 8);
        if (l15 == 0) {
          const int i = 16 * fi + 4 * g + r;
          const int slot = (MODE == 0) ? (h * 16 + s * 2 + (w & 1)) : ((h >> 2) * 8 + (h & 3) * 2 + (w & 1));
          parts[(size_t)(r0 + i) * 64 + slot] = v;
        }
      }
    }
    __syncthreads();
  }
  {
    float* so;
    int pitch;
    if (MODE == 0) { so = p.out + OUT_RETP + ((size_t)(b * 4 + h) * 256) * 512 + s * 64; pitch = 512; }
    else { so = p.out + OUT_SSMP + ((size_t)(b * 32 + h) * 128) * 64; pitch = 64; }
#pragma unroll
    for (int mf = 0; mf < MF; ++mf)
#pragma unroll
      for (int nf = 0; nf < 4; ++nf)
#pragma unroll
        for (int r = 0; r < 4; ++r)
          so[(size_t)(dw + 16 * mf + 4 * g + r) * pitch + 16 * nf + l15] = S[mf][nf][r];
  }
}

template <int DK, int MODE>
__device__ void rec_sample_item(const Params& p, const int item, unsigned char* smem) {
  float* qS = (float*)smem;
  float* kS = qS + 8 * DK;
  float* vS = kS + 8 * DK;
  float* scS = vS + 512;
  float* redS = scS + 64;
  const int tid = threadIdx.x, lane = tid & 63, w = tid >> 6;
  const int b = item >> 5;
  const int h = (MODE == 0) ? ((item >> 3) & 3) : (item & 31);
  const int s = (MODE == 0) ? (item & 7) : 0;
  const int row0 = NPROMPT + b * 8;
  const u16* src;
  int sstride, qcol, kcol, vcol;
  if (MODE == 0) {
    src = (const u16*)(p.ws + OFF_PROJ); sstride = 6144;
    qcol = h * 256; kcol = 1024 + h * 256; vcol = 2048 + h * 512 + s * 64;
  } else {
    src = (const u16*)(p.ws + OFF_XBCC); sstride = 4096;
    qcol = 3072 + (h >> 2) * 128; kcol = 2048 + (h >> 2) * 128; vcol = h * 64;
  }
  float cum[8], u[8];
  if (MODE == 0) {
    const float lg = logf(1.0f - exp2f(-5.0f - (float)h));
#pragma unroll
    for (int t = 0; t < 8; ++t) { cum[t] = (float)(t + 1) * lg; u[t] = 1.f; }
  } else {
    const float* dtv = (const float*)(p.ws + OFF_DT);
    const float* cumv = (const float*)(p.ws + OFF_CUM);
#pragma unroll
    for (int t = 0; t < 8; ++t) { cum[t] = cumv[(size_t)(row0 + t) * 32 + h]; u[t] = dtv[(size_t)(row0 + t) * 32 + h]; }
  }
  {
    constexpr int CPR = DK / 8;
    if (tid < 2 * DK) {
      const int which = tid / DK, c = tid % DK;
      const int t = c / CPR, kc = c % CPR;
      u32x4 uu = *(const u32x4*)(src + (size_t)(row0 + t) * sstride + (which ? kcol : qcol) + kc * 8);
      float* dst = (which ? kS : qS) + t * DK + kc * 8;
      dst[0] = bf2f((u16)(uu.x & 0xffff)); dst[1] = bf2f((u16)(uu.x >> 16));
      dst[2] = bf2f((u16)(uu.y & 0xffff)); dst[3] = bf2f((u16)(uu.y >> 16));
      dst[4] = bf2f((u16)(uu.z & 0xffff)); dst[5] = bf2f((u16)(uu.z >> 16));
      dst[6] = bf2f((u16)(uu.w & 0xffff)); dst[7] = bf2f((u16)(uu.w >> 16));
    }
    if (tid < 64) {
      const int t = tid >> 3, kc = tid & 7;
      u32x4 uu = *(const u32x4*)(src + (size_t)(row0 + t) * sstride + vcol + kc * 8);
      float* dst = vS + t * 64 + kc * 8;
      dst[0] = bf2f((u16)(uu.x & 0xffff)); dst[1] = bf2f((u16)(uu.x >> 16));
      dst[2] = bf2f((u16)(uu.y & 0xffff)); dst[3] = bf2f((u16)(uu.y >> 16));
      dst[4] = bf2f((u16)(uu.z & 0xffff)); dst[5] = bf2f((u16)(uu.z >> 16));
      dst[6] = bf2f((u16)(uu.w & 0xffff)); dst[7] = bf2f((u16)(uu.w >> 16));
    }
  }
  __syncthreads();
  {
    const int pair = tid >> 3, part = tid & 7;
    const int i = pair >> 3, j = pair & 7;
    float d = 0.f;
    const float* qp = qS + i * DK + part * (DK / 8);
    const float* kp = kS + j * DK + part * (DK / 8);
#pragma unroll 8
    for (int x = 0; x < DK / 8; ++x) d += qp[x] * kp[x];
    d += __shfl_xor(d, 1); d += __shfl_xor(d, 2); d += __shfl_xor(d, 4);
    if (part == 0) {
      float ci = 0.f, cj = 0.f, uj = 0.f;
#pragma unroll
      for (int t = 0; t < 8; ++t) { if (t == i) ci = cum[t]; if (t == j) { cj = cum[t]; uj = u[t]; } }
      scS[pair] = (j <= i) ? d * __expf(ci - cj) * uj : 0.f;
    }
  }
  const int dg = tid >> 4, eq = tid & 15;
  constexpr int RPT = DK / 32;
  const float* s0;
  float* s1;
  int pitch;
  if (MODE == 0) {
    const size_t base = ((size_t)(b * 4 + h) * 256) * 512 + s * 64;
    s0 = p.state_ret + base; s1 = p.out + OUT_RETS + base; pitch = 512;
  } else {
    const size_t base = ((size_t)(b * 32 + h) * 128) * 64;
    s0 = p.state_ssm + base; s1 = p.out + OUT_SSMS + base; pitch = 64;
  }
  float4 sv[RPT];
#pragma unroll
  for (int x = 0; x < RPT; ++x) sv[x] = *(const float4*)(s0 + (size_t)(dg * RPT + x) * pitch + eq * 4);
  float4 vw[8];
#pragma unroll
  for (int j = 0; j < 8; ++j) {
    float4 v = *(const float4*)(vS + j * 64 + eq * 4);
    const float wj = u[j] * __expf(cum[7] - cum[j]);
    vw[j] = make_float4(v.x * wj, v.y * wj, v.z * wj, v.w * wj);
  }
  const float atot = __expf(cum[7]);
  float4 cx[8];
#pragma unroll
  for (int i = 0; i < 8; ++i) cx[i] = make_float4(0.f, 0.f, 0.f, 0.f);
#pragma unroll
  for (int x = 0; x < RPT; ++x) {
    __builtin_amdgcn_sched_barrier(0);
    const int d = dg * RPT + x;
    const float4 so = sv[x];
    float4 sn = make_float4(so.x * atot, so.y * atot, so.z * atot, so.w * atot);
#pragma unroll
    for (int j = 0; j < 8; ++j) {
      const float kk = kS[j * DK + d];
      sn.x += kk * vw[j].x; sn.y += kk * vw[j].y; sn.z += kk * vw[j].z; sn.w += kk * vw[j].w;
    }
    *(float4*)(s1 + (size_t)d * pitch + eq * 4) = sn;
#pragma unroll
    for (int i = 0; i < 8; ++i) {
      const float qq = qS[i * DK + d];
      cx[i].x += qq * so.x; cx[i].y += qq * so.y; cx[i].z += qq * so.z; cx[i].w += qq * so.w;
    }
  }
#pragma unroll
  for (int i = 0; i < 8; ++i) {
    float4 v = cx[i];
    v.x += __shfl_xor(v.x, 16); v.y += __shfl_xor(v.y, 16); v.z += __shfl_xor(v.z, 16); v.w += __shfl_xor(v.w, 16);
    v.x += __shfl_xor(v.x, 32); v.y += __shfl_xor(v.y, 32); v.z += __shfl_xor(v.z, 32); v.w += __shfl_xor(v.w, 32);
    if ((lane >> 4) == 0) *(float4*)(redS + (w * 8 + i) * 64 + eq * 4) = v;
  }
  __syncthreads();
  {
    const int i = w, e = lane;
    float o = 0.f;
#pragma unroll
    for (int ww = 0; ww < 8; ++ww) o += redS[(ww * 8 + i) * 64 + e];
    float ci = 0.f;
#pragma unroll
    for (int t = 0; t < 8; ++t) if (t == i) ci = cum[t];
    o *= __expf(ci);
#pragma unroll
    for (int j = 0; j < 8; ++j) if (j <= i) o += scS[i * 8 + j] * vS[j * 64 + e];
    const int row = row0 + i;
    u16* aout = (u16*)(p.ws + OFF_A2);
    float* parts = (float*)(p.ws + OFF_PARTS);
    const u16* gsrc = (const u16*)(p.ws + OFF_PROJ);
    if (MODE == 0) {
      const float gv = bf2f(gsrc[(size_t)row * 6144 + 4096 + h * 512 + s * 64 + e]);
      const float ssq = wave_sum(o * o);
      const float val = o * p.ret_head_norm[h * 512 + s * 64 + e] * silu(gv);
      aout[(size_t)row * 2048 + h * 512 + s * 64 + e] = f2bf(val);
      if (lane < 2) parts[(size_t)row * 64 + h * 16 + s * 2 + lane] = lane == 0 ? ssq : 0.f;
    } else {
      const float zv = bf2f(gsrc[(size_t)row * 6144 + h * 64 + e]);
      const float y = o + vS[i * 64 + e] * p.ssm_d[h];
      const float gg = y * silu(zv);
      const float ssq = wave_sum(gg * gg);
      aout[(size_t)row * 2048 + h * 64 + e] = f2bf(gg * p.ssm_gate_norm[h * 64 + e]);
      if (lane < 2) parts[(size_t)row * 64 + (h >> 2) * 8 + (h & 3) * 2 + lane] = lane == 0 ? ssq : 0.f;
    }
  }
  __syncthreads();
}

template <int DK, int MODE>
__device__ void phase_rec(const Params& p, unsigned char* smem) {
  for (int item = blockIdx.x; item < 256; item += gridDim.x) rec_prompt_item<DK, MODE>(p, item, smem);
  for (int item = blockIdx.x; item < 4096; item += gridDim.x) rec_sample_item<DK, MODE>(p, item, smem);
}

#ifndef PHASE_MASK
#define PHASE_MASK 0x3ff
#endif
template <int PH>
__device__ __forceinline__ void run_phase(Params p, unsigned char* smem) {
  asm volatile("" : "+s"(p.ws), "+s"(p.out));
  if (PH == 0) phase_prep(p, smem);
  if (PH == 1)
    gemm_phase<0, 0>(p, (const u16*)(p.ws + OFF_H), (const u16*)(p.ws + OFF_WT0), 1024, 48, nullptr, nullptr, smem);
  if (PH == 2) phase_rec<256, 0>(p, smem);
  if (PH == 3)
    gemm_phase<1, 4>(p, (const u16*)(p.ws + OFF_A2), (const u16*)(p.ws + OFF_WT1), 2048, 8, nullptr,
                     (float*)(p.ws + OFF_X1), smem);
  if (PH == 4) phase_norm<0>(p, (const float*)(p.ws + OFF_X1), p.ssm_norm);
  if (PH == 5)
    gemm_phase<2, 0>(p, (const u16*)(p.ws + OFF_H), (const u16*)(p.ws + OFF_WT2), 1024, 49, nullptr, nullptr, smem);
  if (PH == 6) phase_conv(p);
  if (PH == 7) phase_rec<128, 1>(p, smem);
  if (PH == 8)
    gemm_phase<1, 8>(p, (const u16*)(p.ws + OFF_A2), (const u16*)(p.ws + OFF_WT3), 2048, 8,
                     (const float*)(p.ws + OFF_X1), (float*)(p.ws + OFF_X2), smem);
  if (PH == 9) phase_norm<1>(p, (const float*)(p.ws + OFF_X2), p.final_norm);
}

#define RUN_PHASE(k)                                   \
  if ((PHASE_MASK >> k) & 1) {                         \
    if (lo <= k && k <= hi) {                          \
      run_phase<k>(p, smem);                           \
      if (k < hi) grid.sync();                         \
    }                                                  \
  }

__global__ void __launch_bounds__(NTHR) fwd_megakernel(Params p) {
  __shared__ __attribute__((aligned(16))) unsigned char smem[LDS_BYTES];
  cg::grid_group grid = cg::this_grid();
  const int lo = (int)p.phase_lo, hi = (int)p.phase_hi;
  RUN_PHASE(0)
  RUN_PHASE(1)
  RUN_PHASE(2)
  RUN_PHASE(3)
  RUN_PHASE(4)
  RUN_PHASE(5)
  RUN_PHASE(6)
  RUN_PHASE(7)
  RUN_PHASE(8)
  RUN_PHASE(9)
}

#ifndef ONE_LAUNCH
#define ONE_LAUNCH 1
#endif

extern "C" void kernel_launch(void* const* d_in, const int* in_sizes, int n_in, void* d_out, int out_size, void* d_ws,
                              size_t ws_size, hipStream_t stream) {
  static int grid_blocks = 0;
  if (!grid_blocks) {
    int dev = 0, cus = 0, per_cu = 0;
    hipGetDevice(&dev);
    hipDeviceGetAttribute(&cus, hipDeviceAttributeMultiprocessorCount, dev);
    hipOccupancyMaxActiveBlocksPerMultiprocessor(&per_cu, fwd_megakernel, NTHR, 0);
    if (per_cu < 1) per_cu = 1;
    if (per_cu > 1) per_cu = 1;
    grid_blocks = cus * per_cu;
  }
  Params p{};
  const float** pf = (const float**)&p;
  for (int i = 0; i < 19; ++i) pf[i] = (const float*)d_in[i];
  p.out = (float*)d_out;
  p.ws = (unsigned char*)d_ws;
#if ONE_LAUNCH
  p.phase_lo = 0; p.phase_hi = 9;
  void* args[] = {&p};
  hipError_t e = hipLaunchCooperativeKernel((void*)fwd_megakernel, dim3(grid_blocks), dim3(NTHR), args, 0, stream);
  if (e != hipSuccess) fprintf(stderr, "cooperative launch failed: %s (grid %d)\n", hipGetErrorString(e), grid_blocks);
#else
  for (int ph = 0; ph <= 9; ++ph) {
    p.phase_lo = ph; p.phase_hi = ph;
    void* args[] = {&p};
    hipLaunchCooperativeKernel((void*)fwd_megakernel, dim3(grid_blocks), dim3(NTHR), args, 0, stream);
  }
#endif
}
```

```cpp
#include <hip/hip_runtime.h>
#include <hip/hip_cooperative_groups.h>
#include <stdint.h>
#include <stdio.h>
namespace cg = cooperative_groups;

typedef __attribute__((ext_vector_type(8))) short bf16x8;
typedef __attribute__((ext_vector_type(4))) short s16x4;
typedef __attribute__((ext_vector_type(4))) float f32x4;
typedef unsigned short u16;
typedef __attribute__((ext_vector_type(4))) unsigned int u32x4;
typedef __attribute__((ext_vector_type(2))) unsigned int u32x2;

#define NTHR 512
#define T_TOK 17408
#define NPROMPT 16384
#define LDS_BYTES 143360

constexpr size_t OFF_WT0 = 0;
constexpr size_t OFF_WT1 = OFF_WT0 + (size_t)6144 * 1024 * 2;
constexpr size_t OFF_WT2 = OFF_WT1 + (size_t)1024 * 2048 * 2;
constexpr size_t OFF_WT3 = OFF_WT2 + (size_t)6272 * 1024 * 2;
constexpr size_t OFF_ROPE = OFF_WT3 + (size_t)1024 * 2048 * 2;
constexpr size_t OFF_H = OFF_ROPE + (size_t)2056 * 128 * 8;
constexpr size_t OFF_PROJ = OFF_H + (size_t)T_TOK * 1024 * 2;
constexpr size_t OFF_A2 = OFF_PROJ + (size_t)T_TOK * 6144 * 2;
constexpr size_t OFF_PARTS = OFF_A2 + (size_t)T_TOK * 2048 * 2;
constexpr size_t OFF_X1 = OFF_PARTS + (size_t)T_TOK * 64 * 4;
constexpr size_t OFF_X2 = OFF_X1 + (size_t)T_TOK * 1024 * 4;
constexpr size_t OFF_XBCC = OFF_X2 + (size_t)T_TOK * 1024 * 4;
constexpr size_t OFF_DTRAW = OFF_XBCC + (size_t)T_TOK * 4096 * 2;
constexpr size_t OFF_DT = OFF_DTRAW + (size_t)T_TOK * 32 * 4;
constexpr size_t OFF_CUM = OFF_DT + (size_t)T_TOK * 32 * 4;
constexpr size_t OFF_BAR = OFF_CUM + (size_t)T_TOK * 32 * 4;

constexpr size_t OUT_Y = 0;
constexpr size_t OUT_RETP = 17825792;
constexpr size_t OUT_RETS = 22020096;
constexpr size_t OUT_SSMP = 89128960;
constexpr size_t OUT_SSMS = 91226112;
constexpr size_t OUT_CONVP = 124780544;
constexpr size_t OUT_CONVS = 124878848;

struct Params {
  const float *x_prompt, *x_sample, *state_ret, *state_ssm, *state_conv, *ret_norm, *ret_w_in, *ret_head_norm,
      *ret_w_out, *ssm_norm, *ssm_w_in, *ssm_conv_w, *ssm_conv_b, *ssm_dt_bias, *ssm_a_log, *ssm_d, *ssm_gate_norm,
      *ssm_w_out, *final_norm;
  float* out;
  unsigned char* ws;
  long long phase_lo, phase_hi, dup;
};

__device__ __forceinline__ u16 f2bf(float f) {
  uint32_t u = __float_as_uint(f);
  u += 0x7fffu + ((u >> 16) & 1u);
  return (u16)(u >> 16);
}
__device__ __forceinline__ float bf2f(u16 h) { return __uint_as_float(((uint32_t)h) << 16); }
__device__ __forceinline__ uint32_t pack2(float a, float b) { return (uint32_t)f2bf(a) | ((uint32_t)f2bf(b) << 16); }
__device__ __forceinline__ float silu(float x) { return x / (1.0f + __expf(-x)); }
__device__ __forceinline__ float wave_sum(float v) {
#pragma unroll
  for (int o = 32; o > 0; o >>= 1) v += __shfl_xor(v, o);
  return v;
}
__device__ __forceinline__ const float* xrow(const Params& p, int r) {
  return r < NPROMPT ? p.x_prompt + (size_t)r * 1024 : p.x_sample + (size_t)(r - NPROMPT) * 1024;
}
__device__ __forceinline__ s16x4 trread(const unsigned char* ptr) {
  return __builtin_amdgcn_ds_read_tr16_b64_v4i16((s16x4 __attribute__((address_space(3)))*)ptr);
}
__device__ __forceinline__ bf16x8 cat8(s16x4 a, s16x4 b) {
  bf16x8 r;
  r[0] = a[0]; r[1] = a[1]; r[2] = a[2]; r[3] = a[3];
  r[4] = b[0]; r[5] = b[1]; r[6] = b[2]; r[7] = b[3];
  return r;
}
__device__ __forceinline__ bf16x8 trfrag(const unsigned char* img, int rs, int kbase, int nbase, int lane) {
  const int g = lane >> 4, q = (lane & 15) >> 2, pp = lane & 3;
  const unsigned char* a = img + (kbase + 8 * g + q) * rs + (nbase + 4 * pp) * 2;
  s16x4 t0 = trread(a);
  s16x4 t1 = trread(a + 4 * rs);
  return cat8(t0, t1);
}

__device__ __forceinline__ int colmap_retin(int p) {
  if (p < 2048) {
    int hb = p & ~255, pp = p & 255;
    int gi = pp >> 5, half = (pp >> 4) & 1, c = pp & 15;
    return hb + half * 128 + gi * 16 + c;
  }
  return p;
}

__device__ void transpose_tile(const float* __restrict__ W, u16* __restrict__ Wt, int K, int N, int mode, int nt, int kt,
                               unsigned char* smem) {
  float* tile = (float*)smem;
  const int tid = threadIdx.x;
#pragma unroll
  for (int i = 0; i < 8; ++i) {
    int idx = tid + NTHR * i;
    int kk = idx >> 6, nn = idx & 63;
    int n = nt * 64 + nn;
    int src = (mode == 1) ? colmap_retin(n) : n;
    float v = 0.f;
    if (src < N) v = W[(size_t)(kt * 64 + kk) * N + src];
    tile[kk * 65 + nn] = v;
  }
  __syncthreads();
  {
    int n = tid >> 3, kc = tid & 7;
    float v[8];
#pragma unroll
    for (int j = 0; j < 8; ++j) v[j] = tile[(kc * 8 + j) * 65 + n];
    u32x4 o;
    o.x = pack2(v[0], v[1]); o.y = pack2(v[2], v[3]); o.z = pack2(v[4], v[5]); o.w = pack2(v[6], v[7]);
    *(u32x4*)(Wt + (size_t)(nt * 64 + n) * K + kt * 64 + kc * 8) = o;
  }
  __syncthreads();
}

__device__ void phase_prep(const Params& p, unsigned char* smem, const int rep) {
  const int tid = threadIdx.x;
  for (int rr = 0; rr < rep; ++rr) {
  u16* Wt0 = (u16*)(p.ws + OFF_WT0);
  u16* Wt1 = (u16*)(p.ws + OFF_WT1);
  u16* Wt2 = (u16*)(p.ws + OFF_WT2);
  u16* Wt3 = (u16*)(p.ws + OFF_WT3);
  const int n0 = 1536, n1 = 512, n2 = 1568, n3 = 512;
  for (int t = blockIdx.x; t < n0 + n1 + n2 + n3; t += gridDim.x) {
    if (t < n0) {
      transpose_tile(p.ret_w_in, Wt0, 1024, 6144, 1, t >> 4, t & 15, smem);
    } else if (t < n0 + n1) {
      int u = t - n0;
      transpose_tile(p.ret_w_out, Wt1, 2048, 1024, 0, u >> 5, u & 31, smem);
    } else if (t < n0 + n1 + n2) {
      int u = t - n0 - n1;
      transpose_tile(p.ssm_w_in, Wt2, 1024, 6176, 0, u >> 4, u & 15, smem);
    } else {
      int u = t - n0 - n1 - n2;
      transpose_tile(p.ssm_w_out, Wt3, 2048, 1024, 0, u >> 5, u & 31, smem);
    }
  }
  float2* rope = (float2*)(p.ws + OFF_ROPE);
  const int gtid = blockIdx.x * NTHR + tid, gn = gridDim.x * NTHR;
  for (int idx = gtid; idx < 2056 * 128; idx += gn) {
    int pi = idx >> 7, i = idx & 127;
    int pos = pi < 2048 ? pi : 16384 + (pi - 2048);
    float freq = (float)exp2(-(double)i * (13.287712379549449 / 128.0));
    float ang = (float)pos * freq;
    float sn, cs;
    sincosf(ang, &sn, &cs);
    rope[idx] = make_float2(cs, sn);
  }
  u16* H = (u16*)(p.ws + OFF_H);
  const int lane = tid & 63, w = tid >> 6;
  for (int row = blockIdx.x * 8 + w; row < T_TOK; row += gridDim.x * 8) {
    const float* xr = xrow(p, row);
    float4 v[4];
    float ss = 0.f;
#pragma unroll
    for (int i = 0; i < 4; ++i) {
      v[i] = *(const float4*)(xr + i * 256 + lane * 4);
      ss += v[i].x * v[i].x + v[i].y * v[i].y + v[i].z * v[i].z + v[i].w * v[i].w;
    }
    ss = wave_sum(ss);
    float rstd = rsqrtf(ss * (1.0f / 1024.0f) + 1e-6f);
#pragma unroll
    for (int i = 0; i < 4; ++i) {
      float4 gg = *(const float4*)(p.ret_norm + i * 256 + lane * 4);
      u32x2 o;
      o.x = pack2(v[i].x * rstd * gg.x, v[i].y * rstd * gg.y);
      o.y = pack2(v[i].z * rstd * gg.z, v[i].w * rstd * gg.w);
      *(u32x2*)(H + (size_t)row * 1024 + i * 256 + lane * 4) = o;
    }
  }
  }
}

template <int MODE>
__device__ void phase_norm(const Params& p, const float* __restrict__ X, const float* __restrict__ gain, const int rep) {
  const int tid = threadIdx.x, lane = tid & 63, w = tid >> 6;
  u16* H = (u16*)(p.ws + OFF_H);
  for (int row0 = blockIdx.x * 8 + w; row0 < T_TOK * rep; row0 += gridDim.x * 8) {
    const int row = row0 % T_TOK;
    const float* xr = X + (size_t)row * 1024;
    float4 v[4];
    float ss = 0.f;
#pragma unroll
    for (int i = 0; i < 4; ++i) {
      v[i] = *(const float4*)(xr + i * 256 + lane * 4);
      ss += v[i].x * v[i].x + v[i].y * v[i].y + v[i].z * v[i].z + v[i].w * v[i].w;
    }
    ss = wave_sum(ss);
    float rstd = rsqrtf(ss * (1.0f / 1024.0f) + 1e-6f);
#pragma unroll
    for (int i = 0; i < 4; ++i) {
      float4 gg = *(const float4*)(gain + i * 256 + lane * 4);
      if (MODE == 0) {
        u32x2 o;
        o.x = pack2(v[i].x * rstd * gg.x, v[i].y * rstd * gg.y);
        o.y = pack2(v[i].z * rstd * gg.z, v[i].w * rstd * gg.w);
        *(u32x2*)(H + (size_t)row * 1024 + i * 256 + lane * 4) = o;
      } else {
        float4 o = make_float4(v[i].x * rstd * gg.x, v[i].y * rstd * gg.y, v[i].z * rstd * gg.z, v[i].w * rstd * gg.w);
        *(float4*)(p.out + OUT_Y + (size_t)row * 1024 + i * 256 + lane * 4) = o;
      }
    }
  }
}

template <int EPI, int NH>
__device__ void gemm_phase(const Params& p, const u16* __restrict__ A, const u16* __restrict__ Bt, const int K, const int NT,
                           const float* __restrict__ resid, float* __restrict__ outf, unsigned char* smem, const int rep,
                           const int nt0 = 0, const bool rev = false) {
  constexpr int BM = 256, BN = 128, BK = 64, LR = 144;
  constexpr int BUFB = (BM + BN) * LR;
  float* rstdS = (float*)(smem + 2 * BUFB);
  const int tid = threadIdx.x, lane = tid & 63, w = tid >> 6;
  const int wm = w >> 1, wn = w & 1, l15 = lane & 15, g = lane >> 4;
  const int KT = K / BK;
  const int ntiles = (T_TOK / BM) * NT;
  const float* parts = (const float*)(p.ws + OFF_PARTS);
  const int srow = tid >> 3, skc = tid & 7;

  for (int tile0 = rev ? (int)(gridDim.x - 1 - blockIdx.x) : (int)blockIdx.x; tile0 < ntiles * rep; tile0 += gridDim.x) {
    const int tile = tile0 % ntiles;
    const int mt = tile / NT, nt = tile - mt * NT + nt0;
    const int m0 = mt * BM, n0 = nt * BN;
    if (NH > 0) {
      for (int idx = tid; idx < BM * NH; idx += NTHR) {
        int row = idx / NH, h = idx % NH;
        const float* pp = parts + (size_t)(m0 + row) * 64 + h * (64 / NH);
        float s = 0.f;
#pragma unroll
        for (int q = 0; q < 64 / NH; ++q) s += pp[q];
        rstdS[idx] = rsqrtf(s / (float)(K / NH) + 1e-6f);
      }
    }
    u32x4 ra[4], rb[2];
    const u16* ap = A + (size_t)(m0 + srow) * K + skc * 8;
    const u16* bp = Bt + (size_t)(n0 + srow) * K + skc * 8;
#pragma unroll
    for (int i = 0; i < 4; ++i) ra[i] = *(const u32x4*)(ap + (size_t)(64 * i) * K);
#pragma unroll
    for (int i = 0; i < 2; ++i) rb[i] = *(const u32x4*)(bp + (size_t)(64 * i) * K);
    {
      unsigned char* base = smem;
#pragma unroll
      for (int i = 0; i < 4; ++i) *(u32x4*)(base + (srow + 64 * i) * LR + skc * 16) = ra[i];
#pragma unroll
      for (int i = 0; i < 2; ++i) *(u32x4*)(base + BM * LR + (srow + 64 * i) * LR + skc * 16) = rb[i];
    }
    __syncthreads();

    f32x4 acc[4][4];
    f32x4 accT[4][4];
#pragma unroll
    for (int i = 0; i < 4; ++i)
#pragma unroll
      for (int j = 0; j < 4; ++j) {
        acc[i][j] = (f32x4){0.f, 0.f, 0.f, 0.f};
        accT[i][j] = (f32x4){0.f, 0.f, 0.f, 0.f};
      }

    for (int kt = 0; kt < KT; ++kt) {
      const bool more = (kt + 1 < KT);
      if (more) {
#pragma unroll
        for (int i = 0; i < 4; ++i) ra[i] = *(const u32x4*)(ap + (size_t)(64 * i) * K + (kt + 1) * BK);
#pragma unroll
        for (int i = 0; i < 2; ++i) rb[i] = *(const u32x4*)(bp + (size_t)(64 * i) * K + (kt + 1) * BK);
      }
      const unsigned char* abase = smem + (kt & 1) * BUFB + (wm * 64 + l15) * LR + g * 16;
      const unsigned char* bbase = smem + (kt & 1) * BUFB + BM * LR + (wn * 64 + l15) * LR + g * 16;
#pragma unroll
      for (int ks = 0; ks < 2; ++ks) {
        bf16x8 af[4], bfr[4];
#pragma unroll
        for (int mf = 0; mf < 4; ++mf) af[mf] = *(const bf16x8*)(abase + mf * 16 * LR + ks * 64);
#pragma unroll
        for (int nf = 0; nf < 4; ++nf) bfr[nf] = *(const bf16x8*)(bbase + nf * 16 * LR + ks * 64);
#pragma unroll
        for (int mf = 0; mf < 4; ++mf)
#pragma unroll
          for (int nf = 0; nf < 4; ++nf)
            acc[mf][nf] = __builtin_amdgcn_mfma_f32_16x16x32_bf16(af[mf], bfr[nf], acc[mf][nf], 0, 0, 0);
      }
      if (NH > 0) {
        const int per = KT / NH;
        if (((kt + 1) % per) == 0) {
          const int h = (kt + 1) / per - 1;
#pragma unroll
          for (int mf = 0; mf < 4; ++mf)
#pragma unroll
            for (int r = 0; r < 4; ++r) {
              float s = rstdS[(wm * 64 + mf * 16 + 4 * g + r) * NH + h];
#pragma unroll
              for (int nf = 0; nf < 4; ++nf) {
                accT[mf][nf][r] += s * acc[mf][nf][r];
                acc[mf][nf][r] = 0.f;
              }
            }
        }
      }
      if (more) {
        unsigned char* base = smem + ((kt + 1) & 1) * BUFB;
#pragma unroll
        for (int i = 0; i < 4; ++i) *(u32x4*)(base + (srow + 64 * i) * LR + skc * 16) = ra[i];
#pragma unroll
        for (int i = 0; i < 2; ++i) *(u32x4*)(base + BM * LR + (srow + 64 * i) * LR + skc * 16) = rb[i];
      }
      __syncthreads();
    }

#pragma unroll
    for (int mf = 0; mf < 4; ++mf) {
#pragma unroll
      for (int r = 0; r < 4; ++r) {
        __builtin_amdgcn_sched_barrier(0);
        const int row = m0 + wm * 64 + mf * 16 + 4 * g + r;
        if (EPI == 0) {
          u16* proj = (u16*)(p.ws + OFF_PROJ) + (size_t)row * 6144;
          if (n0 < 2048) {
            const float2* rope = (const float2*)(p.ws + OFF_ROPE);
            const int pi = row < NPROMPT ? (row & 2047) : 2048 + ((row - NPROMPT) & 7);
#pragma unroll
            for (int np = 0; np < 2; ++np) {
              const int pc = n0 + wn * 64 + np * 32;
              const int i = ((pc & 255) >> 5) * 16 + l15;
              const float2 cs = rope[pi * 128 + i];
              const float x1 = acc[mf][2 * np][r], x2 = acc[mf][2 * np + 1][r];
              float y1 = x1 * cs.x - x2 * cs.y, y2 = x1 * cs.y + x2 * cs.x;
              if (pc >= 1024) { y1 *= 0.0625f; y2 *= 0.0625f; }
              const int f1 = (pc & ~255) + i;
              proj[f1] = f2bf(y1);
              proj[f1 + 128] = f2bf(y2);
            }
          } else {
#pragma unroll
            for (int nf = 0; nf < 4; ++nf) proj[n0 + wn * 64 + nf * 16 + l15] = f2bf(acc[mf][nf][r]);
          }
        } else if (EPI == 1) {
#pragma unroll
          for (int nf = 0; nf < 4; ++nf) {
            const int col = n0 + wn * 64 + nf * 16 + l15;
            const float rv = resid ? resid[(size_t)row * 1024 + col] : xrow(p, row)[col];
            const float a = (NH > 0) ? accT[mf][nf][r] : acc[mf][nf][r];
            outf[(size_t)row * 1024 + col] = rv + a;
          }
        } else {
          u16* proj = (u16*)(p.ws + OFF_PROJ) + (size_t)row * 6144;
          float* dtraw = (float*)(p.ws + OFF_DTRAW) + (size_t)row * 32;
          float* cvo = nullptr;
          if (row < NPROMPT) {
            const int t = row & 2047;
            if (t >= 2045) cvo = p.out + OUT_CONVP + ((size_t)(row >> 11) * 3 + (t - 2045)) * 4096;
          } else {
            const int rs = row - NPROMPT, t = rs & 7;
            if (t >= 5) cvo = p.out + OUT_CONVS + ((size_t)(rs >> 3) * 3 + (t - 5)) * 4096;
          }
#pragma unroll
          for (int nf = 0; nf < 4; ++nf) {
            const int col = n0 + wn * 64 + nf * 16 + l15;
            const float a = acc[mf][nf][r];
            if (col < 6144) {
              proj[col] = f2bf(a);
              if (col >= 2048 && cvo) cvo[col - 2048] = a;
            } else if (col < 6176) {
              dtraw[col - 6144] = a;
            }
          }
        }
      }
    }
  }
}

__device__ __forceinline__ int lds_byte(int r, int c) {
  int st = (r >> 4) * 2 + (c >> 5), rr = r & 15, cc = c & 31, ob = rr * 64 + cc * 2;
  return st * 1024 + (ob ^ (((ob >> 9) & 1) << 5));
}
__device__ __forceinline__ void stage_rc(int b, int& R, int& C) {
  int st = b / 1024, sb = b % 1024, swz = sb ^ (((sb >> 9) & 1) << 5);
  R = (st >> 1) * 16 + swz / 64;
  C = (st & 1) * 32 + (swz % 64) / 2;
}

template <int EPI>
__device__ void gemm8_phase(const Params& p, const u16* __restrict__ A, const u16* __restrict__ Bt, const int K, const int nN,
                            unsigned char* smem, const int rep) {
  constexpr int BM8 = 256, BK8 = 64, HALF = 128, NXCD = 8, WGM = 8, HT = HALF * BK8;
  u16* shm = (u16*)smem;
#define SA(b, h) (shm + ((b) * 2 + (h)) * HT)
#define SB(b, h) (shm + (4 + (b) * 2 + (h)) * HT)
#define STAGE(P, BASE, br, kt)                                                                            \
  do {                                                                                                    \
    const int _so = ((br) * K + (kt) * BK8) * 2;                                                          \
    __builtin_amdgcn_raw_ptr_buffer_load_lds(rsrc_##BASE, (__attribute__((address_space(3))) unsigned*)((char*)(P) + threadIdx.x * 16), 16, voff0, _so, 0, 0); \
    __builtin_amdgcn_raw_ptr_buffer_load_lds(rsrc_##BASE, (__attribute__((address_space(3))) unsigned*)((char*)(P) + threadIdx.x * 16 + 8192), 16, voff1, _so, 0, 0); \
  } while (0)
#define LDA(dst, b, h)                                                                                    \
  for (int m = 0; m < 4; ++m)                                                                             \
    for (int k = 0; k < 2; ++k)                                                                           \
      dst[m][k] = *reinterpret_cast<const bf16x8*>((char*)SA(b, h) + lds_byte(wr * 64 + m * 16 + fr, k * 32 + fq * 8))
#define LDB(dst, b, h)                                                                                    \
  for (int n = 0; n < 2; ++n)                                                                             \
    for (int k = 0; k < 2; ++k)                                                                           \
      dst[n][k] = *reinterpret_cast<const bf16x8*>((char*)SB(b, h) + lds_byte(wc * 32 + n * 16 + fr, k * 32 + fq * 8))
#define MMA(ai, bj, At, Bx)                                                                               \
  do {                                                                                                    \
    __builtin_amdgcn_s_setprio(1);                                                                        \
    for (int m = 0; m < 4; ++m)                                                                           \
      for (int n = 0; n < 2; ++n)                                                                         \
        for (int k = 0; k < 2; ++k)                                                                       \
          acc[ai][bj][m][n] = __builtin_amdgcn_mfma_f32_16x16x32_bf16(At[m][k], Bx[n][k], acc[ai][bj][m][n], 0, 0, 0); \
    __builtin_amdgcn_s_setprio(0);                                                                        \
  } while (0)
#define WAIT_V(n) asm volatile("s_waitcnt vmcnt(" #n ")" ::: "memory")
#define WAIT_L(n) asm volatile("s_waitcnt lgkmcnt(" #n ")" ::: "memory")
#define BAR __builtin_amdgcn_s_barrier()
#define SCHED __builtin_amdgcn_sched_barrier(0)

  const int nM = T_TOK / BM8, nwg = nM * nN;
  const int wid = threadIdx.x >> 6, lane = threadIdx.x & 63, wr = wid >> 2, wc = wid & 3, fr = lane & 15, fq = lane >> 4;
  const int nt = K / BK8;
  const __amdgpu_buffer_rsrc_t rsrc_A = __builtin_amdgcn_make_buffer_rsrc((void*)A, (short)0, T_TOK * K * 2, 0x00020000);
  const __amdgpu_buffer_rsrc_t rsrc_Bt = __builtin_amdgcn_make_buffer_rsrc((void*)Bt, (short)0, nN * 256 * K * 2, 0x00020000);
  int voff0, voff1;
  {
    int r_, c_;
    stage_rc(threadIdx.x * 16, r_, c_);
    voff0 = (r_ * K + c_) * 2;
    stage_rc(threadIdx.x * 16 + 8192, r_, c_);
    voff1 = (r_ * K + c_) * 2;
  }

  for (int tile0 = blockIdx.x; tile0 < nwg * rep; tile0 += gridDim.x) {
    const int tile = tile0 % nwg;
    int wgid = tile;
    {
      int q = nwg / NXCD, r = nwg % NXCD, xcd = wgid % NXCD, off = wgid / NXCD;
      wgid = (xcd < r ? xcd * (q + 1) : r * (q + 1) + (xcd - r) * q) + off;
    }
    const int nig = WGM * nN, gid = wgid / nig, fm = gid * WGM, gsz = min(nM - fm, WGM);
    const int pm = fm + ((wgid % nig) % gsz), pn = (wgid % nig) / gsz, brow = pm * BM8, bcol = pn * BM8;

    f32x4 acc[2][2][4][2];
#pragma unroll
    for (int a = 0; a < 2; ++a)
#pragma unroll
      for (int b = 0; b < 2; ++b)
#pragma unroll
        for (int m = 0; m < 4; ++m)
#pragma unroll
          for (int n = 0; n < 2; ++n) acc[a][b][m][n] = (f32x4){0.f, 0.f, 0.f, 0.f};
    bf16x8 At[4][2], B0[2][2], B1[2][2];

    STAGE(SB(0, 0), Bt, bcol, 0); STAGE(SA(0, 0), A, brow, 0);
    STAGE(SB(0, 1), Bt, bcol + HALF, 0); STAGE(SA(0, 1), A, brow + HALF, 0);
    if (wr == 1) BAR;
    WAIT_V(4); BAR;
    STAGE(SB(1, 0), Bt, bcol, 1); STAGE(SA(1, 0), A, brow, 1); STAGE(SB(1, 1), Bt, bcol + HALF, 1);
    WAIT_V(6); BAR;
    for (int t = 0; t < nt - 2; t += 2) {
      LDB(B0, 0, 0); SCHED; LDA(At, 0, 0); STAGE(SA(1, 1), A, brow + HALF, t + 1);
      WAIT_L(8); BAR; WAIT_L(0); MMA(0, 0, At, B0); BAR; SCHED;
      LDB(B1, 0, 1); STAGE(SB(0, 0), Bt, bcol, t + 2);
      BAR; WAIT_L(0); MMA(0, 1, At, B1); BAR;
      LDA(At, 0, 1); STAGE(SA(0, 0), A, brow, t + 2);
      BAR; WAIT_L(0); MMA(1, 0, At, B0); BAR; SCHED;
      STAGE(SB(0, 1), Bt, bcol + HALF, t + 2);
      WAIT_V(6); BAR; MMA(1, 1, At, B1); BAR;
      LDB(B0, 1, 0); SCHED; LDA(At, 1, 0); STAGE(SA(0, 1), A, brow + HALF, t + 2);
      WAIT_L(8); BAR; WAIT_L(0); MMA(0, 0, At, B0); BAR; SCHED;
      LDB(B1, 1, 1); STAGE(SB(1, 0), Bt, bcol, t + 3);
      BAR; WAIT_L(0); MMA(0, 1, At, B1); BAR;
      LDA(At, 1, 1); STAGE(SA(1, 0), A, brow, t + 3);
      BAR; WAIT_L(0); MMA(1, 0, At, B0); BAR; SCHED;
      STAGE(SB(1, 1), Bt, bcol + HALF, t + 3);
      WAIT_V(6); BAR; MMA(1, 1, At, B1); BAR;
    }
    {
      LDB(B0, 0, 0); LDA(At, 0, 0); STAGE(SA(1, 1), A, brow + HALF, nt - 1);
      BAR; WAIT_L(0); MMA(0, 0, At, B0); BAR;
      LDB(B1, 0, 1); BAR; WAIT_L(0); MMA(0, 1, At, B1); BAR;
      LDA(At, 0, 1); WAIT_V(4); BAR; WAIT_L(0); MMA(1, 0, At, B0); MMA(1, 1, At, B1); BAR;
    }
    {
      LDB(B0, 1, 0); LDA(At, 1, 0); WAIT_V(2); BAR; WAIT_L(0); MMA(0, 0, At, B0); BAR;
      LDB(B1, 1, 1); WAIT_V(0); BAR; WAIT_L(0); MMA(0, 1, At, B1); BAR;
      LDA(At, 1, 1); BAR; WAIT_L(0); MMA(1, 0, At, B0); MMA(1, 1, At, B1); BAR;
    }
    if (wr == 0) BAR;

    u16* projb = (u16*)(p.ws + OFF_PROJ);
#pragma unroll
    for (int ai = 0; ai < 2; ++ai)
#pragma unroll
      for (int m = 0; m < 4; ++m)
#pragma unroll
        for (int j = 0; j < 4; ++j) {
          __builtin_amdgcn_sched_barrier(0);
          const int row = brow + ai * HALF + wr * 64 + m * 16 + fq * 4 + j;
          u16* proj = projb + (size_t)row * 6144;
          if (EPI == 0) {
            if (bcol < 2048) {
              const float2* rope = (const float2*)(p.ws + OFF_ROPE);
              const int pi = row < NPROMPT ? (row & 2047) : 2048 + ((row - NPROMPT) & 7);
#pragma unroll
              for (int bj = 0; bj < 2; ++bj) {
                const int pc = bcol + bj * HALF + wc * 32;
                const int i = ((pc & 255) >> 5) * 16 + fr;
                const float2 cs = rope[pi * 128 + i];
                const float x1 = acc[ai][bj][m][0][j], x2 = acc[ai][bj][m][1][j];
                float y1 = x1 * cs.x - x2 * cs.y, y2 = x1 * cs.y + x2 * cs.x;
                if (pc >= 1024) { y1 *= 0.0625f; y2 *= 0.0625f; }
                const int f1 = (pc & ~255) + i;
                proj[f1] = f2bf(y1);
                proj[f1 + 128] = f2bf(y2);
              }
            } else {
#pragma unroll
              for (int bj = 0; bj < 2; ++bj)
#pragma unroll
                for (int n = 0; n < 2; ++n) proj[bcol + bj * HALF + wc * 32 + n * 16 + fr] = f2bf(acc[ai][bj][m][n][j]);
            }
          } else {
            float* cvo = nullptr;
            if (bcol >= 2048) {
              if (row < NPROMPT) {
                const int t = row & 2047;
                if (t >= 2045) cvo = p.out + OUT_CONVP + ((size_t)(row >> 11) * 3 + (t - 2045)) * 4096;
              } else {
                const int rs = row - NPROMPT, t = rs & 7;
                if (t >= 5) cvo = p.out + OUT_CONVS + ((size_t)(rs >> 3) * 3 + (t - 5)) * 4096;
              }
            }
#pragma unroll
            for (int bj = 0; bj < 2; ++bj)
#pragma unroll
              for (int n = 0; n < 2; ++n) {
                const int col = bcol + bj * HALF + wc * 32 + n * 16 + fr;
                const float a = acc[ai][bj][m][n][j];
                proj[col] = f2bf(a);
                if (cvo) cvo[col - 2048] = a;
              }
          }
        }
  }
#undef SA
#undef SB
#undef STAGE
#undef LDA
#undef LDB
#undef MMA
#undef WAIT_V
#undef WAIT_L
#undef BAR
#undef SCHED
}

__device__ void phase_conv(const Params& p, const int rep) {
  const int gtid = blockIdx.x * NTHR + threadIdx.x, gn = gridDim.x * NTHR;
  const float* dtraw = (const float*)(p.ws + OFF_DTRAW);
  float* dtv = (float*)(p.ws + OFF_DT);
  float* cumv = (float*)(p.ws + OFF_CUM);
  for (int idx = gtid; idx < (256 + 128) * 32; idx += gn) {
    const int sc = idx >> 5, h = idx & 31;
    int row0, len;
    if (sc < 256) { row0 = sc * 64; len = 64; } else { row0 = NPROMPT + (sc - 256) * 8; len = 8; }
    const float a = -expf(p.ssm_a_log[h]);
    const float bias = p.ssm_dt_bias[h];
    float cum = 0.f;
    for (int t = 0; t < len; ++t) {
      float x = dtraw[(size_t)(row0 + t) * 32 + h] + bias;
      float dt = x > 20.f ? x : log1pf(expf(x));
      cum += dt * a;
      dtv[(size_t)(row0 + t) * 32 + h] = dt;
      cumv[(size_t)(row0 + t) * 32 + h] = cum;
    }
  }
  const u16* proj = (const u16*)(p.ws + OFF_PROJ);
  u16* xbcc = (u16*)(p.ws + OFF_XBCC);
  for (int idx0 = gtid; idx0 < T_TOK * 512 * rep; idx0 += gn) {
    const int idx = idx0 % (T_TOK * 512);
    const int row = idx >> 9, ch0 = (idx & 511) * 8;
    int t, b;
    const bool samp = row >= NPROMPT;
    if (!samp) { t = row & 2047; b = row >> 11; } else { t = (row - NPROMPT) & 7; b = (row - NPROMPT) >> 3; }
    float acc[8];
    {
      float4 b0 = *(const float4*)(p.ssm_conv_b + ch0), b1 = *(const float4*)(p.ssm_conv_b + ch0 + 4);
      acc[0] = b0.x; acc[1] = b0.y; acc[2] = b0.z; acc[3] = b0.w;
      acc[4] = b1.x; acc[5] = b1.y; acc[6] = b1.z; acc[7] = b1.w;
    }
#pragma unroll
    for (int wv = 0; wv < 4; ++wv) {
      const int tt = t - 3 + wv;
      float xv[8];
      if (tt >= 0) {
        u32x4 u = *(const u32x4*)(proj + (size_t)(row - 3 + wv) * 6144 + 2048 + ch0);
        xv[0] = bf2f((u16)(u.x & 0xffff)); xv[1] = bf2f((u16)(u.x >> 16));
        xv[2] = bf2f((u16)(u.y & 0xffff)); xv[3] = bf2f((u16)(u.y >> 16));
        xv[4] = bf2f((u16)(u.z & 0xffff)); xv[5] = bf2f((u16)(u.z >> 16));
        xv[6] = bf2f((u16)(u.w & 0xffff)); xv[7] = bf2f((u16)(u.w >> 16));
      } else if (samp) {
        const float* sp = p.state_conv + ((size_t)b * 3 + (tt + 3)) * 4096 + ch0;
        float4 s0 = *(const float4*)sp, s1 = *(const float4*)(sp + 4);
        xv[0] = s0.x; xv[1] = s0.y; xv[2] = s0.z; xv[3] = s0.w;
        xv[4] = s1.x; xv[5] = s1.y; xv[6] = s1.z; xv[7] = s1.w;
      } else {
#pragma unroll
        for (int j = 0; j < 8; ++j) xv[j] = 0.f;
      }
      float4 w0 = *(const float4*)(p.ssm_conv_w + (size_t)wv * 4096 + ch0);
      float4 w1 = *(const float4*)(p.ssm_conv_w + (size_t)wv * 4096 + ch0 + 4);
      acc[0] += xv[0] * w0.x; acc[1] += xv[1] * w0.y; acc[2] += xv[2] * w0.z; acc[3] += xv[3] * w0.w;
      acc[4] += xv[4] * w1.x; acc[5] += xv[5] * w1.y; acc[6] += xv[6] * w1.z; acc[7] += xv[7] * w1.w;
    }
    u32x4 o;
    o.x = pack2(silu(acc[0]), silu(acc[1]));
    o.y = pack2(silu(acc[2]), silu(acc[3]));
    o.z = pack2(silu(acc[4]), silu(acc[5]));
    o.w = pack2(silu(acc[6]), silu(acc[7]));
    *(u32x4*)(xbcc + (size_t)row * 4096 + ch0) = o;
  }
}

template <int DK, int MODE>
__device__ void rec_prompt_item(const Params& p, const int item, unsigned char* smem) {
  constexpr int QS = (DK + 16) * 2;
  constexpr int VS = 160, PS = 144;
  constexpr int MF = DK / 128;
  constexpr int KS = DK / 32;
  constexpr int NQ = DK / 64;
  constexpr int CPR = DK / 8;
  unsigned char* Qs = smem;
  unsigned char* Ks = Qs + 64 * QS;
  unsigned char* STs = Ks + 64 * QS;
  unsigned char* Vs = STs + 64 * QS;
  unsigned char* Vts = Vs + 64 * VS;
  unsigned char* Ps = Vts + 64 * VS;
  float* cumS = (float*)(Ps + 64 * PS);
  float* uS = cumS + 64;

  const int tid = threadIdx.x, lane = tid & 63, w = tid >> 6;
  const int l15 = lane & 15, g = lane >> 4;
  const int b = item >> 5;
  const int h = (MODE == 0) ? ((item >> 3) & 3) : (item & 31);
  const int s = (MODE == 0) ? (item & 7) : 0;
  const int row0 = b * 2048;

  const u16* src;
  int sstride, qcol, kcol, vcol;
  if (MODE == 0) {
    src = (const u16*)(p.ws + OFF_PROJ); sstride = 6144;
    qcol = h * 256; kcol = 1024 + h * 256; vcol = 2048 + h * 512 + s * 64;
  } else {
    src = (const u16*)(p.ws + OFF_XBCC); sstride = 4096;
    qcol = 3072 + (h >> 2) * 128; kcol = 2048 + (h >> 2) * 128; vcol = h * 64;
  }
  const float* dtv = (const float*)(p.ws + OFF_DT);
  const float* cumv = (const float*)(p.ws + OFF_CUM);
  const float lg = (MODE == 0) ? logf(1.0f - exp2f(-5.0f - (float)h)) : 0.f;

  const int vrow = tid >> 3, vkc = tid & 7;
  const int jt = tid & 63;

  u32x4 rq[NQ], rk[NQ], rv;
  float pcj = 0.f, puj = 1.f, pclast = 0.f, pct = 0.f, put = 1.f;

  f32x4 S[MF][4];
#pragma unroll
  for (int i = 0; i < MF; ++i)
#pragma unroll
    for (int j = 0; j < 4; ++j) S[i][j] = (f32x4){0.f, 0.f, 0.f, 0.f};

  {
    const int r0 = row0;
#pragma unroll
    for (int i = 0; i < NQ; ++i) {
      int c = tid + NTHR * i, rr = c / CPR, kc = c % CPR;
      rq[i] = *(const u32x4*)(src + (size_t)(r0 + rr) * sstride + qcol + kc * 8);
      rk[i] = *(const u32x4*)(src + (size_t)(r0 + rr) * sstride + kcol + kc * 8);
    }
    rv = *(const u32x4*)(src + (size_t)(r0 + vrow) * sstride + vcol + vkc * 8);
    if (MODE == 1) {
      pcj = cumv[(size_t)(r0 + vrow) * 32 + h]; puj = dtv[(size_t)(r0 + vrow) * 32 + h];
      pclast = cumv[(size_t)(r0 + 63) * 32 + h];
      pct = cumv[(size_t)(r0 + jt) * 32 + h]; put = dtv[(size_t)(r0 + jt) * 32 + h];
    }
  }

  const int fi = w >> 1, fe0 = 2 * (w & 1);
  const int dw = w * (DK / 8);

  for (int c = 0; c < 32; ++c) {
    const int r0 = row0 + c * 64;
#pragma unroll
    for (int i = 0; i < NQ; ++i) {
      int cc = tid + NTHR * i, rr = cc / CPR, kc = cc % CPR;
      *(u32x4*)(Qs + rr * QS + kc * 16) = rq[i];
      *(u32x4*)(Ks + rr * QS + kc * 16) = rk[i];
    }
    {
      *(u32x4*)(Vs + vrow * VS + vkc * 16) = rv;
      float cj, uj, cl;
      if (MODE == 0) { cj = (float)(vrow + 1) * lg; uj = 1.f; cl = 64.f * lg; } else { cj = pcj; uj = puj; cl = pclast; }
      const float wj = uj * __expf(cl - cj);
      u32x4 o;
      o.x = pack2(bf2f((u16)(rv.x & 0xffff)) * wj, bf2f((u16)(rv.x >> 16)) * wj);
      o.y = pack2(bf2f((u16)(rv.y & 0xffff)) * wj, bf2f((u16)(rv.y >> 16)) * wj);
      o.z = pack2(bf2f((u16)(rv.z & 0xffff)) * wj, bf2f((u16)(rv.z >> 16)) * wj);
      o.w = pack2(bf2f((u16)(rv.w & 0xffff)) * wj, bf2f((u16)(rv.w >> 16)) * wj);
      *(u32x4*)(Vts + vrow * VS + vkc * 16) = o;
    }
    if (tid < 64) {
      if (MODE == 0) { cumS[tid] = (float)(tid + 1) * lg; uS[tid] = 1.f; } else { cumS[tid] = pct; uS[tid] = put; }
    }
#pragma unroll
    for (int mf = 0; mf < MF; ++mf)
#pragma unroll
      for (int nf = 0; nf < 4; ++nf) {
        u32x2 o;
        o.x = pack2(S[mf][nf][0], S[mf][nf][1]);
        o.y = pack2(S[mf][nf][2], S[mf][nf][3]);
        *(u32x2*)(STs + (16 * nf + l15) * QS + (dw + 16 * mf + 4 * g) * 2) = o;
      }
    __syncthreads();
    if (c + 1 < 32) {
      const int r1 = r0 + 64;
#pragma unroll
      for (int i = 0; i < NQ; ++i) {
        int cc = tid + NTHR * i, rr = cc / CPR, kc = cc % CPR;
        rq[i] = *(const u32x4*)(src + (size_t)(r1 + rr) * sstride + qcol + kc * 8);
        rk[i] = *(const u32x4*)(src + (size_t)(r1 + rr) * sstride + kcol + kc * 8);
      }
      rv = *(const u32x4*)(src + (size_t)(r1 + vrow) * sstride + vcol + vkc * 8);
      if (MODE == 1) {
        pcj = cumv[(size_t)(r1 + vrow) * 32 + h]; puj = dtv[(size_t)(r1 + vrow) * 32 + h];
        pclast = cumv[(size_t)(r1 + 63) * 32 + h];
        pct = cumv[(size_t)(r1 + jt) * 32 + h]; put = dtv[(size_t)(r1 + jt) * 32 + h];
      }
    }
    u16 gz[2][4];
    {
      const u16* gsrc = (const u16*)(p.ws + OFF_PROJ);
      const int gcol = (MODE == 0) ? (4096 + h * 512 + s * 64) : (h * 64);
#pragma unroll
      for (int x = 0; x < 2; ++x)
#pragma unroll
        for (int r = 0; r < 4; ++r)
          gz[x][r] = gsrc[(size_t)(r0 + 16 * fi + 4 * g + r) * 6144 + gcol + 16 * (fe0 + x) + l15];
    }
    f32x4 sc[2], cr[2];
#pragma unroll
    for (int x = 0; x < 2; ++x) { sc[x] = (f32x4){0.f, 0.f, 0.f, 0.f}; cr[x] = (f32x4){0.f, 0.f, 0.f, 0.f}; }
#pragma unroll 2
    for (int ks = 0; ks < KS; ++ks) {
      const bf16x8 a = *(const bf16x8*)(Qs + (16 * fi + l15) * QS + ks * 64 + g * 16);
#pragma unroll
      for (int x = 0; x < 2; ++x) {
        const int fj = fe0 + x;
        if (fj <= fi) {
          const bf16x8 bk = *(const bf16x8*)(Ks + (16 * fj + l15) * QS + ks * 64 + g * 16);
          sc[x] = __builtin_amdgcn_mfma_f32_16x16x32_bf16(a, bk, sc[x], 0, 0, 0);
        }
        const bf16x8 bs = *(const bf16x8*)(STs + (16 * (fe0 + x) + l15) * QS + ks * 64 + g * 16);
        cr[x] = __builtin_amdgcn_mfma_f32_16x16x32_bf16(a, bs, cr[x], 0, 0, 0);
      }
    }
    float ci[4];
#pragma unroll
    for (int r = 0; r < 4; ++r) ci[r] = cumS[16 * fi + 4 * g + r];
#pragma unroll
    for (int x = 0; x < 2; ++x) {
      const int fj = fe0 + x;
      const int j = 16 * fj + l15;
      const float cj = cumS[j], uj = uS[j];
#pragma unroll
      for (int r = 0; r < 4; ++r) {
        const int i = 16 * fi + 4 * g + r;
        float v = 0.f;
        if (fj <= fi && j <= i) v = sc[x][r] * __expf(ci[r] - cj) * uj;
        *(u16*)(Ps + i * PS + j * 2) = f2bf(v);
      }
    }
    {
      const float atot = __expf(cumS[63]);
#pragma unroll
      for (int mf = 0; mf < MF; ++mf)
#pragma unroll
        for (int nf = 0; nf < 4; ++nf)
#pragma unroll
          for (int r = 0; r < 4; ++r) S[mf][nf][r] *= atot;
#pragma unroll
      for (int ks = 0; ks < 2; ++ks) {
        bf16x8 af[MF], bfv[4];
#pragma unroll
        for (int mf = 0; mf < MF; ++mf) af[mf] = trfrag(Ks, QS, 32 * ks, dw + 16 * mf, lane);
#pragma unroll
        for (int nf = 0; nf < 4; ++nf) bfv[nf] = trfrag(Vts, VS, 32 * ks, 16 * nf, lane);
#pragma unroll
        for (int mf = 0; mf < MF; ++mf)
#pragma unroll
          for (int nf = 0; nf < 4; ++nf)
            S[mf][nf] = __builtin_amdgcn_mfma_f32_16x16x32_bf16(af[mf], bfv[nf], S[mf][nf], 0, 0, 0);
      }
    }
    __syncthreads();
    f32x4 in[2];
#pragma unroll
    for (int x = 0; x < 2; ++x) in[x] = (f32x4){0.f, 0.f, 0.f, 0.f};
#pragma unroll
    for (int ks = 0; ks < 2; ++ks) {
      if (2 * ks <= fi) {
        const bf16x8 a = *(const bf16x8*)(Ps + (16 * fi + l15) * PS + ks * 64 + g * 16);
#pragma unroll
        for (int x = 0; x < 2; ++x) {
          const bf16x8 bv = trfrag(Vs, VS, 32 * ks, 16 * (fe0 + x), lane);
          in[x] = __builtin_amdgcn_mfma_f32_16x16x32_bf16(a, bv, in[x], 0, 0, 0);
        }
      }
    }
    {
      float ss[4] = {0.f, 0.f, 0.f, 0.f};
      u16* aout = (u16*)(p.ws + OFF_A2);
      float* parts = (float*)(p.ws + OFF_PARTS);
#pragma unroll
      for (int x = 0; x < 2; ++x) {
        const int e = 16 * (fe0 + x) + l15;
        float gn, dsk = 0.f;
        int ocol;
        if (MODE == 0) { gn = p.ret_head_norm[h * 512 + s * 64 + e]; ocol = h * 512 + s * 64 + e; }
        else { gn = p.ssm_gate_norm[h * 64 + e]; dsk = p.ssm_d[h]; ocol = h * 64 + e; }
#pragma unroll
        for (int r = 0; r < 4; ++r) {
          const int i = 16 * fi + 4 * g + r;
          float o = in[x][r] + cr[x][r] * __expf(ci[r]);
          const float gv = bf2f(gz[x][r]);
          float val;
          if (MODE == 0) {
            ss[r] += o * o;
            val = o * gn * silu(gv);
          } else {
            const float xs = bf2f(*(const u16*)(Vs + i * VS + e * 2));
            const float y = o + xs * dsk;
            const float gg = y * silu(gv);
            ss[r] += gg * gg;
            val = gg * gn;
          }
          aout[(size_t)(r0 + i) * 2048 + ocol] = f2bf(val);
        }
      }
#pragma unroll
      for (int r = 0; r < 4; ++r) {
        float v = ss[r];
        v += __shfl_xor(v, 1); v += __shfl_xor(v, 2); v += __shfl_xor(v, 4); v += __shfl_xor(v, 8);
        if (l15 == 0) {
          const int i = 16 * fi + 4 * g + r;
          const int slot = (MODE == 0) ? (h * 16 + s * 2 + (w & 1)) : ((h >> 2) * 8 + (h & 3) * 2 + (w & 1));
          parts[(size_t)(r0 + i) * 64 + slot] = v;
        }
      }
    }
    __syncthreads();
  }
  {
    float* so;
    int pitch;
    if (MODE == 0) { so = p.out + OUT_RETP + ((size_t)(b * 4 + h) * 256) * 512 + s * 64; pitch = 512; }
    else { so = p.out + OUT_SSMP + ((size_t)(b * 32 + h) * 128) * 64; pitch = 64; }
#pragma unroll
    for (int mf = 0; mf < MF; ++mf)
#pragma unroll
      for (int nf = 0; nf < 4; ++nf)
#pragma unroll
        for (int r = 0; r < 4; ++r)
          so[(size_t)(dw + 16 * mf + 4 * g + r) * pitch + 16 * nf + l15] = S[mf][nf][r];
  }
}

template <int DK, int MODE>
__device__ void rec_sample_item(const Params& p, const int item, unsigned char* smem) {
  float* qS = (float*)smem;
  float* kS = qS + 8 * DK;
  float* vS = kS + 8 * DK;
  float* scS = vS + 512;
  float* redS = scS + 64;
  const int tid = threadIdx.x, lane = tid & 63, w = tid >> 6;
  const int b = item >> 5;
  const int h = (MODE == 0) ? ((item >> 3) & 3) : (item & 31);
  const int s = (MODE == 0) ? (item & 7) : 0;
  const int row0 = NPROMPT + b * 8;
  const u16* src;
  int sstride, qcol, kcol, vcol;
  if (MODE == 0) {
    src = (const u16*)(p.ws + OFF_PROJ); sstride = 6144;
    qcol = h * 256; kcol = 1024 + h * 256; vcol = 2048 + h * 512 + s * 64;
  } else {
    src = (const u16*)(p.ws + OFF_XBCC); sstride = 4096;
    qcol = 3072 + (h >> 2) * 128; kcol = 2048 + (h >> 2) * 128; vcol = h * 64;
  }
  float cum[8], u[8];
  if (MODE == 0) {
    const float lg = logf(1.0f - exp2f(-5.0f - (float)h));
#pragma unroll
    for (int t = 0; t < 8; ++t) { cum[t] = (float)(t + 1) * lg; u[t] = 1.f; }
  } else {
    const float* dtv = (const float*)(p.ws + OFF_DT);
    const float* cumv = (const float*)(p.ws + OFF_CUM);
#pragma unroll
    for (int t = 0; t < 8; ++t) { cum[t] = cumv[(size_t)(row0 + t) * 32 + h]; u[t] = dtv[(size_t)(row0 + t) * 32 + h]; }
  }
  {
    constexpr int CPR = DK / 8;
    if (tid < 2 * DK) {
      const int which = tid / DK, c = tid % DK;
      const int t = c / CPR, kc = c % CPR;
      u32x4 uu = *(const u32x4*)(src + (size_t)(row0 + t) * sstride + (which ? kcol : qcol) + kc * 8);
      float* dst = (which ? kS : qS) + t * DK + kc * 8;
      dst[0] = bf2f((u16)(uu.x & 0xffff)); dst[1] = bf2f((u16)(uu.x >> 16));
      dst[2] = bf2f((u16)(uu.y & 0xffff)); dst[3] = bf2f((u16)(uu.y >> 16));
      dst[4] = bf2f((u16)(uu.z & 0xffff)); dst[5] = bf2f((u16)(uu.z >> 16));
      dst[6] = bf2f((u16)(uu.w & 0xffff)); dst[7] = bf2f((u16)(uu.w >> 16));
    }
    if (tid < 64) {
      const int t = tid >> 3, kc = tid & 7;
      u32x4 uu = *(const u32x4*)(src + (size_t)(row0 + t) * sstride + vcol + kc * 8);
      float* dst = vS + t * 64 + kc * 8;
      dst[0] = bf2f((u16)(uu.x & 0xffff)); dst[1] = bf2f((u16)(uu.x >> 16));
      dst[2] = bf2f((u16)(uu.y & 0xffff)); dst[3] = bf2f((u16)(uu.y >> 16));
      dst[4] = bf2f((u16)(uu.z & 0xffff)); dst[5] = bf2f((u16)(uu.z >> 16));
      dst[6] = bf2f((u16)(uu.w & 0xffff)); dst[7] = bf2f((u16)(uu.w >> 16));
    }
  }
  __syncthreads();
  {
    const int pair = tid >> 3, part = tid & 7;
    const int i = pair >> 3, j = pair & 7;
    float d = 0.f;
    const float* qp = qS + i * DK + part * (DK / 8);
    const float* kp = kS + j * DK + part * (DK / 8);
#pragma unroll 8
    for (int x = 0; x < DK / 8; ++x) d += qp[x] * kp[x];
    d += __shfl_xor(d, 1); d += __shfl_xor(d, 2); d += __shfl_xor(d, 4);
    if (part == 0) {
      float ci = 0.f, cj = 0.f, uj = 0.f;
#pragma unroll
      for (int t = 0; t < 8; ++t) { if (t == i) ci = cum[t]; if (t == j) { cj = cum[t]; uj = u[t]; } }
      scS[pair] = (j <= i) ? d * __expf(ci - cj) * uj : 0.f;
    }
  }
  const int dg = tid >> 4, eq = tid & 15;
  constexpr int RPT = DK / 32;
  const float* s0;
  float* s1;
  int pitch;
  if (MODE == 0) {
    const size_t base = ((size_t)(b * 4 + h) * 256) * 512 + s * 64;
    s0 = p.state_ret + base; s1 = p.out + OUT_RETS + base; pitch = 512;
  } else {
    const size_t base = ((size_t)(b * 32 + h) * 128) * 64;
    s0 = p.state_ssm + base; s1 = p.out + OUT_SSMS + base; pitch = 64;
  }
  float4 sv[RPT];
#pragma unroll
  for (int x = 0; x < RPT; ++x) sv[x] = *(const float4*)(s0 + (size_t)(dg * RPT + x) * pitch + eq * 4);
  float4 vw[8];
#pragma unroll
  for (int j = 0; j < 8; ++j) {
    float4 v = *(const float4*)(vS + j * 64 + eq * 4);
    const float wj = u[j] * __expf(cum[7] - cum[j]);
    vw[j] = make_float4(v.x * wj, v.y * wj, v.z * wj, v.w * wj);
  }
  const float atot = __expf(cum[7]);
  float4 cx[8];
#pragma unroll
  for (int i = 0; i < 8; ++i) cx[i] = make_float4(0.f, 0.f, 0.f, 0.f);
#pragma unroll
  for (int x = 0; x < RPT; ++x) {
    __builtin_amdgcn_sched_barrier(0);
    const int d = dg * RPT + x;
    const float4 so = sv[x];
    float4 sn = make_float4(so.x * atot, so.y * atot, so.z * atot, so.w * atot);
#pragma unroll
    for (int j = 0; j < 8; ++j) {
      const float kk = kS[j * DK + d];
      sn.x += kk * vw[j].x; sn.y += kk * vw[j].y; sn.z += kk * vw[j].z; sn.w += kk * vw[j].w;
    }
    *(float4*)(s1 + (size_t)d * pitch + eq * 4) = sn;
#pragma unroll
    for (int i = 0; i < 8; ++i) {
      const float qq = qS[i * DK + d];
      cx[i].x += qq * so.x; cx[i].y += qq * so.y; cx[i].z += qq * so.z; cx[i].w += qq * so.w;
    }
  }
#pragma unroll
  for (int i = 0; i < 8; ++i) {
    float4 v = cx[i];
    v.x += __shfl_xor(v.x, 16); v.y += __shfl_xor(v.y, 16); v.z += __shfl_xor(v.z, 16); v.w += __shfl_xor(v.w, 16);
    v.x += __shfl_xor(v.x, 32); v.y += __shfl_xor(v.y, 32); v.z += __shfl_xor(v.z, 32); v.w += __shfl_xor(v.w, 32);
    if ((lane >> 4) == 0) *(float4*)(redS + (w * 8 + i) * 64 + eq * 4) = v;
  }
  __syncthreads();
  {
    const int i = w, e = lane;
    float o = 0.f;
#pragma unroll
    for (int ww = 0; ww < 8; ++ww) o += redS[(ww * 8 + i) * 64 + e];
    float ci = 0.f;
#pragma unroll
    for (int t = 0; t < 8; ++t) if (t == i) ci = cum[t];
    o *= __expf(ci);
#pragma unroll
    for (int j = 0; j < 8; ++j) if (j <= i) o += scS[i * 8 + j] * vS[j * 64 + e];
    const int row = row0 + i;
    u16* aout = (u16*)(p.ws + OFF_A2);
    float* parts = (float*)(p.ws + OFF_PARTS);
    const u16* gsrc = (const u16*)(p.ws + OFF_PROJ);
    if (MODE == 0) {
      const float gv = bf2f(gsrc[(size_t)row * 6144 + 4096 + h * 512 + s * 64 + e]);
      const float ssq = wave_sum(o * o);
      const float val = o * p.ret_head_norm[h * 512 + s * 64 + e] * silu(gv);
      aout[(size_t)row * 2048 + h * 512 + s * 64 + e] = f2bf(val);
      if (lane < 2) parts[(size_t)row * 64 + h * 16 + s * 2 + lane] = lane == 0 ? ssq : 0.f;
    } else {
      const float zv = bf2f(gsrc[(size_t)row * 6144 + h * 64 + e]);
      const float y = o + vS[i * 64 + e] * p.ssm_d[h];
      const float gg = y * silu(zv);
      const float ssq = wave_sum(gg * gg);
      aout[(size_t)row * 2048 + h * 64 + e] = f2bf(gg * p.ssm_gate_norm[h * 64 + e]);
      if (lane < 2) parts[(size_t)row * 64 + (h >> 2) * 8 + (h & 3) * 2 + lane] = lane == 0 ? ssq : 0.f;
    }
  }
  __syncthreads();
}

template <int DK, int MODE>
__device__ void phase_rec(const Params& p, unsigned char* smem, const int rep_p, const int rep_s) {
  for (int item = blockIdx.x; item < 256 * rep_p; item += gridDim.x) rec_prompt_item<DK, MODE>(p, item & 255, smem);
  for (int item = blockIdx.x; item < 4096 * rep_s; item += gridDim.x) rec_sample_item<DK, MODE>(p, item & 4095, smem);
}

#ifndef PHASE_MASK
#define PHASE_MASK 0x3ff
#endif
#ifndef DUP_MASK
#define DUP_MASK 0x000
#endif
#define XB_TMO      128
#define XB_XCNT(j)  (256  + 64 * (j))
#define XB_XSUB(j)  (1280 + 64 * (j))
#define XB_XGEN(j)  (2304 + 64 * (j))
#define XB_TOP      3328
#define XB_TOPGEN   3392
#define XCD_BAR_WORDS 3456
#define XB_SPIN_CAP (1u << 20)
#define LAS __attribute__((address_space(3)))
__device__ __forceinline__ unsigned xb_ld(unsigned* p) { return __hip_atomic_load(p, __ATOMIC_RELAXED, __HIP_MEMORY_SCOPE_AGENT); }
__device__ __forceinline__ unsigned xb_add(unsigned* p, unsigned v) { return __hip_atomic_fetch_add(p, v, __ATOMIC_RELAXED, __HIP_MEMORY_SCOPE_AGENT); }
__device__ __forceinline__ unsigned xb_xcc_id() { return (unsigned)__builtin_amdgcn_s_getreg((3 << 11) | 20) & 0xFu; }
#define XB_SPIN(cond, bar) do { unsigned _sp = 0; while (cond) { __builtin_amdgcn_s_sleep(1); \
    if ((++_sp & 255u) == 0u) { if (xb_ld(&(bar)[XB_TMO])) break; if (_sp > XB_SPIN_CAP) { atomicAdd(&(bar)[XB_TMO], 1u); break; } } } } while (0)
struct XcdBarrier {
  unsigned* bar; unsigned x;
  volatile LAS unsigned* st;
};
__device__ __forceinline__ XcdBarrier xcd_barrier_post(unsigned* bar, volatile LAS unsigned* st) {
  XcdBarrier b; b.bar = bar; b.x = xb_xcc_id(); b.st = st;
  if (threadIdx.x == 0) (void)xb_add(&bar[XB_XCNT(b.x)], 1u);
  return b;
}
__device__ __forceinline__ void xcd_barrier_complete(unsigned* bar, unsigned x, unsigned& nloc, unsigned& nx) {
  const unsigned G = gridDim.x * gridDim.y * gridDim.z;
  unsigned sum, cnt, mine, sp = 0u;
  for (;;) {
    sum = 0u; cnt = 0u; mine = 0u;
#pragma unroll
    for (unsigned j = 0; j < 16; ++j) { const unsigned c = xb_ld(&bar[XB_XCNT(j)]); sum += c; cnt += (c > 0u) ? 1u : 0u; mine = (j == x) ? c : mine; }
    if (sum == G) break;
    __builtin_amdgcn_s_sleep(1);
    if ((++sp & 255u) == 0u) { if (xb_ld(&bar[XB_TMO])) break; if (sp > XB_SPIN_CAP) { atomicAdd(&bar[XB_TMO], 1u); break; } }
  }
  nloc = mine > 0u ? mine : 1u; nx = cnt > 0u ? cnt : 1u;
}
__device__ __forceinline__ void xcd_barrier(const XcdBarrier& b) {
  asm volatile("s_waitcnt vmcnt(0)" ::: "memory");
  __syncthreads();
  if (threadIdx.x == 0) {
    unsigned* bar = b.bar;
    __builtin_amdgcn_s_waitcnt(0);
    unsigned nloc = b.st[0], nx = b.st[1];
    if (nloc == 0u) { xcd_barrier_complete(bar, b.x, nloc, nx); b.st[0] = nloc; b.st[1] = nx; }
    const unsigned old = xb_add(&bar[XB_XSUB(b.x)], 1u);
    const unsigned gen = old / nloc;
    if (old + 1u == (gen + 1u) * nloc) {
      __builtin_amdgcn_fence(__ATOMIC_RELEASE, "agent");
      asm volatile("s_waitcnt vmcnt(0)" ::: "memory");
      const unsigned og = xb_add(&bar[XB_TOP], 1u);
      const unsigned tg = og / nx;
      if (og + 1u == (tg + 1u) * nx) xb_add(&bar[XB_TOPGEN], 1u);
      else XB_SPIN(xb_ld(&bar[XB_TOPGEN]) == tg, bar);
      __builtin_amdgcn_fence(__ATOMIC_ACQUIRE, "agent");
      xb_add(&bar[XB_XGEN(b.x)], 1u);
      asm volatile("s_waitcnt vmcnt(0)" ::: "memory");
    } else {
      XB_SPIN(xb_ld(&bar[XB_XGEN(b.x)]) == gen, bar);
      __builtin_amdgcn_fence(__ATOMIC_ACQUIRE, "agent");
      asm volatile("s_waitcnt vmcnt(0)" ::: "memory");
    }
  }
  __syncthreads();
}

template <int PH>
__device__ __forceinline__ void run_phase(Params p, unsigned char* smem) {
  asm volatile("" : "+s"(p.ws), "+s"(p.out));
  const int rep = 1 + (int)((p.dup >> PH) & 1);
  if (PH == 0) phase_prep(p, smem, rep);
  if (PH == 1) gemm8_phase<0>(p, (const u16*)(p.ws + OFF_H), (const u16*)(p.ws + OFF_WT0), 1024, 24, smem, rep);
  if (PH == 2) phase_rec<256, 0>(p, smem, rep, 1 + (int)((p.dup >> (PH + 16)) & 1));
  if (PH == 3)
    gemm_phase<1, 4>(p, (const u16*)(p.ws + OFF_A2), (const u16*)(p.ws + OFF_WT1), 2048, 8, nullptr,
                     (float*)(p.ws + OFF_X1), smem, rep);
  if (PH == 4) phase_norm<0>(p, (const float*)(p.ws + OFF_X1), p.ssm_norm, rep);
  if (PH == 5) {
    gemm8_phase<2>(p, (const u16*)(p.ws + OFF_H), (const u16*)(p.ws + OFF_WT2), 1024, 24, smem, rep);
    __syncthreads();
    gemm_phase<2, 0>(p, (const u16*)(p.ws + OFF_H), (const u16*)(p.ws + OFF_WT2), 1024, 1, nullptr, nullptr, smem, 1, 48, true);
  }
  if (PH == 6) phase_conv(p, rep);
  if (PH == 7) phase_rec<128, 1>(p, smem, rep, 1 + (int)((p.dup >> (PH + 16)) & 1));
  if (PH == 8)
    gemm_phase<1, 8>(p, (const u16*)(p.ws + OFF_A2), (const u16*)(p.ws + OFF_WT3), 2048, 8,
                     (const float*)(p.ws + OFF_X1), (float*)(p.ws + OFF_X2), smem, rep);
  if (PH == 9) phase_norm<1>(p, (const float*)(p.ws + OFF_X2), p.final_norm, rep);
}

#define RUN_PHASE(k)                                   \
  if ((PHASE_MASK >> k) & 1) {                         \
    if (lo <= k && k <= hi) {                          \
      run_phase<k>(p, smem);                           \
      if (k < hi) xcd_barrier(xb);                     \
    }                                                  \
  }

__global__ void __launch_bounds__(NTHR) fwd_megakernel(Params p) {
  __shared__ __attribute__((aligned(16))) unsigned char smem[LDS_BYTES];
  cg::grid_group grid = cg::this_grid();
  const int lo = (int)p.phase_lo, hi = (int)p.phase_hi;
  if (lo > 1000) grid.sync();
  volatile LAS unsigned* xst = (volatile LAS unsigned*)(smem + LDS_BYTES - 16);
  if (threadIdx.x == 0) { xst[0] = 0u; xst[1] = 0u; }
  __syncthreads();
  const XcdBarrier xb = xcd_barrier_post((unsigned*)(p.ws + OFF_BAR), xst);
  RUN_PHASE(0)
  RUN_PHASE(1)
  RUN_PHASE(2)
  RUN_PHASE(3)
  RUN_PHASE(4)
  RUN_PHASE(5)
  RUN_PHASE(6)
  RUN_PHASE(7)
  RUN_PHASE(8)
  RUN_PHASE(9)
}

#ifndef ONE_LAUNCH
#define ONE_LAUNCH 1
#endif

extern "C" void kernel_launch(void* const* d_in, const int* in_sizes, int n_in, void* d_out, int out_size, void* d_ws,
                              size_t ws_size, hipStream_t stream) {
  static int grid_blocks = 0;
  if (!grid_blocks) {
    int dev = 0, cus = 0, per_cu = 0;
    hipGetDevice(&dev);
    hipDeviceGetAttribute(&cus, hipDeviceAttributeMultiprocessorCount, dev);
    hipOccupancyMaxActiveBlocksPerMultiprocessor(&per_cu, fwd_megakernel, NTHR, 0);
    if (per_cu < 1) per_cu = 1;
    if (per_cu > 1) per_cu = 1;
    grid_blocks = cus * per_cu;
  }
  Params p{};
  const float** pf = (const float**)&p;
  for (int i = 0; i < 19; ++i) pf[i] = (const float*)d_in[i];
  p.out = (float*)d_out;
  p.ws = (unsigned char*)d_ws;
#if ONE_LAUNCH
  hipMemsetAsync((unsigned char*)d_ws + OFF_BAR, 0, XCD_BAR_WORDS * 4, stream);
  p.phase_lo = 0; p.phase_hi = 9; p.dup = DUP_MASK;
  void* args[] = {&p};
  hipError_t e = hipLaunchCooperativeKernel((void*)fwd_megakernel, dim3(grid_blocks), dim3(NTHR), args, 0, stream);
  if (e != hipSuccess) fprintf(stderr, "cooperative launch failed: %s (grid %d)\n", hipGetErrorString(e), grid_blocks);
#else
  for (int ph = 0; ph <= 9; ++ph) {
    p.phase_lo = ph; p.phase_hi = ph;
    void* args[] = {&p};
    hipLaunchCooperativeKernel((void*)fwd_megakernel, dim3(grid_blocks), dim3(NTHR), args, 0, stream);
  }
#endif
}
```

```cpp
#include <hip/hip_runtime.h>
#include <hip/hip_cooperative_groups.h>
#include <stdint.h>
#include <stdio.h>
namespace cg = cooperative_groups;

typedef __attribute__((ext_vector_type(8))) short bf16x8;
typedef __attribute__((ext_vector_type(4))) short s16x4;
typedef __attribute__((ext_vector_type(4))) float f32x4;
typedef unsigned short u16;
typedef __attribute__((ext_vector_type(4))) unsigned int u32x4;
typedef __attribute__((ext_vector_type(2))) unsigned int u32x2;

#define NTHR 512
#define T_TOK 17408
#define NPROMPT 16384
#define LDS_BYTES 143360

constexpr size_t OFF_WT0 = 0;
constexpr size_t OFF_WT1 = OFF_WT0 + (size_t)6144 * 1024 * 2;
constexpr size_t OFF_WT2 = OFF_WT1 + (size_t)1024 * 2048 * 2;
constexpr size_t OFF_WT3 = OFF_WT2 + (size_t)6272 * 1024 * 2;
constexpr size_t OFF_ROPE = OFF_WT3 + (size_t)1024 * 2048 * 2;
constexpr size_t OFF_H = OFF_ROPE + (size_t)2056 * 128 * 8;
constexpr size_t OFF_PROJ = OFF_H + (size_t)T_TOK * 1024 * 2;
constexpr size_t OFF_A2 = OFF_PROJ + (size_t)T_TOK * 6144 * 2;
constexpr size_t OFF_PARTS = OFF_A2 + (size_t)T_TOK * 2048 * 2;
constexpr size_t OFF_X1 = OFF_PARTS + (size_t)T_TOK * 64 * 4;
constexpr size_t OFF_X2 = OFF_X1 + (size_t)T_TOK * 1024 * 4;
constexpr size_t OFF_XBCC = OFF_X2 + (size_t)T_TOK * 1024 * 4;
constexpr size_t OFF_DTRAW = OFF_XBCC + (size_t)T_TOK * 4096 * 2;
constexpr size_t OFF_DT = OFF_DTRAW + (size_t)T_TOK * 32 * 4;
constexpr size_t OFF_CUM = OFF_DT + (size_t)T_TOK * 32 * 4;
constexpr size_t OFF_BAR = OFF_CUM + (size_t)T_TOK * 32 * 4;

constexpr size_t OUT_Y = 0;
constexpr size_t OUT_RETP = 17825792;
constexpr size_t OUT_RETS = 22020096;
constexpr size_t OUT_SSMP = 89128960;
constexpr size_t OUT_SSMS = 91226112;
constexpr size_t OUT_CONVP = 124780544;
constexpr size_t OUT_CONVS = 124878848;

struct Params {
  const float *x_prompt, *x_sample, *state_ret, *state_ssm, *state_conv, *ret_norm, *ret_w_in, *ret_head_norm,
      *ret_w_out, *ssm_norm, *ssm_w_in, *ssm_conv_w, *ssm_conv_b, *ssm_dt_bias, *ssm_a_log, *ssm_d, *ssm_gate_norm,
      *ssm_w_out, *final_norm;
  float* out;
  unsigned char* ws;
  long long phase_lo, phase_hi, dup, tidx;
};

__device__ __forceinline__ u16 f2bf(float f) {
  uint32_t u = __float_as_uint(f);
  u += 0x7fffu + ((u >> 16) & 1u);
  return (u16)(u >> 16);
}
__device__ __forceinline__ float bf2f(u16 h) { return __uint_as_float(((uint32_t)h) << 16); }
__device__ __forceinline__ uint32_t pack2(float a, float b) { return (uint32_t)f2bf(a) | ((uint32_t)f2bf(b) << 16); }
__device__ __forceinline__ float silu(float x) { return x / (1.0f + __expf(-x)); }
__device__ __forceinline__ float wave_sum(float v) {
#pragma unroll
  for (int o = 32; o > 0; o >>= 1) v += __shfl_xor(v, o);
  return v;
}
__device__ __forceinline__ const float* xrow(const Params& p, int r) {
  return r < NPROMPT ? p.x_prompt + (size_t)r * 1024 : p.x_sample + (size_t)(r - NPROMPT) * 1024;
}
__device__ __forceinline__ s16x4 trread(const unsigned char* ptr) {
  return __builtin_amdgcn_ds_read_tr16_b64_v4i16((s16x4 __attribute__((address_space(3)))*)ptr);
}
__device__ __forceinline__ bf16x8 cat8(s16x4 a, s16x4 b) {
  bf16x8 r;
  r[0] = a[0]; r[1] = a[1]; r[2] = a[2]; r[3] = a[3];
  r[4] = b[0]; r[5] = b[1]; r[6] = b[2]; r[7] = b[3];
  return r;
}
__device__ __forceinline__ bf16x8 trfrag(const unsigned char* img, int rs, int kbase, int nbase, int lane) {
  const int g = lane >> 4, q = (lane & 15) >> 2, pp = lane & 3;
  const unsigned char* a = img + (kbase + 8 * g + q) * rs + (nbase + 4 * pp) * 2;
  s16x4 t0 = trread(a);
  s16x4 t1 = trread(a + 4 * rs);
  return cat8(t0, t1);
}

__device__ __forceinline__ int colmap_retin(int p) {
  if (p < 2048) {
    int hb = p & ~255, pp = p & 255;
    int gi = pp >> 5, half = (pp >> 4) & 1, c = pp & 15;
    return hb + half * 128 + gi * 16 + c;
  }
  return p;
}

__device__ void transpose_tile(const float* __restrict__ W, u16* __restrict__ Wt, int K, int N, int mode, int nt, int kt,
                               unsigned char* smem, const int tid) {
  float* tile = (float*)smem;
#pragma unroll
  for (int i = 0; i < 8; ++i) {
    int idx = tid + NTHR * i;
    int kk = idx >> 6, nn = idx & 63;
    int n = nt * 64 + nn;
    int src = (mode == 1) ? colmap_retin(n) : n;
    float v = 0.f;
    if (src < N) v = W[(size_t)(kt * 64 + kk) * N + src];
    tile[kk * 65 + nn] = v;
  }
  __syncthreads();
  {
    int n = tid >> 3, kc = tid & 7;
    float v[8];
#pragma unroll
    for (int j = 0; j < 8; ++j) v[j] = tile[(kc * 8 + j) * 65 + n];
    u32x4 o;
    o.x = pack2(v[0], v[1]); o.y = pack2(v[2], v[3]); o.z = pack2(v[4], v[5]); o.w = pack2(v[6], v[7]);
    *(u32x4*)(Wt + (size_t)(nt * 64 + n) * K + kt * 64 + kc * 8) = o;
  }
  __syncthreads();
}

__device__ void phase_prep(const Params& p, unsigned char* smem, const int rep) {
  const int tid = (int)p.tidx;
  for (int rr = 0; rr < rep; ++rr) {
  u16* Wt0 = (u16*)(p.ws + OFF_WT0);
  u16* Wt1 = (u16*)(p.ws + OFF_WT1);
  u16* Wt2 = (u16*)(p.ws + OFF_WT2);
  u16* Wt3 = (u16*)(p.ws + OFF_WT3);
  const int n0 = 1536, n1 = 512, n2 = 1568, n3 = 512;
  for (int t = blockIdx.x; t < n0 + n1 + n2 + n3; t += gridDim.x) {
    if (t < n0) {
      transpose_tile(p.ret_w_in, Wt0, 1024, 6144, 1, t >> 4, t & 15, smem, tid);
    } else if (t < n0 + n1) {
      int u = t - n0;
      transpose_tile(p.ret_w_out, Wt1, 2048, 1024, 0, u >> 5, u & 31, smem, tid);
    } else if (t < n0 + n1 + n2) {
      int u = t - n0 - n1;
      transpose_tile(p.ssm_w_in, Wt2, 1024, 6176, 0, u >> 4, u & 15, smem, tid);
    } else {
      int u = t - n0 - n1 - n2;
      transpose_tile(p.ssm_w_out, Wt3, 2048, 1024, 0, u >> 5, u & 31, smem, tid);
    }
  }
  float2* rope = (float2*)(p.ws + OFF_ROPE);
  const int gtid = blockIdx.x * NTHR + tid, gn = gridDim.x * NTHR;
  for (int idx = gtid; idx < 2056 * 128; idx += gn) {
    int pi = idx >> 7, i = idx & 127;
    int pos = pi < 2048 ? pi : 16384 + (pi - 2048);
    float freq = (float)exp2(-(double)i * (13.287712379549449 / 128.0));
    float ang = (float)pos * freq;
    float sn, cs;
    sincosf(ang, &sn, &cs);
    rope[idx] = make_float2(cs, sn);
  }
  u16* H = (u16*)(p.ws + OFF_H);
  const int lane = tid & 63, w = tid >> 6;
  for (int row = blockIdx.x * 8 + w; row < T_TOK; row += gridDim.x * 8) {
    const float* xr = xrow(p, row);
    float4 v[4];
    float ss = 0.f;
#pragma unroll
    for (int i = 0; i < 4; ++i) {
      v[i] = *(const float4*)(xr + i * 256 + lane * 4);
      ss += v[i].x * v[i].x + v[i].y * v[i].y + v[i].z * v[i].z + v[i].w * v[i].w;
    }
    ss = wave_sum(ss);
    float rstd = rsqrtf(ss * (1.0f / 1024.0f) + 1e-6f);
#pragma unroll
    for (int i = 0; i < 4; ++i) {
      float4 gg = *(const float4*)(p.ret_norm + i * 256 + lane * 4);
      u32x2 o;
      o.x = pack2(v[i].x * rstd * gg.x, v[i].y * rstd * gg.y);
      o.y = pack2(v[i].z * rstd * gg.z, v[i].w * rstd * gg.w);
      *(u32x2*)(H + (size_t)row * 1024 + i * 256 + lane * 4) = o;
    }
  }
  }
}

template <int MODE>
__device__ void phase_norm(const Params& p, const float* __restrict__ X, const float* __restrict__ gain, const int rep) {
  const int tid = (int)p.tidx, lane = tid & 63, w = tid >> 6;
  u16* H = (u16*)(p.ws + OFF_H);
  for (int row0 = blockIdx.x * 8 + w; row0 < T_TOK * rep; row0 += gridDim.x * 8) {
    const int row = row0 % T_TOK;
    const float* xr = X + (size_t)row * 1024;
    float4 v[4];
    float ss = 0.f;
#pragma unroll
    for (int i = 0; i < 4; ++i) {
      v[i] = *(const float4*)(xr + i * 256 + lane * 4);
      ss += v[i].x * v[i].x + v[i].y * v[i].y + v[i].z * v[i].z + v[i].w * v[i].w;
    }
    ss = wave_sum(ss);
    float rstd = rsqrtf(ss * (1.0f / 1024.0f) + 1e-6f);
#pragma unroll
    for (int i = 0; i < 4; ++i) {
      float4 gg = *(const float4*)(gain + i * 256 + lane * 4);
      if (MODE == 0) {
        u32x2 o;
        o.x = pack2(v[i].x * rstd * gg.x, v[i].y * rstd * gg.y);
        o.y = pack2(v[i].z * rstd * gg.z, v[i].w * rstd * gg.w);
        *(u32x2*)(H + (size_t)row * 1024 + i * 256 + lane * 4) = o;
      } else {
        float4 o = make_float4(v[i].x * rstd * gg.x, v[i].y * rstd * gg.y, v[i].z * rstd * gg.z, v[i].w * rstd * gg.w);
        *(float4*)(p.out + OUT_Y + (size_t)row * 1024 + i * 256 + lane * 4) = o;
      }
    }
  }
}

template <int EPI, int NH>
__device__ void gemm_phase(const Params& p, const u16* __restrict__ A, const u16* __restrict__ Bt, const int K, const int NT,
                           const float* __restrict__ resid, float* __restrict__ outf, unsigned char* smem, const int rep,
                           const int mtiles, const int nt0 = 0, const bool rev = false) {
  constexpr int BM = 256, BN = 128, BK = 64, LR = 144;
  constexpr int BUFB = (BM + BN) * LR;
  float* rstdS = (float*)(smem + 2 * BUFB);
  const int tid = (int)p.tidx, lane = tid & 63, w = tid >> 6;
  const int wm = w >> 1, wn = w & 1, l15 = lane & 15, g = lane >> 4;
  const int KT = K / BK;
  const int ntiles = mtiles * NT;
  const float* parts = (const float*)(p.ws + OFF_PARTS);
  const int srow = tid >> 3, skc = tid & 7;

  for (int tile0 = rev ? (int)(gridDim.x - 1 - blockIdx.x) : (int)blockIdx.x; tile0 < ntiles * rep; tile0 += gridDim.x) {
    const int tile = tile0 % ntiles;
    const int mt = tile / NT, nt = tile - mt * NT + nt0;
    const int m0 = mt * BM, n0 = nt * BN;
    if (NH > 0) {
      for (int idx = tid; idx < BM * NH; idx += NTHR) {
        int row = idx / NH, h = idx % NH;
        const float* pp = parts + (size_t)(m0 + row) * 64 + h * (64 / NH);
        float s = 0.f;
#pragma unroll
        for (int q = 0; q < 64 / NH; ++q) s += pp[q];
        rstdS[idx] = rsqrtf(s / (float)(K / NH) + 1e-6f);
      }
    }
    u32x4 ra[4], rb[2];
    const u16* ap = A + (size_t)(m0 + srow) * K + skc * 8;
    const u16* bp = Bt + (size_t)(n0 + srow) * K + skc * 8;
#pragma unroll
    for (int i = 0; i < 4; ++i) ra[i] = *(const u32x4*)(ap + (size_t)(64 * i) * K);
#pragma unroll
    for (int i = 0; i < 2; ++i) rb[i] = *(const u32x4*)(bp + (size_t)(64 * i) * K);
    {
      unsigned char* base = smem;
#pragma unroll
      for (int i = 0; i < 4; ++i) *(u32x4*)(base + (srow + 64 * i) * LR + skc * 16) = ra[i];
#pragma unroll
      for (int i = 0; i < 2; ++i) *(u32x4*)(base + BM * LR + (srow + 64 * i) * LR + skc * 16) = rb[i];
    }
    __syncthreads();

    f32x4 acc[4][4];
    f32x4 accT[4][4];
#pragma unroll
    for (int i = 0; i < 4; ++i)
#pragma unroll
      for (int j = 0; j < 4; ++j) {
        acc[i][j] = (f32x4){0.f, 0.f, 0.f, 0.f};
        accT[i][j] = (f32x4){0.f, 0.f, 0.f, 0.f};
      }

    for (int kt = 0; kt < KT; ++kt) {
      const bool more = (kt + 1 < KT);
      if (more) {
#pragma unroll
        for (int i = 0; i < 4; ++i) ra[i] = *(const u32x4*)(ap + (size_t)(64 * i) * K + (kt + 1) * BK);
#pragma unroll
        for (int i = 0; i < 2; ++i) rb[i] = *(const u32x4*)(bp + (size_t)(64 * i) * K + (kt + 1) * BK);
      }
      const unsigned char* abase = smem + (kt & 1) * BUFB + (wm * 64 + l15) * LR + g * 16;
      const unsigned char* bbase = smem + (kt & 1) * BUFB + BM * LR + (wn * 64 + l15) * LR + g * 16;
#pragma unroll
      for (int ks = 0; ks < 2; ++ks) {
        bf16x8 af[4], bfr[4];
#pragma unroll
        for (int mf = 0; mf < 4; ++mf) af[mf] = *(const bf16x8*)(abase + mf * 16 * LR + ks * 64);
#pragma unroll
        for (int nf = 0; nf < 4; ++nf) bfr[nf] = *(const bf16x8*)(bbase + nf * 16 * LR + ks * 64);
#pragma unroll
        for (int mf = 0; mf < 4; ++mf)
#pragma unroll
          for (int nf = 0; nf < 4; ++nf)
            acc[mf][nf] = __builtin_amdgcn_mfma_f32_16x16x32_bf16(af[mf], bfr[nf], acc[mf][nf], 0, 0, 0);
      }
      if (NH > 0) {
        const int per = KT / NH;
        if (((kt + 1) % per) == 0) {
          const int h = (kt + 1) / per - 1;
#pragma unroll
          for (int mf = 0; mf < 4; ++mf)
#pragma unroll
            for (int r = 0; r < 4; ++r) {
              float s = rstdS[(wm * 64 + mf * 16 + 4 * g + r) * NH + h];
#pragma unroll
              for (int nf = 0; nf < 4; ++nf) {
                accT[mf][nf][r] += s * acc[mf][nf][r];
                acc[mf][nf][r] = 0.f;
              }
            }
        }
      }
      if (more) {
        unsigned char* base = smem + ((kt + 1) & 1) * BUFB;
#pragma unroll
        for (int i = 0; i < 4; ++i) *(u32x4*)(base + (srow + 64 * i) * LR + skc * 16) = ra[i];
#pragma unroll
        for (int i = 0; i < 2; ++i) *(u32x4*)(base + BM * LR + (srow + 64 * i) * LR + skc * 16) = rb[i];
      }
      __syncthreads();
    }

#pragma unroll
    for (int mf = 0; mf < 4; ++mf) {
#pragma unroll
      for (int r = 0; r < 4; ++r) {
        __builtin_amdgcn_sched_barrier(0);
        const int row = m0 + wm * 64 + mf * 16 + 4 * g + r;
        if (EPI == 0) {
          u16* proj = (u16*)(p.ws + OFF_PROJ) + (size_t)row * 6144;
          if (n0 < 2048) {
            const float2* rope = (const float2*)(p.ws + OFF_ROPE);
            const int pi = row < NPROMPT ? (row & 2047) : 2048 + ((row - NPROMPT) & 7);
#pragma unroll
            for (int np = 0; np < 2; ++np) {
              const int pc = n0 + wn * 64 + np * 32;
              const int i = ((pc & 255) >> 5) * 16 + l15;
              const float2 cs = rope[pi * 128 + i];
              const float x1 = acc[mf][2 * np][r], x2 = acc[mf][2 * np + 1][r];
              float y1 = x1 * cs.x - x2 * cs.y, y2 = x1 * cs.y + x2 * cs.x;
              if (pc >= 1024) { y1 *= 0.0625f; y2 *= 0.0625f; }
              const int f1 = (pc & ~255) + i;
              proj[f1] = f2bf(y1);
              proj[f1 + 128] = f2bf(y2);
            }
          } else {
#pragma unroll
            for (int nf = 0; nf < 4; ++nf) proj[n0 + wn * 64 + nf * 16 + l15] = f2bf(acc[mf][nf][r]);
          }
        } else if (EPI == 1) {
#pragma unroll
          for (int nf = 0; nf < 4; ++nf) {
            const int col = n0 + wn * 64 + nf * 16 + l15;
            const float rv = resid ? resid[(size_t)row * 1024 + col] : xrow(p, row)[col];
            const float a = (NH > 0) ? accT[mf][nf][r] : acc[mf][nf][r];
            outf[(size_t)row * 1024 + col] = rv + a;
          }
        } else {
          u16* proj = (u16*)(p.ws + OFF_PROJ) + (size_t)row * 6144;
          float* dtraw = (float*)(p.ws + OFF_DTRAW) + (size_t)row * 32;
          float* cvo = nullptr;
          if (row < NPROMPT) {
            const int t = row & 2047;
            if (t >= 2045) cvo = p.out + OUT_CONVP + ((size_t)(row >> 11) * 3 + (t - 2045)) * 4096;
          } else {
            const int rs = row - NPROMPT, t = rs & 7;
            if (t >= 5) cvo = p.out + OUT_CONVS + ((size_t)(rs >> 3) * 3 + (t - 5)) * 4096;
          }
#pragma unroll
          for (int nf = 0; nf < 4; ++nf) {
            const int col = n0 + wn * 64 + nf * 16 + l15;
            const float a = acc[mf][nf][r];
            if (col < 6144) {
              proj[col] = f2bf(a);
              if (col >= 2048 && cvo) cvo[col - 2048] = a;
            } else if (col < 6176) {
              dtraw[col - 6144] = a;
            }
          }
        }
      }
    }
  }
}


template <int NH>
__device__ void gemm_sample_rows(const Params& p, const u16* __restrict__ A, const u16* __restrict__ Bt,
                                 const float* __restrict__ resid, float* __restrict__ outf, unsigned char* smem, const int rep) {
  constexpr int K = 2048, RS = 65;
  float* red = (float*)smem;
  float* rstdS = red + 8 * 64 * RS;
  const int tid = (int)p.tidx, lane = tid & 63, w = tid >> 6, l15 = lane & 15, g = lane >> 4;
  const float* parts = (const float*)(p.ws + OFF_PARTS);
  for (int item0 = blockIdx.x; item0 < 256 * rep; item0 += gridDim.x) {
    const int item = item0 & 255;
    const int m0 = NPROMPT + (item >> 4) * 64, n0 = (item & 15) * 64;
    for (int idx = tid; idx < 64 * NH; idx += NTHR) {
      const int row = idx / NH, h = idx % NH;
      const float* pp = parts + (size_t)(m0 + row) * 64 + h * (64 / NH);
      float sm = 0.f;
#pragma unroll
      for (int q = 0; q < 64 / NH; ++q) sm += pp[q];
      rstdS[idx] = rsqrtf(sm / (float)(K / NH) + 1e-6f);
    }
    f32x4 acc[4][4];
#pragma unroll
    for (int i = 0; i < 4; ++i)
#pragma unroll
      for (int j = 0; j < 4; ++j) acc[i][j] = (f32x4){0.f, 0.f, 0.f, 0.f};
    const u16* ap = A + (size_t)(m0 + l15) * K + w * 256 + 8 * g;
    const u16* bp = Bt + (size_t)(n0 + l15) * K + w * 256 + 8 * g;
#pragma unroll 2
    for (int ks = 0; ks < 8; ++ks) {
      bf16x8 af[4], bfr[4];
#pragma unroll
      for (int mf = 0; mf < 4; ++mf) af[mf] = *(const bf16x8*)(ap + (size_t)(mf * 16) * K + ks * 32);
#pragma unroll
      for (int nf = 0; nf < 4; ++nf) bfr[nf] = *(const bf16x8*)(bp + (size_t)(nf * 16) * K + ks * 32);
#pragma unroll
      for (int mf = 0; mf < 4; ++mf)
#pragma unroll
        for (int nf = 0; nf < 4; ++nf)
          acc[mf][nf] = __builtin_amdgcn_mfma_f32_16x16x32_bf16(af[mf], bfr[nf], acc[mf][nf], 0, 0, 0);
    }
    __syncthreads();
    {
      const int h = (w * 256) / (K / NH);
#pragma unroll
      for (int mf = 0; mf < 4; ++mf)
#pragma unroll
        for (int r = 0; r < 4; ++r) {
          const int row = mf * 16 + 4 * g + r;
          const float sc = rstdS[row * NH + h];
#pragma unroll
          for (int nf = 0; nf < 4; ++nf) red[(w * 64 + row) * RS + nf * 16 + l15] = acc[mf][nf][r] * sc;
        }
    }
    __syncthreads();
    {
      const int row = tid >> 3, c0 = (tid & 7) * 8;
      float o[8];
      const size_t gidx = (size_t)(m0 + row) * 1024 + n0 + c0;
      const float* rp = resid ? resid + gidx : p.x_sample + (size_t)(m0 - NPROMPT + row) * 1024 + n0 + c0;
      const float4 r0 = *(const float4*)rp, r1 = *(const float4*)(rp + 4);
      o[0] = r0.x; o[1] = r0.y; o[2] = r0.z; o[3] = r0.w; o[4] = r1.x; o[5] = r1.y; o[6] = r1.z; o[7] = r1.w;
#pragma unroll
      for (int ww = 0; ww < 8; ++ww)
#pragma unroll
        for (int j = 0; j < 8; ++j) o[j] += red[(ww * 64 + row) * RS + c0 + j];
      *(float4*)(outf + gidx) = make_float4(o[0], o[1], o[2], o[3]);
      *(float4*)(outf + gidx + 4) = make_float4(o[4], o[5], o[6], o[7]);
    }
    __syncthreads();
  }
}

__device__ __forceinline__ int lds_byte(int r, int c) {
  int st = (r >> 4) * 2 + (c >> 5), rr = r & 15, cc = c & 31, ob = rr * 64 + cc * 2;
  return st * 1024 + (ob ^ (((ob >> 9) & 1) << 5));
}
__device__ __forceinline__ void stage_rc(int b, int& R, int& C) {
  int st = b / 1024, sb = b % 1024, swz = sb ^ (((sb >> 9) & 1) << 5);
  R = (st >> 1) * 16 + swz / 64;
  C = (st & 1) * 32 + (swz % 64) / 2;
}

template <int EPI>
__device__ void gemm8_phase(const Params& p, const u16* __restrict__ A, const u16* __restrict__ Bt, const int K, const int nN,
                            unsigned char* smem, const int rep) {
  constexpr int BM8 = 256, BK8 = 64, HALF = 128, NXCD = 8, WGM = 8, HT = HALF * BK8;
  u16* shm = (u16*)smem;
#define SA(b, h) (shm + ((b) * 2 + (h)) * HT)
#define SB(b, h) (shm + (4 + (b) * 2 + (h)) * HT)
#define STAGE(P, BASE, br, kt)                                                                            \
  do {                                                                                                    \
    const int _so = ((br) * K + (kt) * BK8) * 2;                                                          \
    __builtin_amdgcn_raw_ptr_buffer_load_lds(rsrc_##BASE, (__attribute__((address_space(3))) unsigned*)((char*)(P) + (int)p.tidx * 16), 16, voff0, _so, 0, 0); \
    __builtin_amdgcn_raw_ptr_buffer_load_lds(rsrc_##BASE, (__attribute__((address_space(3))) unsigned*)((char*)(P) + (int)p.tidx * 16 + 8192), 16, voff1, _so, 0, 0); \
  } while (0)
#define LDA(dst, b, h)                                                                                    \
  for (int m = 0; m < 4; ++m)                                                                             \
    for (int k = 0; k < 2; ++k)                                                                           \
      dst[m][k] = *reinterpret_cast<const bf16x8*>((char*)SA(b, h) + lds_byte(wr * 64 + m * 16 + fr, k * 32 + fq * 8))
#define LDB(dst, b, h)                                                                                    \
  for (int n = 0; n < 2; ++n)                                                                             \
    for (int k = 0; k < 2; ++k)                                                                           \
      dst[n][k] = *reinterpret_cast<const bf16x8*>((char*)SB(b, h) + lds_byte(wc * 32 + n * 16 + fr, k * 32 + fq * 8))
#define MMA(ai, bj, At, Bx)                                                                               \
  do {                                                                                                    \
    __builtin_amdgcn_s_setprio(1);                                                                        \
    for (int m = 0; m < 4; ++m)                                                                           \
      for (int n = 0; n < 2; ++n)                                                                         \
        for (int k = 0; k < 2; ++k)                                                                       \
          acc[ai][bj][m][n] = __builtin_amdgcn_mfma_f32_16x16x32_bf16(At[m][k], Bx[n][k], acc[ai][bj][m][n], 0, 0, 0); \
    __builtin_amdgcn_s_setprio(0);                                                                        \
  } while (0)
#define WAIT_V(n) asm volatile("s_waitcnt vmcnt(" #n ")" ::: "memory")
#define WAIT_L(n) asm volatile("s_waitcnt lgkmcnt(" #n ")" ::: "memory")
#define BAR __builtin_amdgcn_s_barrier()
#define SCHED __builtin_amdgcn_sched_barrier(0)

  const int nM = T_TOK / BM8, nwg = nM * nN;
  const int wid = (int)p.tidx >> 6, lane = (int)p.tidx & 63, wr = wid >> 2, wc = wid & 3, fr = lane & 15, fq = lane >> 4;
  const int nt = K / BK8;
  const __amdgpu_buffer_rsrc_t rsrc_A = __builtin_amdgcn_make_buffer_rsrc((void*)A, (short)0, T_TOK * K * 2, 0x00020000);
  const __amdgpu_buffer_rsrc_t rsrc_Bt = __builtin_amdgcn_make_buffer_rsrc((void*)Bt, (short)0, nN * 256 * K * 2, 0x00020000);
  int voff0, voff1;
  {
    int r_, c_;
    stage_rc((int)p.tidx * 16, r_, c_);
    voff0 = (r_ * K + c_) * 2;
    stage_rc((int)p.tidx * 16 + 8192, r_, c_);
    voff1 = (r_ * K + c_) * 2;
  }

  for (int tile0 = blockIdx.x; tile0 < nwg * rep; tile0 += gridDim.x) {
    const int tile = tile0 % nwg;
    int wgid = tile;
    {
      int q = nwg / NXCD, r = nwg % NXCD, xcd = wgid % NXCD, off = wgid / NXCD;
      wgid = (xcd < r ? xcd * (q + 1) : r * (q + 1) + (xcd - r) * q) + off;
    }
    const int nig = WGM * nN, gid = wgid / nig, fm = gid * WGM, gsz = min(nM - fm, WGM);
    const int pm = fm + ((wgid % nig) % gsz), pn = (wgid % nig) / gsz, brow = pm * BM8, bcol = pn * BM8;

    f32x4 acc[2][2][4][2];
#pragma unroll
    for (int a = 0; a < 2; ++a)
#pragma unroll
      for (int b = 0; b < 2; ++b)
#pragma unroll
        for (int m = 0; m < 4; ++m)
#pragma unroll
          for (int n = 0; n < 2; ++n) acc[a][b][m][n] = (f32x4){0.f, 0.f, 0.f, 0.f};
    bf16x8 At[4][2], B0[2][2], B1[2][2];

    STAGE(SB(0, 0), Bt, bcol, 0); STAGE(SA(0, 0), A, brow, 0);
    STAGE(SB(0, 1), Bt, bcol + HALF, 0); STAGE(SA(0, 1), A, brow + HALF, 0);
    if (wr == 1) BAR;
    WAIT_V(4); BAR;
    STAGE(SB(1, 0), Bt, bcol, 1); STAGE(SA(1, 0), A, brow, 1); STAGE(SB(1, 1), Bt, bcol + HALF, 1);
    WAIT_V(6); BAR;
    for (int t = 0; t < nt - 2; t += 2) {
      LDB(B0, 0, 0); SCHED; LDA(At, 0, 0); STAGE(SA(1, 1), A, brow + HALF, t + 1);
      WAIT_L(8); BAR; WAIT_L(0); MMA(0, 0, At, B0); BAR; SCHED;
      LDB(B1, 0, 1); STAGE(SB(0, 0), Bt, bcol, t + 2);
      BAR; WAIT_L(0); MMA(0, 1, At, B1); BAR;
      LDA(At, 0, 1); STAGE(SA(0, 0), A, brow, t + 2);
      BAR; WAIT_L(0); MMA(1, 0, At, B0); BAR; SCHED;
      STAGE(SB(0, 1), Bt, bcol + HALF, t + 2);
      WAIT_V(6); BAR; MMA(1, 1, At, B1); BAR;
      LDB(B0, 1, 0); SCHED; LDA(At, 1, 0); STAGE(SA(0, 1), A, brow + HALF, t + 2);
      WAIT_L(8); BAR; WAIT_L(0); MMA(0, 0, At, B0); BAR; SCHED;
      LDB(B1, 1, 1); STAGE(SB(1, 0), Bt, bcol, t + 3);
      BAR; WAIT_L(0); MMA(0, 1, At, B1); BAR;
      LDA(At, 1, 1); STAGE(SA(1, 0), A, brow, t + 3);
      BAR; WAIT_L(0); MMA(1, 0, At, B0); BAR; SCHED;
      STAGE(SB(1, 1), Bt, bcol + HALF, t + 3);
      WAIT_V(6); BAR; MMA(1, 1, At, B1); BAR;
    }
    {
      LDB(B0, 0, 0); LDA(At, 0, 0); STAGE(SA(1, 1), A, brow + HALF, nt - 1);
      BAR; WAIT_L(0); MMA(0, 0, At, B0); BAR; SCHED;
      LDB(B1, 0, 1); BAR; WAIT_L(0); MMA(0, 1, At, B1); BAR; SCHED;
      LDA(At, 0, 1); WAIT_V(4); BAR; WAIT_L(0); MMA(1, 0, At, B0); MMA(1, 1, At, B1); BAR; SCHED;
    }
    {
      LDB(B0, 1, 0); LDA(At, 1, 0); WAIT_V(2); BAR; WAIT_L(0); MMA(0, 0, At, B0); BAR; SCHED;
      LDB(B1, 1, 1); WAIT_V(0); BAR; WAIT_L(0); MMA(0, 1, At, B1); BAR; SCHED;
      LDA(At, 1, 1); BAR; WAIT_L(0); MMA(1, 0, At, B0); MMA(1, 1, At, B1); BAR; SCHED;
    }
    if (wr == 0) BAR;

    u16* projb = (u16*)(p.ws + OFF_PROJ);
#pragma unroll
    for (int ai = 0; ai < 2; ++ai)
#pragma unroll
      for (int m = 0; m < 4; ++m)
#pragma unroll
        for (int j = 0; j < 4; ++j) {
          __builtin_amdgcn_sched_barrier(0);
          const int row = brow + ai * HALF + wr * 64 + m * 16 + fq * 4 + j;
          u16* proj = projb + (size_t)row * 6144;
          if (EPI == 0) {
            if (bcol < 2048) {
              const float2* rope = (const float2*)(p.ws + OFF_ROPE);
              const int pi = row < NPROMPT ? (row & 2047) : 2048 + ((row - NPROMPT) & 7);
#pragma unroll
              for (int bj = 0; bj < 2; ++bj) {
                const int pc = bcol + bj * HALF + wc * 32;
                const int i = ((pc & 255) >> 5) * 16 + fr;
                const float2 cs = rope[pi * 128 + i];
                const float x1 = acc[ai][bj][m][0][j], x2 = acc[ai][bj][m][1][j];
                float y1 = x1 * cs.x - x2 * cs.y, y2 = x1 * cs.y + x2 * cs.x;
                if (pc >= 1024) { y1 *= 0.0625f; y2 *= 0.0625f; }
                const int f1 = (pc & ~255) + i;
                proj[f1] = f2bf(y1);
                proj[f1 + 128] = f2bf(y2);
              }
            } else {
#pragma unroll
              for (int bj = 0; bj < 2; ++bj)
#pragma unroll
                for (int n = 0; n < 2; ++n) proj[bcol + bj * HALF + wc * 32 + n * 16 + fr] = f2bf(acc[ai][bj][m][n][j]);
            }
          } else {
            float* cvo = nullptr;
            if (bcol >= 2048) {
              if (row < NPROMPT) {
                const int t = row & 2047;
                if (t >= 2045) cvo = p.out + OUT_CONVP + ((size_t)(row >> 11) * 3 + (t - 2045)) * 4096;
              } else {
                const int rs = row - NPROMPT, t = rs & 7;
                if (t >= 5) cvo = p.out + OUT_CONVS + ((size_t)(rs >> 3) * 3 + (t - 5)) * 4096;
              }
            }
#pragma unroll
            for (int bj = 0; bj < 2; ++bj)
#pragma unroll
              for (int n = 0; n < 2; ++n) {
                const int col = bcol + bj * HALF + wc * 32 + n * 16 + fr;
                const float a = acc[ai][bj][m][n][j];
                proj[col] = f2bf(a);
                if (cvo) cvo[col - 2048] = a;
              }
          }
        }
  }
#undef SA
#undef SB
#undef STAGE
#undef LDA
#undef LDB
#undef MMA
#undef WAIT_V
#undef WAIT_L
#undef BAR
#undef SCHED
}

__device__ void phase_conv(const Params& p, const int rep) {
  const int gtid = blockIdx.x * NTHR + (int)p.tidx, gn = gridDim.x * NTHR;
  const float* dtraw = (const float*)(p.ws + OFF_DTRAW);
  float* dtv = (float*)(p.ws + OFF_DT);
  float* cumv = (float*)(p.ws + OFF_CUM);
  for (int idx = gtid; idx < (256 + 128) * 32; idx += gn) {
    const int sc = idx >> 5, h = idx & 31;
    int row0, len;
    if (sc < 256) { row0 = sc * 64; len = 64; } else { row0 = NPROMPT + (sc - 256) * 8; len = 8; }
    const float a = -expf(p.ssm_a_log[h]);
    const float bias = p.ssm_dt_bias[h];
    float cum = 0.f;
    for (int t = 0; t < len; ++t) {
      float x = dtraw[(size_t)(row0 + t) * 32 + h] + bias;
      float dt = x > 20.f ? x : log1pf(expf(x));
      cum += dt * a;
      dtv[(size_t)(row0 + t) * 32 + h] = dt;
      cumv[(size_t)(row0 + t) * 32 + h] = cum;
    }
  }
  const u16* proj = (const u16*)(p.ws + OFF_PROJ);
  u16* xbcc = (u16*)(p.ws + OFF_XBCC);
  for (int idx0 = gtid; idx0 < T_TOK * 512 * rep; idx0 += gn) {
    const int idx = idx0 % (T_TOK * 512);
    const int row = idx >> 9, ch0 = (idx & 511) * 8;
    int t, b;
    const bool samp = row >= NPROMPT;
    if (!samp) { t = row & 2047; b = row >> 11; } else { t = (row - NPROMPT) & 7; b = (row - NPROMPT) >> 3; }
    float acc[8];
    {
      float4 b0 = *(const float4*)(p.ssm_conv_b + ch0), b1 = *(const float4*)(p.ssm_conv_b + ch0 + 4);
      acc[0] = b0.x; acc[1] = b0.y; acc[2] = b0.z; acc[3] = b0.w;
      acc[4] = b1.x; acc[5] = b1.y; acc[6] = b1.z; acc[7] = b1.w;
    }
#pragma unroll
    for (int wv = 0; wv < 4; ++wv) {
      const int tt = t - 3 + wv;
      float xv[8];
      if (tt >= 0) {
        u32x4 u = *(const u32x4*)(proj + (size_t)(row - 3 + wv) * 6144 + 2048 + ch0);
        xv[0] = bf2f((u16)(u.x & 0xffff)); xv[1] = bf2f((u16)(u.x >> 16));
        xv[2] = bf2f((u16)(u.y & 0xffff)); xv[3] = bf2f((u16)(u.y >> 16));
        xv[4] = bf2f((u16)(u.z & 0xffff)); xv[5] = bf2f((u16)(u.z >> 16));
        xv[6] = bf2f((u16)(u.w & 0xffff)); xv[7] = bf2f((u16)(u.w >> 16));
      } else if (samp) {
        const float* sp = p.state_conv + ((size_t)b * 3 + (tt + 3)) * 4096 + ch0;
        float4 s0 = *(const float4*)sp, s1 = *(const float4*)(sp + 4);
        xv[0] = s0.x; xv[1] = s0.y; xv[2] = s0.z; xv[3] = s0.w;
        xv[4] = s1.x; xv[5] = s1.y; xv[6] = s1.z; xv[7] = s1.w;
      } else {
#pragma unroll
        for (int j = 0; j < 8; ++j) xv[j] = 0.f;
      }
      float4 w0 = *(const float4*)(p.ssm_conv_w + (size_t)wv * 4096 + ch0);
      float4 w1 = *(const float4*)(p.ssm_conv_w + (size_t)wv * 4096 + ch0 + 4);
      acc[0] += xv[0] * w0.x; acc[1] += xv[1] * w0.y; acc[2] += xv[2] * w0.z; acc[3] += xv[3] * w0.w;
      acc[4] += xv[4] * w1.x; acc[5] += xv[5] * w1.y; acc[6] += xv[6] * w1.z; acc[7] += xv[7] * w1.w;
    }
    u32x4 o;
    o.x = pack2(silu(acc[0]), silu(acc[1]));
    o.y = pack2(silu(acc[2]), silu(acc[3]));
    o.z = pack2(silu(acc[4]), silu(acc[5]));
    o.w = pack2(silu(acc[6]), silu(acc[7]));
    *(u32x4*)(xbcc + (size_t)row * 4096 + ch0) = o;
  }
}

template <int DK, int MODE>
__device__ void rec_prompt_item(const Params& p, const int item, unsigned char* smem) {
  constexpr int QS = (DK + 16) * 2;
  constexpr int VS = 160, PS = 144;
  constexpr int MF = DK / 128;
  constexpr int KS = DK / 32;
  constexpr int NQ = DK / 64;
  constexpr int CPR = DK / 8;
  unsigned char* Qs = smem;
  unsigned char* Ks = Qs + 64 * QS;
  unsigned char* STs = Ks + 64 * QS;
  unsigned char* Vs = STs + 64 * QS;
  unsigned char* Vts = Vs + 64 * VS;
  unsigned char* Ps = Vts + 64 * VS;
  float* cumS = (float*)(Ps + 64 * PS);
  float* uS = cumS + 64;

  const int tid = (int)p.tidx, lane = tid & 63, w = tid >> 6;
  const int l15 = lane & 15, g = lane >> 4;
  const int b = item >> 5;
  const int h = (MODE == 0) ? ((item >> 3) & 3) : (item & 31);
  const int s = (MODE == 0) ? (item & 7) : 0;
  const int row0 = b * 2048;

  const u16* src;
  int sstride, qcol, kcol, vcol;
  if (MODE == 0) {
    src = (const u16*)(p.ws + OFF_PROJ); sstride = 6144;
    qcol = h * 256; kcol = 1024 + h * 256; vcol = 2048 + h * 512 + s * 64;
  } else {
    src = (const u16*)(p.ws + OFF_XBCC); sstride = 4096;
    qcol = 3072 + (h >> 2) * 128; kcol = 2048 + (h >> 2) * 128; vcol = h * 64;
  }
  const float* dtv = (const float*)(p.ws + OFF_DT);
  const float* cumv = (const float*)(p.ws + OFF_CUM);
  const float lg = (MODE == 0) ? logf(1.0f - exp2f(-5.0f - (float)h)) : 0.f;

  const int vrow = tid >> 3, vkc = tid & 7;
  const int jt = tid & 63;

  u32x4 rq[NQ], rk[NQ], rv;
  float pcj = 0.f, puj = 1.f, pclast = 0.f, pct = 0.f, put = 1.f;

  f32x4 S[MF][4];
#pragma unroll
  for (int i = 0; i < MF; ++i)
#pragma unroll
    for (int j = 0; j < 4; ++j) S[i][j] = (f32x4){0.f, 0.f, 0.f, 0.f};

  {
    const int r0 = row0;
#pragma unroll
    for (int i = 0; i < NQ; ++i) {
      int c = tid + NTHR * i, rr = c / CPR, kc = c % CPR;
      rq[i] = *(const u32x4*)(src + (size_t)(r0 + rr) * sstride + qcol + kc * 8);
      rk[i] = *(const u32x4*)(src + (size_t)(r0 + rr) * sstride + kcol + kc * 8);
    }
    rv = *(const u32x4*)(src + (size_t)(r0 + vrow) * sstride + vcol + vkc * 8);
    if (MODE == 1) {
      pcj = cumv[(size_t)(r0 + vrow) * 32 + h]; puj = dtv[(size_t)(r0 + vrow) * 32 + h];
      pclast = cumv[(size_t)(r0 + 63) * 32 + h];
      pct = cumv[(size_t)(r0 + jt) * 32 + h]; put = dtv[(size_t)(r0 + jt) * 32 + h];
    }
  }

  const int fi = w >> 1, fe0 = 2 * (w & 1);
  const int dw = w * (DK / 8);

  for (int c = 0; c < 32; ++c) {
    const int r0 = row0 + c * 64;
#pragma unroll
    for (int i = 0; i < NQ; ++i) {
      int cc = tid + NTHR * i, rr = cc / CPR, kc = cc % CPR;
      *(u32x4*)(Qs + rr * QS + kc * 16) = rq[i];
      *(u32x4*)(Ks + rr * QS + kc * 16) = rk[i];
    }
    {
      *(u32x4*)(Vs + vrow * VS + vkc * 16) = rv;
      float cj, uj, cl;
      if (MODE == 0) { cj = (float)(vrow + 1) * lg; uj = 1.f; cl = 64.f * lg; } else { cj = pcj; uj = puj; cl = pclast; }
      const float wj = uj * __expf(cl - cj);
      u32x4 o;
      o.x = pack2(bf2f((u16)(rv.x & 0xffff)) * wj, bf2f((u16)(rv.x >> 16)) * wj);
      o.y = pack2(bf2f((u16)(rv.y & 0xffff)) * wj, bf2f((u16)(rv.y >> 16)) * wj);
      o.z = pack2(bf2f((u16)(rv.z & 0xffff)) * wj, bf2f((u16)(rv.z >> 16)) * wj);
      o.w = pack2(bf2f((u16)(rv.w & 0xffff)) * wj, bf2f((u16)(rv.w >> 16)) * wj);
      *(u32x4*)(Vts + vrow * VS + vkc * 16) = o;
    }
    if (tid < 64) {
      if (MODE == 0) { cumS[tid] = (float)(tid + 1) * lg; uS[tid] = 1.f; } else { cumS[tid] = pct; uS[tid] = put; }
    }
#pragma unroll
    for (int mf = 0; mf < MF; ++mf)
#pragma unroll
      for (int nf = 0; nf < 4; ++nf) {
        u32x2 o;
        o.x = pack2(S[mf][nf][0], S[mf][nf][1]);
        o.y = pack2(S[mf][nf][2], S[mf][nf][3]);
        *(u32x2*)(STs + (16 * nf + l15) * QS + (dw + 16 * mf + 4 * g) * 2) = o;
      }
    __syncthreads();
    if (c + 1 < 32) {
      const int r1 = r0 + 64;
#pragma unroll
      for (int i = 0; i < NQ; ++i) {
        int cc = tid + NTHR * i, rr = cc / CPR, kc = cc % CPR;
        rq[i] = *(const u32x4*)(src + (size_t)(r1 + rr) * sstride + qcol + kc * 8);
        rk[i] = *(const u32x4*)(src + (size_t)(r1 + rr) * sstride + kcol + kc * 8);
      }
      rv = *(const u32x4*)(src + (size_t)(r1 + vrow) * sstride + vcol + vkc * 8);
      if (MODE == 1) {
        pcj = cumv[(size_t)(r1 + vrow) * 32 + h]; puj = dtv[(size_t)(r1 + vrow) * 32 + h];
        pclast = cumv[(size_t)(r1 + 63) * 32 + h];
        pct = cumv[(size_t)(r1 + jt) * 32 + h]; put = dtv[(size_t)(r1 + jt) * 32 + h];
      }
    }
    u16 gz[2][4];
    {
      const u16* gsrc = (const u16*)(p.ws + OFF_PROJ);
      const int gcol = (MODE == 0) ? (4096 + h * 512 + s * 64) : (h * 64);
#pragma unroll
      for (int x = 0; x < 2; ++x)
#pragma unroll
        for (int r = 0; r < 4; ++r)
          gz[x][r] = gsrc[(size_t)(r0 + 16 * fi + 4 * g + r) * 6144 + gcol + 16 * (fe0 + x) + l15];
    }
    f32x4 sc[2], cr[2];
#pragma unroll
    for (int x = 0; x < 2; ++x) { sc[x] = (f32x4){0.f, 0.f, 0.f, 0.f}; cr[x] = (f32x4){0.f, 0.f, 0.f, 0.f}; }
#pragma unroll 2
    for (int ks = 0; ks < KS; ++ks) {
      const bf16x8 a = *(const bf16x8*)(Qs + (16 * fi + l15) * QS + ks * 64 + g * 16);
#pragma unroll
      for (int x = 0; x < 2; ++x) {
        const int fj = fe0 + x;
        if (fj <= fi) {
          const bf16x8 bk = *(const bf16x8*)(Ks + (16 * fj + l15) * QS + ks * 64 + g * 16);
          sc[x] = __builtin_amdgcn_mfma_f32_16x16x32_bf16(a, bk, sc[x], 0, 0, 0);
        }
        const bf16x8 bs = *(const bf16x8*)(STs + (16 * (fe0 + x) + l15) * QS + ks * 64 + g * 16);
        cr[x] = __builtin_amdgcn_mfma_f32_16x16x32_bf16(a, bs, cr[x], 0, 0, 0);
      }
    }
    float ci[4];
#pragma unroll
    for (int r = 0; r < 4; ++r) ci[r] = cumS[16 * fi + 4 * g + r];
#pragma unroll
    for (int x = 0; x < 2; ++x) {
      const int fj = fe0 + x;
      const int j = 16 * fj + l15;
      const float cj = cumS[j], uj = uS[j];
#pragma unroll
      for (int r = 0; r < 4; ++r) {
        const int i = 16 * fi + 4 * g + r;
        float v = 0.f;
        if (fj <= fi && j <= i) v = sc[x][r] * __expf(ci[r] - cj) * uj;
        *(u16*)(Ps + i * PS + j * 2) = f2bf(v);
      }
    }
    {
      const float atot = __expf(cumS[63]);
#pragma unroll
      for (int mf = 0; mf < MF; ++mf)
#pragma unroll
        for (int nf = 0; nf < 4; ++nf)
#pragma unroll
          for (int r = 0; r < 4; ++r) S[mf][nf][r] *= atot;
#pragma unroll
      for (int ks = 0; ks < 2; ++ks) {
        bf16x8 af[MF], bfv[4];
#pragma unroll
        for (int mf = 0; mf < MF; ++mf) af[mf] = trfrag(Ks, QS, 32 * ks, dw + 16 * mf, lane);
#pragma unroll
        for (int nf = 0; nf < 4; ++nf) bfv[nf] = trfrag(Vts, VS, 32 * ks, 16 * nf, lane);
#pragma unroll
        for (int mf = 0; mf < MF; ++mf)
#pragma unroll
          for (int nf = 0; nf < 4; ++nf)
            S[mf][nf] = __builtin_amdgcn_mfma_f32_16x16x32_bf16(af[mf], bfv[nf], S[mf][nf], 0, 0, 0);
      }
    }
    __syncthreads();
    f32x4 in[2];
#pragma unroll
    for (int x = 0; x < 2; ++x) in[x] = (f32x4){0.f, 0.f, 0.f, 0.f};
#pragma unroll
    for (int ks = 0; ks < 2; ++ks) {
      if (2 * ks <= fi) {
        const bf16x8 a = *(const bf16x8*)(Ps + (16 * fi + l15) * PS + ks * 64 + g * 16);
#pragma unroll
        for (int x = 0; x < 2; ++x) {
          const bf16x8 bv = trfrag(Vs, VS, 32 * ks, 16 * (fe0 + x), lane);
          in[x] = __builtin_amdgcn_mfma_f32_16x16x32_bf16(a, bv, in[x], 0, 0, 0);
        }
      }
    }
    {
      float ss[4] = {0.f, 0.f, 0.f, 0.f};
      u16* aout = (u16*)(p.ws + OFF_A2);
      float* parts = (float*)(p.ws + OFF_PARTS);
#pragma unroll
      for (int x = 0; x < 2; ++x) {
        const int e = 16 * (fe0 + x) + l15;
        float gn, dsk = 0.f;
        int ocol;
        if (MODE == 0) { gn = p.ret_head_norm[h * 512 + s * 64 + e]; ocol = h * 512 + s * 64 + e; }
        else { gn = p.ssm_gate_norm[h * 64 + e]; dsk = p.ssm_d[h]; ocol = h * 64 + e; }
#pragma unroll
        for (int r = 0; r < 4; ++r) {
          const int i = 16 * fi + 4 * g + r;
          float o = in[x][r] + cr[x][r] * __expf(ci[r]);
          const float gv = bf2f(gz[x][r]);
          float val;
          if (MODE == 0) {
            ss[r] += o * o;
            val = o * gn * silu(gv);
          } else {
            const float xs = bf2f(*(const u16*)(Vs + i * VS + e * 2));
            const float y = o + xs * dsk;
            const float gg = y * silu(gv);
            ss[r] += gg * gg;
            val = gg * gn;
          }
          aout[(size_t)(r0 + i) * 2048 + ocol] = f2bf(val);
        }
      }
#pragma unroll
      for (int r = 0; r < 4; ++r) {
        float v = ss[r];
        v += __shfl_xor(v, 1); v += __shfl_xor(v, 2); v += __shfl_xor(v, 4); v += __shfl_xor(v, 8);
        if (l15 == 0) {
          const int i = 16 * fi + 4 * g + r;
          const int slot = (MODE == 0) ? (h * 16 + s * 2 + (w & 1)) : ((h >> 2) * 8 + (h & 3) * 2 + (w & 1));
          parts[(size_t)(r0 + i) * 64 + slot] = v;
        }
      }
    }
    __syncthreads();
  }
  {
    float* so;
    int pitch;
    if (MODE == 0) { so = p.out + OUT_RETP + ((size_t)(b * 4 + h) * 256) * 512 + s * 64; pitch = 512; }
    else { so = p.out + OUT_SSMP + ((size_t)(b * 32 + h) * 128) * 64; pitch = 64; }
#pragma unroll
    for (int mf = 0; mf < MF; ++mf)
#pragma unroll
      for (int nf = 0; nf < 4; ++nf)
#pragma unroll
        for (int r = 0; r < 4; ++r)
          so[(size_t)(dw + 16 * mf + 4 * g + r) * pitch + 16 * nf + l15] = S[mf][nf][r];
  }
}

#define SAMPLE_DECODE(ITEM, B_, H_, S_)                              \
  const int B_ = (ITEM) >> 5;                                        \
  const int H_ = (MODE == 0) ? (((ITEM) >> 3) & 3) : ((ITEM) & 31);  \
  const int S_ = (MODE == 0) ? ((ITEM) & 7) : 0;

#define SAMPLE_ISSUE(ITEM)                                                                                         \
  {                                                                                                                \
    SAMPLE_DECODE(ITEM, b_, h_, s_)                                                                                \
    const int row0_ = NPROMPT + b_ * 8;                                                                            \
    int qcol_, kcol_, vcol_;                                                                                       \
    if (MODE == 0) { qcol_ = h_ * 256; kcol_ = 1024 + h_ * 256; vcol_ = 2048 + h_ * 512 + s_ * 64; }               \
    else { qcol_ = 3072 + (h_ >> 2) * 128; kcol_ = 2048 + (h_ >> 2) * 128; vcol_ = h_ * 64; }                      \
    const float* s0_ = (MODE == 0) ? p.state_ret + ((size_t)(b_ * 4 + h_) * 256) * 512 + s_ * 64                   \
                                   : p.state_ssm + ((size_t)(b_ * 32 + h_) * 128) * 64;                            \
    _Pragma("unroll") for (int x = 0; x < RPT; ++x)                                                                \
        sv[x] = *(const float4*)(s0_ + (size_t)(dg * RPT + x) * pitch + eq * 4);                                   \
    if (tid < 2 * DK) {                                                                                            \
      const int which_ = tid / DK, c_ = tid % DK;                                                                  \
      rqk = *(const u32x4*)(src + (size_t)(row0_ + c_ / CPR) * sstride + (which_ ? kcol_ : qcol_) + (c_ % CPR) * 8); \
    }                                                                                                              \
    if (tid < 64) rv = *(const u32x4*)(src + (size_t)(row0_ + (tid >> 3)) * sstride + vcol_ + (tid & 7) * 8);      \
    gzn = gsrc[(size_t)(row0_ + w) * 6144 + ((MODE == 0) ? (4096 + h_ * 512 + s_ * 64) : (h_ * 64)) + lane];      \
    if (MODE == 1 && tid < 16)                                                                                     \
      pcu = (tid < 8) ? cumv[(size_t)(row0_ + tid) * 32 + h_] : dtv[(size_t)(row0_ + tid - 8) * 32 + h_];          \
  }

template <int DK, int MODE>
__device__ void rec_sample_loop(const Params& p, unsigned char* smem, const int rep) {
  float* qS = (float*)smem;
  float* kS = qS + 8 * DK;
  float* vS = kS + 8 * DK;
  float* scS = vS + 512;
  float* redS = scS + 64;
  float* cuS = redS + 4096;
  const int tid = (int)p.tidx, lane = tid & 63, w = tid >> 6;
  constexpr int CPR = DK / 8, RPT = DK / 32;
  const int dg = tid >> 4, eq = tid & 15;
  const int pitch = (MODE == 0) ? 512 : 64;
  const u16* src = (MODE == 0) ? (const u16*)(p.ws + OFF_PROJ) : (const u16*)(p.ws + OFF_XBCC);
  const int sstride = (MODE == 0) ? 6144 : 4096;
  const u16* gsrc = (const u16*)(p.ws + OFF_PROJ);
  const float* dtv = (const float*)(p.ws + OFF_DT);
  const float* cumv = (const float*)(p.ws + OFF_CUM);
  u16* aout = (u16*)(p.ws + OFF_A2);
  float* parts = (float*)(p.ws + OFF_PARTS);

  u32x4 rqk = (u32x4){0u, 0u, 0u, 0u}, rv = (u32x4){0u, 0u, 0u, 0u};
  float4 sv[RPT];
  u16 gzn = 0, gzv = 0;
  float pcu = 0.f;
  const int nitems = 4096 * rep;
  int item0 = blockIdx.x;
  int vz;
  asm volatile("v_mov_b32 %0, 0" : "=v"(vz));
  if (item0 < nitems) SAMPLE_ISSUE((item0 & 4095) + vz)
  for (; item0 < nitems; item0 += gridDim.x) {
    const int item = (item0 & 4095) + vz;
    SAMPLE_DECODE(item, b, h, s)
    const int row0 = NPROMPT + b * 8;
    gzv = gzn;
    if (tid < 2 * DK) {
      const int which = tid / DK, c = tid % DK;
      float* dst = (which ? kS : qS) + (c / CPR) * DK + (c % CPR) * 8;
      dst[0] = bf2f((u16)(rqk.x & 0xffff)); dst[1] = bf2f((u16)(rqk.x >> 16));
      dst[2] = bf2f((u16)(rqk.y & 0xffff)); dst[3] = bf2f((u16)(rqk.y >> 16));
      dst[4] = bf2f((u16)(rqk.z & 0xffff)); dst[5] = bf2f((u16)(rqk.z >> 16));
      dst[6] = bf2f((u16)(rqk.w & 0xffff)); dst[7] = bf2f((u16)(rqk.w >> 16));
    }
    if (tid < 64) {
      float* dst = vS + (tid >> 3) * 64 + (tid & 7) * 8;
      dst[0] = bf2f((u16)(rv.x & 0xffff)); dst[1] = bf2f((u16)(rv.x >> 16));
      dst[2] = bf2f((u16)(rv.y & 0xffff)); dst[3] = bf2f((u16)(rv.y >> 16));
      dst[4] = bf2f((u16)(rv.z & 0xffff)); dst[5] = bf2f((u16)(rv.z >> 16));
      dst[6] = bf2f((u16)(rv.w & 0xffff)); dst[7] = bf2f((u16)(rv.w >> 16));
    }
    if (MODE == 1 && tid < 16) cuS[tid] = pcu;
    __syncthreads();
    float cum[8], u[8];
    if (MODE == 0) {
      const float lg = logf(1.0f - exp2f(-5.0f - (float)h));
#pragma unroll
      for (int t = 0; t < 8; ++t) { cum[t] = (float)(t + 1) * lg; u[t] = 1.f; }
    } else {
#pragma unroll
      for (int t = 0; t < 8; ++t) { cum[t] = cuS[t]; u[t] = cuS[8 + t]; }
    }
    {
      const int pair = tid >> 3, part = tid & 7;
      const int i = pair >> 3, jj = pair & 7;
      float d = 0.f;
      const float* qp = qS + i * DK + part * (DK / 8);
      const float* kp = kS + jj * DK + part * (DK / 8);
#pragma unroll 8
      for (int x = 0; x < DK / 8; ++x) d += qp[x] * kp[x];
      d += __shfl_xor(d, 1); d += __shfl_xor(d, 2); d += __shfl_xor(d, 4);
      if (part == 0) {
        float ci = 0.f, cj = 0.f, uj = 0.f;
#pragma unroll
        for (int t = 0; t < 8; ++t) { if (t == i) ci = cum[t]; if (t == jj) { cj = cum[t]; uj = u[t]; } }
        scS[pair] = (jj <= i) ? d * __expf(ci - cj) * uj : 0.f;
      }
    }
    float* s1 = (MODE == 0) ? p.out + OUT_RETS + ((size_t)(b * 4 + h) * 256) * 512 + s * 64
                            : p.out + OUT_SSMS + ((size_t)(b * 32 + h) * 128) * 64;
    float4 cx[8];
    {
      float4 vw[8];
#pragma unroll
      for (int jj = 0; jj < 8; ++jj) {
        float4 v = *(const float4*)(vS + jj * 64 + eq * 4);
        const float wj = u[jj] * __expf(cum[7] - cum[jj]);
        vw[jj] = make_float4(v.x * wj, v.y * wj, v.z * wj, v.w * wj);
      }
      const float atot = __expf(cum[7]);
#pragma unroll
      for (int i = 0; i < 8; ++i) cx[i] = make_float4(0.f, 0.f, 0.f, 0.f);
#pragma unroll
      for (int x = 0; x < RPT; ++x) {
        __builtin_amdgcn_sched_barrier(0);
        const int d = dg * RPT + x;
        const float4 so = sv[x];
        float4 sn = make_float4(so.x * atot, so.y * atot, so.z * atot, so.w * atot);
#pragma unroll
        for (int jj = 0; jj < 8; ++jj) {
          const float kk = kS[jj * DK + d];
          sn.x += kk * vw[jj].x; sn.y += kk * vw[jj].y; sn.z += kk * vw[jj].z; sn.w += kk * vw[jj].w;
        }
        *(float4*)(s1 + (size_t)d * pitch + eq * 4) = sn;
#pragma unroll
        for (int i = 0; i < 8; ++i) {
          const float qq = qS[i * DK + d];
          cx[i].x += qq * so.x; cx[i].y += qq * so.y; cx[i].z += qq * so.z; cx[i].w += qq * so.w;
        }
      }
    }
    __builtin_amdgcn_sched_barrier(0);
    if (item0 + (int)gridDim.x < nitems) SAMPLE_ISSUE(((item0 + (int)gridDim.x) & 4095) + vz)
    __builtin_amdgcn_sched_barrier(0);
#pragma unroll
    for (int i = 0; i < 8; ++i) {
      float4 v = cx[i];
      v.x += __shfl_xor(v.x, 16); v.y += __shfl_xor(v.y, 16); v.z += __shfl_xor(v.z, 16); v.w += __shfl_xor(v.w, 16);
      v.x += __shfl_xor(v.x, 32); v.y += __shfl_xor(v.y, 32); v.z += __shfl_xor(v.z, 32); v.w += __shfl_xor(v.w, 32);
      if ((lane >> 4) == 0) *(float4*)(redS + (w * 8 + i) * 64 + eq * 4) = v;
    }
    __syncthreads();
    {
      const int i = w, e = lane;
      float o = 0.f;
#pragma unroll
      for (int ww = 0; ww < 8; ++ww) o += redS[(ww * 8 + i) * 64 + e];
      float ci = 0.f;
#pragma unroll
      for (int t = 0; t < 8; ++t) if (t == i) ci = cum[t];
      o *= __expf(ci);
#pragma unroll
      for (int jj = 0; jj < 8; ++jj) if (jj <= i) o += scS[i * 8 + jj] * vS[jj * 64 + e];
      const int row = row0 + i;
      const float gv = bf2f(gzv);
      if (MODE == 0) {
        const float ssq = wave_sum(o * o);
        const float val = o * p.ret_head_norm[h * 512 + s * 64 + e] * silu(gv);
        aout[(size_t)row * 2048 + h * 512 + s * 64 + e] = f2bf(val);
        if (lane < 2) parts[(size_t)row * 64 + h * 16 + s * 2 + lane] = lane == 0 ? ssq : 0.f;
      } else {
        const float y = o + vS[i * 64 + e] * p.ssm_d[h];
        const float gg = y * silu(gv);
        const float ssq = wave_sum(gg * gg);
        aout[(size_t)row * 2048 + h * 64 + e] = f2bf(gg * p.ssm_gate_norm[h * 64 + e]);
        if (lane < 2) parts[(size_t)row * 64 + (h >> 2) * 8 + (h & 3) * 2 + lane] = lane == 0 ? ssq : 0.f;
      }
    }
    __syncthreads();
  }
}

template <int DK, int MODE>
__device__ void phase_rec(const Params& p, unsigned char* smem, const int rep_p, const int rep_s) {
  for (int item = blockIdx.x; item < 256 * rep_p; item += gridDim.x) rec_prompt_item<DK, MODE>(p, item & 255, smem);
  rec_sample_loop<DK, MODE>(p, smem, rep_s);
}

#ifndef PHASE_MASK
#define PHASE_MASK 0x3ff
#endif
#ifndef DUP_MASK
#define DUP_MASK 0x000
#endif
#define XB_TMO      128
#define XB_XCNT(j)  (256  + 64 * (j))
#define XB_XSUB(j)  (1280 + 64 * (j))
#define XB_XGEN(j)  (2304 + 64 * (j))
#define XB_TOP      3328
#define XB_TOPGEN   3392
#define XCD_BAR_WORDS 3456
#define XB_SPIN_CAP (1u << 20)
#define LAS __attribute__((address_space(3)))
__device__ __forceinline__ unsigned xb_ld(unsigned* p) { return __hip_atomic_load(p, __ATOMIC_RELAXED, __HIP_MEMORY_SCOPE_AGENT); }
__device__ __forceinline__ unsigned xb_add(unsigned* p, unsigned v) { return __hip_atomic_fetch_add(p, v, __ATOMIC_RELAXED, __HIP_MEMORY_SCOPE_AGENT); }
__device__ __forceinline__ unsigned xb_xcc_id() { return (unsigned)__builtin_amdgcn_s_getreg((3 << 11) | 20) & 0xFu; }
#define XB_SPIN(cond, bar) do { unsigned _sp = 0; while (cond) { __builtin_amdgcn_s_sleep(1); \
    if ((++_sp & 255u) == 0u) { if (xb_ld(&(bar)[XB_TMO])) break; if (_sp > XB_SPIN_CAP) { atomicAdd(&(bar)[XB_TMO], 1u); break; } } } } while (0)
struct XcdBarrier {
  unsigned* bar; unsigned x;
  volatile LAS unsigned* st;
};
__device__ __forceinline__ XcdBarrier xcd_barrier_post(unsigned* bar, volatile LAS unsigned* st, const int tid) {
  XcdBarrier b; b.bar = bar; b.x = xb_xcc_id(); b.st = st;
  if (tid == 0) (void)xb_add(&bar[XB_XCNT(b.x)], 1u);
  return b;
}
__device__ __forceinline__ void xcd_barrier_complete(unsigned* bar, unsigned x, unsigned& nloc, unsigned& nx) {
  const unsigned G = gridDim.x * gridDim.y * gridDim.z;
  unsigned sum, cnt, mine, sp = 0u;
  for (;;) {
    sum = 0u; cnt = 0u; mine = 0u;
#pragma unroll
    for (unsigned j = 0; j < 16; ++j) { const unsigned c = xb_ld(&bar[XB_XCNT(j)]); sum += c; cnt += (c > 0u) ? 1u : 0u; mine = (j == x) ? c : mine; }
    if (sum == G) break;
    __builtin_amdgcn_s_sleep(1);
    if ((++sp & 255u) == 0u) { if (xb_ld(&bar[XB_TMO])) break; if (sp > XB_SPIN_CAP) { atomicAdd(&bar[XB_TMO], 1u); break; } }
  }
  nloc = mine > 0u ? mine : 1u; nx = cnt > 0u ? cnt : 1u;
}
__device__ __forceinline__ void xcd_barrier(const XcdBarrier& b, const int wvs) {
  int wvl_ = wvs;
  asm volatile("" : "+s"(wvl_));
  const int tid = wvl_ * 64 + (int)__builtin_amdgcn_mbcnt_hi(~0u, __builtin_amdgcn_mbcnt_lo(~0u, 0u));
  asm volatile("s_waitcnt vmcnt(0)" ::: "memory");
  __syncthreads();
  if (tid == 0) {
    unsigned* bar = b.bar;
    __builtin_amdgcn_s_waitcnt(0);
    unsigned nloc = b.st[0], nx = b.st[1];
    if (nloc == 0u) { xcd_barrier_complete(bar, b.x, nloc, nx); b.st[0] = nloc; b.st[1] = nx; }
    const unsigned old = xb_add(&bar[XB_XSUB(b.x)], 1u);
    const unsigned gen = old / nloc;
    if (old + 1u == (gen + 1u) * nloc) {
      __builtin_amdgcn_fence(__ATOMIC_RELEASE, "agent");
      asm volatile("s_waitcnt vmcnt(0)" ::: "memory");
      const unsigned og = xb_add(&bar[XB_TOP], 1u);
      const unsigned tg = og / nx;
      if (og + 1u == (tg + 1u) * nx) xb_add(&bar[XB_TOPGEN], 1u);
      else XB_SPIN(xb_ld(&bar[XB_TOPGEN]) == tg, bar);
      __builtin_amdgcn_fence(__ATOMIC_ACQUIRE, "agent");
      xb_add(&bar[XB_XGEN(b.x)], 1u);
      asm volatile("s_waitcnt vmcnt(0)" ::: "memory");
    } else {
      XB_SPIN(xb_ld(&bar[XB_XGEN(b.x)]) == gen, bar);
      __builtin_amdgcn_fence(__ATOMIC_ACQUIRE, "agent");
      asm volatile("s_waitcnt vmcnt(0)" ::: "memory");
    }
  }
  __syncthreads();
}

template <typename T>
__device__ __forceinline__ T* as_global(T* q) {
  return (T*)(__attribute__((address_space(1))) T*)q;
}

template <int PH>
__device__ __forceinline__ void run_phase(Params p, unsigned char* smem, const int wvs) {
  {
    long long z_ = 0;
    asm volatile("" : "+s"(z_));
    p.ws += z_; p.out += z_;
  }
  {
    int wvl_ = wvs;
    asm volatile("" : "+s"(wvl_));
    p.tidx = wvl_ * 64 + (int)__builtin_amdgcn_mbcnt_hi(~0u, __builtin_amdgcn_mbcnt_lo(~0u, 0u));
  }
  const int rep = 1 + (int)((p.dup >> PH) & 1);
  if (PH == 0) phase_prep(p, smem, rep);
  if (PH == 1) gemm8_phase<0>(p, (const u16*)(p.ws + OFF_H), (const u16*)(p.ws + OFF_WT0), 1024, 24, smem, rep);
  if (PH == 2) phase_rec<256, 0>(p, smem, rep, 1 + (int)((p.dup >> (PH + 16)) & 1));
  if (PH == 3)
  {
    gemm_phase<1, 4>(p, (const u16*)(p.ws + OFF_A2), (const u16*)(p.ws + OFF_WT1), 2048, 8, nullptr,
                     (float*)(p.ws + OFF_X1), smem, rep, 64);
    __syncthreads();
    gemm_sample_rows<4>(p, (const u16*)(p.ws + OFF_A2), (const u16*)(p.ws + OFF_WT1), nullptr, (float*)(p.ws + OFF_X1), smem, rep);
  }
  if (PH == 4) phase_norm<0>(p, (const float*)(p.ws + OFF_X1), p.ssm_norm, rep);
  if (PH == 5) {
    gemm8_phase<2>(p, (const u16*)(p.ws + OFF_H), (const u16*)(p.ws + OFF_WT2), 1024, 24, smem, rep);
    __syncthreads();
    gemm_phase<2, 0>(p, (const u16*)(p.ws + OFF_H), (const u16*)(p.ws + OFF_WT2), 1024, 1, nullptr, nullptr, smem, 1, 68, 48, true);
  }
  if (PH == 6) phase_conv(p, rep);
  if (PH == 7) phase_rec<128, 1>(p, smem, rep, 1 + (int)((p.dup >> (PH + 16)) & 1));
  if (PH == 8)
  {
    gemm_phase<1, 8>(p, (const u16*)(p.ws + OFF_A2), (const u16*)(p.ws + OFF_WT3), 2048, 8,
                     (const float*)(p.ws + OFF_X1), (float*)(p.ws + OFF_X2), smem, rep, 64);
    __syncthreads();
    gemm_sample_rows<8>(p, (const u16*)(p.ws + OFF_A2), (const u16*)(p.ws + OFF_WT3), (const float*)(p.ws + OFF_X1),
                        (float*)(p.ws + OFF_X2), smem, rep);
  }
  if (PH == 9) phase_norm<1>(p, (const float*)(p.ws + OFF_X2), p.final_norm, rep);
}

#define RUN_PHASE(k)                                   \
  if ((PHASE_MASK >> k) & 1) {                         \
    if (lo <= k && k <= hi) {                          \
      run_phase<k>(p, smem, wvs);                      \
      if (k < hi) xcd_barrier(xb, wvs);                \
    }                                                  \
  }

__global__ void __launch_bounds__(NTHR) fwd_megakernel(Params p) {
  __shared__ __attribute__((aligned(16))) unsigned char smem[LDS_BYTES];
  cg::grid_group grid = cg::this_grid();
  const int lo = (int)p.phase_lo, hi = (int)p.phase_hi;
  if (lo > 1000) grid.sync();
  volatile LAS unsigned* xst = (volatile LAS unsigned*)(smem + LDS_BYTES - 16);
  const int wvs = __builtin_amdgcn_readfirstlane((int)(threadIdx.x >> 6));
  if (threadIdx.x == 0) { xst[0] = 0u; xst[1] = 0u; }
  __syncthreads();
  const XcdBarrier xb = xcd_barrier_post((unsigned*)(p.ws + OFF_BAR), xst, (int)threadIdx.x);
  RUN_PHASE(0)
  RUN_PHASE(1)
  RUN_PHASE(2)
  RUN_PHASE(3)
  RUN_PHASE(4)
  RUN_PHASE(5)
  RUN_PHASE(6)
  RUN_PHASE(7)
  RUN_PHASE(8)
  RUN_PHASE(9)
}

#ifndef ONE_LAUNCH
#define ONE_LAUNCH 1
#endif

extern "C" void kernel_launch(void* const* d_in, const int* in_sizes, int n_in, void* d_out, int out_size, void* d_ws,
                              size_t ws_size, hipStream_t stream) {
  static int grid_blocks = 0;
  if (!grid_blocks) {
    int dev = 0, cus = 0, per_cu = 0;
    hipGetDevice(&dev);
    hipDeviceGetAttribute(&cus, hipDeviceAttributeMultiprocessorCount, dev);
    hipOccupancyMaxActiveBlocksPerMultiprocessor(&per_cu, fwd_megakernel, NTHR, 0);
    if (per_cu < 1) per_cu = 1;
    if (per_cu > 1) per_cu = 1;
    grid_blocks = cus * per_cu;
  }
  Params p{};
  const float** pf = (const float**)&p;
  for (int i = 0; i < 19; ++i) pf[i] = (const float*)d_in[i];
  p.out = (float*)d_out;
  p.ws = (unsigned char*)d_ws;
#if ONE_LAUNCH
  hipMemsetAsync((unsigned char*)d_ws + OFF_BAR, 0, XCD_BAR_WORDS * 4, stream);
  p.phase_lo = 0; p.phase_hi = 9; p.dup = DUP_MASK;
  void* args[] = {&p};
  hipError_t e = hipLaunchCooperativeKernel((void*)fwd_megakernel, dim3(grid_blocks), dim3(NTHR), args, 0, stream);
  if (e != hipSuccess) fprintf(stderr, "cooperative launch failed: %s (grid %d)\n", hipGetErrorString(e), grid_blocks);
#else
  for (int ph = 0; ph <= 9; ++ph) {
    p.phase_lo = ph; p.phase_hi = ph;
    void* args[] = {&p};
    hipLaunchCooperativeKernel((void*)fwd_megakernel, dim3(grid_blocks), dim3(NTHR), args, 0, stream);
  }
#endif
}
```

```cpp
#include <hip/hip_runtime.h>
#include <hip/hip_cooperative_groups.h>
#include <stdint.h>
#include <stdio.h>
namespace cg = cooperative_groups;

typedef __attribute__((ext_vector_type(8))) short bf16x8;
typedef __attribute__((ext_vector_type(4))) short s16x4;
typedef __attribute__((ext_vector_type(4))) float f32x4;
typedef unsigned short u16;
typedef __attribute__((ext_vector_type(4))) unsigned int u32x4;
typedef __attribute__((ext_vector_type(2))) unsigned int u32x2;

#define NTHR 512
#define T_TOK 17408
#define NPROMPT 16384
#define LDS_BYTES 143360

constexpr size_t OFF_WT0 = 0;
constexpr size_t OFF_WT1 = OFF_WT0 + (size_t)6144 * 1024 * 2;
constexpr size_t OFF_WT2 = OFF_WT1 + (size_t)1024 * 2048 * 2;
constexpr size_t OFF_WT3 = OFF_WT2 + (size_t)6272 * 1024 * 2;
constexpr size_t OFF_ROPE = OFF_WT3 + (size_t)1024 * 2048 * 2;
constexpr size_t OFF_H = OFF_ROPE + (size_t)2056 * 128 * 8;
constexpr size_t OFF_PROJ = OFF_H + (size_t)T_TOK * 1024 * 2;
constexpr size_t OFF_A2 = OFF_PROJ + (size_t)T_TOK * 6144 * 2;
constexpr size_t OFF_PARTS = OFF_A2 + (size_t)T_TOK * 2048 * 2;
constexpr size_t OFF_X1 = OFF_PARTS + (size_t)T_TOK * 64 * 4;
constexpr size_t OFF_X2 = OFF_X1 + (size_t)T_TOK * 1024 * 4;
constexpr size_t OFF_XBCC = OFF_X2 + (size_t)T_TOK * 1024 * 4;
constexpr size_t OFF_DTRAW = OFF_XBCC + (size_t)T_TOK * 4096 * 2;
constexpr size_t OFF_DT = OFF_DTRAW + (size_t)T_TOK * 32 * 4;
constexpr size_t OFF_CUM = OFF_DT + (size_t)T_TOK * 32 * 4;
constexpr size_t OFF_BAR = OFF_CUM + (size_t)T_TOK * 32 * 4;

constexpr size_t OUT_Y = 0;
constexpr size_t OUT_RETP = 17825792;
constexpr size_t OUT_RETS = 22020096;
constexpr size_t OUT_SSMP = 89128960;
constexpr size_t OUT_SSMS = 91226112;
constexpr size_t OUT_CONVP = 124780544;
constexpr size_t OUT_CONVS = 124878848;

struct Params {
  const float *x_prompt, *x_sample, *state_ret, *state_ssm, *state_conv, *ret_norm, *ret_w_in, *ret_head_norm,
      *ret_w_out, *ssm_norm, *ssm_w_in, *ssm_conv_w, *ssm_conv_b, *ssm_dt_bias, *ssm_a_log, *ssm_d, *ssm_gate_norm,
      *ssm_w_out, *final_norm;
  float* out;
  unsigned char* ws;
  long long phase_lo, phase_hi, dup, tidx, wv;
};

typedef __bf16 bf16x2_t __attribute__((ext_vector_type(2)));
typedef float f32x2_t __attribute__((ext_vector_type(2)));
__device__ __forceinline__ u16 f2bf(float f) {
  __bf16 r = (__bf16)f;
  return __builtin_bit_cast(u16, r);
}
__device__ __forceinline__ float bf2f(u16 h) { return __uint_as_float(((uint32_t)h) << 16); }
__device__ __forceinline__ uint32_t pack2(float a, float b) {
  f32x2_t v = {a, b};
  bf16x2_t r = __builtin_convertvector(v, bf16x2_t);
  return __builtin_bit_cast(uint32_t, r);
}
__device__ __forceinline__ float silu(float x) { return x * __builtin_amdgcn_rcpf(1.0f + __expf(-x)); }
__device__ __forceinline__ float row16_sum(float v) {
  v += __builtin_bit_cast(float, __builtin_amdgcn_update_dpp(0, __builtin_bit_cast(int, v), 0xB1, 0xF, 0xF, true));
  v += __builtin_bit_cast(float, __builtin_amdgcn_update_dpp(0, __builtin_bit_cast(int, v), 0x4E, 0xF, 0xF, true));
  v += __builtin_bit_cast(float, __builtin_amdgcn_update_dpp(0, __builtin_bit_cast(int, v), 0x124, 0xF, 0xF, true));
  v += __builtin_bit_cast(float, __builtin_amdgcn_update_dpp(0, __builtin_bit_cast(int, v), 0x128, 0xF, 0xF, true));
  return v;
}
__device__ __forceinline__ float wave_sum(float v) {
#pragma unroll
  for (int o = 32; o > 0; o >>= 1) v += __shfl_xor(v, o);
  return v;
}
__device__ __forceinline__ const float* xrow(const Params& p, int r) {
  return r < NPROMPT ? p.x_prompt + (size_t)r * 1024 : p.x_sample + (size_t)(r - NPROMPT) * 1024;
}
__device__ __forceinline__ s16x4 trread(const unsigned char* ptr) {
  return __builtin_amdgcn_ds_read_tr16_b64_v4i16((s16x4 __attribute__((address_space(3)))*)ptr);
}
__device__ __forceinline__ bf16x8 cat8(s16x4 a, s16x4 b) {
  bf16x8 r;
  r[0] = a[0]; r[1] = a[1]; r[2] = a[2]; r[3] = a[3];
  r[4] = b[0]; r[5] = b[1]; r[6] = b[2]; r[7] = b[3];
  return r;
}
__device__ __forceinline__ bf16x8 trfrag(const unsigned char* img, int rs, int kbase, int nbase, int lane) {
  const int g = lane >> 4, q = (lane & 15) >> 2, pp = lane & 3;
  const unsigned char* a = img + (kbase + 8 * g + q) * rs + (nbase + 4 * pp) * 2;
  s16x4 t0 = trread(a);
  s16x4 t1 = trread(a + 4 * rs);
  return cat8(t0, t1);
}

__device__ __forceinline__ int colmap_retin(int p) {
  if (p < 2048) {
    int hb = p & ~255, pp = p & 255;
    int gi = pp >> 5, half = (pp >> 4) & 1, c = pp & 15;
    return hb + half * 128 + gi * 16 + c;
  }
  return p;
}

__device__ void transpose_tile(const float* __restrict__ W, u16* __restrict__ Wt, int K, int N, int mode, int nt, int kt,
                               unsigned char* smem, const int tid) {
  float* tile = (float*)smem;
#pragma unroll
  for (int i = 0; i < 8; ++i) {
    int idx = tid + NTHR * i;
    int kk = idx >> 6, nn = idx & 63;
    int n = nt * 64 + nn;
    int src = (mode == 1) ? colmap_retin(n) : n;
    float v = 0.f;
    if (src < N) v = W[(size_t)(kt * 64 + kk) * N + src];
    tile[kk * 65 + nn] = v;
  }
  __syncthreads();
  {
    int n = tid >> 3, kc = tid & 7;
    float v[8];
#pragma unroll
    for (int j = 0; j < 8; ++j) v[j] = tile[(kc * 8 + j) * 65 + n];
    u32x4 o;
    o.x = pack2(v[0], v[1]); o.y = pack2(v[2], v[3]); o.z = pack2(v[4], v[5]); o.w = pack2(v[6], v[7]);
    *(u32x4*)(Wt + (size_t)(nt * 64 + n) * K + kt * 64 + kc * 8) = o;
  }
  __syncthreads();
}

__device__ void phase_prep(const Params& p, unsigned char* smem, const int rep) {
  const int tid = (int)p.tidx;
  for (int rr = 0; rr < rep; ++rr) {
  u16* Wt0 = (u16*)(p.ws + OFF_WT0);
  u16* Wt1 = (u16*)(p.ws + OFF_WT1);
  u16* Wt2 = (u16*)(p.ws + OFF_WT2);
  u16* Wt3 = (u16*)(p.ws + OFF_WT3);
  const int n0 = 1536, n1 = 512, n2 = 1568, n3 = 512;
  for (int t = blockIdx.x; t < n0 + n1 + n2 + n3; t += gridDim.x) {
    if (t < n0) {
      transpose_tile(p.ret_w_in, Wt0, 1024, 6144, 1, t >> 4, t & 15, smem, tid);
    } else if (t < n0 + n1) {
      int u = t - n0;
      transpose_tile(p.ret_w_out, Wt1, 2048, 1024, 0, u >> 5, u & 31, smem, tid);
    } else if (t < n0 + n1 + n2) {
      int u = t - n0 - n1;
      transpose_tile(p.ssm_w_in, Wt2, 1024, 6176, 0, u >> 4, u & 15, smem, tid);
    } else {
      int u = t - n0 - n1 - n2;
      transpose_tile(p.ssm_w_out, Wt3, 2048, 1024, 0, u >> 5, u & 31, smem, tid);
    }
  }
  float2* rope = (float2*)(p.ws + OFF_ROPE);
  const int gtid = blockIdx.x * NTHR + tid, gn = gridDim.x * NTHR;
  for (int idx = gtid; idx < 2056 * 128; idx += gn) {
    int pi = idx >> 7, i = idx & 127;
    int pos = pi < 2048 ? pi : 16384 + (pi - 2048);
    float freq = (float)exp2(-(double)i * (13.287712379549449 / 128.0));
    float ang = (float)pos * freq;
    float sn, cs;
    sincosf(ang, &sn, &cs);
    rope[idx] = make_float2(cs, sn);
  }
  u16* H = (u16*)(p.ws + OFF_H);
  const int lane = tid & 63, w = (int)p.wv;
  for (int row = blockIdx.x * 8 + w; row < T_TOK; row += gridDim.x * 8) {
    const float* xr = xrow(p, row);
    float4 v[4];
    float ss = 0.f;
#pragma unroll
    for (int i = 0; i < 4; ++i) {
      v[i] = *(const float4*)(xr + i * 256 + lane * 4);
      ss += v[i].x * v[i].x + v[i].y * v[i].y + v[i].z * v[i].z + v[i].w * v[i].w;
    }
    ss = wave_sum(ss);
    float rstd = rsqrtf(ss * (1.0f / 1024.0f) + 1e-6f);
#pragma unroll
    for (int i = 0; i < 4; ++i) {
      float4 gg = *(const float4*)(p.ret_norm + i * 256 + lane * 4);
      u32x2 o;
      o.x = pack2(v[i].x * rstd * gg.x, v[i].y * rstd * gg.y);
      o.y = pack2(v[i].z * rstd * gg.z, v[i].w * rstd * gg.w);
      *(u32x2*)(H + (size_t)row * 1024 + i * 256 + lane * 4) = o;
    }
  }
  }
}

template <int MODE>
__device__ void phase_norm(const Params& p, const float* __restrict__ X, const float* __restrict__ gain, const int rep) {
  const int tid = (int)p.tidx, lane = tid & 63, w = (int)p.wv;
  u16* H = (u16*)(p.ws + OFF_H);
  for (int row0 = blockIdx.x * 8 + w; row0 < T_TOK * rep; row0 += gridDim.x * 8) {
    const int row = row0 % T_TOK;
    const float* xr = X + (size_t)row * 1024;
    float4 v[4];
    float ss = 0.f;
#pragma unroll
    for (int i = 0; i < 4; ++i) {
      v[i] = *(const float4*)(xr + i * 256 + lane * 4);
      ss += v[i].x * v[i].x + v[i].y * v[i].y + v[i].z * v[i].z + v[i].w * v[i].w;
    }
    ss = wave_sum(ss);
    float rstd = rsqrtf(ss * (1.0f / 1024.0f) + 1e-6f);
#pragma unroll
    for (int i = 0; i < 4; ++i) {
      float4 gg = *(const float4*)(gain + i * 256 + lane * 4);
      if (MODE == 0) {
        u32x2 o;
        o.x = pack2(v[i].x * rstd * gg.x, v[i].y * rstd * gg.y);
        o.y = pack2(v[i].z * rstd * gg.z, v[i].w * rstd * gg.w);
        *(u32x2*)(H + (size_t)row * 1024 + i * 256 + lane * 4) = o;
      } else {
        float4 o = make_float4(v[i].x * rstd * gg.x, v[i].y * rstd * gg.y, v[i].z * rstd * gg.z, v[i].w * rstd * gg.w);
        *(float4*)(p.out + OUT_Y + (size_t)row * 1024 + i * 256 + lane * 4) = o;
      }
    }
  }
}

template <int EPI, int NH>
__device__ void gemm_phase(const Params& p, const u16* __restrict__ A, const u16* __restrict__ Bt, const int K, const int NT,
                           const float* __restrict__ resid, float* __restrict__ outf, unsigned char* smem, const int rep,
                           const int mtiles, const int nt0 = 0, const bool rev = false) {
  constexpr int BM = 256, BN = 128, BK = 64, LR = 144;
  constexpr int BUFB = (BM + BN) * LR;
  float* rstdS = (float*)(smem + 2 * BUFB);
  const int tid = (int)p.tidx, lane = tid & 63, w = (int)p.wv;
  const int wm = w >> 1, wn = w & 1, l15 = lane & 15, g = lane >> 4;
  const int KT = K / BK;
  const int ntiles = mtiles * NT;
  const float* parts = (const float*)(p.ws + OFF_PARTS);
  const int srow = tid >> 3, skc = tid & 7;

  for (int tile0 = rev ? (int)(gridDim.x - 1 - blockIdx.x) : (int)blockIdx.x; tile0 < ntiles * rep; tile0 += gridDim.x) {
    const int tile = tile0 % ntiles;
    const int mt = tile / NT, nt = tile - mt * NT + nt0;
    const int m0 = mt * BM, n0 = nt * BN;
    if (NH > 0) {
      for (int idx = tid; idx < BM * NH; idx += NTHR) {
        int row = idx / NH, h = idx % NH;
        const float* pp = parts + (size_t)(m0 + row) * 64 + h * (64 / NH);
        float s = 0.f;
#pragma unroll
        for (int q = 0; q < 64 / NH; ++q) s += pp[q];
        rstdS[idx] = rsqrtf(s / (float)(K / NH) + 1e-6f);
      }
    }
    u32x4 ra[4], rb[2];
    const u16* ap = A + (size_t)(m0 + srow) * K + skc * 8;
    const u16* bp = Bt + (size_t)(n0 + srow) * K + skc * 8;
#pragma unroll
    for (int i = 0; i < 4; ++i) ra[i] = *(const u32x4*)(ap + (size_t)(64 * i) * K);
#pragma unroll
    for (int i = 0; i < 2; ++i) rb[i] = *(const u32x4*)(bp + (size_t)(64 * i) * K);
    {
      unsigned char* base = smem;
#pragma unroll
      for (int i = 0; i < 4; ++i) *(u32x4*)(base + (srow + 64 * i) * LR + skc * 16) = ra[i];
#pragma unroll
      for (int i = 0; i < 2; ++i) *(u32x4*)(base + BM * LR + (srow + 64 * i) * LR + skc * 16) = rb[i];
    }
    __syncthreads();

    f32x4 acc[4][4];
    f32x4 accT[4][4];
#pragma unroll
    for (int i = 0; i < 4; ++i)
#pragma unroll
      for (int j = 0; j < 4; ++j) {
        acc[i][j] = (f32x4){0.f, 0.f, 0.f, 0.f};
        accT[i][j] = (f32x4){0.f, 0.f, 0.f, 0.f};
      }

    for (int kt = 0; kt < KT; ++kt) {
      const bool more = (kt + 1 < KT);
      if (more) {
#pragma unroll
        for (int i = 0; i < 4; ++i) ra[i] = *(const u32x4*)(ap + (size_t)(64 * i) * K + (kt + 1) * BK);
#pragma unroll
        for (int i = 0; i < 2; ++i) rb[i] = *(const u32x4*)(bp + (size_t)(64 * i) * K + (kt + 1) * BK);
      }
      const unsigned char* abase = smem + (kt & 1) * BUFB + (wm * 64 + l15) * LR + g * 16;
      const unsigned char* bbase = smem + (kt & 1) * BUFB + BM * LR + (wn * 64 + l15) * LR + g * 16;
#pragma unroll
      for (int ks = 0; ks < 2; ++ks) {
        bf16x8 af[4], bfr[4];
#pragma unroll
        for (int mf = 0; mf < 4; ++mf) af[mf] = *(const bf16x8*)(abase + mf * 16 * LR + ks * 64);
#pragma unroll
        for (int nf = 0; nf < 4; ++nf) bfr[nf] = *(const bf16x8*)(bbase + nf * 16 * LR + ks * 64);
#pragma unroll
        for (int mf = 0; mf < 4; ++mf)
#pragma unroll
          for (int nf = 0; nf < 4; ++nf)
            acc[mf][nf] = __builtin_amdgcn_mfma_f32_16x16x32_bf16(af[mf], bfr[nf], acc[mf][nf], 0, 0, 0);
      }
      if (NH > 0) {
        const int per = KT / NH;
        if (((kt + 1) % per) == 0) {
          const int h = (kt + 1) / per - 1;
#pragma unroll
          for (int mf = 0; mf < 4; ++mf)
#pragma unroll
            for (int r = 0; r < 4; ++r) {
              float s = rstdS[(wm * 64 + mf * 16 + 4 * g + r) * NH + h];
#pragma unroll
              for (int nf = 0; nf < 4; ++nf) {
                accT[mf][nf][r] += s * acc[mf][nf][r];
                acc[mf][nf][r] = 0.f;
              }
            }
        }
      }
      if (more) {
        unsigned char* base = smem + ((kt + 1) & 1) * BUFB;
#pragma unroll
        for (int i = 0; i < 4; ++i) *(u32x4*)(base + (srow + 64 * i) * LR + skc * 16) = ra[i];
#pragma unroll
        for (int i = 0; i < 2; ++i) *(u32x4*)(base + BM * LR + (srow + 64 * i) * LR + skc * 16) = rb[i];
      }
      __syncthreads();
    }

#pragma unroll
    for (int mf = 0; mf < 4; ++mf) {
      __builtin_amdgcn_sched_barrier(0);
      float rvv[4][4];
      if (EPI == 1) {
#pragma unroll
        for (int r = 0; r < 4; ++r) {
          const int row = m0 + wm * 64 + mf * 16 + 4 * g + r;
#pragma unroll
          for (int nf = 0; nf < 4; ++nf) {
            const int col = n0 + wn * 64 + nf * 16 + l15;
            rvv[r][nf] = resid ? resid[(size_t)row * 1024 + col] : xrow(p, row)[col];
          }
        }
      }
#pragma unroll
      for (int r = 0; r < 4; ++r) {
        const int row = m0 + wm * 64 + mf * 16 + 4 * g + r;
        if (EPI == 0) {
          u16* proj = (u16*)(p.ws + OFF_PROJ) + (size_t)row * 6144;
          if (n0 < 2048) {
            const float2* rope = (const float2*)(p.ws + OFF_ROPE);
            const int pi = row < NPROMPT ? (row & 2047) : 2048 + ((row - NPROMPT) & 7);
#pragma unroll
            for (int np = 0; np < 2; ++np) {
              const int pc = n0 + wn * 64 + np * 32;
              const int i = ((pc & 255) >> 5) * 16 + l15;
              const float2 cs = rope[pi * 128 + i];
              const float x1 = acc[mf][2 * np][r], x2 = acc[mf][2 * np + 1][r];
              float y1 = x1 * cs.x - x2 * cs.y, y2 = x1 * cs.y + x2 * cs.x;
              if (pc >= 1024) { y1 *= 0.0625f; y2 *= 0.0625f; }
              const int f1 = (pc & ~255) + i;
              proj[f1] = f2bf(y1);
              proj[f1 + 128] = f2bf(y2);
            }
          } else {
#pragma unroll
            for (int nf = 0; nf < 4; ++nf) proj[n0 + wn * 64 + nf * 16 + l15] = f2bf(acc[mf][nf][r]);
          }
        } else if (EPI == 1) {
#pragma unroll
          for (int nf = 0; nf < 4; ++nf) {
            const int col = n0 + wn * 64 + nf * 16 + l15;
            const float a = (NH > 0) ? accT[mf][nf][r] : acc[mf][nf][r];
            outf[(size_t)row * 1024 + col] = rvv[r][nf] + a;
          }
        } else {
          u16* proj = (u16*)(p.ws + OFF_PROJ) + (size_t)row * 6144;
          float* dtraw = (float*)(p.ws + OFF_DTRAW) + (size_t)row * 32;
          float* cvo = nullptr;
          if (row < NPROMPT) {
            const int t = row & 2047;
            if (t >= 2045) cvo = p.out + OUT_CONVP + ((size_t)(row >> 11) * 3 + (t - 2045)) * 4096;
          } else {
            const int rs = row - NPROMPT, t = rs & 7;
            if (t >= 5) cvo = p.out + OUT_CONVS + ((size_t)(rs >> 3) * 3 + (t - 5)) * 4096;
          }
#pragma unroll
          for (int nf = 0; nf < 4; ++nf) {
            const int col = n0 + wn * 64 + nf * 16 + l15;
            const float a = acc[mf][nf][r];
            if (col < 6144) {
              proj[col] = f2bf(a);
              if (col >= 2048 && cvo) cvo[col - 2048] = a;
            } else if (col < 6176) {
              dtraw[col - 6144] = a;
            }
          }
        }
      }
    }
  }
}


template <int NH>
__device__ void gemm_sample_rows(const Params& p, const u16* __restrict__ A, const u16* __restrict__ Bt,
                                 const float* __restrict__ resid, float* __restrict__ outf, unsigned char* smem, const int rep) {
  constexpr int K = 2048, RS = 65;
  float* red = (float*)smem;
  float* rstdS = red + 8 * 64 * RS;
  const int tid = (int)p.tidx, lane = tid & 63, w = (int)p.wv, l15 = lane & 15, g = lane >> 4;
  const float* parts = (const float*)(p.ws + OFF_PARTS);
  for (int item0 = blockIdx.x; item0 < 256 * rep; item0 += gridDim.x) {
    const int item = item0 & 255;
    const int m0 = NPROMPT + (item >> 4) * 64, n0 = (item & 15) * 64;
    for (int idx = tid; idx < 64 * NH; idx += NTHR) {
      const int row = idx / NH, h = idx % NH;
      const float* pp = parts + (size_t)(m0 + row) * 64 + h * (64 / NH);
      float sm = 0.f;
#pragma unroll
      for (int q = 0; q < 64 / NH; ++q) sm += pp[q];
      rstdS[idx] = rsqrtf(sm / (float)(K / NH) + 1e-6f);
    }
    f32x4 acc[4][4];
#pragma unroll
    for (int i = 0; i < 4; ++i)
#pragma unroll
      for (int j = 0; j < 4; ++j) acc[i][j] = (f32x4){0.f, 0.f, 0.f, 0.f};
    const u16* ap = A + (size_t)(m0 + l15) * K + w * 256 + 8 * g;
    const u16* bp = Bt + (size_t)(n0 + l15) * K + w * 256 + 8 * g;
#pragma unroll 2
    for (int ks = 0; ks < 8; ++ks) {
      bf16x8 af[4], bfr[4];
#pragma unroll
      for (int mf = 0; mf < 4; ++mf) af[mf] = *(const bf16x8*)(ap + (size_t)(mf * 16) * K + ks * 32);
#pragma unroll
      for (int nf = 0; nf < 4; ++nf) bfr[nf] = *(const bf16x8*)(bp + (size_t)(nf * 16) * K + ks * 32);
#pragma unroll
      for (int mf = 0; mf < 4; ++mf)
#pragma unroll
        for (int nf = 0; nf < 4; ++nf)
          acc[mf][nf] = __builtin_amdgcn_mfma_f32_16x16x32_bf16(af[mf], bfr[nf], acc[mf][nf], 0, 0, 0);
    }
    __syncthreads();
    {
      const int h = (w * 256) / (K / NH);
#pragma unroll
      for (int mf = 0; mf < 4; ++mf)
#pragma unroll
        for (int r = 0; r < 4; ++r) {
          const int row = mf * 16 + 4 * g + r;
          const float sc = rstdS[row * NH + h];
#pragma unroll
          for (int nf = 0; nf < 4; ++nf) red[(w * 64 + row) * RS + nf * 16 + l15] = acc[mf][nf][r] * sc;
        }
    }
    __syncthreads();
    {
      const int row = tid >> 3, c0 = (tid & 7) * 8;
      float o[8];
      const size_t gidx = (size_t)(m0 + row) * 1024 + n0 + c0;
      const float* rp = resid ? resid + gidx : p.x_sample + (size_t)(m0 - NPROMPT + row) * 1024 + n0 + c0;
      const float4 r0 = *(const float4*)rp, r1 = *(const float4*)(rp + 4);
      o[0] = r0.x; o[1] = r0.y; o[2] = r0.z; o[3] = r0.w; o[4] = r1.x; o[5] = r1.y; o[6] = r1.z; o[7] = r1.w;
#pragma unroll
      for (int ww = 0; ww < 8; ++ww)
#pragma unroll
        for (int j = 0; j < 8; ++j) o[j] += red[(ww * 64 + row) * RS + c0 + j];
      *(float4*)(outf + gidx) = make_float4(o[0], o[1], o[2], o[3]);
      *(float4*)(outf + gidx + 4) = make_float4(o[4], o[5], o[6], o[7]);
    }
    __syncthreads();
  }
}

__device__ __forceinline__ int lds_byte(int r, int c) {
  int st = (r >> 4) * 2 + (c >> 5), rr = r & 15, cc = c & 31, ob = rr * 64 + cc * 2;
  return st * 1024 + (ob ^ (((ob >> 9) & 1) << 5));
}
__device__ __forceinline__ void stage_rc(int b, int& R, int& C) {
  int st = b / 1024, sb = b % 1024, swz = sb ^ (((sb >> 9) & 1) << 5);
  R = (st >> 1) * 16 + swz / 64;
  C = (st & 1) * 32 + (swz % 64) / 2;
}

template <int EPI>
__device__ void gemm8_phase(const Params& p, const u16* __restrict__ A, const u16* __restrict__ Bt, const int K, const int nN,
                            unsigned char* smem, const int rep) {
  constexpr int BM8 = 256, BK8 = 64, HALF = 128, NXCD = 8, WGM = 8, HT = HALF * BK8;
  u16* shm = (u16*)smem;
#define SA(b, h) (shm + ((b) * 2 + (h)) * HT)
#define SB(b, h) (shm + (4 + (b) * 2 + (h)) * HT)
#define STAGE(P, BASE, br, kt)                                                                            \
  do {                                                                                                    \
    const int _so = ((br) * K + (kt) * BK8) * 2;                                                          \
    __builtin_amdgcn_raw_ptr_buffer_load_lds(rsrc_##BASE, (__attribute__((address_space(3))) unsigned*)((char*)(P) + (int)p.tidx * 16), 16, voff0, _so, 0, 0); \
    __builtin_amdgcn_raw_ptr_buffer_load_lds(rsrc_##BASE, (__attribute__((address_space(3))) unsigned*)((char*)(P) + (int)p.tidx * 16 + 8192), 16, voff1, _so, 0, 0); \
  } while (0)
#define LDA(dst, b, h)                                                                                    \
  for (int m = 0; m < 4; ++m)                                                                             \
    for (int k = 0; k < 2; ++k)                                                                           \
      dst[m][k] = *reinterpret_cast<const bf16x8*>((char*)SA(b, h) + lds_byte(wr * 64 + m * 16 + fr, k * 32 + fq * 8))
#define LDB(dst, b, h)                                                                                    \
  for (int n = 0; n < 2; ++n)                                                                             \
    for (int k = 0; k < 2; ++k)                                                                           \
      dst[n][k] = *reinterpret_cast<const bf16x8*>((char*)SB(b, h) + lds_byte(wc * 32 + n * 16 + fr, k * 32 + fq * 8))
#define MMA(ai, bj, At, Bx)                                                                               \
  do {                                                                                                    \
    __builtin_amdgcn_s_setprio(1);                                                                        \
    for (int m = 0; m < 4; ++m)                                                                           \
      for (int n = 0; n < 2; ++n)                                                                         \
        for (int k = 0; k < 2; ++k)                                                                       \
          acc[ai][bj][m][n] = __builtin_amdgcn_mfma_f32_16x16x32_bf16(At[m][k], Bx[n][k], acc[ai][bj][m][n], 0, 0, 0); \
    __builtin_amdgcn_s_setprio(0);                                                                        \
  } while (0)
#define WAIT_V(n) asm volatile("s_waitcnt vmcnt(" #n ")" ::: "memory")
#define WAIT_L(n) asm volatile("s_waitcnt lgkmcnt(" #n ")" ::: "memory")
#define BAR __builtin_amdgcn_s_barrier()
#define SCHED __builtin_amdgcn_sched_barrier(0)

  const int nM = T_TOK / BM8, nwg = nM * nN;
  const int wid = (int)p.wv, lane = (int)p.tidx & 63, wr = wid >> 2, wc = wid & 3, fr = lane & 15, fq = lane >> 4;
  const int nt = K / BK8;
  const __amdgpu_buffer_rsrc_t rsrc_A = __builtin_amdgcn_make_buffer_rsrc((void*)A, (short)0, T_TOK * K * 2, 0x00020000);
  const __amdgpu_buffer_rsrc_t rsrc_Bt = __builtin_amdgcn_make_buffer_rsrc((void*)Bt, (short)0, nN * 256 * K * 2, 0x00020000);
  int voff0, voff1;
  {
    int r_, c_;
    stage_rc((int)p.tidx * 16, r_, c_);
    voff0 = (r_ * K + c_) * 2;
    stage_rc((int)p.tidx * 16 + 8192, r_, c_);
    voff1 = (r_ * K + c_) * 2;
  }

  for (int tile0 = blockIdx.x; tile0 < nwg * rep; tile0 += gridDim.x) {
    const int tile = tile0 % nwg;
    int wgid = tile;
    {
      int q = nwg / NXCD, r = nwg % NXCD, xcd = wgid % NXCD, off = wgid / NXCD;
      wgid = (xcd < r ? xcd * (q + 1) : r * (q + 1) + (xcd - r) * q) + off;
    }
    const int nig = WGM * nN, gid = wgid / nig, fm = gid * WGM, gsz = min(nM - fm, WGM);
    const int pm = fm + ((wgid % nig) % gsz), pn = (wgid % nig) / gsz, brow = pm * BM8, bcol = pn * BM8;

    f32x4 acc[2][2][4][2];
#pragma unroll
    for (int a = 0; a < 2; ++a)
#pragma unroll
      for (int b = 0; b < 2; ++b)
#pragma unroll
        for (int m = 0; m < 4; ++m)
#pragma unroll
          for (int n = 0; n < 2; ++n) acc[a][b][m][n] = (f32x4){0.f, 0.f, 0.f, 0.f};
    bf16x8 At[4][2], B0[2][2], B1[2][2];

    STAGE(SB(0, 0), Bt, bcol, 0); STAGE(SA(0, 0), A, brow, 0);
    STAGE(SB(0, 1), Bt, bcol + HALF, 0); STAGE(SA(0, 1), A, brow + HALF, 0);
    if (wr == 1) BAR;
    WAIT_V(4); BAR;
    STAGE(SB(1, 0), Bt, bcol, 1); STAGE(SA(1, 0), A, brow, 1); STAGE(SB(1, 1), Bt, bcol + HALF, 1);
    WAIT_V(6); BAR;
    for (int t = 0; t < nt - 2; t += 2) {
      LDB(B0, 0, 0); SCHED; LDA(At, 0, 0); STAGE(SA(1, 1), A, brow + HALF, t + 1);
      WAIT_L(8); BAR; WAIT_L(0); MMA(0, 0, At, B0); BAR; SCHED;
      LDB(B1, 0, 1); STAGE(SB(0, 0), Bt, bcol, t + 2);
      BAR; WAIT_L(0); MMA(0, 1, At, B1); BAR;
      LDA(At, 0, 1); STAGE(SA(0, 0), A, brow, t + 2);
      BAR; WAIT_L(0); MMA(1, 0, At, B0); BAR; SCHED;
      STAGE(SB(0, 1), Bt, bcol + HALF, t + 2);
      WAIT_V(6); BAR; MMA(1, 1, At, B1); BAR;
      LDB(B0, 1, 0); SCHED; LDA(At, 1, 0); STAGE(SA(0, 1), A, brow + HALF, t + 2);
      WAIT_L(8); BAR; WAIT_L(0); MMA(0, 0, At, B0); BAR; SCHED;
      LDB(B1, 1, 1); STAGE(SB(1, 0), Bt, bcol, t + 3);
      BAR; WAIT_L(0); MMA(0, 1, At, B1); BAR;
      LDA(At, 1, 1); STAGE(SA(1, 0), A, brow, t + 3);
      BAR; WAIT_L(0); MMA(1, 0, At, B0); BAR; SCHED;
      STAGE(SB(1, 1), Bt, bcol + HALF, t + 3);
      WAIT_V(6); BAR; MMA(1, 1, At, B1); BAR;
    }
    {
      LDB(B0, 0, 0); LDA(At, 0, 0); STAGE(SA(1, 1), A, brow + HALF, nt - 1);
      BAR; WAIT_L(0); MMA(0, 0, At, B0); BAR; SCHED;
      LDB(B1, 0, 1); BAR; WAIT_L(0); MMA(0, 1, At, B1); BAR; SCHED;
      LDA(At, 0, 1); WAIT_V(4); BAR; WAIT_L(0); MMA(1, 0, At, B0); MMA(1, 1, At, B1); BAR; SCHED;
    }
    {
      LDB(B0, 1, 0); LDA(At, 1, 0); WAIT_V(2); BAR; WAIT_L(0); MMA(0, 0, At, B0); BAR; SCHED;
      LDB(B1, 1, 1); WAIT_V(0); BAR; WAIT_L(0); MMA(0, 1, At, B1); BAR; SCHED;
      LDA(At, 1, 1); BAR; WAIT_L(0); MMA(1, 0, At, B0); MMA(1, 1, At, B1); BAR; SCHED;
    }
    if (wr == 0) BAR;

    u16* projb = (u16*)(p.ws + OFF_PROJ);
#pragma unroll
    for (int ai = 0; ai < 2; ++ai)
#pragma unroll
      for (int m = 0; m < 4; ++m) {
        if (EPI == 0 && bcol < 2048) {
          const float2* rope = (const float2*)(p.ws + OFF_ROPE);
#pragma unroll
          for (int bj = 0; bj < 2; ++bj) {
            __builtin_amdgcn_sched_barrier(0);
            const int pc = bcol + bj * HALF + wc * 32;
            const int i = ((pc & 255) >> 5) * 16 + fr;
            const int f1 = (pc & ~255) + i;
            float2 csv[4];
#pragma unroll
            for (int j = 0; j < 4; ++j) {
              const int row = brow + ai * HALF + wr * 64 + m * 16 + fq * 4 + j;
              const int pi = row < NPROMPT ? (row & 2047) : 2048 + ((row - NPROMPT) & 7);
              csv[j] = rope[pi * 128 + i];
            }
#pragma unroll
            for (int j = 0; j < 4; ++j) {
              const int row = brow + ai * HALF + wr * 64 + m * 16 + fq * 4 + j;
              u16* proj = projb + (size_t)row * 6144;
              const float2 cs = csv[j];
              const float x1 = acc[ai][bj][m][0][j], x2 = acc[ai][bj][m][1][j];
              float y1 = x1 * cs.x - x2 * cs.y, y2 = x1 * cs.y + x2 * cs.x;
              if (pc >= 1024) { y1 *= 0.0625f; y2 *= 0.0625f; }
              proj[f1] = f2bf(y1);
              proj[f1 + 128] = f2bf(y2);
            }
          }
        } else {
#pragma unroll
          for (int j = 0; j < 4; ++j) {
            __builtin_amdgcn_sched_barrier(0);
            const int row = brow + ai * HALF + wr * 64 + m * 16 + fq * 4 + j;
            u16* proj = projb + (size_t)row * 6144;
            float* cvo = nullptr;
            if (EPI == 2 && bcol >= 2048) {
              if (row < NPROMPT) {
                const int t = row & 2047;
                if (t >= 2045) cvo = p.out + OUT_CONVP + ((size_t)(row >> 11) * 3 + (t - 2045)) * 4096;
              } else {
                const int rs = row - NPROMPT, t = rs & 7;
                if (t >= 5) cvo = p.out + OUT_CONVS + ((size_t)(rs >> 3) * 3 + (t - 5)) * 4096;
              }
            }
#pragma unroll
            for (int bj = 0; bj < 2; ++bj)
#pragma unroll
              for (int n = 0; n < 2; ++n) {
                const int col = bcol + bj * HALF + wc * 32 + n * 16 + fr;
                const float a = acc[ai][bj][m][n][j];
                proj[col] = f2bf(a);
                if (EPI == 2 && cvo) cvo[col - 2048] = a;
              }
          }
        }
      }
  }
#undef SA
#undef SB
#undef STAGE
#undef LDA
#undef LDB
#undef MMA
#undef WAIT_V
#undef WAIT_L
#undef BAR
#undef SCHED
}

__device__ __forceinline__ void unpack8(const u32x4 u, float* xv) {
  xv[0] = bf2f((u16)(u.x & 0xffff)); xv[1] = bf2f((u16)(u.x >> 16));
  xv[2] = bf2f((u16)(u.y & 0xffff)); xv[3] = bf2f((u16)(u.y >> 16));
  xv[4] = bf2f((u16)(u.z & 0xffff)); xv[5] = bf2f((u16)(u.z >> 16));
  xv[6] = bf2f((u16)(u.w & 0xffff)); xv[7] = bf2f((u16)(u.w >> 16));
}

__device__ void phase_conv(const Params& p, unsigned char* smem, const int rep) {
  const int tid = (int)p.tidx;
  const float* dtraw = (const float*)(p.ws + OFF_DTRAW);
  float* dtv = (float*)(p.ws + OFF_DT);
  float* cumv = (float*)(p.ws + OFF_CUM);
  {
    float* laS = (float*)smem;
    const int tok = tid >> 3, h0 = (tid & 7) * 4;
    const float4 bias = *(const float4*)(p.ssm_dt_bias + h0);
    const float4 al = *(const float4*)(p.ssm_a_log + h0);
    const float4 an = make_float4(-expf(al.x), -expf(al.y), -expf(al.z), -expf(al.w));
    for (int sc = blockIdx.x; sc < 384; sc += gridDim.x) {
      int row0, len;
      if (sc < 256) { row0 = sc * 64; len = 64; } else { row0 = NPROMPT + (sc - 256) * 8; len = 8; }
      if (tok < len) {
        const float4 x = *(const float4*)(dtraw + (size_t)(row0 + tok) * 32 + h0);
        float4 dt;
        { float v = x.x + bias.x; dt.x = v > 20.f ? v : log1pf(expf(v)); }
        { float v = x.y + bias.y; dt.y = v > 20.f ? v : log1pf(expf(v)); }
        { float v = x.z + bias.z; dt.z = v > 20.f ? v : log1pf(expf(v)); }
        { float v = x.w + bias.w; dt.w = v > 20.f ? v : log1pf(expf(v)); }
        *(float4*)(dtv + (size_t)(row0 + tok) * 32 + h0) = dt;
        *(float4*)(laS + tok * 32 + h0) = make_float4(dt.x * an.x, dt.y * an.y, dt.z * an.z, dt.w * an.w);
      }
      __syncthreads();
      if (tok < len) {
        float4 c = make_float4(0.f, 0.f, 0.f, 0.f);
        for (int t = 0; t <= tok; ++t) {
          const float4 v = *(const float4*)(laS + t * 32 + h0);
          c.x += v.x; c.y += v.y; c.z += v.z; c.w += v.w;
        }
        *(float4*)(cumv + (size_t)(row0 + tok) * 32 + h0) = c;
      }
      __syncthreads();
    }
  }
  const u16* proj = (const u16*)(p.ws + OFF_PROJ);
  u16* xbcc = (u16*)(p.ws + OFF_XBCC);
  const int gtid = blockIdx.x * NTHR + tid;
  const int ch0 = (gtid & 511) * 8, rb = gtid >> 9;
  float wgt[4][8], bs[8];
#pragma unroll
  for (int wv = 0; wv < 4; ++wv) {
    const float4 w0 = *(const float4*)(p.ssm_conv_w + (size_t)wv * 4096 + ch0);
    const float4 w1 = *(const float4*)(p.ssm_conv_w + (size_t)wv * 4096 + ch0 + 4);
    wgt[wv][0] = w0.x; wgt[wv][1] = w0.y; wgt[wv][2] = w0.z; wgt[wv][3] = w0.w;
    wgt[wv][4] = w1.x; wgt[wv][5] = w1.y; wgt[wv][6] = w1.z; wgt[wv][7] = w1.w;
  }
  {
    const float4 b0 = *(const float4*)(p.ssm_conv_b + ch0), b1 = *(const float4*)(p.ssm_conv_b + ch0 + 4);
    bs[0] = b0.x; bs[1] = b0.y; bs[2] = b0.z; bs[3] = b0.w; bs[4] = b1.x; bs[5] = b1.y; bs[6] = b1.z; bs[7] = b1.w;
  }
  const int rows_per = T_TOK / (int)(gridDim.x * NTHR / 512);
  for (int rr = 0; rr < rep; ++rr) {
    float hm3[8], hm2[8], hm1[8];
    const int rbeg = rb * rows_per;
    u32x4 cur[4], nxt[4];
#pragma unroll
    for (int q = 0; q < 4; ++q) cur[q] = *(const u32x4*)(proj + (size_t)(rbeg + q) * 6144 + 2048 + ch0);
    for (int r4 = 0; r4 < rows_per; r4 += 4) {
#pragma unroll
      for (int q = 0; q < 4; ++q) {
        nxt[q] = cur[q];
        if (r4 + 4 + q < rows_per) nxt[q] = *(const u32x4*)(proj + (size_t)(rbeg + r4 + 4 + q) * 6144 + 2048 + ch0);
      }
#pragma unroll
      for (int q4 = 0; q4 < 4; ++q4) {
        const int r = r4 + q4;
        const int row = rbeg + r;
        const bool samp = row >= NPROMPT;
        const int t = samp ? ((row - NPROMPT) & 7) : (row & 2047);
        const int b = samp ? ((row - NPROMPT) >> 3) : (row >> 11);
        if (r == 0 || t == 0) {
#pragma unroll
          for (int k = 1; k <= 3; ++k) {
            float hv[8];
            if (t - k >= 0) {
              unpack8(*(const u32x4*)(proj + (size_t)(row - k) * 6144 + 2048 + ch0), hv);
            } else if (samp) {
              const float* sp = p.state_conv + ((size_t)b * 3 + (t - k + 3)) * 4096 + ch0;
              const float4 s0 = *(const float4*)sp, s1 = *(const float4*)(sp + 4);
              hv[0] = s0.x; hv[1] = s0.y; hv[2] = s0.z; hv[3] = s0.w; hv[4] = s1.x; hv[5] = s1.y; hv[6] = s1.z; hv[7] = s1.w;
            } else {
#pragma unroll
              for (int q = 0; q < 8; ++q) hv[q] = 0.f;
            }
#pragma unroll
            for (int q = 0; q < 8; ++q) {
              if (k == 1) hm1[q] = hv[q];
              if (k == 2) hm2[q] = hv[q];
              if (k == 3) hm3[q] = hv[q];
            }
          }
        }
        float xc[8], o[8];
        unpack8(cur[q4], xc);
#pragma unroll
        for (int q = 0; q < 8; ++q) {
          const float a = bs[q] + hm3[q] * wgt[0][q] + hm2[q] * wgt[1][q] + hm1[q] * wgt[2][q] + xc[q] * wgt[3][q];
          o[q] = silu(a);
          hm3[q] = hm2[q]; hm2[q] = hm1[q]; hm1[q] = xc[q];
        }
        u32x4 ov;
        ov.x = pack2(o[0], o[1]); ov.y = pack2(o[2], o[3]); ov.z = pack2(o[4], o[5]); ov.w = pack2(o[6], o[7]);
        *(u32x4*)(xbcc + (size_t)row * 4096 + ch0) = ov;
      }
#pragma unroll
      for (int q = 0; q < 4; ++q) cur[q] = nxt[q];
    }
  }
}

template <int DK, int MODE>
__device__ void rec_prompt_item(const Params& p, const int item, unsigned char* smem) {
  constexpr int QS = (DK + 16) * 2;
  constexpr int VS = 160, PS = 144;
  constexpr int MF = DK / 128;
  constexpr int KS = DK / 32;
  constexpr int NQ = DK / 64;
  constexpr int CPR = DK / 8;
  unsigned char* Qs = smem;
  unsigned char* Ks = Qs + 64 * QS;
  unsigned char* STs = Ks + 64 * QS;
  unsigned char* Vs = STs + 64 * QS;
  unsigned char* Vts = Vs + 64 * VS;
  unsigned char* Ps = Vts + 64 * VS;
  float* cumS = (float*)(Ps + 64 * PS);
  float* uS = cumS + 64;

  const int tid = (int)p.tidx, lane = tid & 63, w = tid >> 6;
  const int l15 = lane & 15, g = lane >> 4;
  const int b = item >> 5;
  const int h = (MODE == 0) ? ((item >> 3) & 3) : (item & 31);
  const int s = (MODE == 0) ? (item & 7) : 0;
  const int row0 = b * 2048;

  const u16* src;
  int sstride, qcol, kcol, vcol;
  if (MODE == 0) {
    src = (const u16*)(p.ws + OFF_PROJ); sstride = 6144;
    qcol = h * 256; kcol = 1024 + h * 256; vcol = 2048 + h * 512 + s * 64;
  } else {
    src = (const u16*)(p.ws + OFF_XBCC); sstride = 4096;
    qcol = 3072 + (h >> 2) * 128; kcol = 2048 + (h >> 2) * 128; vcol = h * 64;
  }
  const float* dtv = (const float*)(p.ws + OFF_DT);
  const float* cumv = (const float*)(p.ws + OFF_CUM);
  const float lg = (MODE == 0) ? logf(1.0f - exp2f(-5.0f - (float)h)) : 0.f;

  const int vrow = tid >> 3, vkc = tid & 7;
  const int jt = tid & 63;

  constexpr int NSET = (MODE == 1) ? 2 : 1;
  u32x4 rq[2][NQ], rk[2][NQ], rv[2];
  float pcj[2] = {0.f, 0.f}, puj[2] = {1.f, 1.f}, pclast[2] = {0.f, 0.f}, pct[2] = {0.f, 0.f}, put[2] = {1.f, 1.f};
  u16 gz[2][2][4];
  const u16* gsrc = (const u16*)(p.ws + OFF_PROJ);
  const int gcol = (MODE == 0) ? (4096 + h * 512 + s * 64) : (h * 64);
  const int fi = w >> 1, fe0 = 2 * (w & 1);
  const int fis = (int)p.wv >> 1, fe0s = 2 * ((int)p.wv & 1);
  const int dw = w * (DK / 8);

#define PF_ISSUE(SET, RBASE)                                                                       \
  {                                                                                                \
    const int rb_ = (RBASE);                                                                       \
    _Pragma("unroll") for (int i = 0; i < NQ; ++i) {                                               \
      int c_ = tid + NTHR * i, rr_ = c_ / CPR, kc_ = c_ % CPR;                                     \
      rq[SET][i] = *(const u32x4*)(src + (size_t)(rb_ + rr_) * sstride + qcol + kc_ * 8);          \
      rk[SET][i] = *(const u32x4*)(src + (size_t)(rb_ + rr_) * sstride + kcol + kc_ * 8);          \
    }                                                                                              \
    rv[SET] = *(const u32x4*)(src + (size_t)(rb_ + vrow) * sstride + vcol + vkc * 8);              \
    if (MODE == 1) {                                                                               \
      pcj[SET] = cumv[(size_t)(rb_ + vrow) * 32 + h]; puj[SET] = dtv[(size_t)(rb_ + vrow) * 32 + h]; \
      pclast[SET] = cumv[(size_t)(rb_ + 63) * 32 + h];                                             \
      pct[SET] = cumv[(size_t)(rb_ + jt) * 32 + h]; put[SET] = dtv[(size_t)(rb_ + jt) * 32 + h];   \
    }                                                                                              \
    _Pragma("unroll") for (int x = 0; x < 2; ++x)                                                  \
      _Pragma("unroll") for (int r = 0; r < 4; ++r)                                                \
        gz[SET][x][r] = gsrc[(size_t)(rb_ + 16 * fi + 4 * g + r) * 6144 + gcol + 16 * (fe0 + x) + l15]; \
  }

  f32x4 S[MF][4];
#pragma unroll
  for (int i = 0; i < MF; ++i)
#pragma unroll
    for (int j = 0; j < 4; ++j) S[i][j] = (f32x4){0.f, 0.f, 0.f, 0.f};

  float gnv[2];
  const float dsk = (MODE == 1) ? p.ssm_d[h] : 0.f;
#pragma unroll
  for (int x = 0; x < 2; ++x) {
    const int e = 16 * (fe0 + x) + l15;
    gnv[x] = (MODE == 0) ? p.ret_head_norm[h * 512 + s * 64 + e] : p.ssm_gate_norm[h * 64 + e];
  }

  PF_ISSUE(0, row0)
  if (NSET == 2) PF_ISSUE(1, row0 + 64)

  for (int c2 = 0; c2 < 32; c2 += 2) {
#pragma unroll
   for (int par2 = 0; par2 < 2; ++par2) {
    const int par = par2 & (NSET - 1);
    const int c = c2 + par2;
    const int r0 = row0 + c * 64;
#pragma unroll
    for (int i = 0; i < NQ; ++i) {
      int cc = tid + NTHR * i, rr = cc / CPR, kc = cc % CPR;
      *(u32x4*)(Qs + rr * QS + kc * 16) = rq[par][i];
      *(u32x4*)(Ks + rr * QS + kc * 16) = rk[par][i];
    }
    {
      const u32x4 rvv = rv[par];
      *(u32x4*)(Vs + vrow * VS + vkc * 16) = rvv;
      float cj, uj, cl;
      if (MODE == 0) { cj = (float)(vrow + 1) * lg; uj = 1.f; cl = 64.f * lg; } else { cj = pcj[par]; uj = puj[par]; cl = pclast[par]; }
      const float wj = uj * __expf(cl - cj);
      u32x4 o;
      o.x = pack2(bf2f((u16)(rvv.x & 0xffff)) * wj, bf2f((u16)(rvv.x >> 16)) * wj);
      o.y = pack2(bf2f((u16)(rvv.y & 0xffff)) * wj, bf2f((u16)(rvv.y >> 16)) * wj);
      o.z = pack2(bf2f((u16)(rvv.z & 0xffff)) * wj, bf2f((u16)(rvv.z >> 16)) * wj);
      o.w = pack2(bf2f((u16)(rvv.w & 0xffff)) * wj, bf2f((u16)(rvv.w >> 16)) * wj);
      *(u32x4*)(Vts + vrow * VS + vkc * 16) = o;
    }
    if (tid < 64) {
      if (MODE == 0) { cumS[tid] = (float)(tid + 1) * lg; uS[tid] = 1.f; } else { cumS[tid] = pct[par]; uS[tid] = put[par]; }
    }
#pragma unroll
    for (int mf = 0; mf < MF; ++mf)
#pragma unroll
      for (int nf = 0; nf < 4; ++nf) {
        u32x2 o;
        o.x = pack2(S[mf][nf][0], S[mf][nf][1]);
        o.y = pack2(S[mf][nf][2], S[mf][nf][3]);
        *(u32x2*)(STs + (16 * nf + l15) * QS + (dw + 16 * mf + 4 * g) * 2) = o;
      }
    u16 gzc[2][4];
#pragma unroll
    for (int x = 0; x < 2; ++x)
#pragma unroll
      for (int r = 0; r < 4; ++r) gzc[x][r] = gz[par][x][r];
    __syncthreads();
    if (c + NSET < 32) PF_ISSUE(par, r0 + 64 * NSET)
    f32x4 sc[2], cr[2];
#pragma unroll
    for (int x = 0; x < 2; ++x) { sc[x] = (f32x4){0.f, 0.f, 0.f, 0.f}; cr[x] = (f32x4){0.f, 0.f, 0.f, 0.f}; }
#pragma unroll 4
    for (int ks = 0; ks < KS; ++ks) {
      const bf16x8 a = *(const bf16x8*)(Qs + (16 * fi + l15) * QS + ks * 64 + g * 16);
      bf16x8 bk[2], bs[2];
#pragma unroll
      for (int x = 0; x < 2; ++x) {
        bk[x] = *(const bf16x8*)(Ks + (16 * (fe0 + x) + l15) * QS + ks * 64 + g * 16);
        bs[x] = *(const bf16x8*)(STs + (16 * (fe0 + x) + l15) * QS + ks * 64 + g * 16);
      }
#pragma unroll
      for (int x = 0; x < 2; ++x) {
        sc[x] = __builtin_amdgcn_mfma_f32_16x16x32_bf16(a, bk[x], sc[x], 0, 0, 0);
        cr[x] = __builtin_amdgcn_mfma_f32_16x16x32_bf16(a, bs[x], cr[x], 0, 0, 0);
      }
    }
    float ci[4];
#pragma unroll
    for (int r = 0; r < 4; ++r) ci[r] = cumS[16 * fi + 4 * g + r];
#pragma unroll
    for (int x = 0; x < 2; ++x) {
      const int fj = fe0 + x;
      const int j = 16 * fj + l15;
      const float cj = cumS[j], uj = uS[j];
#pragma unroll
      for (int r = 0; r < 4; ++r) {
        const int i = 16 * fi + 4 * g + r;
        float v = 0.f;
        if (j <= i) v = sc[x][r] * __expf(ci[r] - cj) * uj;
        *(u16*)(Ps + i * PS + j * 2) = f2bf(v);
      }
    }
    {
      const float atot = __expf(cumS[63]);
#pragma unroll
      for (int mf = 0; mf < MF; ++mf)
#pragma unroll
        for (int nf = 0; nf < 4; ++nf)
#pragma unroll
          for (int r = 0; r < 4; ++r) S[mf][nf][r] *= atot;
#pragma unroll
      for (int ks = 0; ks < 2; ++ks) {
        bf16x8 af[MF], bfv[4];
#pragma unroll
        for (int mf = 0; mf < MF; ++mf) af[mf] = trfrag(Ks, QS, 32 * ks, dw + 16 * mf, lane);
#pragma unroll
        for (int nf = 0; nf < 4; ++nf) bfv[nf] = trfrag(Vts, VS, 32 * ks, 16 * nf, lane);
#pragma unroll
        for (int mf = 0; mf < MF; ++mf)
#pragma unroll
          for (int nf = 0; nf < 4; ++nf)
            S[mf][nf] = __builtin_amdgcn_mfma_f32_16x16x32_bf16(af[mf], bfv[nf], S[mf][nf], 0, 0, 0);
      }
    }
    __syncthreads();
    f32x4 in[2];
#pragma unroll
    for (int x = 0; x < 2; ++x) in[x] = (f32x4){0.f, 0.f, 0.f, 0.f};
#pragma unroll
    for (int ks = 0; ks < 2; ++ks) {
      const bf16x8 a = *(const bf16x8*)(Ps + (16 * fi + l15) * PS + ks * 64 + g * 16);
      bf16x8 bv[2];
#pragma unroll
      for (int x = 0; x < 2; ++x) bv[x] = trfrag(Vs, VS, 32 * ks, 16 * (fe0 + x), lane);
#pragma unroll
      for (int x = 0; x < 2; ++x) in[x] = __builtin_amdgcn_mfma_f32_16x16x32_bf16(a, bv[x], in[x], 0, 0, 0);
    }
    {
      float ss[4] = {0.f, 0.f, 0.f, 0.f};
      u16* aout = (u16*)(p.ws + OFF_A2);
      float* parts = (float*)(p.ws + OFF_PARTS);
#pragma unroll
      for (int x = 0; x < 2; ++x) {
        const int e = 16 * (fe0 + x) + l15;
        const float gn = gnv[x];
        const int ocol = (MODE == 0) ? (h * 512 + s * 64 + e) : (h * 64 + e);
#pragma unroll
        for (int r = 0; r < 4; ++r) {
          const int i = 16 * fi + 4 * g + r;
          float o = in[x][r] + cr[x][r] * __expf(ci[r]);
          const float gv = bf2f(gzc[x][r]);
          float val;
          if (MODE == 0) {
            ss[r] += o * o;
            val = o * gn * silu(gv);
          } else {
            const float xs = bf2f(*(const u16*)(Vs + i * VS + e * 2));
            const float y = o + xs * dsk;
            const float gg = y * silu(gv);
            ss[r] += gg * gg;
            val = gg * gn;
          }
          aout[(size_t)(r0 + i) * 2048 + ocol] = f2bf(val);
        }
      }
#pragma unroll
      for (int r = 0; r < 4; ++r) {
        const float v = row16_sum(ss[r]);
        if (l15 == 0) {
          const int i = 16 * fi + 4 * g + r;
          const int slot = (MODE == 0) ? (h * 16 + s * 2 + (w & 1)) : ((h >> 2) * 8 + (h & 3) * 2 + (w & 1));
          parts[(size_t)(r0 + i) * 64 + slot] = v;
        }
      }
    }
    __syncthreads();
   }
  }
#undef PF_ISSUE
  {
    float* so;
    int pitch;
    if (MODE == 0) { so = p.out + OUT_RETP + ((size_t)(b * 4 + h) * 256) * 512 + s * 64; pitch = 512; }
    else { so = p.out + OUT_SSMP + ((size_t)(b * 32 + h) * 128) * 64; pitch = 64; }
#pragma unroll
    for (int mf = 0; mf < MF; ++mf)
#pragma unroll
      for (int nf = 0; nf < 4; ++nf)
#pragma unroll
        for (int r = 0; r < 4; ++r)
          so[(size_t)(dw + 16 * mf + 4 * g + r) * pitch + 16 * nf + l15] = S[mf][nf][r];
  }
}

#define SAMPLE_DECODE(ITEM, B_, H_, S_)                              \
  const int B_ = (ITEM) >> 5;                                        \
  const int H_ = (MODE == 0) ? (((ITEM) >> 3) & 3) : ((ITEM) & 31);  \
  const int S_ = (MODE == 0) ? ((ITEM) & 7) : 0;

#define SAMPLE_ISSUE(SET, ITEM)                                                                                       \
  {                                                                                                                \
    SAMPLE_DECODE(ITEM, b_, h_, s_)                                                                                \
    const int row0_ = NPROMPT + b_ * 8;                                                                            \
    int qcol_, kcol_, vcol_;                                                                                       \
    if (MODE == 0) { qcol_ = h_ * 256; kcol_ = 1024 + h_ * 256; vcol_ = 2048 + h_ * 512 + s_ * 64; }               \
    else { qcol_ = 3072 + (h_ >> 2) * 128; kcol_ = 2048 + (h_ >> 2) * 128; vcol_ = h_ * 64; }                      \
    const float* s0_ = (MODE == 0) ? p.state_ret + ((size_t)(b_ * 4 + h_) * 256) * 512 + s_ * 64                   \
                                   : p.state_ssm + ((size_t)(b_ * 32 + h_) * 128) * 64;                            \
    _Pragma("unroll") for (int x = 0; x < RPT; ++x)                                                                \
        sv[SET][x] = *(const float4*)(s0_ + (size_t)(dg * RPT + x) * pitch + eq * 4);                                 \
    if (tid < 2 * DK) {                                                                                            \
      const int which_ = tid / DK, c_ = tid % DK;                                                                  \
      rqk[SET] = *(const u32x4*)(src + (size_t)(row0_ + c_ / CPR) * sstride + (which_ ? kcol_ : qcol_) + (c_ % CPR) * 8); \
    }                                                                                                              \
    if (tid < 64) rv[SET] = *(const u32x4*)(src + (size_t)(row0_ + (tid >> 3)) * sstride + vcol_ + (tid & 7) * 8);      \
    gzs[SET] = gsrc[(size_t)(row0_ + w) * 6144 + ((MODE == 0) ? (4096 + h_ * 512 + s_ * 64) : (h_ * 64)) + lane];      \
    if (MODE == 1 && tid < 16)                                                                                     \
      pcu[SET] = (tid < 8) ? cumv[(size_t)(row0_ + tid) * 32 + h_] : dtv[(size_t)(row0_ + tid - 8) * 32 + h_];          \
  }

template <int DK, int MODE>
__device__ void rec_sample_loop(const Params& p, unsigned char* smem, const int rep) {
  float* qS = (float*)smem;
  float* kS = qS + 8 * DK;
  float* vS = kS + 8 * DK;
  float* scS = vS + 512;
  float* redS = scS + 64;
  float* cuS = redS + 16384;
  float* qT = cuS + 64;
  float* kT = qT + 8 * DK;
  const int tid = (int)p.tidx, lane = tid & 63, w = tid >> 6;
  constexpr int CPR = DK / 8, RPT = DK / 32;
  const int dg = tid >> 4, eq = tid & 15;
  const int pitch = (MODE == 0) ? 512 : 64;
  const u16* src = (MODE == 0) ? (const u16*)(p.ws + OFF_PROJ) : (const u16*)(p.ws + OFF_XBCC);
  const int sstride = (MODE == 0) ? 6144 : 4096;
  const u16* gsrc = (const u16*)(p.ws + OFF_PROJ);
  const float* dtv = (const float*)(p.ws + OFF_DT);
  const float* cumv = (const float*)(p.ws + OFF_CUM);
  u16* aout = (u16*)(p.ws + OFF_A2);
  float* parts = (float*)(p.ws + OFF_PARTS);

  u32x4 rqk[2] = {(u32x4){0u, 0u, 0u, 0u}, (u32x4){0u, 0u, 0u, 0u}}, rv[2] = {(u32x4){0u, 0u, 0u, 0u}, (u32x4){0u, 0u, 0u, 0u}};
  float4 sv[2][RPT];
  u16 gzs[2] = {0, 0};
  float pcu[2] = {0.f, 0.f};
  const int nitems = 4096 * rep;
  const int G = (int)gridDim.x;
  int vz;
  asm volatile("v_mov_b32 %0, 0" : "=v"(vz));
  if ((int)blockIdx.x < nitems) SAMPLE_ISSUE(0, ((int)blockIdx.x & 4095) + vz)
  for (int itb = blockIdx.x; itb < nitems; itb += 2 * G) {
#pragma unroll
   for (int par = 0; par < 2; ++par) {
    const int item0 = itb + par * G;
    if (item0 < nitems) {
    if (item0 + G < nitems) SAMPLE_ISSUE(par ^ 1, ((item0 + G) & 4095) + vz)
    __builtin_amdgcn_sched_barrier(0);
    const int item = (item0 & 4095) + vz;
    SAMPLE_DECODE(item, b, h, s)
    const int row0 = NPROMPT + b * 8;
    const u16 gzv = gzs[par];
    const u32x4 rqkc = rqk[par], rvc = rv[par];
    if (tid < 2 * DK) {
      const int which = tid / DK, c = tid % DK;
      float* dst = (which ? kS : qS) + (c / CPR) * DK + (c % CPR) * 8;
      dst[0] = bf2f((u16)(rqkc.x & 0xffff)); dst[1] = bf2f((u16)(rqkc.x >> 16));
      dst[2] = bf2f((u16)(rqkc.y & 0xffff)); dst[3] = bf2f((u16)(rqkc.y >> 16));
      dst[4] = bf2f((u16)(rqkc.z & 0xffff)); dst[5] = bf2f((u16)(rqkc.z >> 16));
      dst[6] = bf2f((u16)(rqkc.w & 0xffff)); dst[7] = bf2f((u16)(rqkc.w >> 16));
      float* dT = (which ? kT : qT) + ((c % CPR) * 8) * 8 + (c / CPR);
#pragma unroll
      for (int x = 0; x < 8; ++x) dT[x * 8] = dst[x];
    }
    if (tid < 64) {
      float* dst = vS + (tid >> 3) * 64 + (tid & 7) * 8;
      dst[0] = bf2f((u16)(rvc.x & 0xffff)); dst[1] = bf2f((u16)(rvc.x >> 16));
      dst[2] = bf2f((u16)(rvc.y & 0xffff)); dst[3] = bf2f((u16)(rvc.y >> 16));
      dst[4] = bf2f((u16)(rvc.z & 0xffff)); dst[5] = bf2f((u16)(rvc.z >> 16));
      dst[6] = bf2f((u16)(rvc.w & 0xffff)); dst[7] = bf2f((u16)(rvc.w >> 16));
    }
    if (MODE == 1 && tid < 16) cuS[tid] = pcu[par];
    __syncthreads();
    float cum[8], u[8];
    if (MODE == 0) {
      const float lg = logf(1.0f - exp2f(-5.0f - (float)h));
#pragma unroll
      for (int t = 0; t < 8; ++t) { cum[t] = (float)(t + 1) * lg; u[t] = 1.f; }
    } else {
#pragma unroll
      for (int t = 0; t < 8; ++t) { cum[t] = cuS[t]; u[t] = cuS[8 + t]; }
    }
    {
      const int pair = tid >> 3, part = tid & 7;
      const int i = pair >> 3, jj = pair & 7;
      float d = 0.f;
      const float* qp = qS + i * DK + part * (DK / 8);
      const float* kp = kS + jj * DK + part * (DK / 8);
#pragma unroll 8
      for (int x = 0; x < DK / 8; ++x) d += qp[x] * kp[x];
      d += __shfl_xor(d, 1); d += __shfl_xor(d, 2); d += __shfl_xor(d, 4);
      if (part == 0) {
        float ci = 0.f, cj = 0.f, uj = 0.f;
#pragma unroll
        for (int t = 0; t < 8; ++t) { if (t == i) ci = cum[t]; if (t == jj) { cj = cum[t]; uj = u[t]; } }
        scS[pair] = (jj <= i) ? d * __expf(ci - cj) * uj : 0.f;
      }
    }
    float* s1 = (MODE == 0) ? p.out + OUT_RETS + ((size_t)(b * 4 + h) * 256) * 512 + s * 64
                            : p.out + OUT_SSMS + ((size_t)(b * 32 + h) * 128) * 64;
    {
      float4 cx[4];
      {
        float4 vw[8];
#pragma unroll
        for (int jj = 0; jj < 8; ++jj) {
          float4 v = *(const float4*)(vS + jj * 64 + eq * 4);
          const float wj = u[jj] * __expf(cum[7] - cum[jj]);
          vw[jj] = make_float4(v.x * wj, v.y * wj, v.z * wj, v.w * wj);
        }
        const float atot = __expf(cum[7]);
#pragma unroll
        for (int i = 0; i < 4; ++i) cx[i] = make_float4(0.f, 0.f, 0.f, 0.f);
#pragma unroll
        for (int x = 0; x < RPT; ++x) {
          __builtin_amdgcn_sched_barrier(0);
          const int d = dg * RPT + x;
          const float4 so = sv[par][x];
          float4 sn = make_float4(so.x * atot, so.y * atot, so.z * atot, so.w * atot);
          const float4 k0 = *(const float4*)(kT + d * 8), k1 = *(const float4*)(kT + d * 8 + 4);
          const float kq[8] = {k0.x, k0.y, k0.z, k0.w, k1.x, k1.y, k1.z, k1.w};
#pragma unroll
          for (int jj = 0; jj < 8; ++jj) {
            const float kk = kq[jj];
            sn.x += kk * vw[jj].x; sn.y += kk * vw[jj].y; sn.z += kk * vw[jj].z; sn.w += kk * vw[jj].w;
          }
          *(float4*)(s1 + (size_t)d * pitch + eq * 4) = sn;
          const float4 q0 = *(const float4*)(qT + d * 8);
          const float qv[4] = {q0.x, q0.y, q0.z, q0.w};
#pragma unroll
          for (int i = 0; i < 4; ++i) {
            const float qq = qv[i];
            cx[i].x += qq * so.x; cx[i].y += qq * so.y; cx[i].z += qq * so.z; cx[i].w += qq * so.w;
          }
        }
      }
      __builtin_amdgcn_sched_barrier(0);
#pragma unroll
      for (int i = 0; i < 4; ++i) {
        *(float4*)(redS + (dg * 8 + i) * 64 + eq * 4) = cx[i];
        cx[i] = make_float4(0.f, 0.f, 0.f, 0.f);
      }
#pragma unroll
      for (int x = 0; x < RPT; ++x) {
        __builtin_amdgcn_sched_barrier(0);
        const int d = dg * RPT + x;
        const float4 so = sv[par][x];
        const float4 q1 = *(const float4*)(qT + d * 8 + 4);
        const float qv[4] = {q1.x, q1.y, q1.z, q1.w};
#pragma unroll
        for (int i = 0; i < 4; ++i) {
          const float qq = qv[i];
          cx[i].x += qq * so.x; cx[i].y += qq * so.y; cx[i].z += qq * so.z; cx[i].w += qq * so.w;
        }
      }
      __builtin_amdgcn_sched_barrier(0);
#pragma unroll
      for (int i = 0; i < 4; ++i) {
        *(float4*)(redS + (dg * 8 + 4 + i) * 64 + eq * 4) = cx[i];
      }
    }
    __syncthreads();
    {
      const int i = w, e = lane;
      float o = 0.f;
#pragma unroll
      for (int ww = 0; ww < 32; ++ww) o += redS[(ww * 8 + i) * 64 + e];
      float ci = 0.f;
#pragma unroll
      for (int t = 0; t < 8; ++t) if (t == i) ci = cum[t];
      o *= __expf(ci);
#pragma unroll
      for (int jj = 0; jj < 8; ++jj) if (jj <= i) o += scS[i * 8 + jj] * vS[jj * 64 + e];
      const int row = row0 + i;
      const float gv = bf2f(gzv);
      if (MODE == 0) {
        const float ssq = wave_sum(o * o);
        const float val = o * p.ret_head_norm[h * 512 + s * 64 + e] * silu(gv);
        aout[(size_t)row * 2048 + h * 512 + s * 64 + e] = f2bf(val);
        if (lane < 2) parts[(size_t)row * 64 + h * 16 + s * 2 + lane] = lane == 0 ? ssq : 0.f;
      } else {
        const float y = o + vS[i * 64 + e] * p.ssm_d[h];
        const float gg = y * silu(gv);
        const float ssq = wave_sum(gg * gg);
        aout[(size_t)row * 2048 + h * 64 + e] = f2bf(gg * p.ssm_gate_norm[h * 64 + e]);
        if (lane < 2) parts[(size_t)row * 64 + (h >> 2) * 8 + (h & 3) * 2 + lane] = lane == 0 ? ssq : 0.f;
      }
    }
    __syncthreads();
    }
   }
  }
}

template <int DK, int MODE>
__device__ void phase_rec(const Params& p, unsigned char* smem, const int rep_p, const int rep_s) {
  for (int item = blockIdx.x; item < 256 * rep_p; item += gridDim.x) rec_prompt_item<DK, MODE>(p, item & 255, smem);
  rec_sample_loop<DK, MODE>(p, smem, rep_s);
}

#ifndef PHASE_MASK
#define PHASE_MASK 0x3ff
#endif
#ifndef DUP_MASK
#define DUP_MASK 0x000
#endif
#define XB_TMO      128
#define XB_XCNT(j)  (256  + 64 * (j))
#define XB_XSUB(j)  (1280 + 64 * (j))
#define XB_XGEN(j)  (2304 + 64 * (j))
#define XB_TOP      3328
#define XB_TOPGEN   3392
#define XCD_BAR_WORDS 3456
#define XB_SPIN_CAP (1u << 20)
#define LAS __attribute__((address_space(3)))
__device__ __forceinline__ unsigned xb_ld(unsigned* p) { return __hip_atomic_load(p, __ATOMIC_RELAXED, __HIP_MEMORY_SCOPE_AGENT); }
__device__ __forceinline__ unsigned xb_add(unsigned* p, unsigned v) { return __hip_atomic_fetch_add(p, v, __ATOMIC_RELAXED, __HIP_MEMORY_SCOPE_AGENT); }
__device__ __forceinline__ unsigned xb_xcc_id() { return (unsigned)__builtin_amdgcn_s_getreg((3 << 11) | 20) & 0xFu; }
#define XB_SPIN(cond, bar) do { unsigned _sp = 0; while (cond) { __builtin_amdgcn_s_sleep(1); \
    if ((++_sp & 255u) == 0u) { if (xb_ld(&(bar)[XB_TMO])) break; if (_sp > XB_SPIN_CAP) { atomicAdd(&(bar)[XB_TMO], 1u); break; } } } } while (0)
struct XcdBarrier {
  unsigned* bar; unsigned x;
  volatile LAS unsigned* st;
};
__device__ __forceinline__ XcdBarrier xcd_barrier_post(unsigned* bar, volatile LAS unsigned* st, const int tid) {
  XcdBarrier b; b.bar = bar; b.x = xb_xcc_id(); b.st = st;
  if (tid == 0) (void)xb_add(&bar[XB_XCNT(b.x)], 1u);
  return b;
}
__device__ __forceinline__ void xcd_barrier_complete(unsigned* bar, unsigned x, unsigned& nloc, unsigned& nx) {
  const unsigned G = gridDim.x * gridDim.y * gridDim.z;
  unsigned sum, cnt, mine, sp = 0u;
  for (;;) {
    sum = 0u; cnt = 0u; mine = 0u;
#pragma unroll
    for (unsigned j = 0; j < 16; ++j) { const unsigned c = xb_ld(&bar[XB_XCNT(j)]); sum += c; cnt += (c > 0u) ? 1u : 0u; mine = (j == x) ? c : mine; }
    if (sum == G) break;
    __builtin_amdgcn_s_sleep(1);
    if ((++sp & 255u) == 0u) { if (xb_ld(&bar[XB_TMO])) break; if (sp > XB_SPIN_CAP) { atomicAdd(&bar[XB_TMO], 1u); break; } }
  }
  nloc = mine > 0u ? mine : 1u; nx = cnt > 0u ? cnt : 1u;
}
__device__ __forceinline__ void xcd_barrier(const XcdBarrier& b, const int wvs) {
  int wvl_ = wvs;
  asm volatile("" : "+s"(wvl_));
  const int tid = wvl_ * 64 + (int)__builtin_amdgcn_mbcnt_hi(~0u, __builtin_amdgcn_mbcnt_lo(~0u, 0u));
  asm volatile("s_waitcnt vmcnt(0)" ::: "memory");
  __syncthreads();
  if (tid == 0) {
    unsigned* bar = b.bar;
    __builtin_amdgcn_s_waitcnt(0);
    unsigned nloc = b.st[0], nx = b.st[1];
    if (nloc == 0u) { xcd_barrier_complete(bar, b.x, nloc, nx); b.st[0] = nloc; b.st[1] = nx; }
    const unsigned old = xb_add(&bar[XB_XSUB(b.x)], 1u);
    const unsigned gen = old / nloc;
    if (old + 1u == (gen + 1u) * nloc) {
      __builtin_amdgcn_fence(__ATOMIC_RELEASE, "agent");
      asm volatile("s_waitcnt vmcnt(0)" ::: "memory");
      const unsigned og = xb_add(&bar[XB_TOP], 1u);
      const unsigned tg = og / nx;
      if (og + 1u == (tg + 1u) * nx) xb_add(&bar[XB_TOPGEN], 1u);
      else XB_SPIN(xb_ld(&bar[XB_TOPGEN]) == tg, bar);
      __builtin_amdgcn_fence(__ATOMIC_ACQUIRE, "agent");
      xb_add(&bar[XB_XGEN(b.x)], 1u);
      asm volatile("s_waitcnt vmcnt(0)" ::: "memory");
    } else {
      XB_SPIN(xb_ld(&bar[XB_XGEN(b.x)]) == gen, bar);
      __builtin_amdgcn_fence(__ATOMIC_ACQUIRE, "agent");
      asm volatile("s_waitcnt vmcnt(0)" ::: "memory");
    }
  }
  __syncthreads();
}

template <typename T>
__device__ __forceinline__ T* as_global(T* q) {
  return (T*)(__attribute__((address_space(1))) T*)q;
}

template <int PH>
__device__ __forceinline__ void run_phase(Params p, unsigned char* smem, const int wvs) {
  {
    long long z_ = 0;
    asm volatile("" : "+s"(z_));
    p.ws += z_; p.out += z_;
  }
  {
    int wvl_ = wvs;
    asm volatile("" : "+s"(wvl_));
    p.tidx = wvl_ * 64 + (int)__builtin_amdgcn_mbcnt_hi(~0u, __builtin_amdgcn_mbcnt_lo(~0u, 0u));
    p.wv = wvl_;
  }
  const int rep = 1 + (int)((p.dup >> PH) & 1);
  if (PH == 0) phase_prep(p, smem, rep);
  if (PH == 1) gemm8_phase<0>(p, (const u16*)(p.ws + OFF_H), (const u16*)(p.ws + OFF_WT0), 1024, 24, smem, rep);
  if (PH == 2) phase_rec<256, 0>(p, smem, rep, 1 + (int)((p.dup >> (PH + 16)) & 1));
  if (PH == 3)
  {
    gemm_phase<1, 4>(p, (const u16*)(p.ws + OFF_A2), (const u16*)(p.ws + OFF_WT1), 2048, 8, nullptr,
                     (float*)(p.ws + OFF_X1), smem, rep, 64);
    __syncthreads();
    gemm_sample_rows<4>(p, (const u16*)(p.ws + OFF_A2), (const u16*)(p.ws + OFF_WT1), nullptr, (float*)(p.ws + OFF_X1), smem, rep);
  }
  if (PH == 4) phase_norm<0>(p, (const float*)(p.ws + OFF_X1), p.ssm_norm, rep);
  if (PH == 5) {
    gemm8_phase<2>(p, (const u16*)(p.ws + OFF_H), (const u16*)(p.ws + OFF_WT2), 1024, 24, smem, rep);
    __syncthreads();
    gemm_phase<2, 0>(p, (const u16*)(p.ws + OFF_H), (const u16*)(p.ws + OFF_WT2), 1024, 1, nullptr, nullptr, smem, 1, 68, 48, true);
  }
  if (PH == 6) phase_conv(p, smem, rep);
  if (PH == 7) phase_rec<128, 1>(p, smem, rep, 1 + (int)((p.dup >> (PH + 16)) & 1));
  if (PH == 8)
  {
    gemm_phase<1, 8>(p, (const u16*)(p.ws + OFF_A2), (const u16*)(p.ws + OFF_WT3), 2048, 8,
                     (const float*)(p.ws + OFF_X1), (float*)(p.ws + OFF_X2), smem, rep, 64);
    __syncthreads();
    gemm_sample_rows<8>(p, (const u16*)(p.ws + OFF_A2), (const u16*)(p.ws + OFF_WT3), (const float*)(p.ws + OFF_X1),
                        (float*)(p.ws + OFF_X2), smem, rep);
  }
  if (PH == 9) phase_norm<1>(p, (const float*)(p.ws + OFF_X2), p.final_norm, rep);
}

#define RUN_PHASE(k)                                   \
  if ((PHASE_MASK >> k) & 1) {                         \
    if (lo <= k && k <= hi) {                          \
      run_phase<k>(p, smem, wvs);                      \
      if (k < hi) { xcd_barrier(xb, wvs); if ((p.dup >> 30) & 1) { xcd_barrier(xb, wvs); xcd_barrier(xb, wvs); } } \
    }                                                  \
  }

__global__ void __launch_bounds__(NTHR) fwd_megakernel(Params p) {
  __shared__ __attribute__((aligned(16))) unsigned char smem[LDS_BYTES];
  cg::grid_group grid = cg::this_grid();
  const int lo = (int)p.phase_lo, hi = (int)p.phase_hi;
  if (lo > 1000) grid.sync();
  volatile LAS unsigned* xst = (volatile LAS unsigned*)(smem + LDS_BYTES - 16);
  const int wvs = __builtin_amdgcn_readfirstlane((int)(threadIdx.x >> 6));
  if (threadIdx.x == 0) { xst[0] = 0u; xst[1] = 0u; }
  __syncthreads();
  const XcdBarrier xb = xcd_barrier_post((unsigned*)(p.ws + OFF_BAR), xst, (int)threadIdx.x);
  RUN_PHASE(0)
  RUN_PHASE(1)
  RUN_PHASE(2)
  RUN_PHASE(3)
  RUN_PHASE(4)
  RUN_PHASE(5)
  RUN_PHASE(6)
  RUN_PHASE(7)
  RUN_PHASE(8)
  RUN_PHASE(9)
}

#ifndef ONE_LAUNCH
#define ONE_LAUNCH 1
#endif

extern "C" void kernel_launch(void* const* d_in, const int* in_sizes, int n_in, void* d_out, int out_size, void* d_ws,
                              size_t ws_size, hipStream_t stream) {
  static int grid_blocks = 0;
  if (!grid_blocks) {
    int dev = 0, cus = 0, per_cu = 0;
    hipGetDevice(&dev);
    hipDeviceGetAttribute(&cus, hipDeviceAttributeMultiprocessorCount, dev);
    hipOccupancyMaxActiveBlocksPerMultiprocessor(&per_cu, fwd_megakernel, NTHR, 0);
    if (per_cu < 1) per_cu = 1;
    if (per_cu > 1) per_cu = 1;
    grid_blocks = cus * per_cu;
  }
  Params p{};
  const float** pf = (const float**)&p;
  for (int i = 0; i < 19; ++i) pf[i] = (const float*)d_in[i];
  p.out = (float*)d_out;
  p.ws = (unsigned char*)d_ws;
#if ONE_LAUNCH
  hipMemsetAsync((unsigned char*)d_ws + OFF_BAR, 0, XCD_BAR_WORDS * 4, stream);
  p.phase_lo = 0; p.phase_hi = 9; p.dup = DUP_MASK;
  void* args[] = {&p};
  hipError_t e = hipLaunchCooperativeKernel((void*)fwd_megakernel, dim3(grid_blocks), dim3(NTHR), args, 0, stream);
  if (e != hipSuccess) fprintf(stderr, "cooperative launch failed: %s (grid %d)\n", hipGetErrorString(e), grid_blocks);
#else
  for (int ph = 0; ph <= 9; ++ph) {
    p.phase_lo = ph; p.phase_hi = ph;
    void* args[] = {&p};
    hipLaunchCooperativeKernel((void*)fwd_megakernel, dim3(grid_blocks), dim3(NTHR), args, 0, stream);
  }
#endif
}
```

```cpp
#include <hip/hip_runtime.h>
#include <hip/hip_cooperative_groups.h>
#include <stdint.h>
#include <stdio.h>
namespace cg = cooperative_groups;

typedef __attribute__((ext_vector_type(8))) short bf16x8;
typedef __attribute__((ext_vector_type(4))) short s16x4;
typedef __attribute__((ext_vector_type(4))) float f32x4;
typedef unsigned short u16;
typedef __attribute__((ext_vector_type(4))) unsigned int u32x4;
typedef __attribute__((ext_vector_type(2))) unsigned int u32x2;

#define NTHR 512
#define T_TOK 17408
#define NPROMPT 16384
#define LDS_BYTES 143360
#define PROJ_LD 6208

constexpr size_t OFF_WT0 = 0;
constexpr size_t OFF_WT1 = OFF_WT0 + (size_t)6144 * 1024 * 2;
constexpr size_t OFF_WT2 = OFF_WT1 + (size_t)1024 * 2048 * 2;
constexpr size_t OFF_WT3 = OFF_WT2 + (size_t)6272 * 1024 * 2;
constexpr size_t OFF_ROPE = OFF_WT3 + (size_t)1024 * 2048 * 2;
constexpr size_t OFF_H = OFF_ROPE + (size_t)2056 * 128 * 8;
constexpr size_t OFF_PROJ = OFF_H + (size_t)T_TOK * 1024 * 2;
constexpr size_t OFF_A2 = OFF_PROJ + (size_t)T_TOK * PROJ_LD * 2;
constexpr size_t OFF_PARTS = OFF_A2 + (size_t)T_TOK * 2048 * 2;
constexpr size_t OFF_X1 = OFF_PARTS + (size_t)T_TOK * 64 * 4;
constexpr size_t OFF_X2 = OFF_X1 + (size_t)T_TOK * 1024 * 4;
constexpr size_t OFF_XBCC = OFF_X2 + (size_t)T_TOK * 1024 * 4;
constexpr size_t OFF_DTRAW = OFF_XBCC + (size_t)T_TOK * 4096 * 2;
constexpr size_t OFF_DT = OFF_DTRAW + (size_t)T_TOK * 32 * 4;
constexpr size_t OFF_CUM = OFF_DT + (size_t)T_TOK * 32 * 4;
constexpr size_t OFF_BAR = OFF_CUM + (size_t)T_TOK * 32 * 4;

constexpr size_t OUT_Y = 0;
constexpr size_t OUT_RETP = 17825792;
constexpr size_t OUT_RETS = 22020096;
constexpr size_t OUT_SSMP = 89128960;
constexpr size_t OUT_SSMS = 91226112;
constexpr size_t OUT_CONVP = 124780544;
constexpr size_t OUT_CONVS = 124878848;

struct Params {
  const float *x_prompt, *x_sample, *state_ret, *state_ssm, *state_conv, *ret_norm, *ret_w_in, *ret_head_norm,
      *ret_w_out, *ssm_norm, *ssm_w_in, *ssm_conv_w, *ssm_conv_b, *ssm_dt_bias, *ssm_a_log, *ssm_d, *ssm_gate_norm,
      *ssm_w_out, *final_norm;
  float* out;
  unsigned char* ws;
  long long phase_lo, phase_hi, dup, tidx, wv;
};

typedef __bf16 bf16x2_t __attribute__((ext_vector_type(2)));
typedef float f32x2_t __attribute__((ext_vector_type(2)));
__device__ __forceinline__ u16 f2bf(float f) {
  __bf16 r = (__bf16)f;
  return __builtin_bit_cast(u16, r);
}
__device__ __forceinline__ float bf2f(u16 h) { return __uint_as_float(((uint32_t)h) << 16); }
__device__ __forceinline__ uint32_t pack2(float a, float b) {
  f32x2_t v = {a, b};
  bf16x2_t r = __builtin_convertvector(v, bf16x2_t);
  return __builtin_bit_cast(uint32_t, r);
}
__device__ __forceinline__ float silu(float x) { return x * __builtin_amdgcn_rcpf(1.0f + __expf(-x)); }
__device__ __forceinline__ float row16_sum(float v) {
  v += __builtin_bit_cast(float, __builtin_amdgcn_update_dpp(0, __builtin_bit_cast(int, v), 0xB1, 0xF, 0xF, true));
  v += __builtin_bit_cast(float, __builtin_amdgcn_update_dpp(0, __builtin_bit_cast(int, v), 0x4E, 0xF, 0xF, true));
  v += __builtin_bit_cast(float, __builtin_amdgcn_update_dpp(0, __builtin_bit_cast(int, v), 0x124, 0xF, 0xF, true));
  v += __builtin_bit_cast(float, __builtin_amdgcn_update_dpp(0, __builtin_bit_cast(int, v), 0x128, 0xF, 0xF, true));
  return v;
}
__device__ __forceinline__ float wave_sum(float v) {
#pragma unroll
  for (int o = 32; o > 0; o >>= 1) v += __shfl_xor(v, o);
  return v;
}
__device__ __forceinline__ const float* xrow(const Params& p, int r) {
  return r < NPROMPT ? p.x_prompt + (size_t)r * 1024 : p.x_sample + (size_t)(r - NPROMPT) * 1024;
}
__device__ __forceinline__ s16x4 trread(const unsigned char* ptr) {
  return __builtin_amdgcn_ds_read_tr16_b64_v4i16((s16x4 __attribute__((address_space(3)))*)ptr);
}
__device__ __forceinline__ bf16x8 cat8(s16x4 a, s16x4 b) {
  bf16x8 r;
  r[0] = a[0]; r[1] = a[1]; r[2] = a[2]; r[3] = a[3];
  r[4] = b[0]; r[5] = b[1]; r[6] = b[2]; r[7] = b[3];
  return r;
}
__device__ __forceinline__ bf16x8 trfrag(const unsigned char* img, int rs, int kbase, int nbase, int lane) {
  const int g = lane >> 4, q = (lane & 15) >> 2, pp = lane & 3;
  const unsigned char* a = img + (kbase + 8 * g + q) * rs + (nbase + 4 * pp) * 2;
  s16x4 t0 = trread(a);
  s16x4 t1 = trread(a + 4 * rs);
  return cat8(t0, t1);
}

__device__ __forceinline__ int colmap_retin(int p) {
  if (p < 2048) {
    int hb = p & ~255, pp = p & 255;
    int gi = pp >> 5, half = (pp >> 4) & 1, c = pp & 15;
    return hb + half * 128 + gi * 16 + c;
  }
  return p;
}

__device__ void transpose_tile(const float* __restrict__ W, u16* __restrict__ Wt, int K, int N, int mode, int nt, int kt,
                               unsigned char* smem, const int tid) {
  float* tile = (float*)smem;
#pragma unroll
  for (int i = 0; i < 8; ++i) {
    int idx = tid + NTHR * i;
    int kk = idx >> 6, nn = idx & 63;
    int n = nt * 64 + nn;
    int src = (mode == 1) ? colmap_retin(n) : n;
    float v = 0.f;
    if (src < N) v = W[(size_t)(kt * 64 + kk) * N + src];
    tile[kk * 65 + nn] = v;
  }
  __syncthreads();
  {
    int n = tid >> 3, kc = tid & 7;
    float v[8];
#pragma unroll
    for (int j = 0; j < 8; ++j) v[j] = tile[(kc * 8 + j) * 65 + n];
    u32x4 o;
    o.x = pack2(v[0], v[1]); o.y = pack2(v[2], v[3]); o.z = pack2(v[4], v[5]); o.w = pack2(v[6], v[7]);
    *(u32x4*)(Wt + (size_t)(nt * 64 + n) * K + kt * 64 + kc * 8) = o;
  }
  __syncthreads();
}

__device__ void phase_prep(const Params& p, unsigned char* smem, const int rep) {
  const int tid = (int)p.tidx;
  for (int rr = 0; rr < rep; ++rr) {
  u16* Wt0 = (u16*)(p.ws + OFF_WT0);
  u16* Wt1 = (u16*)(p.ws + OFF_WT1);
  u16* Wt2 = (u16*)(p.ws + OFF_WT2);
  u16* Wt3 = (u16*)(p.ws + OFF_WT3);
  const int n0 = 1536, n1 = 512, n2 = 1568, n3 = 512;
  for (int t = blockIdx.x; t < n0 + n1 + n2 + n3; t += gridDim.x) {
    if (t < n0) {
      transpose_tile(p.ret_w_in, Wt0, 1024, 6144, 1, t >> 4, t & 15, smem, tid);
    } else if (t < n0 + n1) {
      int u = t - n0;
      transpose_tile(p.ret_w_out, Wt1, 2048, 1024, 0, u >> 5, u & 31, smem, tid);
    } else if (t < n0 + n1 + n2) {
      int u = t - n0 - n1;
      transpose_tile(p.ssm_w_in, Wt2, 1024, 6176, 0, u >> 4, u & 15, smem, tid);
    } else {
      int u = t - n0 - n1 - n2;
      transpose_tile(p.ssm_w_out, Wt3, 2048, 1024, 0, u >> 5, u & 31, smem, tid);
    }
  }
  float2* rope = (float2*)(p.ws + OFF_ROPE);
  const int gtid = blockIdx.x * NTHR + tid, gn = gridDim.x * NTHR;
  for (int idx = gtid; idx < 2056 * 128; idx += gn) {
    int pi = idx >> 7, i = idx & 127;
    int pos = pi < 2048 ? pi : 16384 + (pi - 2048);
    float freq = (float)exp2(-(double)i * (13.287712379549449 / 128.0));
    float ang = (float)pos * freq;
    float sn, cs;
    sincosf(ang, &sn, &cs);
    rope[idx] = make_float2(cs, sn);
  }
  u16* H = (u16*)(p.ws + OFF_H);
  const int lane = tid & 63, w = (int)p.wv;
  for (int row = blockIdx.x * 8 + w; row < T_TOK; row += gridDim.x * 8) {
    const float* xr = xrow(p, row);
    float4 v[4];
    float ss = 0.f;
#pragma unroll
    for (int i = 0; i < 4; ++i) {
      v[i] = *(const float4*)(xr + i * 256 + lane * 4);
      ss += v[i].x * v[i].x + v[i].y * v[i].y + v[i].z * v[i].z + v[i].w * v[i].w;
    }
    ss = wave_sum(ss);
    float rstd = rsqrtf(ss * (1.0f / 1024.0f) + 1e-6f);
#pragma unroll
    for (int i = 0; i < 4; ++i) {
      float4 gg = *(const float4*)(p.ret_norm + i * 256 + lane * 4);
      u32x2 o;
      o.x = pack2(v[i].x * rstd * gg.x, v[i].y * rstd * gg.y);
      o.y = pack2(v[i].z * rstd * gg.z, v[i].w * rstd * gg.w);
      *(u32x2*)(H + (size_t)row * 1024 + i * 256 + lane * 4) = o;
    }
  }
  }
}

template <int MODE>
__device__ void phase_norm(const Params& p, const float* __restrict__ X, const float* __restrict__ gain, const int rep) {
  const int tid = (int)p.tidx, lane = tid & 63, w = (int)p.wv;
  u16* H = (u16*)(p.ws + OFF_H);
  for (int row0 = blockIdx.x * 8 + w; row0 < T_TOK * rep; row0 += gridDim.x * 8) {
    const int row = row0 % T_TOK;
    const float* xr = X + (size_t)row * 1024;
    float4 v[4];
    float ss = 0.f;
#pragma unroll
    for (int i = 0; i < 4; ++i) {
      v[i] = *(const float4*)(xr + i * 256 + lane * 4);
      ss += v[i].x * v[i].x + v[i].y * v[i].y + v[i].z * v[i].z + v[i].w * v[i].w;
    }
    ss = wave_sum(ss);
    float rstd = rsqrtf(ss * (1.0f / 1024.0f) + 1e-6f);
#pragma unroll
    for (int i = 0; i < 4; ++i) {
      float4 gg = *(const float4*)(gain + i * 256 + lane * 4);
      if (MODE == 0) {
        u32x2 o;
        o.x = pack2(v[i].x * rstd * gg.x, v[i].y * rstd * gg.y);
        o.y = pack2(v[i].z * rstd * gg.z, v[i].w * rstd * gg.w);
        *(u32x2*)(H + (size_t)row * 1024 + i * 256 + lane * 4) = o;
      } else {
        float4 o = make_float4(v[i].x * rstd * gg.x, v[i].y * rstd * gg.y, v[i].z * rstd * gg.z, v[i].w * rstd * gg.w);
        *(float4*)(p.out + OUT_Y + (size_t)row * 1024 + i * 256 + lane * 4) = o;
      }
    }
  }
}

template <int EPI, int NH>
__device__ void gemm_phase(const Params& p, const u16* __restrict__ A, const u16* __restrict__ Bt, const int K, const int NT,
                           const float* __restrict__ resid, float* __restrict__ outf, unsigned char* smem, const int rep,
                           const int mtiles, const int nt0 = 0, const bool rev = false) {
  constexpr int BM = 256, BN = 128, BK = 64, LR = 144;
  constexpr int BUFB = (BM + BN) * LR;
  float* rstdS = (float*)(smem + 2 * BUFB);
  const int tid = (int)p.tidx, lane = tid & 63, w = (int)p.wv;
  const int wm = w >> 1, wn = w & 1, l15 = lane & 15, g = lane >> 4;
  const int KT = K / BK;
  const int ntiles = mtiles * NT;
  const float* parts = (const float*)(p.ws + OFF_PARTS);
  const int srow = tid >> 3, skc = tid & 7;

  for (int tile0 = rev ? (int)(gridDim.x - 1 - blockIdx.x) : (int)blockIdx.x; tile0 < ntiles * rep; tile0 += gridDim.x) {
    const int tile = tile0 % ntiles;
    const int mt = tile / NT, nt = tile - mt * NT + nt0;
    const int m0 = mt * BM, n0 = nt * BN;
    const bool skip_mma = (EPI == 2) && (n0 >= 6144) && (wn == 1);
    if (NH > 0) {
      for (int idx = tid; idx < BM * NH; idx += NTHR) {
        int row = idx / NH, h = idx % NH;
        const float* pp = parts + (size_t)(m0 + row) * 64 + h * (64 / NH);
        float s = 0.f;
#pragma unroll
        for (int q = 0; q < 64 / NH; ++q) s += pp[q];
        rstdS[idx] = rsqrtf(s / (float)(K / NH) + 1e-6f);
      }
    }
    u32x4 ra[2][4], rb[2][2];
    const u16* ap = A + (size_t)(m0 + srow) * K + skc * 8;
    const u16* bp = Bt + (size_t)(n0 + srow) * K + skc * 8;
#pragma unroll
    for (int i = 0; i < 4; ++i) ra[0][i] = *(const u32x4*)(ap + (size_t)(64 * i) * K);
#pragma unroll
    for (int i = 0; i < 2; ++i) rb[0][i] = *(const u32x4*)(bp + (size_t)(64 * i) * K);
#pragma unroll
    for (int i = 0; i < 4; ++i) ra[1][i] = *(const u32x4*)(ap + (size_t)(64 * i) * K + BK);
#pragma unroll
    for (int i = 0; i < 2; ++i) rb[1][i] = *(const u32x4*)(bp + (size_t)(64 * i) * K + BK);
    {
      unsigned char* base = smem;
#pragma unroll
      for (int i = 0; i < 4; ++i) *(u32x4*)(base + (srow + 64 * i) * LR + skc * 16) = ra[0][i];
#pragma unroll
      for (int i = 0; i < 2; ++i) *(u32x4*)(base + BM * LR + (srow + 64 * i) * LR + skc * 16) = rb[0][i];
    }
    __syncthreads();

    f32x4 acc[4][4];
    f32x4 accT[4][4];
#pragma unroll
    for (int i = 0; i < 4; ++i)
#pragma unroll
      for (int j = 0; j < 4; ++j) {
        acc[i][j] = (f32x4){0.f, 0.f, 0.f, 0.f};
        accT[i][j] = (f32x4){0.f, 0.f, 0.f, 0.f};
      }

    for (int kt2 = 0; kt2 < KT; kt2 += 2) {
#pragma unroll
     for (int par = 0; par < 2; ++par) {
      const int kt = kt2 + par;
      if (kt + 2 < KT) {
#pragma unroll
        for (int i = 0; i < 4; ++i) ra[par][i] = *(const u32x4*)(ap + (size_t)(64 * i) * K + (kt + 2) * BK);
#pragma unroll
        for (int i = 0; i < 2; ++i) rb[par][i] = *(const u32x4*)(bp + (size_t)(64 * i) * K + (kt + 2) * BK);
      }
      const unsigned char* abase = smem + par * BUFB + (wm * 64 + l15) * LR + g * 16;
      const unsigned char* bbase = smem + par * BUFB + BM * LR + (wn * 64 + l15) * LR + g * 16;
      if (!skip_mma)
#pragma unroll
      for (int ks = 0; ks < 2; ++ks) {
        bf16x8 af[4], bfr[4];
#pragma unroll
        for (int mf = 0; mf < 4; ++mf) af[mf] = *(const bf16x8*)(abase + mf * 16 * LR + ks * 64);
#pragma unroll
        for (int nf = 0; nf < 4; ++nf) bfr[nf] = *(const bf16x8*)(bbase + nf * 16 * LR + ks * 64);
#pragma unroll
        for (int mf = 0; mf < 4; ++mf)
#pragma unroll
          for (int nf = 0; nf < 4; ++nf)
            acc[mf][nf] = __builtin_amdgcn_mfma_f32_16x16x32_bf16(af[mf], bfr[nf], acc[mf][nf], 0, 0, 0);
      }
      if (NH > 0) {
        const int per = KT / NH;
        if (((kt + 1) % per) == 0) {
          const int h = (kt + 1) / per - 1;
#pragma unroll
          for (int mf = 0; mf < 4; ++mf)
#pragma unroll
            for (int r = 0; r < 4; ++r) {
              float s = rstdS[(wm * 64 + mf * 16 + 4 * g + r) * NH + h];
#pragma unroll
              for (int nf = 0; nf < 4; ++nf) {
                accT[mf][nf][r] += s * acc[mf][nf][r];
                acc[mf][nf][r] = 0.f;
              }
            }
        }
      }
      if (kt + 1 < KT) {
        unsigned char* base = smem + (par ^ 1) * BUFB;
#pragma unroll
        for (int i = 0; i < 4; ++i) *(u32x4*)(base + (srow + 64 * i) * LR + skc * 16) = ra[par ^ 1][i];
#pragma unroll
        for (int i = 0; i < 2; ++i) *(u32x4*)(base + BM * LR + (srow + 64 * i) * LR + skc * 16) = rb[par ^ 1][i];
      }
      __syncthreads();
     }
    }

#pragma unroll
    for (int mf = 0; mf < 4; ++mf) {
      __builtin_amdgcn_sched_barrier(0);
      float rvv[4][4];
      if (EPI == 1) {
#pragma unroll
        for (int r = 0; r < 4; ++r) {
          const int row = m0 + wm * 64 + mf * 16 + 4 * g + r;
#pragma unroll
          for (int nf = 0; nf < 4; ++nf) {
            const int col = n0 + wn * 64 + nf * 16 + l15;
            rvv[r][nf] = resid ? resid[(size_t)row * 1024 + col] : xrow(p, row)[col];
          }
        }
      }
#pragma unroll
      for (int r = 0; r < 4; ++r) {
        const int row = m0 + wm * 64 + mf * 16 + 4 * g + r;
        if (EPI == 0) {
          u16* proj = (u16*)(p.ws + OFF_PROJ) + (size_t)row * PROJ_LD;
          if (n0 < 2048) {
            const float2* rope = (const float2*)(p.ws + OFF_ROPE);
            const int pi = row < NPROMPT ? (row & 2047) : 2048 + ((row - NPROMPT) & 7);
#pragma unroll
            for (int np = 0; np < 2; ++np) {
              const int pc = n0 + wn * 64 + np * 32;
              const int i = ((pc & 255) >> 5) * 16 + l15;
              const float2 cs = rope[pi * 128 + i];
              const float x1 = acc[mf][2 * np][r], x2 = acc[mf][2 * np + 1][r];
              float y1 = x1 * cs.x - x2 * cs.y, y2 = x1 * cs.y + x2 * cs.x;
              if (pc >= 1024) { y1 *= 0.0625f; y2 *= 0.0625f; }
              const int f1 = (pc & ~255) + i;
              proj[f1] = f2bf(y1);
              proj[f1 + 128] = f2bf(y2);
            }
          } else {
#pragma unroll
            for (int nf = 0; nf < 4; ++nf) proj[n0 + wn * 64 + nf * 16 + l15] = f2bf(acc[mf][nf][r]);
          }
        } else if (EPI == 1) {
#pragma unroll
          for (int nf = 0; nf < 4; ++nf) {
            const int col = n0 + wn * 64 + nf * 16 + l15;
            const float a = (NH > 0) ? accT[mf][nf][r] : acc[mf][nf][r];
            outf[(size_t)row * 1024 + col] = rvv[r][nf] + a;
          }
        } else {
          u16* proj = (u16*)(p.ws + OFF_PROJ) + (size_t)row * PROJ_LD;
          float* dtraw = (float*)(p.ws + OFF_DTRAW) + (size_t)row * 32;
          float* cvo = nullptr;
          if (row < NPROMPT) {
            const int t = row & 2047;
            if (t >= 2045) cvo = p.out + OUT_CONVP + ((size_t)(row >> 11) * 3 + (t - 2045)) * 4096;
          } else {
            const int rs = row - NPROMPT, t = rs & 7;
            if (t >= 5) cvo = p.out + OUT_CONVS + ((size_t)(rs >> 3) * 3 + (t - 5)) * 4096;
          }
#pragma unroll
          for (int nf = 0; nf < 4; ++nf) {
            const int col = n0 + wn * 64 + nf * 16 + l15;
            const float a = acc[mf][nf][r];
            if (col < 6144) {
              proj[col] = f2bf(a);
              if (col >= 2048 && cvo) cvo[col - 2048] = a;
            } else if (col < 6176) {
              dtraw[col - 6144] = a;
            }
          }
        }
      }
    }
  }
}


template <int NH>
__device__ void gemm_sample_rows(const Params& p, const u16* __restrict__ A, const u16* __restrict__ Bt,
                                 const float* __restrict__ resid, float* __restrict__ outf, unsigned char* smem, const int rep) {
  constexpr int K = 2048, RS = 65;
  float* red = (float*)smem;
  float* rstdS = red + 8 * 64 * RS;
  const int tid = (int)p.tidx, lane = tid & 63, w = (int)p.wv, l15 = lane & 15, g = lane >> 4;
  const float* parts = (const float*)(p.ws + OFF_PARTS);
  for (int item0 = blockIdx.x; item0 < 256 * rep; item0 += gridDim.x) {
    const int item = item0 & 255;
    const int m0 = NPROMPT + (item >> 4) * 64, n0 = (item & 15) * 64;
    for (int idx = tid; idx < 64 * NH; idx += NTHR) {
      const int row = idx / NH, h = idx % NH;
      const float* pp = parts + (size_t)(m0 + row) * 64 + h * (64 / NH);
      float sm = 0.f;
#pragma unroll
      for (int q = 0; q < 64 / NH; ++q) sm += pp[q];
      rstdS[idx] = rsqrtf(sm / (float)(K / NH) + 1e-6f);
    }
    f32x4 acc[4][4];
#pragma unroll
    for (int i = 0; i < 4; ++i)
#pragma unroll
      for (int j = 0; j < 4; ++j) acc[i][j] = (f32x4){0.f, 0.f, 0.f, 0.f};
    const u16* ap = A + (size_t)(m0 + l15) * K + w * 256 + 8 * g;
    const u16* bp = Bt + (size_t)(n0 + l15) * K + w * 256 + 8 * g;
#pragma unroll 2
    for (int ks = 0; ks < 8; ++ks) {
      bf16x8 af[4], bfr[4];
#pragma unroll
      for (int mf = 0; mf < 4; ++mf) af[mf] = *(const bf16x8*)(ap + (size_t)(mf * 16) * K + ks * 32);
#pragma unroll
      for (int nf = 0; nf < 4; ++nf) bfr[nf] = *(const bf16x8*)(bp + (size_t)(nf * 16) * K + ks * 32);
#pragma unroll
      for (int mf = 0; mf < 4; ++mf)
#pragma unroll
        for (int nf = 0; nf < 4; ++nf)
          acc[mf][nf] = __builtin_amdgcn_mfma_f32_16x16x32_bf16(af[mf], bfr[nf], acc[mf][nf], 0, 0, 0);
    }
    __syncthreads();
    {
      const int h = (w * 256) / (K / NH);
#pragma unroll
      for (int mf = 0; mf < 4; ++mf)
#pragma unroll
        for (int r = 0; r < 4; ++r) {
          const int row = mf * 16 + 4 * g + r;
          const float sc = rstdS[row * NH + h];
#pragma unroll
          for (int nf = 0; nf < 4; ++nf) red[(w * 64 + row) * RS + nf * 16 + l15] = acc[mf][nf][r] * sc;
        }
    }
    __syncthreads();
    {
      const int row = tid >> 3, c0 = (tid & 7) * 8;
      float o[8];
      const size_t gidx = (size_t)(m0 + row) * 1024 + n0 + c0;
      const float* rp = resid ? resid + gidx : p.x_sample + (size_t)(m0 - NPROMPT + row) * 1024 + n0 + c0;
      const float4 r0 = *(const float4*)rp, r1 = *(const float4*)(rp + 4);
      o[0] = r0.x; o[1] = r0.y; o[2] = r0.z; o[3] = r0.w; o[4] = r1.x; o[5] = r1.y; o[6] = r1.z; o[7] = r1.w;
#pragma unroll
      for (int ww = 0; ww < 8; ++ww)
#pragma unroll
        for (int j = 0; j < 8; ++j) o[j] += red[(ww * 64 + row) * RS + c0 + j];
      *(float4*)(outf + gidx) = make_float4(o[0], o[1], o[2], o[3]);
      *(float4*)(outf + gidx + 4) = make_float4(o[4], o[5], o[6], o[7]);
    }
    __syncthreads();
  }
}

__device__ __forceinline__ int lds_byte(int r, int c) {
  int st = (r >> 4) * 2 + (c >> 5), rr = r & 15, cc = c & 31, ob = rr * 64 + cc * 2;
  return st * 1024 + (ob ^ (((ob >> 9) & 1) << 5));
}
__device__ __forceinline__ void stage_rc(int b, int& R, int& C) {
  int st = b / 1024, sb = b % 1024, swz = sb ^ (((sb >> 9) & 1) << 5);
  R = (st >> 1) * 16 + swz / 64;
  C = (st & 1) * 32 + (swz % 64) / 2;
}

template <int EPI>
__device__ void gemm8_phase(const Params& p, const u16* __restrict__ A, const u16* __restrict__ Bt, const int K, const int nN,
                            unsigned char* smem, const int rep) {
  constexpr int BM8 = 256, BK8 = 64, HALF = 128, NXCD = 8, WGM = 8, HT = HALF * BK8;
  u16* shm = (u16*)smem;
#define SA(b, h) (shm + ((b) * 2 + (h)) * HT)
#define SB(b, h) (shm + (4 + (b) * 2 + (h)) * HT)
#define STAGE(P, BASE, br, kt)                                                                            \
  do {                                                                                                    \
    const int _so = ((br) * K + (kt) * BK8) * 2;                                                          \
    __builtin_amdgcn_raw_ptr_buffer_load_lds(rsrc_##BASE, (__attribute__((address_space(3))) unsigned*)((char*)(P) + (int)p.tidx * 16), 16, voff0, _so, 0, 0); \
    __builtin_amdgcn_raw_ptr_buffer_load_lds(rsrc_##BASE, (__attribute__((address_space(3))) unsigned*)((char*)(P) + (int)p.tidx * 16 + 8192), 16, voff1, _so, 0, 0); \
  } while (0)
#define LDA(dst, b, h)                                                                                    \
  for (int m = 0; m < 4; ++m)                                                                             \
    for (int k = 0; k < 2; ++k)                                                                           \
      dst[m][k] = *reinterpret_cast<const bf16x8*>((char*)SA(b, h) + lds_byte(wr * 64 + m * 16 + fr, k * 32 + fq * 8))
#define LDB(dst, b, h)                                                                                    \
  for (int n = 0; n < 2; ++n)                                                                             \
    for (int k = 0; k < 2; ++k)                                                                           \
      dst[n][k] = *reinterpret_cast<const bf16x8*>((char*)SB(b, h) + lds_byte(wc * 32 + n * 16 + fr, k * 32 + fq * 8))
#define MMA(ai, bj, At, Bx)                                                                               \
  do {                                                                                                    \
    __builtin_amdgcn_s_setprio(1);                                                                        \
    for (int m = 0; m < 4; ++m)                                                                           \
      for (int n = 0; n < 2; ++n)                                                                         \
        for (int k = 0; k < 2; ++k)                                                                       \
          acc[ai][bj][m][n] = __builtin_amdgcn_mfma_f32_16x16x32_bf16(At[m][k], Bx[n][k], acc[ai][bj][m][n], 0, 0, 0); \
    __builtin_amdgcn_s_setprio(0);                                                                        \
  } while (0)
#define WAIT_V(n) asm volatile("s_waitcnt vmcnt(" #n ")" ::: "memory")
#define WAIT_L(n) asm volatile("s_waitcnt lgkmcnt(" #n ")" ::: "memory")
#define BAR __builtin_amdgcn_s_barrier()
#define SCHED __builtin_amdgcn_sched_barrier(0)

  const int nM = T_TOK / BM8, nwg = nM * nN;
  const int wid = (int)p.wv, lane = (int)p.tidx & 63, wr = wid >> 2, wc = wid & 3, fr = lane & 15, fq = lane >> 4;
  const int nt = K / BK8;
  const __amdgpu_buffer_rsrc_t rsrc_A = __builtin_amdgcn_make_buffer_rsrc((void*)A, (short)0, T_TOK * K * 2, 0x00020000);
  const __amdgpu_buffer_rsrc_t rsrc_Bt = __builtin_amdgcn_make_buffer_rsrc((void*)Bt, (short)0, nN * 256 * K * 2, 0x00020000);
  int voff0, voff1;
  {
    int r_, c_;
    stage_rc((int)p.tidx * 16, r_, c_);
    voff0 = (r_ * K + c_) * 2;
    stage_rc((int)p.tidx * 16 + 8192, r_, c_);
    voff1 = (r_ * K + c_) * 2;
  }

  for (int tile0 = blockIdx.x; tile0 < nwg * rep; tile0 += gridDim.x) {
    const int tile = tile0 % nwg;
    int wgid = tile;
    {
      int q = nwg / NXCD, r = nwg % NXCD, xcd = wgid % NXCD, off = wgid / NXCD;
      wgid = (xcd < r ? xcd * (q + 1) : r * (q + 1) + (xcd - r) * q) + off;
    }
    const int nig = WGM * nN, gid = wgid / nig, fm = gid * WGM, gsz = min(nM - fm, WGM);
    const int pm = fm + ((wgid % nig) % gsz), pn = (wgid % nig) / gsz, brow = pm * BM8, bcol = pn * BM8;

    f32x4 acc[2][2][4][2];
#pragma unroll
    for (int a = 0; a < 2; ++a)
#pragma unroll
      for (int b = 0; b < 2; ++b)
#pragma unroll
        for (int m = 0; m < 4; ++m)
#pragma unroll
          for (int n = 0; n < 2; ++n) acc[a][b][m][n] = (f32x4){0.f, 0.f, 0.f, 0.f};
    bf16x8 At[4][2], B0[2][2], B1[2][2];

    STAGE(SB(0, 0), Bt, bcol, 0); STAGE(SA(0, 0), A, brow, 0);
    STAGE(SB(0, 1), Bt, bcol + HALF, 0); STAGE(SA(0, 1), A, brow + HALF, 0);
    if (wr == 1) BAR;
    WAIT_V(4); BAR;
    STAGE(SB(1, 0), Bt, bcol, 1); STAGE(SA(1, 0), A, brow, 1); STAGE(SB(1, 1), Bt, bcol + HALF, 1);
    WAIT_V(6); BAR;
    for (int t = 0; t < nt - 2; t += 2) {
      LDB(B0, 0, 0); SCHED; LDA(At, 0, 0); STAGE(SA(1, 1), A, brow + HALF, t + 1);
      WAIT_L(8); BAR; WAIT_L(0); MMA(0, 0, At, B0); BAR; SCHED;
      LDB(B1, 0, 1); STAGE(SB(0, 0), Bt, bcol, t + 2);
      BAR; WAIT_L(0); MMA(0, 1, At, B1); BAR;
      LDA(At, 0, 1); STAGE(SA(0, 0), A, brow, t + 2);
      BAR; WAIT_L(0); MMA(1, 0, At, B0); BAR; SCHED;
      STAGE(SB(0, 1), Bt, bcol + HALF, t + 2);
      WAIT_V(6); BAR; MMA(1, 1, At, B1); BAR;
      LDB(B0, 1, 0); SCHED; LDA(At, 1, 0); STAGE(SA(0, 1), A, brow + HALF, t + 2);
      WAIT_L(8); BAR; WAIT_L(0); MMA(0, 0, At, B0); BAR; SCHED;
      LDB(B1, 1, 1); STAGE(SB(1, 0), Bt, bcol, t + 3);
      BAR; WAIT_L(0); MMA(0, 1, At, B1); BAR;
      LDA(At, 1, 1); STAGE(SA(1, 0), A, brow, t + 3);
      BAR; WAIT_L(0); MMA(1, 0, At, B0); BAR; SCHED;
      STAGE(SB(1, 1), Bt, bcol + HALF, t + 3);
      WAIT_V(6); BAR; MMA(1, 1, At, B1); BAR;
    }
    {
      LDB(B0, 0, 0); LDA(At, 0, 0); STAGE(SA(1, 1), A, brow + HALF, nt - 1);
      BAR; WAIT_L(0); MMA(0, 0, At, B0); BAR; SCHED;
      LDB(B1, 0, 1); BAR; WAIT_L(0); MMA(0, 1, At, B1); BAR; SCHED;
      LDA(At, 0, 1); WAIT_V(4); BAR; WAIT_L(0); MMA(1, 0, At, B0); MMA(1, 1, At, B1); BAR; SCHED;
    }
    {
      LDB(B0, 1, 0); LDA(At, 1, 0); WAIT_V(2); BAR; WAIT_L(0); MMA(0, 0, At, B0); BAR; SCHED;
      LDB(B1, 1, 1); WAIT_V(0); BAR; WAIT_L(0); MMA(0, 1, At, B1); BAR; SCHED;
      LDA(At, 1, 1); BAR; WAIT_L(0); MMA(1, 0, At, B0); MMA(1, 1, At, B1); BAR; SCHED;
    }
    if (wr == 0) BAR;

    u16* projb = (u16*)(p.ws + OFF_PROJ);
#pragma unroll
    for (int ai = 0; ai < 2; ++ai)
#pragma unroll
      for (int m = 0; m < 4; ++m) {
        if (EPI == 0 && bcol < 2048) {
          const float2* rope = (const float2*)(p.ws + OFF_ROPE);
#pragma unroll
          for (int bj = 0; bj < 2; ++bj) {
            __builtin_amdgcn_sched_barrier(0);
            const int pc = bcol + bj * HALF + wc * 32;
            const int i = ((pc & 255) >> 5) * 16 + fr;
            const int f1 = (pc & ~255) + i;
            float2 csv[4];
#pragma unroll
            for (int j = 0; j < 4; ++j) {
              const int row = brow + ai * HALF + wr * 64 + m * 16 + fq * 4 + j;
              const int pi = row < NPROMPT ? (row & 2047) : 2048 + ((row - NPROMPT) & 7);
              csv[j] = rope[pi * 128 + i];
            }
#pragma unroll
            for (int j = 0; j < 4; ++j) {
              const int row = brow + ai * HALF + wr * 64 + m * 16 + fq * 4 + j;
              u16* proj = projb + (size_t)row * PROJ_LD;
              const float2 cs = csv[j];
              const float x1 = acc[ai][bj][m][0][j], x2 = acc[ai][bj][m][1][j];
              float y1 = x1 * cs.x - x2 * cs.y, y2 = x1 * cs.y + x2 * cs.x;
              if (pc >= 1024) { y1 *= 0.0625f; y2 *= 0.0625f; }
              proj[f1] = f2bf(y1);
              proj[f1 + 128] = f2bf(y2);
            }
          }
        } else {
#pragma unroll
          for (int j = 0; j < 4; ++j) {
            __builtin_amdgcn_sched_barrier(0);
            const int row = brow + ai * HALF + wr * 64 + m * 16 + fq * 4 + j;
            u16* proj = projb + (size_t)row * PROJ_LD;
            float* cvo = nullptr;
            if (EPI == 2 && bcol >= 2048) {
              if (row < NPROMPT) {
                const int t = row & 2047;
                if (t >= 2045) cvo = p.out + OUT_CONVP + ((size_t)(row >> 11) * 3 + (t - 2045)) * 4096;
              } else {
                const int rs = row - NPROMPT, t = rs & 7;
                if (t >= 5) cvo = p.out + OUT_CONVS + ((size_t)(rs >> 3) * 3 + (t - 5)) * 4096;
              }
            }
#pragma unroll
            for (int bj = 0; bj < 2; ++bj)
#pragma unroll
              for (int n = 0; n < 2; ++n) {
                const int col = bcol + bj * HALF + wc * 32 + n * 16 + fr;
                const float a = acc[ai][bj][m][n][j];
                proj[col] = f2bf(a);
                if (EPI == 2 && cvo) cvo[col - 2048] = a;
              }
          }
        }
      }
  }
#undef SA
#undef SB
#undef STAGE
#undef LDA
#undef LDB
#undef MMA
#undef WAIT_V
#undef WAIT_L
#undef BAR
#undef SCHED
}

__device__ __forceinline__ void unpack8(const u32x4 u, float* xv) {
  xv[0] = bf2f((u16)(u.x & 0xffff)); xv[1] = bf2f((u16)(u.x >> 16));
  xv[2] = bf2f((u16)(u.y & 0xffff)); xv[3] = bf2f((u16)(u.y >> 16));
  xv[4] = bf2f((u16)(u.z & 0xffff)); xv[5] = bf2f((u16)(u.z >> 16));
  xv[6] = bf2f((u16)(u.w & 0xffff)); xv[7] = bf2f((u16)(u.w >> 16));
}

__device__ void phase_conv(const Params& p, unsigned char* smem, const int rep) {
  const int tid = (int)p.tidx;
  const float* dtraw = (const float*)(p.ws + OFF_DTRAW);
  float* dtv = (float*)(p.ws + OFF_DT);
  float* cumv = (float*)(p.ws + OFF_CUM);
  {
    float* laS = (float*)smem;
    const int tok = tid >> 3, h0 = (tid & 7) * 4;
    const float4 bias = *(const float4*)(p.ssm_dt_bias + h0);
    const float4 al = *(const float4*)(p.ssm_a_log + h0);
    const float4 an = make_float4(-expf(al.x), -expf(al.y), -expf(al.z), -expf(al.w));
    for (int sc = blockIdx.x; sc < 384; sc += gridDim.x) {
      int row0, len;
      if (sc < 256) { row0 = sc * 64; len = 64; } else { row0 = NPROMPT + (sc - 256) * 8; len = 8; }
      if (tok < len) {
        const float4 x = *(const float4*)(dtraw + (size_t)(row0 + tok) * 32 + h0);
        float4 dt;
        { float v = x.x + bias.x; dt.x = v > 20.f ? v : log1pf(expf(v)); }
        { float v = x.y + bias.y; dt.y = v > 20.f ? v : log1pf(expf(v)); }
        { float v = x.z + bias.z; dt.z = v > 20.f ? v : log1pf(expf(v)); }
        { float v = x.w + bias.w; dt.w = v > 20.f ? v : log1pf(expf(v)); }
        *(float4*)(dtv + (size_t)(row0 + tok) * 32 + h0) = dt;
        *(float4*)(laS + tok * 32 + h0) = make_float4(dt.x * an.x, dt.y * an.y, dt.z * an.z, dt.w * an.w);
      }
      __syncthreads();
      if (tok < len) {
        float4 c = make_float4(0.f, 0.f, 0.f, 0.f);
        for (int t = 0; t <= tok; ++t) {
          const float4 v = *(const float4*)(laS + t * 32 + h0);
          c.x += v.x; c.y += v.y; c.z += v.z; c.w += v.w;
        }
        *(float4*)(cumv + (size_t)(row0 + tok) * 32 + h0) = c;
      }
      __syncthreads();
    }
  }
  const u16* proj = (const u16*)(p.ws + OFF_PROJ);
  u16* xbcc = (u16*)(p.ws + OFF_XBCC);
  const int gtid = blockIdx.x * NTHR + tid;
  const int ch0 = (gtid & 511) * 8, rb = gtid >> 9;
  float wgt[4][8], bs[8];
#pragma unroll
  for (int wv = 0; wv < 4; ++wv) {
    const float4 w0 = *(const float4*)(p.ssm_conv_w + (size_t)wv * 4096 + ch0);
    const float4 w1 = *(const float4*)(p.ssm_conv_w + (size_t)wv * 4096 + ch0 + 4);
    wgt[wv][0] = w0.x; wgt[wv][1] = w0.y; wgt[wv][2] = w0.z; wgt[wv][3] = w0.w;
    wgt[wv][4] = w1.x; wgt[wv][5] = w1.y; wgt[wv][6] = w1.z; wgt[wv][7] = w1.w;
  }
  {
    const float4 b0 = *(const float4*)(p.ssm_conv_b + ch0), b1 = *(const float4*)(p.ssm_conv_b + ch0 + 4);
    bs[0] = b0.x; bs[1] = b0.y; bs[2] = b0.z; bs[3] = b0.w; bs[4] = b1.x; bs[5] = b1.y; bs[6] = b1.z; bs[7] = b1.w;
  }
  const int rows_per = T_TOK / (int)(gridDim.x * NTHR / 512);
  for (int rr = 0; rr < rep; ++rr) {
    float hm3[8], hm2[8], hm1[8];
    const int rbeg = rb * rows_per;
    u32x4 cur[4], nxt[4];
#pragma unroll
    for (int q = 0; q < 4; ++q) cur[q] = *(const u32x4*)(proj + (size_t)(rbeg + q) * PROJ_LD + 2048 + ch0);
    for (int r4 = 0; r4 < rows_per; r4 += 4) {
#pragma unroll
      for (int q = 0; q < 4; ++q) {
        nxt[q] = cur[q];
        if (r4 + 4 + q < rows_per) nxt[q] = *(const u32x4*)(proj + (size_t)(rbeg + r4 + 4 + q) * PROJ_LD + 2048 + ch0);
      }
#pragma unroll
      for (int q4 = 0; q4 < 4; ++q4) {
        const int r = r4 + q4;
        const int row = rbeg + r;
        const bool samp = row >= NPROMPT;
        const int t = samp ? ((row - NPROMPT) & 7) : (row & 2047);
        const int b = samp ? ((row - NPROMPT) >> 3) : (row >> 11);
        if (r == 0 || t == 0) {
#pragma unroll
          for (int k = 1; k <= 3; ++k) {
            float hv[8];
            if (t - k >= 0) {
              unpack8(*(const u32x4*)(proj + (size_t)(row - k) * PROJ_LD + 2048 + ch0), hv);
            } else if (samp) {
              const float* sp = p.state_conv + ((size_t)b * 3 + (t - k + 3)) * 4096 + ch0;
              const float4 s0 = *(const float4*)sp, s1 = *(const float4*)(sp + 4);
              hv[0] = s0.x; hv[1] = s0.y; hv[2] = s0.z; hv[3] = s0.w; hv[4] = s1.x; hv[5] = s1.y; hv[6] = s1.z; hv[7] = s1.w;
            } else {
#pragma unroll
              for (int q = 0; q < 8; ++q) hv[q] = 0.f;
            }
#pragma unroll
            for (int q = 0; q < 8; ++q) {
              if (k == 1) hm1[q] = hv[q];
              if (k == 2) hm2[q] = hv[q];
              if (k == 3) hm3[q] = hv[q];
            }
          }
        }
        float xc[8], o[8];
        unpack8(cur[q4], xc);
#pragma unroll
        for (int q = 0; q < 8; ++q) {
          const float a = bs[q] + hm3[q] * wgt[0][q] + hm2[q] * wgt[1][q] + hm1[q] * wgt[2][q] + xc[q] * wgt[3][q];
          o[q] = silu(a);
          hm3[q] = hm2[q]; hm2[q] = hm1[q]; hm1[q] = xc[q];
        }
        u32x4 ov;
        ov.x = pack2(o[0], o[1]); ov.y = pack2(o[2], o[3]); ov.z = pack2(o[4], o[5]); ov.w = pack2(o[6], o[7]);
        *(u32x4*)(xbcc + (size_t)row * 4096 + ch0) = ov;
      }
#pragma unroll
      for (int q = 0; q < 4; ++q) cur[q] = nxt[q];
    }
  }
}

template <int DK, int MODE>
__device__ void rec_prompt_item(const Params& p, const int item, unsigned char* smem) {
  constexpr int QS = (DK + 16) * 2;
  constexpr int VS = 160, PS = 144;
  constexpr int MF = DK / 128;
  constexpr int KS = DK / 32;
  constexpr int NQ = DK / 64;
  constexpr int CPR = DK / 8;
  unsigned char* Qs = smem;
  unsigned char* Ks = Qs + 64 * QS;
  unsigned char* STs = Ks + 64 * QS;
  unsigned char* Vs = STs + 64 * QS;
  unsigned char* Vts = Vs + 64 * VS;
  unsigned char* Ps = Vts + 64 * VS;
  float* cumS = (float*)(Ps + 64 * PS);
  float* uS = cumS + 64;

  const int tid = (int)p.tidx, lane = tid & 63, w = tid >> 6;
  const int l15 = lane & 15, g = lane >> 4;
  const int b = item >> 5;
  const int h = (MODE == 0) ? ((item >> 3) & 3) : (item & 31);
  const int s = (MODE == 0) ? (item & 7) : 0;
  const int row0 = b * 2048;

  const u16* src;
  int sstride, qcol, kcol, vcol;
  if (MODE == 0) {
    src = (const u16*)(p.ws + OFF_PROJ); sstride = PROJ_LD;
    qcol = h * 256; kcol = 1024 + h * 256; vcol = 2048 + h * 512 + s * 64;
  } else {
    src = (const u16*)(p.ws + OFF_XBCC); sstride = 4096;
    qcol = 3072 + (h >> 2) * 128; kcol = 2048 + (h >> 2) * 128; vcol = h * 64;
  }
  const float* dtv = (const float*)(p.ws + OFF_DT);
  const float* cumv = (const float*)(p.ws + OFF_CUM);
  const float lg = (MODE == 0) ? logf(1.0f - exp2f(-5.0f - (float)h)) : 0.f;

  const int vrow = tid >> 3, vkc = tid & 7;
  const int jt = tid & 63;

  constexpr int NSET = (MODE == 1) ? 2 : 1;
  u32x4 rq[2][NQ], rk[2][NQ], rv[2];
  float pcj[2] = {0.f, 0.f}, puj[2] = {1.f, 1.f}, pclast[2] = {0.f, 0.f}, pct[2] = {0.f, 0.f}, put[2] = {1.f, 1.f};
  u16 gz[2][2][4];
  const u16* gsrc = (const u16*)(p.ws + OFF_PROJ);
  const int gcol = (MODE == 0) ? (4096 + h * 512 + s * 64) : (h * 64);
  const int fi = w >> 1, fe0 = 2 * (w & 1);
  const int fis = (int)p.wv >> 1, fe0s = 2 * ((int)p.wv & 1);
  const int dw = w * (DK / 8);

#define PF_ISSUE(SET, RBASE)                                                                       \
  {                                                                                                \
    const int rb_ = (RBASE);                                                                       \
    _Pragma("unroll") for (int i = 0; i < NQ; ++i) {                                               \
      int c_ = tid + NTHR * i, rr_ = c_ / CPR, kc_ = c_ % CPR;                                     \
      rq[SET][i] = *(const u32x4*)(src + (size_t)(rb_ + rr_) * sstride + qcol + kc_ * 8);          \
      rk[SET][i] = *(const u32x4*)(src + (size_t)(rb_ + rr_) * sstride + kcol + kc_ * 8);          \
    }                                                                                              \
    rv[SET] = *(const u32x4*)(src + (size_t)(rb_ + vrow) * sstride + vcol + vkc * 8);              \
    if (MODE == 1) {                                                                               \
      pcj[SET] = cumv[(size_t)(rb_ + vrow) * 32 + h]; puj[SET] = dtv[(size_t)(rb_ + vrow) * 32 + h]; \
      pclast[SET] = cumv[(size_t)(rb_ + 63) * 32 + h];                                             \
      pct[SET] = cumv[(size_t)(rb_ + jt) * 32 + h]; put[SET] = dtv[(size_t)(rb_ + jt) * 32 + h];   \
    }                                                                                              \
    _Pragma("unroll") for (int x = 0; x < 2; ++x)                                                  \
      _Pragma("unroll") for (int r = 0; r < 4; ++r)                                                \
        gz[SET][x][r] = gsrc[(size_t)(rb_ + 16 * fi + 4 * g + r) * PROJ_LD + gcol + 16 * (fe0 + x) + l15]; \
  }

  f32x4 S[MF][4];
#pragma unroll
  for (int i = 0; i < MF; ++i)
#pragma unroll
    for (int j = 0; j < 4; ++j) S[i][j] = (f32x4){0.f, 0.f, 0.f, 0.f};

  float gnv[2];
  const float dsk = (MODE == 1) ? p.ssm_d[h] : 0.f;
#pragma unroll
  for (int x = 0; x < 2; ++x) {
    const int e = 16 * (fe0 + x) + l15;
    gnv[x] = (MODE == 0) ? p.ret_head_norm[h * 512 + s * 64 + e] : p.ssm_gate_norm[h * 64 + e];
  }

  PF_ISSUE(0, row0)
  if (NSET == 2) PF_ISSUE(1, row0 + 64)

  for (int c2 = 0; c2 < 32; c2 += 2) {
#pragma unroll
   for (int par2 = 0; par2 < 2; ++par2) {
    const int par = par2 & (NSET - 1);
    const int c = c2 + par2;
    const int r0 = row0 + c * 64;
#pragma unroll
    for (int i = 0; i < NQ; ++i) {
      int cc = tid + NTHR * i, rr = cc / CPR, kc = cc % CPR;
      *(u32x4*)(Qs + rr * QS + kc * 16) = rq[par][i];
      *(u32x4*)(Ks + rr * QS + kc * 16) = rk[par][i];
    }
    {
      const u32x4 rvv = rv[par];
      *(u32x4*)(Vs + vrow * VS + vkc * 16) = rvv;
      float cj, uj, cl;
      if (MODE == 0) { cj = (float)(vrow + 1) * lg; uj = 1.f; cl = 64.f * lg; } else { cj = pcj[par]; uj = puj[par]; cl = pclast[par]; }
      const float wj = uj * __expf(cl - cj);
      u32x4 o;
      o.x = pack2(bf2f((u16)(rvv.x & 0xffff)) * wj, bf2f((u16)(rvv.x >> 16)) * wj);
      o.y = pack2(bf2f((u16)(rvv.y & 0xffff)) * wj, bf2f((u16)(rvv.y >> 16)) * wj);
      o.z = pack2(bf2f((u16)(rvv.z & 0xffff)) * wj, bf2f((u16)(rvv.z >> 16)) * wj);
      o.w = pack2(bf2f((u16)(rvv.w & 0xffff)) * wj, bf2f((u16)(rvv.w >> 16)) * wj);
      *(u32x4*)(Vts + vrow * VS + vkc * 16) = o;
    }
    if (tid < 64) {
      if (MODE == 0) { cumS[tid] = (float)(tid + 1) * lg; uS[tid] = 1.f; } else { cumS[tid] = pct[par]; uS[tid] = put[par]; }
    }
#pragma unroll
    for (int mf = 0; mf < MF; ++mf)
#pragma unroll
      for (int nf = 0; nf < 4; ++nf) {
        u32x2 o;
        o.x = pack2(S[mf][nf][0], S[mf][nf][1]);
        o.y = pack2(S[mf][nf][2], S[mf][nf][3]);
        *(u32x2*)(STs + (16 * nf + l15) * QS + (dw + 16 * mf + 4 * g) * 2) = o;
      }
    u16 gzc[2][4];
#pragma unroll
    for (int x = 0; x < 2; ++x)
#pragma unroll
      for (int r = 0; r < 4; ++r) gzc[x][r] = gz[par][x][r];
    __syncthreads();
    if (c + NSET < 32) PF_ISSUE(par, r0 + 64 * NSET)
    f32x4 sc[2], cr[2];
#pragma unroll
    for (int x = 0; x < 2; ++x) { sc[x] = (f32x4){0.f, 0.f, 0.f, 0.f}; cr[x] = (f32x4){0.f, 0.f, 0.f, 0.f}; }
#pragma unroll 4
    for (int ks = 0; ks < KS; ++ks) {
      const bf16x8 a = *(const bf16x8*)(Qs + (16 * fi + l15) * QS + ks * 64 + g * 16);
      bf16x8 bk[2], bs[2];
#pragma unroll
      for (int x = 0; x < 2; ++x) {
        bk[x] = *(const bf16x8*)(Ks + (16 * (fe0 + x) + l15) * QS + ks * 64 + g * 16);
        bs[x] = *(const bf16x8*)(STs + (16 * (fe0 + x) + l15) * QS + ks * 64 + g * 16);
      }
#pragma unroll
      for (int x = 0; x < 2; ++x) {
        sc[x] = __builtin_amdgcn_mfma_f32_16x16x32_bf16(a, bk[x], sc[x], 0, 0, 0);
        cr[x] = __builtin_amdgcn_mfma_f32_16x16x32_bf16(a, bs[x], cr[x], 0, 0, 0);
      }
    }
    float ci[4];
#pragma unroll
    for (int r = 0; r < 4; ++r) ci[r] = cumS[16 * fi + 4 * g + r];
#pragma unroll
    for (int x = 0; x < 2; ++x) {
      const int fj = fe0 + x;
      const int j = 16 * fj + l15;
      const float cj = cumS[j], uj = uS[j];
#pragma unroll
      for (int r = 0; r < 4; ++r) {
        const int i = 16 * fi + 4 * g + r;
        float v = 0.f;
        if (j <= i) v = sc[x][r] * __expf(ci[r] - cj) * uj;
        *(u16*)(Ps + i * PS + j * 2) = f2bf(v);
      }
    }
    {
      const float atot = __expf(cumS[63]);
#pragma unroll
      for (int mf = 0; mf < MF; ++mf)
#pragma unroll
        for (int nf = 0; nf < 4; ++nf)
#pragma unroll
          for (int r = 0; r < 4; ++r) S[mf][nf][r] *= atot;
#pragma unroll
      for (int ks = 0; ks < 2; ++ks) {
        bf16x8 af[MF], bfv[4];
#pragma unroll
        for (int mf = 0; mf < MF; ++mf) af[mf] = trfrag(Ks, QS, 32 * ks, dw + 16 * mf, lane);
#pragma unroll
        for (int nf = 0; nf < 4; ++nf) bfv[nf] = trfrag(Vts, VS, 32 * ks, 16 * nf, lane);
#pragma unroll
        for (int mf = 0; mf < MF; ++mf)
#pragma unroll
          for (int nf = 0; nf < 4; ++nf)
            S[mf][nf] = __builtin_amdgcn_mfma_f32_16x16x32_bf16(af[mf], bfv[nf], S[mf][nf], 0, 0, 0);
      }
    }
    __syncthreads();
    f32x4 in[2];
#pragma unroll
    for (int x = 0; x < 2; ++x) in[x] = (f32x4){0.f, 0.f, 0.f, 0.f};
#pragma unroll
    for (int ks = 0; ks < 2; ++ks) {
      const bf16x8 a = *(const bf16x8*)(Ps + (16 * fi + l15) * PS + ks * 64 + g * 16);
      bf16x8 bv[2];
#pragma unroll
      for (int x = 0; x < 2; ++x) bv[x] = trfrag(Vs, VS, 32 * ks, 16 * (fe0 + x), lane);
#pragma unroll
      for (int x = 0; x < 2; ++x) in[x] = __builtin_amdgcn_mfma_f32_16x16x32_bf16(a, bv[x], in[x], 0, 0, 0);
    }
    {
      float ss[4] = {0.f, 0.f, 0.f, 0.f};
      u16* aout = (u16*)(p.ws + OFF_A2);
      float* parts = (float*)(p.ws + OFF_PARTS);
#pragma unroll
      for (int x = 0; x < 2; ++x) {
        const int e = 16 * (fe0 + x) + l15;
        const float gn = gnv[x];
        const int ocol = (MODE == 0) ? (h * 512 + s * 64 + e) : (h * 64 + e);
#pragma unroll
        for (int r = 0; r < 4; ++r) {
          const int i = 16 * fi + 4 * g + r;
          float o = in[x][r] + cr[x][r] * __expf(ci[r]);
          const float gv = bf2f(gzc[x][r]);
          float val;
          if (MODE == 0) {
            ss[r] += o * o;
            val = o * gn * silu(gv);
          } else {
            const float xs = bf2f(*(const u16*)(Vs + i * VS + e * 2));
            const float y = o + xs * dsk;
            const float gg = y * silu(gv);
            ss[r] += gg * gg;
            val = gg * gn;
          }
          aout[(size_t)(r0 + i) * 2048 + ocol] = f2bf(val);
        }
      }
#pragma unroll
      for (int r = 0; r < 4; ++r) {
        const float v = row16_sum(ss[r]);
        if (l15 == 0) {
          const int i = 16 * fi + 4 * g + r;
          const int slot = (MODE == 0) ? (h * 16 + s * 2 + (w & 1)) : ((h >> 2) * 8 + (h & 3) * 2 + (w & 1));
          parts[(size_t)(r0 + i) * 64 + slot] = v;
        }
      }
    }
    __syncthreads();
   }
  }
#undef PF_ISSUE
  {
    float* so;
    int pitch;
    if (MODE == 0) { so = p.out + OUT_RETP + ((size_t)(b * 4 + h) * 256) * 512 + s * 64; pitch = 512; }
    else { so = p.out + OUT_SSMP + ((size_t)(b * 32 + h) * 128) * 64; pitch = 64; }
#pragma unroll
    for (int mf = 0; mf < MF; ++mf)
#pragma unroll
      for (int nf = 0; nf < 4; ++nf)
#pragma unroll
        for (int r = 0; r < 4; ++r)
          so[(size_t)(dw + 16 * mf + 4 * g + r) * pitch + 16 * nf + l15] = S[mf][nf][r];
  }
}

#define SAMPLE_DECODE(ITEM, B_, H_, S_)                              \
  const int B_ = (ITEM) >> 5;                                        \
  const int H_ = (MODE == 0) ? (((ITEM) >> 3) & 3) : ((ITEM) & 31);  \
  const int S_ = (MODE == 0) ? ((ITEM) & 7) : 0;

#define SAMPLE_ISSUE(SET, ITEM)                                                                                       \
  {                                                                                                                \
    SAMPLE_DECODE(ITEM, b_, h_, s_)                                                                                \
    const int row0_ = NPROMPT + b_ * 8;                                                                            \
    int qcol_, kcol_, vcol_;                                                                                       \
    if (MODE == 0) { qcol_ = h_ * 256; kcol_ = 1024 + h_ * 256; vcol_ = 2048 + h_ * 512 + s_ * 64; }               \
    else { qcol_ = 3072 + (h_ >> 2) * 128; kcol_ = 2048 + (h_ >> 2) * 128; vcol_ = h_ * 64; }                      \
    const float* s0_ = (MODE == 0) ? p.state_ret + ((size_t)(b_ * 4 + h_) * 256) * 512 + s_ * 64                   \
                                   : p.state_ssm + ((size_t)(b_ * 32 + h_) * 128) * 64;                            \
    _Pragma("unroll") for (int x = 0; x < RPT; ++x)                                                                \
        sv[SET][x] = *(const float4*)(s0_ + (size_t)(dg * RPT + x) * pitch + eq * 4);                                 \
    if (tid < 2 * DK) {                                                                                            \
      const int which_ = tid / DK, c_ = tid % DK;                                                                  \
      rqk[SET] = *(const u32x4*)(src + (size_t)(row0_ + c_ / CPR) * sstride + (which_ ? kcol_ : qcol_) + (c_ % CPR) * 8); \
    }                                                                                                              \
    if (tid < 64) rv[SET] = *(const u32x4*)(src + (size_t)(row0_ + (tid >> 3)) * sstride + vcol_ + (tid & 7) * 8);      \
    gzs[SET] = gsrc[(size_t)(row0_ + w) * PROJ_LD + ((MODE == 0) ? (4096 + h_ * 512 + s_ * 64) : (h_ * 64)) + lane];      \
    if (MODE == 1 && tid < 16)                                                                                     \
      pcu[SET] = (tid < 8) ? cumv[(size_t)(row0_ + tid) * 32 + h_] : dtv[(size_t)(row0_ + tid - 8) * 32 + h_];          \
  }

template <int DK, int MODE>
__device__ void rec_sample_loop(const Params& p, unsigned char* smem, const int rep) {
  float* qS = (float*)smem;
  float* kS = qS + 8 * DK;
  float* vS = kS + 8 * DK;
  float* scS = vS + 512;
  float* redS = scS + 64;
  float* cuS = redS + 16384;
  float* qT = cuS + 64;
  float* kT = qT + 8 * DK;
  const int tid = (int)p.tidx, lane = tid & 63, w = tid >> 6;
  constexpr int CPR = DK / 8, RPT = DK / 32;
  const int dg = tid >> 4, eq = tid & 15;
  const int pitch = (MODE == 0) ? 512 : 64;
  const u16* src = (MODE == 0) ? (const u16*)(p.ws + OFF_PROJ) : (const u16*)(p.ws + OFF_XBCC);
  const int sstride = (MODE == 0) ? PROJ_LD : 4096;
  const u16* gsrc = (const u16*)(p.ws + OFF_PROJ);
  const float* dtv = (const float*)(p.ws + OFF_DT);
  const float* cumv = (const float*)(p.ws + OFF_CUM);
  u16* aout = (u16*)(p.ws + OFF_A2);
  float* parts = (float*)(p.ws + OFF_PARTS);

  u32x4 rqk[2] = {(u32x4){0u, 0u, 0u, 0u}, (u32x4){0u, 0u, 0u, 0u}}, rv[2] = {(u32x4){0u, 0u, 0u, 0u}, (u32x4){0u, 0u, 0u, 0u}};
  float4 sv[2][RPT];
  u16 gzs[2] = {0, 0};
  float pcu[2] = {0.f, 0.f};
  const int nitems = 4096 * rep;
  const int G = (int)gridDim.x;
  int vz;
  asm volatile("v_mov_b32 %0, 0" : "=v"(vz));
  if ((int)blockIdx.x < nitems) SAMPLE_ISSUE(0, ((int)blockIdx.x & 4095) + vz)
  for (int itb = blockIdx.x; itb < nitems; itb += 2 * G) {
#pragma unroll
   for (int par = 0; par < 2; ++par) {
    const int item0 = itb + par * G;
    if (item0 < nitems) {
    if (item0 + G < nitems) SAMPLE_ISSUE(par ^ 1, ((item0 + G) & 4095) + vz)
    __builtin_amdgcn_sched_barrier(0);
    const int item = (item0 & 4095) + vz;
    SAMPLE_DECODE(item, b, h, s)
    const int row0 = NPROMPT + b * 8;
    const u16 gzv = gzs[par];
    const u32x4 rqkc = rqk[par], rvc = rv[par];
    if (tid < 2 * DK) {
      const int which = tid / DK, c = tid % DK;
      float* dst = (which ? kS : qS) + (c / CPR) * DK + (c % CPR) * 8;
      dst[0] = bf2f((u16)(rqkc.x & 0xffff)); dst[1] = bf2f((u16)(rqkc.x >> 16));
      dst[2] = bf2f((u16)(rqkc.y & 0xffff)); dst[3] = bf2f((u16)(rqkc.y >> 16));
      dst[4] = bf2f((u16)(rqkc.z & 0xffff)); dst[5] = bf2f((u16)(rqkc.z >> 16));
      dst[6] = bf2f((u16)(rqkc.w & 0xffff)); dst[7] = bf2f((u16)(rqkc.w >> 16));
      float* dT = (which ? kT : qT) + ((c % CPR) * 8) * 8 + (c / CPR);
#pragma unroll
      for (int x = 0; x < 8; ++x) dT[x * 8] = dst[x];
    }
    if (tid < 64) {
      float* dst = vS + (tid >> 3) * 64 + (tid & 7) * 8;
      dst[0] = bf2f((u16)(rvc.x & 0xffff)); dst[1] = bf2f((u16)(rvc.x >> 16));
      dst[2] = bf2f((u16)(rvc.y & 0xffff)); dst[3] = bf2f((u16)(rvc.y >> 16));
      dst[4] = bf2f((u16)(rvc.z & 0xffff)); dst[5] = bf2f((u16)(rvc.z >> 16));
      dst[6] = bf2f((u16)(rvc.w & 0xffff)); dst[7] = bf2f((u16)(rvc.w >> 16));
    }
    if (MODE == 1 && tid < 16) cuS[tid] = pcu[par];
    __syncthreads();
    float cum[8], u[8];
    if (MODE == 0) {
      const float lg = logf(1.0f - exp2f(-5.0f - (float)h));
#pragma unroll
      for (int t = 0; t < 8; ++t) { cum[t] = (float)(t + 1) * lg; u[t] = 1.f; }
    } else {
#pragma unroll
      for (int t = 0; t < 8; ++t) { cum[t] = cuS[t]; u[t] = cuS[8 + t]; }
    }
    {
      const int pair = tid >> 3, part = tid & 7;
      const int i = pair >> 3, jj = pair & 7;
      float d = 0.f;
      const float* qp = qS + i * DK + part * (DK / 8);
      const float* kp = kS + jj * DK + part * (DK / 8);
#pragma unroll 8
      for (int x = 0; x < DK / 8; ++x) d += qp[x] * kp[x];
      d += __shfl_xor(d, 1); d += __shfl_xor(d, 2); d += __shfl_xor(d, 4);
      if (part == 0) {
        float ci = 0.f, cj = 0.f, uj = 0.f;
#pragma unroll
        for (int t = 0; t < 8; ++t) { if (t == i) ci = cum[t]; if (t == jj) { cj = cum[t]; uj = u[t]; } }
        scS[pair] = (jj <= i) ? d * __expf(ci - cj) * uj : 0.f;
      }
    }
    float* s1 = (MODE == 0) ? p.out + OUT_RETS + ((size_t)(b * 4 + h) * 256) * 512 + s * 64
                            : p.out + OUT_SSMS + ((size_t)(b * 32 + h) * 128) * 64;
    {
      float4 cx[4];
      {
        float4 vw[8];
#pragma unroll
        for (int jj = 0; jj < 8; ++jj) {
          float4 v = *(const float4*)(vS + jj * 64 + eq * 4);
          const float wj = u[jj] * __expf(cum[7] - cum[jj]);
          vw[jj] = make_float4(v.x * wj, v.y * wj, v.z * wj, v.w * wj);
        }
        const float atot = __expf(cum[7]);
#pragma unroll
        for (int i = 0; i < 4; ++i) cx[i] = make_float4(0.f, 0.f, 0.f, 0.f);
#pragma unroll
        for (int x = 0; x < RPT; ++x) {
          __builtin_amdgcn_sched_barrier(0);
          const int d = dg * RPT + x;
          const float4 so = sv[par][x];
          float4 sn = make_float4(so.x * atot, so.y * atot, so.z * atot, so.w * atot);
          const float4 k0 = *(const float4*)(kT + d * 8), k1 = *(const float4*)(kT + d * 8 + 4);
          const float kq[8] = {k0.x, k0.y, k0.z, k0.w, k1.x, k1.y, k1.z, k1.w};
#pragma unroll
          for (int jj = 0; jj < 8; ++jj) {
            const float kk = kq[jj];
            sn.x += kk * vw[jj].x; sn.y += kk * vw[jj].y; sn.z += kk * vw[jj].z; sn.w += kk * vw[jj].w;
          }
          *(float4*)(s1 + (size_t)d * pitch + eq * 4) = sn;
          const float4 q0 = *(const float4*)(qT + d * 8);
          const float qv[4] = {q0.x, q0.y, q0.z, q0.w};
#pragma unroll
          for (int i = 0; i < 4; ++i) {
            const float qq = qv[i];
            cx[i].x += qq * so.x; cx[i].y += qq * so.y; cx[i].z += qq * so.z; cx[i].w += qq * so.w;
          }
        }
      }
      __builtin_amdgcn_sched_barrier(0);
#pragma unroll
      for (int i = 0; i < 4; ++i) {
        *(float4*)(redS + (dg * 8 + i) * 64 + eq * 4) = cx[i];
        cx[i] = make_float4(0.f, 0.f, 0.f, 0.f);
      }
#pragma unroll
      for (int x = 0; x < RPT; ++x) {
        __builtin_amdgcn_sched_barrier(0);
        const int d = dg * RPT + x;
        const float4 so = sv[par][x];
        const float4 q1 = *(const float4*)(qT + d * 8 + 4);
        const float qv[4] = {q1.x, q1.y, q1.z, q1.w};
#pragma unroll
        for (int i = 0; i < 4; ++i) {
          const float qq = qv[i];
          cx[i].x += qq * so.x; cx[i].y += qq * so.y; cx[i].z += qq * so.z; cx[i].w += qq * so.w;
        }
      }
      __builtin_amdgcn_sched_barrier(0);
#pragma unroll
      for (int i = 0; i < 4; ++i) {
        *(float4*)(redS + (dg * 8 + 4 + i) * 64 + eq * 4) = cx[i];
      }
    }
    __syncthreads();
    {
      const int i = w, e = lane;
      float o = 0.f;
#pragma unroll
      for (int ww = 0; ww < 32; ++ww) o += redS[(ww * 8 + i) * 64 + e];
      float ci = 0.f;
#pragma unroll
      for (int t = 0; t < 8; ++t) if (t == i) ci = cum[t];
      o *= __expf(ci);
#pragma unroll
      for (int jj = 0; jj < 8; ++jj) if (jj <= i) o += scS[i * 8 + jj] * vS[jj * 64 + e];
      const int row = row0 + i;
      const float gv = bf2f(gzv);
      if (MODE == 0) {
        const float ssq = wave_sum(o * o);
        const float val = o * p.ret_head_norm[h * 512 + s * 64 + e] * silu(gv);
        aout[(size_t)row * 2048 + h * 512 + s * 64 + e] = f2bf(val);
        if (lane < 2) parts[(size_t)row * 64 + h * 16 + s * 2 + lane] = lane == 0 ? ssq : 0.f;
      } else {
        const float y = o + vS[i * 64 + e] * p.ssm_d[h];
        const float gg = y * silu(gv);
        const float ssq = wave_sum(gg * gg);
        aout[(size_t)row * 2048 + h * 64 + e] = f2bf(gg * p.ssm_gate_norm[h * 64 + e]);
        if (lane < 2) parts[(size_t)row * 64 + (h >> 2) * 8 + (h & 3) * 2 + lane] = lane == 0 ? ssq : 0.f;
      }
    }
    __syncthreads();
    }
   }
  }
}

template <int DK, int MODE>
__device__ void phase_rec(const Params& p, unsigned char* smem, const int rep_p, const int rep_s) {
  for (int item = blockIdx.x; item < 256 * rep_p; item += gridDim.x) rec_prompt_item<DK, MODE>(p, item & 255, smem);
  rec_sample_loop<DK, MODE>(p, smem, rep_s);
}

#ifndef PHASE_MASK
#define PHASE_MASK 0x3ff
#endif
#ifndef DUP_MASK
#define DUP_MASK 0x000
#endif
#define XB_TMO      128
#define XB_XCNT(j)  (256  + 64 * (j))
#define XB_XSUB(j)  (1280 + 64 * (j))
#define XB_XGEN(j)  (2304 + 64 * (j))
#define XB_TOP      3328
#define XB_TOPGEN   3392
#define XCD_BAR_WORDS 3456
#define XB_SPIN_CAP (1u << 20)
#define LAS __attribute__((address_space(3)))
__device__ __forceinline__ unsigned xb_ld(unsigned* p) { return __hip_atomic_load(p, __ATOMIC_RELAXED, __HIP_MEMORY_SCOPE_AGENT); }
__device__ __forceinline__ unsigned xb_add(unsigned* p, unsigned v) { return __hip_atomic_fetch_add(p, v, __ATOMIC_RELAXED, __HIP_MEMORY_SCOPE_AGENT); }
__device__ __forceinline__ unsigned xb_xcc_id() { return (unsigned)__builtin_amdgcn_s_getreg((3 << 11) | 20) & 0xFu; }
#define XB_SPIN(cond, bar) do { unsigned _sp = 0; while (cond) { __builtin_amdgcn_s_sleep(1); \
    if ((++_sp & 255u) == 0u) { if (xb_ld(&(bar)[XB_TMO])) break; if (_sp > XB_SPIN_CAP) { atomicAdd(&(bar)[XB_TMO], 1u); break; } } } } while (0)
struct XcdBarrier {
  unsigned* bar; unsigned x;
  volatile LAS unsigned* st;
};
__device__ __forceinline__ XcdBarrier xcd_barrier_post(unsigned* bar, volatile LAS unsigned* st, const int tid) {
  XcdBarrier b; b.bar = bar; b.x = xb_xcc_id(); b.st = st;
  if (tid == 0) (void)xb_add(&bar[XB_XCNT(b.x)], 1u);
  return b;
}
__device__ __forceinline__ void xcd_barrier_complete(unsigned* bar, unsigned x, unsigned& nloc, unsigned& nx) {
  const unsigned G = gridDim.x * gridDim.y * gridDim.z;
  unsigned sum, cnt, mine, sp = 0u;
  for (;;) {
    sum = 0u; cnt = 0u; mine = 0u;
#pragma unroll
    for (unsigned j = 0; j < 16; ++j) { const unsigned c = xb_ld(&bar[XB_XCNT(j)]); sum += c; cnt += (c > 0u) ? 1u : 0u; mine = (j == x) ? c : mine; }
    if (sum == G) break;
    __builtin_amdgcn_s_sleep(1);
    if ((++sp & 255u) == 0u) { if (xb_ld(&bar[XB_TMO])) break; if (sp > XB_SPIN_CAP) { atomicAdd(&bar[XB_TMO], 1u); break; } }
  }
  nloc = mine > 0u ? mine : 1u; nx = cnt > 0u ? cnt : 1u;
}
__device__ __forceinline__ void xcd_barrier(const XcdBarrier& b, const int wvs) {
  int wvl_ = wvs;
  asm volatile("" : "+s"(wvl_));
  const int tid = wvl_ * 64 + (int)__builtin_amdgcn_mbcnt_hi(~0u, __builtin_amdgcn_mbcnt_lo(~0u, 0u));
  asm volatile("s_waitcnt vmcnt(0)" ::: "memory");
  __syncthreads();
  if (tid == 0) {
    unsigned* bar = b.bar;
    __builtin_amdgcn_s_waitcnt(0);
    unsigned nloc = b.st[0], nx = b.st[1];
    if (nloc == 0u) { xcd_barrier_complete(bar, b.x, nloc, nx); b.st[0] = nloc; b.st[1] = nx; }
    const unsigned old = xb_add(&bar[XB_XSUB(b.x)], 1u);
    const unsigned gen = old / nloc;
    if (old + 1u == (gen + 1u) * nloc) {
      __builtin_amdgcn_fence(__ATOMIC_RELEASE, "agent");
      asm volatile("s_waitcnt vmcnt(0)" ::: "memory");
      const unsigned og = xb_add(&bar[XB_TOP], 1u);
      const unsigned tg = og / nx;
      if (og + 1u == (tg + 1u) * nx) xb_add(&bar[XB_TOPGEN], 1u);
      else XB_SPIN(xb_ld(&bar[XB_TOPGEN]) == tg, bar);
      __builtin_amdgcn_fence(__ATOMIC_ACQUIRE, "agent");
      xb_add(&bar[XB_XGEN(b.x)], 1u);
      asm volatile("s_waitcnt vmcnt(0)" ::: "memory");
    } else {
      XB_SPIN(xb_ld(&bar[XB_XGEN(b.x)]) == gen, bar);
      __builtin_amdgcn_fence(__ATOMIC_ACQUIRE, "agent");
      asm volatile("s_waitcnt vmcnt(0)" ::: "memory");
    }
  }
  __syncthreads();
}

template <typename T>
__device__ __forceinline__ T* as_global(T* q) {
  return (T*)(__attribute__((address_space(1))) T*)q;
}

template <int PH>
__device__ __forceinline__ void run_phase(Params p, unsigned char* smem, const int wvs) {
  {
    long long z_ = 0;
    asm volatile("" : "+s"(z_));
    p.ws += z_; p.out += z_;
  }
  {
    int wvl_ = wvs;
    asm volatile("" : "+s"(wvl_));
    p.tidx = wvl_ * 64 + (int)__builtin_amdgcn_mbcnt_hi(~0u, __builtin_amdgcn_mbcnt_lo(~0u, 0u));
    p.wv = wvl_;
  }
  const int rep = 1 + (int)((p.dup >> PH) & 1);
  if (PH == 0) phase_prep(p, smem, rep);
  if (PH == 1) gemm8_phase<0>(p, (const u16*)(p.ws + OFF_H), (const u16*)(p.ws + OFF_WT0), 1024, 24, smem, rep);
  if (PH == 2) phase_rec<256, 0>(p, smem, rep, 1 + (int)((p.dup >> (PH + 16)) & 1));
  if (PH == 3)
  {
    gemm_phase<1, 4>(p, (const u16*)(p.ws + OFF_A2), (const u16*)(p.ws + OFF_WT1), 2048, 8, nullptr,
                     (float*)(p.ws + OFF_X1), smem, rep, 64);
    __syncthreads();
    gemm_sample_rows<4>(p, (const u16*)(p.ws + OFF_A2), (const u16*)(p.ws + OFF_WT1), nullptr, (float*)(p.ws + OFF_X1), smem, rep);
  }
  if (PH == 4) phase_norm<0>(p, (const float*)(p.ws + OFF_X1), p.ssm_norm, rep);
  if (PH == 5) {
    gemm8_phase<2>(p, (const u16*)(p.ws + OFF_H), (const u16*)(p.ws + OFF_WT2), 1024, 24, smem, rep);
    __syncthreads();
    gemm_phase<2, 0>(p, (const u16*)(p.ws + OFF_H), (const u16*)(p.ws + OFF_WT2), 1024, 1, nullptr, nullptr, smem, 1, 68, 48, true);
  }
  if (PH == 6) phase_conv(p, smem, rep);
  if (PH == 7) phase_rec<128, 1>(p, smem, rep, 1 + (int)((p.dup >> (PH + 16)) & 1));
  if (PH == 8)
  {
    gemm_phase<1, 8>(p, (const u16*)(p.ws + OFF_A2), (const u16*)(p.ws + OFF_WT3), 2048, 8,
                     (const float*)(p.ws + OFF_X1), (float*)(p.ws + OFF_X2), smem, rep, 64);
    __syncthreads();
    gemm_sample_rows<8>(p, (const u16*)(p.ws + OFF_A2), (const u16*)(p.ws + OFF_WT3), (const float*)(p.ws + OFF_X1),
                        (float*)(p.ws + OFF_X2), smem, rep);
  }
  if (PH == 9) phase_norm<1>(p, (const float*)(p.ws + OFF_X2), p.final_norm, rep);
}

#define RUN_PHASE(k)                                   \
  if ((PHASE_MASK >> k) & 1) {                         \
    if (lo <= k && k <= hi) {                          \
      run_phase<k>(p, smem, wvs);                      \
      if (k < hi) { xcd_barrier(xb, wvs); if ((p.dup >> 30) & 1) { xcd_barrier(xb, wvs); xcd_barrier(xb, wvs); } } \
    }                                                  \
  }

__global__ void __launch_bounds__(NTHR) fwd_megakernel(Params p) {
  __shared__ __attribute__((aligned(16))) unsigned char smem[LDS_BYTES];
  cg::grid_group grid = cg::this_grid();
  const int lo = (int)p.phase_lo, hi = (int)p.phase_hi;
  if (lo > 1000) grid.sync();
  volatile LAS unsigned* xst = (volatile LAS unsigned*)(smem + LDS_BYTES - 16);
  const int wvs = __builtin_amdgcn_readfirstlane((int)(threadIdx.x >> 6));
  if (threadIdx.x == 0) { xst[0] = 0u; xst[1] = 0u; }
  __syncthreads();
  const XcdBarrier xb = xcd_barrier_post((unsigned*)(p.ws + OFF_BAR), xst, (int)threadIdx.x);
  RUN_PHASE(0)
  RUN_PHASE(1)
  RUN_PHASE(2)
  RUN_PHASE(3)
  RUN_PHASE(4)
  RUN_PHASE(5)
  RUN_PHASE(6)
  RUN_PHASE(7)
  RUN_PHASE(8)
  RUN_PHASE(9)
}

#ifndef ONE_LAUNCH
#define ONE_LAUNCH 1
#endif

extern "C" void kernel_launch(void* const* d_in, const int* in_sizes, int n_in, void* d_out, int out_size, void* d_ws,
                              size_t ws_size, hipStream_t stream) {
  static int grid_blocks = 0;
  if (!grid_blocks) {
    int dev = 0, cus = 0, per_cu = 0;
    hipGetDevice(&dev);
    hipDeviceGetAttribute(&cus, hipDeviceAttributeMultiprocessorCount, dev);
    hipOccupancyMaxActiveBlocksPerMultiprocessor(&per_cu, fwd_megakernel, NTHR, 0);
    if (per_cu < 1) per_cu = 1;
    if (per_cu > 1) per_cu = 1;
    grid_blocks = cus * per_cu;
  }
  Params p{};
  const float** pf = (const float**)&p;
  for (int i = 0; i < 19; ++i) pf[i] = (const float*)d_in[i];
  p.out = (float*)d_out;
  p.ws = (unsigned char*)d_ws;
#if ONE_LAUNCH
  hipMemsetAsync((unsigned char*)d_ws + OFF_BAR, 0, XCD_BAR_WORDS * 4, stream);
  p.phase_lo = 0; p.phase_hi = 9; p.dup = DUP_MASK;
  void* args[] = {&p};
  hipError_t e = hipLaunchCooperativeKernel((void*)fwd_megakernel, dim3(grid_blocks), dim3(NTHR), args, 0, stream);
  if (e != hipSuccess) fprintf(stderr, "cooperative launch failed: %s (grid %d)\n", hipGetErrorString(e), grid_blocks);
#else
  for (int ph = 0; ph <= 9; ++ph) {
    p.phase_lo = ph; p.phase_hi = ph;
    void* args[] = {&p};
    hipLaunchCooperativeKernel((void*)fwd_megakernel, dim3(grid_blocks), dim3(NTHR), args, 0, stream);
  }
#endif
}
```

```cpp
#include <hip/hip_runtime.h>
#include <hip/hip_cooperative_groups.h>
#include <stdint.h>
#include <stdio.h>
namespace cg = cooperative_groups;

typedef __attribute__((ext_vector_type(8))) short bf16x8;
typedef __attribute__((ext_vector_type(4))) short s16x4;
typedef __attribute__((ext_vector_type(4))) float f32x4;
typedef unsigned short u16;
typedef __attribute__((ext_vector_type(4))) unsigned int u32x4;
typedef __attribute__((ext_vector_type(2))) unsigned int u32x2;

#define NTHR 512
#define T_TOK 17408
#define NPROMPT 16384
#define LDS_BYTES 143360
#define PROJ_LD 6208

constexpr size_t OFF_WT0 = 0;
constexpr size_t OFF_WT1 = OFF_WT0 + (size_t)6144 * 1024 * 2;
constexpr size_t OFF_WT2 = OFF_WT1 + (size_t)1024 * 2048 * 2;
constexpr size_t OFF_WT3 = OFF_WT2 + (size_t)6272 * 1024 * 2;
constexpr size_t OFF_ROPE = OFF_WT3 + (size_t)1024 * 2048 * 2;
constexpr size_t OFF_H = OFF_ROPE + (size_t)2056 * 128 * 8;
constexpr size_t OFF_PROJ = OFF_H + (size_t)T_TOK * 1024 * 2;
constexpr size_t OFF_A2 = OFF_PROJ + (size_t)T_TOK * PROJ_LD * 2;
constexpr size_t OFF_PARTS = OFF_A2 + (size_t)T_TOK * 2048 * 2;
constexpr size_t OFF_X1 = OFF_PARTS + (size_t)T_TOK * 64 * 4;
constexpr size_t OFF_X2 = OFF_X1 + (size_t)T_TOK * 1024 * 4;
constexpr size_t OFF_XBCC = OFF_X2 + (size_t)T_TOK * 1024 * 4;
constexpr size_t OFF_DTRAW = OFF_XBCC + (size_t)T_TOK * 4096 * 2;
constexpr size_t OFF_DT = OFF_DTRAW + (size_t)T_TOK * 32 * 4;
constexpr size_t OFF_CUM = OFF_DT + (size_t)T_TOK * 32 * 4;
constexpr size_t OFF_BAR = OFF_CUM + (size_t)T_TOK * 32 * 4;

constexpr size_t OUT_Y = 0;
constexpr size_t OUT_RETP = 17825792;
constexpr size_t OUT_RETS = 22020096;
constexpr size_t OUT_SSMP = 89128960;
constexpr size_t OUT_SSMS = 91226112;
constexpr size_t OUT_CONVP = 124780544;
constexpr size_t OUT_CONVS = 124878848;

struct Params {
  const float *x_prompt, *x_sample, *state_ret, *state_ssm, *state_conv, *ret_norm, *ret_w_in, *ret_head_norm,
      *ret_w_out, *ssm_norm, *ssm_w_in, *ssm_conv_w, *ssm_conv_b, *ssm_dt_bias, *ssm_a_log, *ssm_d, *ssm_gate_norm,
      *ssm_w_out, *final_norm;
  float* out;
  unsigned char* ws;
  long long phase_lo, phase_hi, dup, tidx, wv;
};

typedef __bf16 bf16x2_t __attribute__((ext_vector_type(2)));
typedef float f32x2_t __attribute__((ext_vector_type(2)));
__device__ __forceinline__ u16 f2bf(float f) {
  __bf16 r = (__bf16)f;
  return __builtin_bit_cast(u16, r);
}
__device__ __forceinline__ float bf2f(u16 h) { return __uint_as_float(((uint32_t)h) << 16); }
__device__ __forceinline__ uint32_t pack2(float a, float b) {
  f32x2_t v = {a, b};
  bf16x2_t r = __builtin_convertvector(v, bf16x2_t);
  return __builtin_bit_cast(uint32_t, r);
}
__device__ __forceinline__ float silu(float x) { return x * __builtin_amdgcn_rcpf(1.0f + __expf(-x)); }
__device__ __forceinline__ float row16_sum(float v) {
  v += __builtin_bit_cast(float, __builtin_amdgcn_update_dpp(0, __builtin_bit_cast(int, v), 0xB1, 0xF, 0xF, true));
  v += __builtin_bit_cast(float, __builtin_amdgcn_update_dpp(0, __builtin_bit_cast(int, v), 0x4E, 0xF, 0xF, true));
  v += __builtin_bit_cast(float, __builtin_amdgcn_update_dpp(0, __builtin_bit_cast(int, v), 0x124, 0xF, 0xF, true));
  v += __builtin_bit_cast(float, __builtin_amdgcn_update_dpp(0, __builtin_bit_cast(int, v), 0x128, 0xF, 0xF, true));
  return v;
}
__device__ __forceinline__ float wave_sum(float v) {
#pragma unroll
  for (int o = 32; o > 0; o >>= 1) v += __shfl_xor(v, o);
  return v;
}
__device__ __forceinline__ const float* xrow(const Params& p, int r) {
  return r < NPROMPT ? p.x_prompt + (size_t)r * 1024 : p.x_sample + (size_t)(r - NPROMPT) * 1024;
}
__device__ __forceinline__ s16x4 trread(const unsigned char* ptr) {
  return __builtin_amdgcn_ds_read_tr16_b64_v4i16((s16x4 __attribute__((address_space(3)))*)ptr);
}
__device__ __forceinline__ bf16x8 cat8(s16x4 a, s16x4 b) {
  bf16x8 r;
  r[0] = a[0]; r[1] = a[1]; r[2] = a[2]; r[3] = a[3];
  r[4] = b[0]; r[5] = b[1]; r[6] = b[2]; r[7] = b[3];
  return r;
}
__device__ __forceinline__ bf16x8 trfrag(const unsigned char* img, int rs, int kbase, int nbase, int lane) {
  const int g = lane >> 4, q = (lane & 15) >> 2, pp = lane & 3;
  const unsigned char* a = img + (kbase + 8 * g + q) * rs + (nbase + 4 * pp) * 2;
  s16x4 t0 = trread(a);
  s16x4 t1 = trread(a + 4 * rs);
  return cat8(t0, t1);
}

__device__ __forceinline__ int colmap_retin(int p) {
  if (p < 2048) {
    int hb = p & ~255, pp = p & 255;
    int gi = pp >> 5, half = (pp >> 4) & 1, c = pp & 15;
    return hb + half * 128 + gi * 16 + c;
  }
  return p;
}

__device__ void transpose_tile(const float* __restrict__ W, u16* __restrict__ Wt, int K, int N, int mode, int nt, int kt,
                               unsigned char* smem, const int tid) {
  float* tile = (float*)smem;
#pragma unroll
  for (int i = 0; i < 8; ++i) {
    int idx = tid + NTHR * i;
    int kk = idx >> 6, nn = idx & 63;
    int n = nt * 64 + nn;
    int src = (mode == 1) ? colmap_retin(n) : n;
    float v = 0.f;
    if (src < N) v = W[(size_t)(kt * 64 + kk) * N + src];
    tile[kk * 65 + nn] = v;
  }
  __syncthreads();
  {
    int n = tid >> 3, kc = tid & 7;
    float v[8];
#pragma unroll
    for (int j = 0; j < 8; ++j) v[j] = tile[(kc * 8 + j) * 65 + n];
    u32x4 o;
    o.x = pack2(v[0], v[1]); o.y = pack2(v[2], v[3]); o.z = pack2(v[4], v[5]); o.w = pack2(v[6], v[7]);
    *(u32x4*)(Wt + (size_t)(nt * 64 + n) * K + kt * 64 + kc * 8) = o;
  }
  __syncthreads();
}

__device__ void phase_prep(const Params& p, unsigned char* smem, const int rep) {
  const int tid = (int)p.tidx;
  for (int rr = 0; rr < rep; ++rr) {
  u16* Wt0 = (u16*)(p.ws + OFF_WT0);
  for (int t = blockIdx.x; t < 1536; t += gridDim.x)
    transpose_tile(p.ret_w_in, Wt0, 1024, 6144, 1, t >> 4, t & 15, smem, tid);
  float2* rope = (float2*)(p.ws + OFF_ROPE);
  const int gtid = blockIdx.x * NTHR + tid, gn = gridDim.x * NTHR;
  for (int idx = gtid; idx < 2056 * 128; idx += gn) {
    int pi = idx >> 7, i = idx & 127;
    int pos = pi < 2048 ? pi : 16384 + (pi - 2048);
    float freq = (float)exp2(-(double)i * (13.287712379549449 / 128.0));
    float ang = (float)pos * freq;
    float sn, cs;
    sincosf(ang, &sn, &cs);
    rope[idx] = make_float2(cs, sn);
  }
  u16* H = (u16*)(p.ws + OFF_H);
  const int lane = tid & 63, w = (int)p.wv;
  for (int row = blockIdx.x * 8 + w; row < T_TOK; row += gridDim.x * 8) {
    const float* xr = xrow(p, row);
    float4 v[4];
    float ss = 0.f;
#pragma unroll
    for (int i = 0; i < 4; ++i) {
      v[i] = *(const float4*)(xr + i * 256 + lane * 4);
      ss += v[i].x * v[i].x + v[i].y * v[i].y + v[i].z * v[i].z + v[i].w * v[i].w;
    }
    ss = wave_sum(ss);
    float rstd = rsqrtf(ss * (1.0f / 1024.0f) + 1e-6f);
#pragma unroll
    for (int i = 0; i < 4; ++i) {
      float4 gg = *(const float4*)(p.ret_norm + i * 256 + lane * 4);
      u32x2 o;
      o.x = pack2(v[i].x * rstd * gg.x, v[i].y * rstd * gg.y);
      o.y = pack2(v[i].z * rstd * gg.z, v[i].w * rstd * gg.w);
      *(u32x2*)(H + (size_t)row * 1024 + i * 256 + lane * 4) = o;
    }
  }
  }
}

__device__ void transpose_later_weights(const Params& p, unsigned char* smem, const int first_blk) {
  const int tid = (int)p.tidx;
  u16* Wt1 = (u16*)(p.ws + OFF_WT1);
  u16* Wt2 = (u16*)(p.ws + OFF_WT2);
  u16* Wt3 = (u16*)(p.ws + OFF_WT3);
  const int n1 = 512, n2 = 1568, n3 = 512;
  if ((int)blockIdx.x < first_blk) return;
  const int nb = (int)gridDim.x - first_blk;
  for (int t = (int)blockIdx.x - first_blk; t < n1 + n2 + n3; t += nb) {
    if (t < n1) {
      transpose_tile(p.ret_w_out, Wt1, 2048, 1024, 0, t >> 5, t & 31, smem, tid);
    } else if (t < n1 + n2) {
      int u = t - n1;
      transpose_tile(p.ssm_w_in, Wt2, 1024, 6176, 0, u >> 4, u & 15, smem, tid);
    } else {
      int u = t - n1 - n2;
      transpose_tile(p.ssm_w_out, Wt3, 2048, 1024, 0, u >> 5, u & 31, smem, tid);
    }
  }
}

template <int MODE>
__device__ void phase_norm(const Params& p, const float* __restrict__ X, const float* __restrict__ gain, const int rep) {
  const int tid = (int)p.tidx, lane = tid & 63, w = (int)p.wv;
  u16* H = (u16*)(p.ws + OFF_H);
  for (int row0 = blockIdx.x * 8 + w; row0 < T_TOK * rep; row0 += gridDim.x * 8) {
    const int row = row0 % T_TOK;
    const float* xr = X + (size_t)row * 1024;
    float4 v[4];
    float ss = 0.f;
#pragma unroll
    for (int i = 0; i < 4; ++i) {
      v[i] = *(const float4*)(xr + i * 256 + lane * 4);
      ss += v[i].x * v[i].x + v[i].y * v[i].y + v[i].z * v[i].z + v[i].w * v[i].w;
    }
    ss = wave_sum(ss);
    float rstd = rsqrtf(ss * (1.0f / 1024.0f) + 1e-6f);
#pragma unroll
    for (int i = 0; i < 4; ++i) {
      float4 gg = *(const float4*)(gain + i * 256 + lane * 4);
      if (MODE == 0) {
        u32x2 o;
        o.x = pack2(v[i].x * rstd * gg.x, v[i].y * rstd * gg.y);
        o.y = pack2(v[i].z * rstd * gg.z, v[i].w * rstd * gg.w);
        *(u32x2*)(H + (size_t)row * 1024 + i * 256 + lane * 4) = o;
      } else {
        float4 o = make_float4(v[i].x * rstd * gg.x, v[i].y * rstd * gg.y, v[i].z * rstd * gg.z, v[i].w * rstd * gg.w);
        *(float4*)(p.out + OUT_Y + (size_t)row * 1024 + i * 256 + lane * 4) = o;
      }
    }
  }
}

template <int EPI, int NH>
__device__ void gemm_phase(const Params& p, const u16* __restrict__ A, const u16* __restrict__ Bt, const int K, const int NT,
                           const float* __restrict__ resid, float* __restrict__ outf, unsigned char* smem, const int rep,
                           const int mtiles, const int nt0 = 0, const bool rev = false) {
  constexpr int BM = 256, BN = 128, BK = 64, LR = 144;
  constexpr int BUFB = (BM + BN) * LR;
  float* rstdS = (float*)(smem + 2 * BUFB);
  const int tid = (int)p.tidx, lane = tid & 63, w = (int)p.wv;
  const int wm = w >> 1, wn = w & 1, l15 = lane & 15, g = lane >> 4;
  const int KT = K / BK;
  const int ntiles = mtiles * NT;
  const float* parts = (const float*)(p.ws + OFF_PARTS);
  const int srow = tid >> 3, skc = tid & 7;

  for (int tile0 = rev ? (int)(gridDim.x - 1 - blockIdx.x) : (int)blockIdx.x; tile0 < ntiles * rep; tile0 += gridDim.x) {
    const int tile = tile0 % ntiles;
    const int mt = tile / NT, nt = tile - mt * NT + nt0;
    const int m0 = mt * BM, n0 = nt * BN;
    const bool skip_mma = (EPI == 2) && (n0 >= 6144) && (wn == 1);
    if (NH > 0) {
      for (int idx = tid; idx < BM * NH; idx += NTHR) {
        int row = idx / NH, h = idx % NH;
        const float* pp = parts + (size_t)(m0 + row) * 64 + h * (64 / NH);
        float s = 0.f;
#pragma unroll
        for (int q = 0; q < 64 / NH; ++q) s += pp[q];
        rstdS[idx] = rsqrtf(s / (float)(K / NH) + 1e-6f);
      }
    }
    u32x4 ra[2][4], rb[2][2];
    const u16* ap = A + (size_t)(m0 + srow) * K + skc * 8;
    const u16* bp = Bt + (size_t)(n0 + srow) * K + skc * 8;
#pragma unroll
    for (int i = 0; i < 4; ++i) ra[0][i] = *(const u32x4*)(ap + (size_t)(64 * i) * K);
#pragma unroll
    for (int i = 0; i < 2; ++i) rb[0][i] = *(const u32x4*)(bp + (size_t)(64 * i) * K);
#pragma unroll
    for (int i = 0; i < 4; ++i) ra[1][i] = *(const u32x4*)(ap + (size_t)(64 * i) * K + BK);
#pragma unroll
    for (int i = 0; i < 2; ++i) rb[1][i] = *(const u32x4*)(bp + (size_t)(64 * i) * K + BK);
    {
      unsigned char* base = smem;
#pragma unroll
      for (int i = 0; i < 4; ++i) *(u32x4*)(base + (srow + 64 * i) * LR + skc * 16) = ra[0][i];
#pragma unroll
      for (int i = 0; i < 2; ++i) *(u32x4*)(base + BM * LR + (srow + 64 * i) * LR + skc * 16) = rb[0][i];
    }
    __syncthreads();

    f32x4 acc[4][4];
    f32x4 accT[4][4];
#pragma unroll
    for (int i = 0; i < 4; ++i)
#pragma unroll
      for (int j = 0; j < 4; ++j) {
        acc[i][j] = (f32x4){0.f, 0.f, 0.f, 0.f};
        accT[i][j] = (f32x4){0.f, 0.f, 0.f, 0.f};
      }

    for (int kt2 = 0; kt2 < KT; kt2 += 2) {
#pragma unroll
     for (int par = 0; par < 2; ++par) {
      const int kt = kt2 + par;
      if (kt + 2 < KT) {
#pragma unroll
        for (int i = 0; i < 4; ++i) ra[par][i] = *(const u32x4*)(ap + (size_t)(64 * i) * K + (kt + 2) * BK);
#pragma unroll
        for (int i = 0; i < 2; ++i) rb[par][i] = *(const u32x4*)(bp + (size_t)(64 * i) * K + (kt + 2) * BK);
      }
      const unsigned char* abase = smem + par * BUFB + (wm * 64 + l15) * LR + g * 16;
      const unsigned char* bbase = smem + par * BUFB + BM * LR + (wn * 64 + l15) * LR + g * 16;
      if (!skip_mma)
#pragma unroll
      for (int ks = 0; ks < 2; ++ks) {
        bf16x8 af[4], bfr[4];
#pragma unroll
        for (int mf = 0; mf < 4; ++mf) af[mf] = *(const bf16x8*)(abase + mf * 16 * LR + ks * 64);
#pragma unroll
        for (int nf = 0; nf < 4; ++nf) bfr[nf] = *(const bf16x8*)(bbase + nf * 16 * LR + ks * 64);
#pragma unroll
        for (int mf = 0; mf < 4; ++mf)
#pragma unroll
          for (int nf = 0; nf < 4; ++nf)
            acc[mf][nf] = __builtin_amdgcn_mfma_f32_16x16x32_bf16(af[mf], bfr[nf], acc[mf][nf], 0, 0, 0);
      }
      if (NH > 0) {
        const int per = KT / NH;
        if (((kt + 1) % per) == 0) {
          const int h = (kt + 1) / per - 1;
#pragma unroll
          for (int mf = 0; mf < 4; ++mf)
#pragma unroll
            for (int r = 0; r < 4; ++r) {
              float s = rstdS[(wm * 64 + mf * 16 + 4 * g + r) * NH + h];
#pragma unroll
              for (int nf = 0; nf < 4; ++nf) {
                accT[mf][nf][r] += s * acc[mf][nf][r];
                acc[mf][nf][r] = 0.f;
              }
            }
        }
      }
      if (kt + 1 < KT) {
        unsigned char* base = smem + (par ^ 1) * BUFB;
#pragma unroll
        for (int i = 0; i < 4; ++i) *(u32x4*)(base + (srow + 64 * i) * LR + skc * 16) = ra[par ^ 1][i];
#pragma unroll
        for (int i = 0; i < 2; ++i) *(u32x4*)(base + BM * LR + (srow + 64 * i) * LR + skc * 16) = rb[par ^ 1][i];
      }
      __syncthreads();
     }
    }

#pragma unroll
    for (int mf = 0; mf < 4; ++mf) {
      __builtin_amdgcn_sched_barrier(0);
      float rvv[4][4];
      if (EPI == 1) {
#pragma unroll
        for (int r = 0; r < 4; ++r) {
          const int row = m0 + wm * 64 + mf * 16 + 4 * g + r;
#pragma unroll
          for (int nf = 0; nf < 4; ++nf) {
            const int col = n0 + wn * 64 + nf * 16 + l15;
            rvv[r][nf] = resid ? resid[(size_t)row * 1024 + col] : xrow(p, row)[col];
          }
        }
      }
#pragma unroll
      for (int r = 0; r < 4; ++r) {
        const int row = m0 + wm * 64 + mf * 16 + 4 * g + r;
        if (EPI == 0) {
          u16* proj = (u16*)(p.ws + OFF_PROJ) + (size_t)row * PROJ_LD;
          if (n0 < 2048) {
            const float2* rope = (const float2*)(p.ws + OFF_ROPE);
            const int pi = row < NPROMPT ? (row & 2047) : 2048 + ((row - NPROMPT) & 7);
#pragma unroll
            for (int np = 0; np < 2; ++np) {
              const int pc = n0 + wn * 64 + np * 32;
              const int i = ((pc & 255) >> 5) * 16 + l15;
              const float2 cs = rope[pi * 128 + i];
              const float x1 = acc[mf][2 * np][r], x2 = acc[mf][2 * np + 1][r];
              float y1 = x1 * cs.x - x2 * cs.y, y2 = x1 * cs.y + x2 * cs.x;
              if (pc >= 1024) { y1 *= 0.0625f; y2 *= 0.0625f; }
              const int f1 = (pc & ~255) + i;
              proj[f1] = f2bf(y1);
              proj[f1 + 128] = f2bf(y2);
            }
          } else {
#pragma unroll
            for (int nf = 0; nf < 4; ++nf) proj[n0 + wn * 64 + nf * 16 + l15] = f2bf(acc[mf][nf][r]);
          }
        } else if (EPI == 1) {
#pragma unroll
          for (int nf = 0; nf < 4; ++nf) {
            const int col = n0 + wn * 64 + nf * 16 + l15;
            const float a = (NH > 0) ? accT[mf][nf][r] : acc[mf][nf][r];
            outf[(size_t)row * 1024 + col] = rvv[r][nf] + a;
          }
        } else {
          u16* proj = (u16*)(p.ws + OFF_PROJ) + (size_t)row * PROJ_LD;
          float* dtraw = (float*)(p.ws + OFF_DTRAW) + (size_t)row * 32;
          float* cvo = nullptr;
          if (row < NPROMPT) {
            const int t = row & 2047;
            if (t >= 2045) cvo = p.out + OUT_CONVP + ((size_t)(row >> 11) * 3 + (t - 2045)) * 4096;
          } else {
            const int rs = row - NPROMPT, t = rs & 7;
            if (t >= 5) cvo = p.out + OUT_CONVS + ((size_t)(rs >> 3) * 3 + (t - 5)) * 4096;
          }
#pragma unroll
          for (int nf = 0; nf < 4; ++nf) {
            const int col = n0 + wn * 64 + nf * 16 + l15;
            const float a = acc[mf][nf][r];
            if (col < 6144) {
              proj[col] = f2bf(a);
              if (col >= 2048 && cvo) cvo[col - 2048] = a;
            } else if (col < 6176) {
              dtraw[col - 6144] = a;
            }
          }
        }
      }
    }
  }
}


template <int NH>
__device__ void gemm_sample_rows(const Params& p, const u16* __restrict__ A, const u16* __restrict__ Bt,
                                 const float* __restrict__ resid, float* __restrict__ outf, unsigned char* smem, const int rep) {
  constexpr int K = 2048, RS = 65;
  float* red = (float*)smem;
  float* rstdS = red + 8 * 64 * RS;
  const int tid = (int)p.tidx, lane = tid & 63, w = (int)p.wv, l15 = lane & 15, g = lane >> 4;
  const float* parts = (const float*)(p.ws + OFF_PARTS);
  for (int item0 = blockIdx.x; item0 < 256 * rep; item0 += gridDim.x) {
    const int item = item0 & 255;
    const int m0 = NPROMPT + (item >> 4) * 64, n0 = (item & 15) * 64;
    for (int idx = tid; idx < 64 * NH; idx += NTHR) {
      const int row = idx / NH, h = idx % NH;
      const float* pp = parts + (size_t)(m0 + row) * 64 + h * (64 / NH);
      float sm = 0.f;
#pragma unroll
      for (int q = 0; q < 64 / NH; ++q) sm += pp[q];
      rstdS[idx] = rsqrtf(sm / (float)(K / NH) + 1e-6f);
    }
    f32x4 acc[4][4];
#pragma unroll
    for (int i = 0; i < 4; ++i)
#pragma unroll
      for (int j = 0; j < 4; ++j) acc[i][j] = (f32x4){0.f, 0.f, 0.f, 0.f};
    const u16* ap = A + (size_t)(m0 + l15) * K + w * 256 + 8 * g;
    const u16* bp = Bt + (size_t)(n0 + l15) * K + w * 256 + 8 * g;
#pragma unroll 2
    for (int ks = 0; ks < 8; ++ks) {
      bf16x8 af[4], bfr[4];
#pragma unroll
      for (int mf = 0; mf < 4; ++mf) af[mf] = *(const bf16x8*)(ap + (size_t)(mf * 16) * K + ks * 32);
#pragma unroll
      for (int nf = 0; nf < 4; ++nf) bfr[nf] = *(const bf16x8*)(bp + (size_t)(nf * 16) * K + ks * 32);
#pragma unroll
      for (int mf = 0; mf < 4; ++mf)
#pragma unroll
        for (int nf = 0; nf < 4; ++nf)
          acc[mf][nf] = __builtin_amdgcn_mfma_f32_16x16x32_bf16(af[mf], bfr[nf], acc[mf][nf], 0, 0, 0);
    }
    __syncthreads();
    {
      const int h = (w * 256) / (K / NH);
#pragma unroll
      for (int mf = 0; mf < 4; ++mf)
#pragma unroll
        for (int r = 0; r < 4; ++r) {
          const int row = mf * 16 + 4 * g + r;
          const float sc = rstdS[row * NH + h];
#pragma unroll
          for (int nf = 0; nf < 4; ++nf) red[(w * 64 + row) * RS + nf * 16 + l15] = acc[mf][nf][r] * sc;
        }
    }
    __syncthreads();
    {
      const int row = tid >> 3, c0 = (tid & 7) * 8;
      float o[8];
      const size_t gidx = (size_t)(m0 + row) * 1024 + n0 + c0;
      const float* rp = resid ? resid + gidx : p.x_sample + (size_t)(m0 - NPROMPT + row) * 1024 + n0 + c0;
      const float4 r0 = *(const float4*)rp, r1 = *(const float4*)(rp + 4);
      o[0] = r0.x; o[1] = r0.y; o[2] = r0.z; o[3] = r0.w; o[4] = r1.x; o[5] = r1.y; o[6] = r1.z; o[7] = r1.w;
#pragma unroll
      for (int ww = 0; ww < 8; ++ww)
#pragma unroll
        for (int j = 0; j < 8; ++j) o[j] += red[(ww * 64 + row) * RS + c0 + j];
      *(float4*)(outf + gidx) = make_float4(o[0], o[1], o[2], o[3]);
      *(float4*)(outf + gidx + 4) = make_float4(o[4], o[5], o[6], o[7]);
    }
    __syncthreads();
  }
}

__device__ __forceinline__ int lds_byte(int r, int c) {
  int st = (r >> 4) * 2 + (c >> 5), rr = r & 15, cc = c & 31, ob = rr * 64 + cc * 2;
  return st * 1024 + (ob ^ (((ob >> 9) & 1) << 5));
}
__device__ __forceinline__ void stage_rc(int b, int& R, int& C) {
  int st = b / 1024, sb = b % 1024, swz = sb ^ (((sb >> 9) & 1) << 5);
  R = (st >> 1) * 16 + swz / 64;
  C = (st & 1) * 32 + (swz % 64) / 2;
}

template <int EPI>
__device__ void gemm8_phase(const Params& p, const u16* __restrict__ A, const u16* __restrict__ Bt, const int K, const int nN,
                            unsigned char* smem, const int rep) {
  constexpr int BM8 = 256, BK8 = 64, HALF = 128, NXCD = 8, WGM = 8, HT = HALF * BK8;
  u16* shm = (u16*)smem;
#define SA(b, h) (shm + ((b) * 2 + (h)) * HT)
#define SB(b, h) (shm + (4 + (b) * 2 + (h)) * HT)
#define STAGE(P, BASE, br, kt)                                                                            \
  do {                                                                                                    \
    const int _so = ((br) * K + (kt) * BK8) * 2;                                                          \
    __builtin_amdgcn_raw_ptr_buffer_load_lds(rsrc_##BASE, (__attribute__((address_space(3))) unsigned*)((char*)(P) + (int)p.tidx * 16), 16, voff0, _so, 0, 0); \
    __builtin_amdgcn_raw_ptr_buffer_load_lds(rsrc_##BASE, (__attribute__((address_space(3))) unsigned*)((char*)(P) + (int)p.tidx * 16 + 8192), 16, voff1, _so, 0, 0); \
  } while (0)
#define LDA(dst, b, h)                                                                                    \
  for (int m = 0; m < 4; ++m)                                                                             \
    for (int k = 0; k < 2; ++k)                                                                           \
      dst[m][k] = *reinterpret_cast<const bf16x8*>((char*)SA(b, h) + lds_byte(wr * 64 + m * 16 + fr, k * 32 + fq * 8))
#define LDB(dst, b, h)                                                                                    \
  for (int n = 0; n < 2; ++n)                                                                             \
    for (int k = 0; k < 2; ++k)                                                                           \
      dst[n][k] = *reinterpret_cast<const bf16x8*>((char*)SB(b, h) + lds_byte(wc * 32 + n * 16 + fr, k * 32 + fq * 8))
#define MMA(ai, bj, At, Bx)                                                                               \
  do {                                                                                                    \
    __builtin_amdgcn_s_setprio(1);                                                                        \
    for (int m = 0; m < 4; ++m)                                                                           \
      for (int n = 0; n < 2; ++n)                                                                         \
        for (int k = 0; k < 2; ++k)                                                                       \
          acc[ai][bj][m][n] = __builtin_amdgcn_mfma_f32_16x16x32_bf16(At[m][k], Bx[n][k], acc[ai][bj][m][n], 0, 0, 0); \
    __builtin_amdgcn_s_setprio(0);                                                                        \
  } while (0)
#define WAIT_V(n) asm volatile("s_waitcnt vmcnt(" #n ")" ::: "memory")
#define WAIT_L(n) asm volatile("s_waitcnt lgkmcnt(" #n ")" ::: "memory")
#define BAR __builtin_amdgcn_s_barrier()
#define SCHED __builtin_amdgcn_sched_barrier(0)

  const int nM = T_TOK / BM8, nwg = nM * nN;
  const int wid = (int)p.wv, lane = (int)p.tidx & 63, wr = wid >> 2, wc = wid & 3, fr = lane & 15, fq = lane >> 4;
  const int nt = K / BK8;
  const __amdgpu_buffer_rsrc_t rsrc_A = __builtin_amdgcn_make_buffer_rsrc((void*)A, (short)0, T_TOK * K * 2, 0x00020000);
  const __amdgpu_buffer_rsrc_t rsrc_Bt = __builtin_amdgcn_make_buffer_rsrc((void*)Bt, (short)0, nN * 256 * K * 2, 0x00020000);
  int voff0, voff1;
  {
    int r_, c_;
    stage_rc((int)p.tidx * 16, r_, c_);
    voff0 = (r_ * K + c_) * 2;
    stage_rc((int)p.tidx * 16 + 8192, r_, c_);
    voff1 = (r_ * K + c_) * 2;
  }

  for (int tile0 = blockIdx.x; tile0 < nwg * rep; tile0 += gridDim.x) {
    const int tile = tile0 % nwg;
    int wgid = tile;
    {
      int q = nwg / NXCD, r = nwg % NXCD, xcd = wgid % NXCD, off = wgid / NXCD;
      wgid = (xcd < r ? xcd * (q + 1) : r * (q + 1) + (xcd - r) * q) + off;
    }
    const int nig = WGM * nN, gid = wgid / nig, fm = gid * WGM, gsz = min(nM - fm, WGM);
    const int pm = fm + ((wgid % nig) % gsz), pn = (wgid % nig) / gsz, brow = pm * BM8, bcol = pn * BM8;

    f32x4 acc[2][2][4][2];
#pragma unroll
    for (int a = 0; a < 2; ++a)
#pragma unroll
      for (int b = 0; b < 2; ++b)
#pragma unroll
        for (int m = 0; m < 4; ++m)
#pragma unroll
          for (int n = 0; n < 2; ++n) acc[a][b][m][n] = (f32x4){0.f, 0.f, 0.f, 0.f};
    bf16x8 At[4][2], B0[2][2], B1[2][2];

    STAGE(SB(0, 0), Bt, bcol, 0); STAGE(SA(0, 0), A, brow, 0);
    STAGE(SB(0, 1), Bt, bcol + HALF, 0); STAGE(SA(0, 1), A, brow + HALF, 0);
    if (wr == 1) BAR;
    WAIT_V(4); BAR;
    STAGE(SB(1, 0), Bt, bcol, 1); STAGE(SA(1, 0), A, brow, 1); STAGE(SB(1, 1), Bt, bcol + HALF, 1);
    WAIT_V(6); BAR;
    for (int t = 0; t < nt - 2; t += 2) {
      LDB(B0, 0, 0); SCHED; LDA(At, 0, 0); STAGE(SA(1, 1), A, brow + HALF, t + 1);
      WAIT_L(8); BAR; WAIT_L(0); MMA(0, 0, At, B0); BAR; SCHED;
      LDB(B1, 0, 1); STAGE(SB(0, 0), Bt, bcol, t + 2);
      BAR; WAIT_L(0); MMA(0, 1, At, B1); BAR;
      LDA(At, 0, 1); STAGE(SA(0, 0), A, brow, t + 2);
      BAR; WAIT_L(0); MMA(1, 0, At, B0); BAR; SCHED;
      STAGE(SB(0, 1), Bt, bcol + HALF, t + 2);
      WAIT_V(6); BAR; MMA(1, 1, At, B1); BAR;
      LDB(B0, 1, 0); SCHED; LDA(At, 1, 0); STAGE(SA(0, 1), A, brow + HALF, t + 2);
      WAIT_L(8); BAR; WAIT_L(0); MMA(0, 0, At, B0); BAR; SCHED;
      LDB(B1, 1, 1); STAGE(SB(1, 0), Bt, bcol, t + 3);
      BAR; WAIT_L(0); MMA(0, 1, At, B1); BAR;
      LDA(At, 1, 1); STAGE(SA(1, 0), A, brow, t + 3);
      BAR; WAIT_L(0); MMA(1, 0, At, B0); BAR; SCHED;
      STAGE(SB(1, 1), Bt, bcol + HALF, t + 3);
      WAIT_V(6); BAR; MMA(1, 1, At, B1); BAR;
    }
    {
      LDB(B0, 0, 0); LDA(At, 0, 0); STAGE(SA(1, 1), A, brow + HALF, nt - 1);
      BAR; WAIT_L(0); MMA(0, 0, At, B0); BAR; SCHED;
      LDB(B1, 0, 1); BAR; WAIT_L(0); MMA(0, 1, At, B1); BAR; SCHED;
      LDA(At, 0, 1); WAIT_V(4); BAR; WAIT_L(0); MMA(1, 0, At, B0); MMA(1, 1, At, B1); BAR; SCHED;
    }
    {
      LDB(B0, 1, 0); LDA(At, 1, 0); WAIT_V(2); BAR; WAIT_L(0); MMA(0, 0, At, B0); BAR; SCHED;
      LDB(B1, 1, 1); WAIT_V(0); BAR; WAIT_L(0); MMA(0, 1, At, B1); BAR; SCHED;
      LDA(At, 1, 1); BAR; WAIT_L(0); MMA(1, 0, At, B0); MMA(1, 1, At, B1); BAR; SCHED;
    }
    if (wr == 0) BAR;

    u16* projb = (u16*)(p.ws + OFF_PROJ);
#pragma unroll
    for (int ai = 0; ai < 2; ++ai)
#pragma unroll
      for (int m = 0; m < 4; ++m) {
        if (EPI == 0 && bcol < 2048) {
          const float2* rope = (const float2*)(p.ws + OFF_ROPE);
#pragma unroll
          for (int bj = 0; bj < 2; ++bj) {
            __builtin_amdgcn_sched_barrier(0);
            const int pc = bcol + bj * HALF + wc * 32;
            const int i = ((pc & 255) >> 5) * 16 + fr;
            const int f1 = (pc & ~255) + i;
            float2 csv[4];
#pragma unroll
            for (int j = 0; j < 4; ++j) {
              const int row = brow + ai * HALF + wr * 64 + m * 16 + fq * 4 + j;
              const int pi = row < NPROMPT ? (row & 2047) : 2048 + ((row - NPROMPT) & 7);
              csv[j] = rope[pi * 128 + i];
            }
#pragma unroll
            for (int j = 0; j < 4; ++j) {
              const int row = brow + ai * HALF + wr * 64 + m * 16 + fq * 4 + j;
              u16* proj = projb + (size_t)row * PROJ_LD;
              const float2 cs = csv[j];
              const float x1 = acc[ai][bj][m][0][j], x2 = acc[ai][bj][m][1][j];
              float y1 = x1 * cs.x - x2 * cs.y, y2 = x1 * cs.y + x2 * cs.x;
              if (pc >= 1024) { y1 *= 0.0625f; y2 *= 0.0625f; }
              proj[f1] = f2bf(y1);
              proj[f1 + 128] = f2bf(y2);
            }
          }
        } else {
#pragma unroll
          for (int j = 0; j < 4; ++j) {
            __builtin_amdgcn_sched_barrier(0);
            const int row = brow + ai * HALF + wr * 64 + m * 16 + fq * 4 + j;
            u16* proj = projb + (size_t)row * PROJ_LD;
            float* cvo = nullptr;
            if (EPI == 2 && bcol >= 2048) {
              if (row < NPROMPT) {
                const int t = row & 2047;
                if (t >= 2045) cvo = p.out + OUT_CONVP + ((size_t)(row >> 11) * 3 + (t - 2045)) * 4096;
              } else {
                const int rs = row - NPROMPT, t = rs & 7;
                if (t >= 5) cvo = p.out + OUT_CONVS + ((size_t)(rs >> 3) * 3 + (t - 5)) * 4096;
              }
            }
#pragma unroll
            for (int bj = 0; bj < 2; ++bj)
#pragma unroll
              for (int n = 0; n < 2; ++n) {
                const int col = bcol + bj * HALF + wc * 32 + n * 16 + fr;
                const float a = acc[ai][bj][m][n][j];
                proj[col] = f2bf(a);
                if (EPI == 2 && cvo) cvo[col - 2048] = a;
              }
          }
        }
      }
  }
#undef SA
#undef SB
#undef STAGE
#undef LDA
#undef LDB
#undef MMA
#undef WAIT_V
#undef WAIT_L
#undef BAR
#undef SCHED
}

__device__ __forceinline__ void unpack8(const u32x4 u, float* xv) {
  xv[0] = bf2f((u16)(u.x & 0xffff)); xv[1] = bf2f((u16)(u.x >> 16));
  xv[2] = bf2f((u16)(u.y & 0xffff)); xv[3] = bf2f((u16)(u.y >> 16));
  xv[4] = bf2f((u16)(u.z & 0xffff)); xv[5] = bf2f((u16)(u.z >> 16));
  xv[6] = bf2f((u16)(u.w & 0xffff)); xv[7] = bf2f((u16)(u.w >> 16));
}

__device__ void phase_conv(const Params& p, unsigned char* smem, const int rep) {
  const int tid = (int)p.tidx;
  const float* dtraw = (const float*)(p.ws + OFF_DTRAW);
  float* dtv = (float*)(p.ws + OFF_DT);
  float* cumv = (float*)(p.ws + OFF_CUM);
  {
    float* laS = (float*)smem;
    const int tok = tid >> 3, h0 = (tid & 7) * 4;
    const float4 bias = *(const float4*)(p.ssm_dt_bias + h0);
    const float4 al = *(const float4*)(p.ssm_a_log + h0);
    const float4 an = make_float4(-expf(al.x), -expf(al.y), -expf(al.z), -expf(al.w));
    for (int sc = blockIdx.x; sc < 384; sc += gridDim.x) {
      int row0, len;
      if (sc < 256) { row0 = sc * 64; len = 64; } else { row0 = NPROMPT + (sc - 256) * 8; len = 8; }
      if (tok < len) {
        const float4 x = *(const float4*)(dtraw + (size_t)(row0 + tok) * 32 + h0);
        float4 dt;
        { float v = x.x + bias.x; dt.x = v > 20.f ? v : log1pf(expf(v)); }
        { float v = x.y + bias.y; dt.y = v > 20.f ? v : log1pf(expf(v)); }
        { float v = x.z + bias.z; dt.z = v > 20.f ? v : log1pf(expf(v)); }
        { float v = x.w + bias.w; dt.w = v > 20.f ? v : log1pf(expf(v)); }
        *(float4*)(dtv + (size_t)(row0 + tok) * 32 + h0) = dt;
        *(float4*)(laS + tok * 32 + h0) = make_float4(dt.x * an.x, dt.y * an.y, dt.z * an.z, dt.w * an.w);
      }
      __syncthreads();
      if (tok < len) {
        float4 c = make_float4(0.f, 0.f, 0.f, 0.f);
        for (int t = 0; t <= tok; ++t) {
          const float4 v = *(const float4*)(laS + t * 32 + h0);
          c.x += v.x; c.y += v.y; c.z += v.z; c.w += v.w;
        }
        *(float4*)(cumv + (size_t)(row0 + tok) * 32 + h0) = c;
      }
      __syncthreads();
    }
  }
  const u16* proj = (const u16*)(p.ws + OFF_PROJ);
  u16* xbcc = (u16*)(p.ws + OFF_XBCC);
  const int gtid = blockIdx.x * NTHR + tid;
  const int ch0 = (gtid & 511) * 8, rb = gtid >> 9;
  float wgt[4][8], bs[8];
#pragma unroll
  for (int wv = 0; wv < 4; ++wv) {
    const float4 w0 = *(const float4*)(p.ssm_conv_w + (size_t)wv * 4096 + ch0);
    const float4 w1 = *(const float4*)(p.ssm_conv_w + (size_t)wv * 4096 + ch0 + 4);
    wgt[wv][0] = w0.x; wgt[wv][1] = w0.y; wgt[wv][2] = w0.z; wgt[wv][3] = w0.w;
    wgt[wv][4] = w1.x; wgt[wv][5] = w1.y; wgt[wv][6] = w1.z; wgt[wv][7] = w1.w;
  }
  {
    const float4 b0 = *(const float4*)(p.ssm_conv_b + ch0), b1 = *(const float4*)(p.ssm_conv_b + ch0 + 4);
    bs[0] = b0.x; bs[1] = b0.y; bs[2] = b0.z; bs[3] = b0.w; bs[4] = b1.x; bs[5] = b1.y; bs[6] = b1.z; bs[7] = b1.w;
  }
  const int rows_per = T_TOK / (int)(gridDim.x * NTHR / 512);
  for (int rr = 0; rr < rep; ++rr) {
    float hm3[8], hm2[8], hm1[8];
    const int rbeg = rb * rows_per;
    u32x4 cur[4], nxt[4];
#pragma unroll
    for (int q = 0; q < 4; ++q) cur[q] = *(const u32x4*)(proj + (size_t)(rbeg + q) * PROJ_LD + 2048 + ch0);
    for (int r4 = 0; r4 < rows_per; r4 += 4) {
#pragma unroll
      for (int q = 0; q < 4; ++q) {
        nxt[q] = cur[q];
        if (r4 + 4 + q < rows_per) nxt[q] = *(const u32x4*)(proj + (size_t)(rbeg + r4 + 4 + q) * PROJ_LD + 2048 + ch0);
      }
#pragma unroll
      for (int q4 = 0; q4 < 4; ++q4) {
        const int r = r4 + q4;
        const int row = rbeg + r;
        const bool samp = row >= NPROMPT;
        const int t = samp ? ((row - NPROMPT) & 7) : (row & 2047);
        const int b = samp ? ((row - NPROMPT) >> 3) : (row >> 11);
        if (r == 0 || t == 0) {
#pragma unroll
          for (int k = 1; k <= 3; ++k) {
            float hv[8];
            if (t - k >= 0) {
              unpack8(*(const u32x4*)(proj + (size_t)(row - k) * PROJ_LD + 2048 + ch0), hv);
            } else if (samp) {
              const float* sp = p.state_conv + ((size_t)b * 3 + (t - k + 3)) * 4096 + ch0;
              const float4 s0 = *(const float4*)sp, s1 = *(const float4*)(sp + 4);
              hv[0] = s0.x; hv[1] = s0.y; hv[2] = s0.z; hv[3] = s0.w; hv[4] = s1.x; hv[5] = s1.y; hv[6] = s1.z; hv[7] = s1.w;
            } else {
#pragma unroll
              for (int q = 0; q < 8; ++q) hv[q] = 0.f;
            }
#pragma unroll
            for (int q = 0; q < 8; ++q) {
              if (k == 1) hm1[q] = hv[q];
              if (k == 2) hm2[q] = hv[q];
              if (k == 3) hm3[q] = hv[q];
            }
          }
        }
        float xc[8], o[8];
        unpack8(cur[q4], xc);
#pragma unroll
        for (int q = 0; q < 8; ++q) {
          const float a = bs[q] + hm3[q] * wgt[0][q] + hm2[q] * wgt[1][q] + hm1[q] * wgt[2][q] + xc[q] * wgt[3][q];
          o[q] = silu(a);
          hm3[q] = hm2[q]; hm2[q] = hm1[q]; hm1[q] = xc[q];
        }
        u32x4 ov;
        ov.x = pack2(o[0], o[1]); ov.y = pack2(o[2], o[3]); ov.z = pack2(o[4], o[5]); ov.w = pack2(o[6], o[7]);
        *(u32x4*)(xbcc + (size_t)row * 4096 + ch0) = ov;
      }
#pragma unroll
      for (int q = 0; q < 4; ++q) cur[q] = nxt[q];
    }
  }
}

template <int DK, int MODE>
__device__ void rec_prompt_item(const Params& p, const int item, unsigned char* smem) {
  constexpr int QS = (DK + 16) * 2;
  constexpr int VS = 160, PS = 144;
  constexpr int MF = DK / 128;
  constexpr int KS = DK / 32;
  constexpr int NQ = DK / 64;
  constexpr int CPR = DK / 8;
  unsigned char* Qs = smem;
  unsigned char* Ks = Qs + 64 * QS;
  unsigned char* STs = Ks + 64 * QS;
  unsigned char* Vs = STs + 64 * QS;
  unsigned char* Vts = Vs + 64 * VS;
  unsigned char* Ps = Vts + 64 * VS;
  float* cumS = (float*)(Ps + 64 * PS);
  float* uS = cumS + 64;

  const int tid = (int)p.tidx, lane = tid & 63, w = tid >> 6;
  const int l15 = lane & 15, g = lane >> 4;
  const int b = item >> 5;
  const int h = (MODE == 0) ? ((item >> 3) & 3) : (item & 31);
  const int s = (MODE == 0) ? (item & 7) : 0;
  const int row0 = b * 2048;

  const u16* src;
  int sstride, qcol, kcol, vcol;
  if (MODE == 0) {
    src = (const u16*)(p.ws + OFF_PROJ); sstride = PROJ_LD;
    qcol = h * 256; kcol = 1024 + h * 256; vcol = 2048 + h * 512 + s * 64;
  } else {
    src = (const u16*)(p.ws + OFF_XBCC); sstride = 4096;
    qcol = 3072 + (h >> 2) * 128; kcol = 2048 + (h >> 2) * 128; vcol = h * 64;
  }
  const float* dtv = (const float*)(p.ws + OFF_DT);
  const float* cumv = (const float*)(p.ws + OFF_CUM);
  const float lg = (MODE == 0) ? logf(1.0f - exp2f(-5.0f - (float)h)) : 0.f;

  const int vrow = tid >> 3, vkc = tid & 7;
  const int jt = tid & 63;

  constexpr int NSET = (MODE == 1) ? 2 : 1;
  u32x4 rq[2][NQ], rk[2][NQ], rv[2];
  float pcj[2] = {0.f, 0.f}, puj[2] = {1.f, 1.f}, pclast[2] = {0.f, 0.f}, pct[2] = {0.f, 0.f}, put[2] = {1.f, 1.f};
  u16 gz[2][2][4];
  const u16* gsrc = (const u16*)(p.ws + OFF_PROJ);
  const int gcol = (MODE == 0) ? (4096 + h * 512 + s * 64) : (h * 64);
  const int fi = w >> 1, fe0 = 2 * (w & 1);
  const int fis = (int)p.wv >> 1, fe0s = 2 * ((int)p.wv & 1);
  const int dw = w * (DK / 8);

#define PF_ISSUE(SET, RBASE)                                                                       \
  {                                                                                                \
    const int rb_ = (RBASE);                                                                       \
    _Pragma("unroll") for (int i = 0; i < NQ; ++i) {                                               \
      int c_ = tid + NTHR * i, rr_ = c_ / CPR, kc_ = c_ % CPR;                                     \
      rq[SET][i] = *(const u32x4*)(src + (size_t)(rb_ + rr_) * sstride + qcol + kc_ * 8);          \
      rk[SET][i] = *(const u32x4*)(src + (size_t)(rb_ + rr_) * sstride + kcol + kc_ * 8);          \
    }                                                                                              \
    rv[SET] = *(const u32x4*)(src + (size_t)(rb_ + vrow) * sstride + vcol + vkc * 8);              \
    if (MODE == 1) {                                                                               \
      pcj[SET] = cumv[(size_t)(rb_ + vrow) * 32 + h]; puj[SET] = dtv[(size_t)(rb_ + vrow) * 32 + h]; \
      pclast[SET] = cumv[(size_t)(rb_ + 63) * 32 + h];                                             \
      pct[SET] = cumv[(size_t)(rb_ + jt) * 32 + h]; put[SET] = dtv[(size_t)(rb_ + jt) * 32 + h];   \
    }                                                                                              \
    _Pragma("unroll") for (int x = 0; x < 2; ++x)                                                  \
      _Pragma("unroll") for (int r = 0; r < 4; ++r)                                                \
        gz[SET][x][r] = gsrc[(size_t)(rb_ + 16 * fi + 4 * g + r) * PROJ_LD + gcol + 16 * (fe0 + x) + l15]; \
  }

  f32x4 S[MF][4];
#pragma unroll
  for (int i = 0; i < MF; ++i)
#pragma unroll
    for (int j = 0; j < 4; ++j) S[i][j] = (f32x4){0.f, 0.f, 0.f, 0.f};

  float gnv[2];
  const float dsk = (MODE == 1) ? p.ssm_d[h] : 0.f;
#pragma unroll
  for (int x = 0; x < 2; ++x) {
    const int e = 16 * (fe0 + x) + l15;
    gnv[x] = (MODE == 0) ? p.ret_head_norm[h * 512 + s * 64 + e] : p.ssm_gate_norm[h * 64 + e];
  }

  PF_ISSUE(0, row0)
  if (NSET == 2) PF_ISSUE(1, row0 + 64)

  for (int c2 = 0; c2 < 32; c2 += 2) {
#pragma unroll
   for (int par2 = 0; par2 < 2; ++par2) {
    const int par = par2 & (NSET - 1);
    const int c = c2 + par2;
    const int r0 = row0 + c * 64;
#pragma unroll
    for (int i = 0; i < NQ; ++i) {
      int cc = tid + NTHR * i, rr = cc / CPR, kc = cc % CPR;
      *(u32x4*)(Qs + rr * QS + kc * 16) = rq[par][i];
      *(u32x4*)(Ks + rr * QS + kc * 16) = rk[par][i];
    }
    {
      const u32x4 rvv = rv[par];
      *(u32x4*)(Vs + vrow * VS + vkc * 16) = rvv;
      float cj, uj, cl;
      if (MODE == 0) { cj = (float)(vrow + 1) * lg; uj = 1.f; cl = 64.f * lg; } else { cj = pcj[par]; uj = puj[par]; cl = pclast[par]; }
      const float wj = uj * __expf(cl - cj);
      u32x4 o;
      o.x = pack2(bf2f((u16)(rvv.x & 0xffff)) * wj, bf2f((u16)(rvv.x >> 16)) * wj);
      o.y = pack2(bf2f((u16)(rvv.y & 0xffff)) * wj, bf2f((u16)(rvv.y >> 16)) * wj);
      o.z = pack2(bf2f((u16)(rvv.z & 0xffff)) * wj, bf2f((u16)(rvv.z >> 16)) * wj);
      o.w = pack2(bf2f((u16)(rvv.w & 0xffff)) * wj, bf2f((u16)(rvv.w >> 16)) * wj);
      *(u32x4*)(Vts + vrow * VS + vkc * 16) = o;
    }
    if (tid < 64) {
      if (MODE == 0) { cumS[tid] = (float)(tid + 1) * lg; uS[tid] = 1.f; } else { cumS[tid] = pct[par]; uS[tid] = put[par]; }
    }
#pragma unroll
    for (int mf = 0; mf < MF; ++mf)
#pragma unroll
      for (int nf = 0; nf < 4; ++nf) {
        u32x2 o;
        o.x = pack2(S[mf][nf][0], S[mf][nf][1]);
        o.y = pack2(S[mf][nf][2], S[mf][nf][3]);
        *(u32x2*)(STs + (16 * nf + l15) * QS + (dw + 16 * mf + 4 * g) * 2) = o;
      }
    u16 gzc[2][4];
#pragma unroll
    for (int x = 0; x < 2; ++x)
#pragma unroll
      for (int r = 0; r < 4; ++r) gzc[x][r] = gz[par][x][r];
    __syncthreads();
    if (c + NSET < 32) PF_ISSUE(par, r0 + 64 * NSET)
    f32x4 sc[2], cr[2];
#pragma unroll
    for (int x = 0; x < 2; ++x) { sc[x] = (f32x4){0.f, 0.f, 0.f, 0.f}; cr[x] = (f32x4){0.f, 0.f, 0.f, 0.f}; }
#pragma unroll 4
    for (int ks = 0; ks < KS; ++ks) {
      const bf16x8 a = *(const bf16x8*)(Qs + (16 * fi + l15) * QS + ks * 64 + g * 16);
      bf16x8 bk[2], bs[2];
#pragma unroll
      for (int x = 0; x < 2; ++x) {
        bk[x] = *(const bf16x8*)(Ks + (16 * (fe0 + x) + l15) * QS + ks * 64 + g * 16);
        bs[x] = *(const bf16x8*)(STs + (16 * (fe0 + x) + l15) * QS + ks * 64 + g * 16);
      }
#pragma unroll
      for (int x = 0; x < 2; ++x) {
        sc[x] = __builtin_amdgcn_mfma_f32_16x16x32_bf16(a, bk[x], sc[x], 0, 0, 0);
        cr[x] = __builtin_amdgcn_mfma_f32_16x16x32_bf16(a, bs[x], cr[x], 0, 0, 0);
      }
    }
    float ci[4];
#pragma unroll
    for (int r = 0; r < 4; ++r) ci[r] = cumS[16 * fi + 4 * g + r];
#pragma unroll
    for (int x = 0; x < 2; ++x) {
      const int fj = fe0 + x;
      const int j = 16 * fj + l15;
      const float cj = cumS[j], uj = uS[j];
#pragma unroll
      for (int r = 0; r < 4; ++r) {
        const int i = 16 * fi + 4 * g + r;
        float v = 0.f;
        if (j <= i) v = sc[x][r] * __expf(ci[r] - cj) * uj;
        *(u16*)(Ps + i * PS + j * 2) = f2bf(v);
      }
    }
    {
      const float atot = __expf(cumS[63]);
#pragma unroll
      for (int mf = 0; mf < MF; ++mf)
#pragma unroll
        for (int nf = 0; nf < 4; ++nf)
#pragma unroll
          for (int r = 0; r < 4; ++r) S[mf][nf][r] *= atot;
#pragma unroll
      for (int ks = 0; ks < 2; ++ks) {
        bf16x8 af[MF], bfv[4];
#pragma unroll
        for (int mf = 0; mf < MF; ++mf) af[mf] = trfrag(Ks, QS, 32 * ks, dw + 16 * mf, lane);
#pragma unroll
        for (int nf = 0; nf < 4; ++nf) bfv[nf] = trfrag(Vts, VS, 32 * ks, 16 * nf, lane);
#pragma unroll
        for (int mf = 0; mf < MF; ++mf)
#pragma unroll
          for (int nf = 0; nf < 4; ++nf)
            S[mf][nf] = __builtin_amdgcn_mfma_f32_16x16x32_bf16(af[mf], bfv[nf], S[mf][nf], 0, 0, 0);
      }
    }
    __syncthreads();
    f32x4 in[2];
#pragma unroll
    for (int x = 0; x < 2; ++x) in[x] = (f32x4){0.f, 0.f, 0.f, 0.f};
#pragma unroll
    for (int ks = 0; ks < 2; ++ks) {
      const bf16x8 a = *(const bf16x8*)(Ps + (16 * fi + l15) * PS + ks * 64 + g * 16);
      bf16x8 bv[2];
#pragma unroll
      for (int x = 0; x < 2; ++x) bv[x] = trfrag(Vs, VS, 32 * ks, 16 * (fe0 + x), lane);
#pragma unroll
      for (int x = 0; x < 2; ++x) in[x] = __builtin_amdgcn_mfma_f32_16x16x32_bf16(a, bv[x], in[x], 0, 0, 0);
    }
    {
      float ss[4] = {0.f, 0.f, 0.f, 0.f};
      u16* aout = (u16*)(p.ws + OFF_A2);
      float* parts = (float*)(p.ws + OFF_PARTS);
#pragma unroll
      for (int x = 0; x < 2; ++x) {
        const int e = 16 * (fe0 + x) + l15;
        const float gn = gnv[x];
        const int ocol = (MODE == 0) ? (h * 512 + s * 64 + e) : (h * 64 + e);
#pragma unroll
        for (int r = 0; r < 4; ++r) {
          const int i = 16 * fi + 4 * g + r;
          float o = in[x][r] + cr[x][r] * __expf(ci[r]);
          const float gv = bf2f(gzc[x][r]);
          float val;
          if (MODE == 0) {
            ss[r] += o * o;
            val = o * gn * silu(gv);
          } else {
            const float xs = bf2f(*(const u16*)(Vs + i * VS + e * 2));
            const float y = o + xs * dsk;
            const float gg = y * silu(gv);
            ss[r] += gg * gg;
            val = gg * gn;
          }
          aout[(size_t)(r0 + i) * 2048 + ocol] = f2bf(val);
        }
      }
#pragma unroll
      for (int r = 0; r < 4; ++r) {
        const float v = row16_sum(ss[r]);
        if (l15 == 0) {
          const int i = 16 * fi + 4 * g + r;
          const int slot = (MODE == 0) ? (h * 16 + s * 2 + (w & 1)) : ((h >> 2) * 8 + (h & 3) * 2 + (w & 1));
          parts[(size_t)(r0 + i) * 64 + slot] = v;
        }
      }
    }
    __syncthreads();
   }
  }
#undef PF_ISSUE
  {
    float* so;
    int pitch;
    if (MODE == 0) { so = p.out + OUT_RETP + ((size_t)(b * 4 + h) * 256) * 512 + s * 64; pitch = 512; }
    else { so = p.out + OUT_SSMP + ((size_t)(b * 32 + h) * 128) * 64; pitch = 64; }
#pragma unroll
    for (int mf = 0; mf < MF; ++mf)
#pragma unroll
      for (int nf = 0; nf < 4; ++nf)
#pragma unroll
        for (int r = 0; r < 4; ++r)
          so[(size_t)(dw + 16 * mf + 4 * g + r) * pitch + 16 * nf + l15] = S[mf][nf][r];
  }
}

#define SAMPLE_DECODE(ITEM, B_, H_, S_)                              \
  const int B_ = (ITEM) >> 5;                                        \
  const int H_ = (MODE == 0) ? (((ITEM) >> 3) & 3) : ((ITEM) & 31);  \
  const int S_ = (MODE == 0) ? ((ITEM) & 7) : 0;

#define SAMPLE_ISSUE(SET, ITEM)                                                                                     \
  {                                                                                                                \
    SAMPLE_DECODE(ITEM, b_, h_, s_)                                                                                \
    const int row0_ = NPROMPT + b_ * 8;                                                                            \
    int qcol_, kcol_, vcol_;                                                                                       \
    if (MODE == 0) { qcol_ = h_ * 256; kcol_ = 1024 + h_ * 256; vcol_ = 2048 + h_ * 512 + s_ * 64; }               \
    else { qcol_ = 3072 + (h_ >> 2) * 128; kcol_ = 2048 + (h_ >> 2) * 128; vcol_ = h_ * 64; }                      \
    const float* s0_ = (MODE == 0) ? p.state_ret + ((size_t)(b_ * 4 + h_) * 256) * 512 + s_ * 64                   \
                                   : p.state_ssm + ((size_t)(b_ * 32 + h_) * 128) * 64;                            \
    _Pragma("unroll") for (int db = 0; db < NB; ++db)                                                              \
      _Pragma("unroll") for (int eb = 0; eb < 4; ++eb)                                                             \
        _Pragma("unroll") for (int r = 0; r < 4; ++r)                                                              \
          sv[SET][db][eb][r] = s0_[(size_t)(dbase + 16 * db + 4 * g + r) * pitch + 16 * eb + l15];                \
    if (tid < 2 * DK) {                                                                                            \
      const int which_ = tid / DK, c_ = tid % DK;                                                                  \
      rqk[SET] = *(const u32x4*)(src + (size_t)(row0_ + c_ / CPR) * sstride + (which_ ? kcol_ : qcol_) + (c_ % CPR) * 8); \
    }                                                                                                              \
    if (tid < 64) {                                                                                                \
      rv[SET] = *(const u32x4*)(src + (size_t)(row0_ + (tid >> 3)) * sstride + vcol_ + (tid & 7) * 8);             \
      if (MODE == 1) {                                                                                             \
        pvc[SET] = cumv[(size_t)(row0_ + (tid >> 3)) * 32 + h_];                                                   \
        pvu[SET] = dtv[(size_t)(row0_ + (tid >> 3)) * 32 + h_];                                                    \
        pvl[SET] = cumv[(size_t)(row0_ + 7) * 32 + h_];                                                            \
      }                                                                                                            \
    }                                                                                                              \
    gzs[SET] = gsrc[(size_t)(row0_ + w) * PROJ_LD + ((MODE == 0) ? (4096 + h_ * 512 + s_ * 64) : (h_ * 64)) + lane]; \
    if (MODE == 1 && tid < 16)                                                                                     \
      pcu[SET] = (tid < 8) ? cumv[(size_t)(row0_ + tid) * 32 + h_] : dtv[(size_t)(row0_ + tid - 8) * 32 + h_];     \
  }

template <int DK, int MODE>
__device__ void rec_sample_loop(const Params& p, unsigned char* smem, const int rep) {
  constexpr int SET_FLOATS = 8 * DK + 8 * DK + 512 + 64 + 4096 + 64 + (DK * 8 + 64 * 8) / 2;
  const int tid = (int)p.tidx, lane = tid & 63, w = tid >> 6;
  const int l15 = lane & 15, g = lane >> 4;
  constexpr int CPR = DK / 8;
  constexpr int DPW = DK / 8;
  constexpr int NB = DPW / 16;
  const int dbase = w * DPW;
  const int pitch = (MODE == 0) ? 512 : 64;
  int vz;
  asm volatile("v_mov_b32 %0, 0" : "=v"(vz));
  const u16* src = ((MODE == 0) ? (const u16*)(p.ws + OFF_PROJ) : (const u16*)(p.ws + OFF_XBCC)) + vz;
  const int sstride = (MODE == 0) ? PROJ_LD : 4096;
  const u16* gsrc = (const u16*)(p.ws + OFF_PROJ) + vz;
  const float* dtv = (const float*)(p.ws + OFF_DT) + vz;
  const float* cumv = (const float*)(p.ws + OFF_CUM) + vz;
  u16* aout = (u16*)(p.ws + OFF_A2);
  float* parts = (float*)(p.ws + OFF_PARTS);

  u32x4 rqk[2] = {(u32x4){0u, 0u, 0u, 0u}, (u32x4){0u, 0u, 0u, 0u}}, rv[2] = {(u32x4){0u, 0u, 0u, 0u}, (u32x4){0u, 0u, 0u, 0u}};
  f32x4 sv[2][NB][4];
  u16 gzs[2] = {0, 0};
  float pcu[2] = {0.f, 0.f}, pvc[2] = {0.f, 0.f}, pvu[2] = {1.f, 1.f}, pvl[2] = {0.f, 0.f};
  const int nitems = 4096 * rep;
  const int G = (int)gridDim.x;
  if ((int)blockIdx.x < nitems) SAMPLE_ISSUE(0, ((int)blockIdx.x & 4095) + vz)
  for (int itb = blockIdx.x; itb < nitems; itb += 2 * G) {
#pragma unroll
   for (int par = 0; par < 2; ++par) {
    const int item0 = itb + par * G;
    if (item0 < nitems) {
    if (item0 + G < nitems) SAMPLE_ISSUE(par ^ 1, ((item0 + G) & 4095) + vz)
    __builtin_amdgcn_sched_barrier(0);
    const int item = (item0 & 4095) + vz;
    SAMPLE_DECODE(item, b, h, s)
    const int row0 = NPROMPT + b * 8;
    const u16 gzv = gzs[par];
    const u32x4 rqkc = rqk[par], rvc = rv[par];
    float* qS = (float*)smem + par * SET_FLOATS;
    float* kS = qS + 8 * DK;
    float* vS = kS + 8 * DK;
    float* scS = vS + 512;
    float* redS = scS + 64;
    float* cuS = redS + 4096;
    u16* kTb = (u16*)(cuS + 64);
    u16* vwTb = kTb + DK * 8;
    const float lgh = (MODE == 0) ? logf(1.0f - exp2f(-5.0f - (float)h)) : 0.f;
    if (tid < 2 * DK) {
      const int which = tid / DK, c = tid % DK;
      float* dst = (which ? kS : qS) + (c / CPR) * DK + (c % CPR) * 8;
      dst[0] = bf2f((u16)(rqkc.x & 0xffff)); dst[1] = bf2f((u16)(rqkc.x >> 16));
      dst[2] = bf2f((u16)(rqkc.y & 0xffff)); dst[3] = bf2f((u16)(rqkc.y >> 16));
      dst[4] = bf2f((u16)(rqkc.z & 0xffff)); dst[5] = bf2f((u16)(rqkc.z >> 16));
      dst[6] = bf2f((u16)(rqkc.w & 0xffff)); dst[7] = bf2f((u16)(rqkc.w >> 16));
      if (which) {
        u16* dT = kTb + ((c % CPR) * 8) * 8 + (c / CPR);
        dT[0 * 8] = (u16)(rqkc.x & 0xffff); dT[1 * 8] = (u16)(rqkc.x >> 16);
        dT[2 * 8] = (u16)(rqkc.y & 0xffff); dT[3 * 8] = (u16)(rqkc.y >> 16);
        dT[4 * 8] = (u16)(rqkc.z & 0xffff); dT[5 * 8] = (u16)(rqkc.z >> 16);
        dT[6 * 8] = (u16)(rqkc.w & 0xffff); dT[7 * 8] = (u16)(rqkc.w >> 16);
      }
    }
    if (tid < 64) {
      const int t = tid >> 3, kc = tid & 7;
      float vv[8];
      vv[0] = bf2f((u16)(rvc.x & 0xffff)); vv[1] = bf2f((u16)(rvc.x >> 16));
      vv[2] = bf2f((u16)(rvc.y & 0xffff)); vv[3] = bf2f((u16)(rvc.y >> 16));
      vv[4] = bf2f((u16)(rvc.z & 0xffff)); vv[5] = bf2f((u16)(rvc.z >> 16));
      vv[6] = bf2f((u16)(rvc.w & 0xffff)); vv[7] = bf2f((u16)(rvc.w >> 16));
      float* dst = vS + t * 64 + kc * 8;
      const float wt = (MODE == 0) ? __expf((float)(7 - t) * lgh) : pvu[par] * __expf(pvl[par] - pvc[par]);
      u16* dT = vwTb + (kc * 8) * 8 + t;
#pragma unroll
      for (int x = 0; x < 8; ++x) { dst[x] = vv[x]; dT[x * 8] = f2bf(vv[x] * wt); }
    }
    if (MODE == 1 && tid < 16) cuS[tid] = pcu[par];
    __syncthreads();
    float cum[8], u[8];
    if (MODE == 0) {
#pragma unroll
      for (int t = 0; t < 8; ++t) { cum[t] = (float)(t + 1) * lgh; u[t] = 1.f; }
    } else {
#pragma unroll
      for (int t = 0; t < 8; ++t) { cum[t] = cuS[t]; u[t] = cuS[8 + t]; }
    }
    if (w == 0) {
      f32x4 sacc = (f32x4){0.f, 0.f, 0.f, 0.f};
#pragma unroll
      for (int ks = 0; ks < DK / 32; ++ks) {
        const float* qp = qS + (l15 & 7) * DK + ks * 32 + 8 * g;
        const float* kp = kS + (l15 & 7) * DK + ks * 32 + 8 * g;
        const float4 a0 = *(const float4*)qp, a1 = *(const float4*)(qp + 4);
        const float4 b0 = *(const float4*)kp, b1 = *(const float4*)(kp + 4);
        u32x4 qa_, kb_;
        qa_.x = pack2(a0.x, a0.y); qa_.y = pack2(a0.z, a0.w); qa_.z = pack2(a1.x, a1.y); qa_.w = pack2(a1.z, a1.w);
        kb_.x = pack2(b0.x, b0.y); kb_.y = pack2(b0.z, b0.w); kb_.z = pack2(b1.x, b1.y); kb_.w = pack2(b1.z, b1.w);
        sacc = __builtin_amdgcn_mfma_f32_16x16x32_bf16(__builtin_bit_cast(bf16x8, qa_), __builtin_bit_cast(bf16x8, kb_), sacc, 0, 0, 0);
      }
      if (g < 2 && l15 < 8) {
        float cj = 0.f, uj = 0.f;
#pragma unroll
        for (int t = 0; t < 8; ++t) if (t == l15) { cj = cum[t]; uj = u[t]; }
#pragma unroll
        for (int r = 0; r < 4; ++r) {
          const int i = 4 * g + r;
          float ci = 0.f;
#pragma unroll
          for (int t = 0; t < 8; ++t) if (t == i) ci = cum[t];
          scS[i * 8 + l15] = (l15 <= i) ? sacc[r] * __expf(ci - cj) * uj : 0.f;
        }
      }
    }
    {
      float* s1 = (MODE == 0) ? p.out + OUT_RETS + ((size_t)(b * 4 + h) * 256) * 512 + s * 64
                              : p.out + OUT_SSMS + ((size_t)(b * 32 + h) * 128) * 64;
      const float atot = __expf(cum[7]);
      const bf16x8 zero8 = (bf16x8){0, 0, 0, 0, 0, 0, 0, 0};
      bf16x8 kA[NB], vB[4], qa;
#pragma unroll
      for (int db = 0; db < NB; ++db) {
        const bf16x8 t8 = *(const bf16x8*)(kTb + (dbase + 16 * db + l15) * 8);
        kA[db] = (g == 0) ? t8 : zero8;
      }
#pragma unroll
      for (int eb = 0; eb < 4; ++eb) {
        const bf16x8 t8 = *(const bf16x8*)(vwTb + (16 * eb + l15) * 8);
        vB[eb] = (g == 0) ? t8 : zero8;
      }
      {
        const float* qrow = qS + (l15 & 7) * DK + dbase + 4 * g;
        const float4 q0 = *(const float4*)qrow;
        float4 q1 = make_float4(0.f, 0.f, 0.f, 0.f);
        if (NB == 2) q1 = *(const float4*)(qrow + 16);
        u32x4 qq;
        qq.x = pack2(q0.x, q0.y); qq.y = pack2(q0.z, q0.w); qq.z = pack2(q1.x, q1.y); qq.w = pack2(q1.z, q1.w);
        if (l15 >= 8) qq = (u32x4){0u, 0u, 0u, 0u};
        qa = __builtin_bit_cast(bf16x8, qq);
      }
#pragma unroll
      for (int eb = 0; eb < 4; ++eb) {
        u32x4 sb;
        sb.x = pack2(sv[par][0][eb][0], sv[par][0][eb][1]);
        sb.y = pack2(sv[par][0][eb][2], sv[par][0][eb][3]);
        if (NB == 2) {
          sb.z = pack2(sv[par][NB - 1][eb][0], sv[par][NB - 1][eb][1]);
          sb.w = pack2(sv[par][NB - 1][eb][2], sv[par][NB - 1][eb][3]);
        } else { sb.z = 0u; sb.w = 0u; }
        const f32x4 o3 = __builtin_amdgcn_mfma_f32_16x16x32_bf16(qa, __builtin_bit_cast(bf16x8, sb),
                                                                 (f32x4){0.f, 0.f, 0.f, 0.f}, 0, 0, 0);
        if (g < 2) {
#pragma unroll
          for (int r = 0; r < 4; ++r) redS[(w * 8 + 4 * g + r) * 64 + 16 * eb + l15] = o3[r];
        }
#pragma unroll
        for (int db = 0; db < NB; ++db) {
          f32x4 c = sv[par][db][eb];
          c[0] *= atot; c[1] *= atot; c[2] *= atot; c[3] *= atot;
          const f32x4 dn = __builtin_amdgcn_mfma_f32_16x16x32_bf16(kA[db], vB[eb], c, 0, 0, 0);
#pragma unroll
          for (int r = 0; r < 4; ++r) s1[(size_t)(dbase + 16 * db + 4 * g + r) * pitch + 16 * eb + l15] = dn[r];
        }
      }
    }
    __syncthreads();
    {
      const int i = w, e = lane;
      float o = 0.f;
#pragma unroll
      for (int ww = 0; ww < 8; ++ww) o += redS[(ww * 8 + i) * 64 + e];
      float ci = 0.f;
#pragma unroll
      for (int t = 0; t < 8; ++t) if (t == i) ci = cum[t];
      o *= __expf(ci);
#pragma unroll
      for (int jj = 0; jj < 8; ++jj) if (jj <= i) o += scS[i * 8 + jj] * vS[jj * 64 + e];
      const int row = row0 + i;
      const float gv = bf2f(gzv);
      if (MODE == 0) {
        const float ssq = wave_sum(o * o);
        const float val = o * p.ret_head_norm[h * 512 + s * 64 + e] * silu(gv);
        aout[(size_t)row * 2048 + h * 512 + s * 64 + e] = f2bf(val);
        if (lane < 2) parts[(size_t)row * 64 + h * 16 + s * 2 + lane] = lane == 0 ? ssq : 0.f;
      } else {
        const float y = o + vS[i * 64 + e] * p.ssm_d[h];
        const float gg = y * silu(gv);
        const float ssq = wave_sum(gg * gg);
        aout[(size_t)row * 2048 + h * 64 + e] = f2bf(gg * p.ssm_gate_norm[h * 64 + e]);
        if (lane < 2) parts[(size_t)row * 64 + (h >> 2) * 8 + (h & 3) * 2 + lane] = lane == 0 ? ssq : 0.f;
      }
    }
    }
   }
  }
  __syncthreads();
}

template <int DK, int MODE>
__device__ void phase_rec(const Params& p, unsigned char* smem, const int rep_p, const int rep_s) {
  for (int item = blockIdx.x; item < 256 * rep_p; item += gridDim.x) rec_prompt_item<DK, MODE>(p, item & 255, smem);
  rec_sample_loop<DK, MODE>(p, smem, rep_s);
}

#ifndef PHASE_MASK
#define PHASE_MASK 0x3ff
#endif
#ifndef DUP_MASK
#define DUP_MASK 0x000
#endif
#define XB_TMO      128
#define XB_XCNT(j)  (256  + 64 * (j))
#define XB_XSUB(j)  (1280 + 64 * (j))
#define XB_XGEN(j)  (2304 + 64 * (j))
#define XB_TOP      3328
#define XB_TOPGEN   3392
#define XCD_BAR_WORDS 3456
#define XB_SPIN_CAP (1u << 20)
#define LAS __attribute__((address_space(3)))
__device__ __forceinline__ unsigned xb_ld(unsigned* p) { return __hip_atomic_load(p, __ATOMIC_RELAXED, __HIP_MEMORY_SCOPE_AGENT); }
__device__ __forceinline__ unsigned xb_add(unsigned* p, unsigned v) { return __hip_atomic_fetch_add(p, v, __ATOMIC_RELAXED, __HIP_MEMORY_SCOPE_AGENT); }
__device__ __forceinline__ unsigned xb_xcc_id() { return (unsigned)__builtin_amdgcn_s_getreg((3 << 11) | 20) & 0xFu; }
#define XB_SPIN(cond, bar) do { unsigned _sp = 0; while (cond) { __builtin_amdgcn_s_sleep(1); \
    if ((++_sp & 255u) == 0u) { if (xb_ld(&(bar)[XB_TMO])) break; if (_sp > XB_SPIN_CAP) { atomicAdd(&(bar)[XB_TMO], 1u); break; } } } } while (0)
struct XcdBarrier {
  unsigned* bar; unsigned x;
  volatile LAS unsigned* st;
};
__device__ __forceinline__ XcdBarrier xcd_barrier_post(unsigned* bar, volatile LAS unsigned* st, const int tid) {
  XcdBarrier b; b.bar = bar; b.x = xb_xcc_id(); b.st = st;
  if (tid == 0) (void)xb_add(&bar[XB_XCNT(b.x)], 1u);
  return b;
}
__device__ __forceinline__ void xcd_barrier_complete(unsigned* bar, unsigned x, unsigned& nloc, unsigned& nx) {
  const unsigned G = gridDim.x * gridDim.y * gridDim.z;
  unsigned sum, cnt, mine, sp = 0u;
  for (;;) {
    sum = 0u; cnt = 0u; mine = 0u;
#pragma unroll
    for (unsigned j = 0; j < 16; ++j) { const unsigned c = xb_ld(&bar[XB_XCNT(j)]); sum += c; cnt += (c > 0u) ? 1u : 0u; mine = (j == x) ? c : mine; }
    if (sum == G) break;
    __builtin_amdgcn_s_sleep(1);
    if ((++sp & 255u) == 0u) { if (xb_ld(&bar[XB_TMO])) break; if (sp > XB_SPIN_CAP) { atomicAdd(&bar[XB_TMO], 1u); break; } }
  }
  nloc = mine > 0u ? mine : 1u; nx = cnt > 0u ? cnt : 1u;
}
__device__ __forceinline__ void xcd_barrier(const XcdBarrier& b, const int wvs) {
  int wvl_ = wvs;
  asm volatile("" : "+s"(wvl_));
  const int tid = wvl_ * 64 + (int)__builtin_amdgcn_mbcnt_hi(~0u, __builtin_amdgcn_mbcnt_lo(~0u, 0u));
  asm volatile("s_waitcnt vmcnt(0)" ::: "memory");
  __syncthreads();
  if (tid == 0) {
    unsigned* bar = b.bar;
    __builtin_amdgcn_s_waitcnt(0);
    unsigned nloc = b.st[0], nx = b.st[1];
    if (nloc == 0u) { xcd_barrier_complete(bar, b.x, nloc, nx); b.st[0] = nloc; b.st[1] = nx; }
    const unsigned old = xb_add(&bar[XB_XSUB(b.x)], 1u);
    const unsigned gen = old / nloc;
    if (old + 1u == (gen + 1u) * nloc) {
      __builtin_amdgcn_fence(__ATOMIC_RELEASE, "agent");
      asm volatile("s_waitcnt vmcnt(0)" ::: "memory");
      const unsigned og = xb_add(&bar[XB_TOP], 1u);
      const unsigned tg = og / nx;
      if (og + 1u == (tg + 1u) * nx) xb_add(&bar[XB_TOPGEN], 1u);
      else XB_SPIN(xb_ld(&bar[XB_TOPGEN]) == tg, bar);
      __builtin_amdgcn_fence(__ATOMIC_ACQUIRE, "agent");
      xb_add(&bar[XB_XGEN(b.x)], 1u);
      asm volatile("s_waitcnt vmcnt(0)" ::: "memory");
    } else {
      XB_SPIN(xb_ld(&bar[XB_XGEN(b.x)]) == gen, bar);
      __builtin_amdgcn_fence(__ATOMIC_ACQUIRE, "agent");
      asm volatile("s_waitcnt vmcnt(0)" ::: "memory");
    }
  }
  __syncthreads();
}

template <typename T>
__device__ __forceinline__ T* as_global(T* q) {
  return (T*)(__attribute__((address_space(1))) T*)q;
}

template <int PH>
__device__ __forceinline__ void run_phase(Params p, unsigned char* smem, const int wvs) {
  {
    long long z_ = 0;
    asm volatile("" : "+s"(z_));
    p.ws += z_; p.out += z_;
  }
  {
    int wvl_ = wvs;
    asm volatile("" : "+s"(wvl_));
    p.tidx = wvl_ * 64 + (int)__builtin_amdgcn_mbcnt_hi(~0u, __builtin_amdgcn_mbcnt_lo(~0u, 0u));
    p.wv = wvl_;
  }
  const int rep = 1 + (int)((p.dup >> PH) & 1);
  if (PH == 0) phase_prep(p, smem, rep);
  if (PH == 1) {
    gemm8_phase<0>(p, (const u16*)(p.ws + OFF_H), (const u16*)(p.ws + OFF_WT0), 1024, 24, smem, rep);
    __syncthreads();
    transpose_later_weights(p, smem, (68 * 24) % (int)gridDim.x);
  }
  if (PH == 2) phase_rec<256, 0>(p, smem, rep, 1 + (int)((p.dup >> (PH + 16)) & 1));
  if (PH == 3)
  {
    gemm_phase<1, 4>(p, (const u16*)(p.ws + OFF_A2), (const u16*)(p.ws + OFF_WT1), 2048, 8, nullptr,
                     (float*)(p.ws + OFF_X1), smem, rep, 64);
    __syncthreads();
    gemm_sample_rows<4>(p, (const u16*)(p.ws + OFF_A2), (const u16*)(p.ws + OFF_WT1), nullptr, (float*)(p.ws + OFF_X1), smem, rep);
  }
  if (PH == 4) phase_norm<0>(p, (const float*)(p.ws + OFF_X1), p.ssm_norm, rep);
  if (PH == 5) {
    gemm8_phase<2>(p, (const u16*)(p.ws + OFF_H), (const u16*)(p.ws + OFF_WT2), 1024, 24, smem, rep);
    __syncthreads();
    gemm_phase<2, 0>(p, (const u16*)(p.ws + OFF_H), (const u16*)(p.ws + OFF_WT2), 1024, 1, nullptr, nullptr, smem, 1, 68, 48, true);
  }
  if (PH == 6) phase_conv(p, smem, rep);
  if (PH == 7) phase_rec<128, 1>(p, smem, rep, 1 + (int)((p.dup >> (PH + 16)) & 1));
  if (PH == 8)
  {
    gemm_phase<1, 8>(p, (const u16*)(p.ws + OFF_A2), (const u16*)(p.ws + OFF_WT3), 2048, 8,
                     (const float*)(p.ws + OFF_X1), (float*)(p.ws + OFF_X2), smem, rep, 64);
    __syncthreads();
    gemm_sample_rows<8>(p, (const u16*)(p.ws + OFF_A2), (const u16*)(p.ws + OFF_WT3), (const float*)(p.ws + OFF_X1),
                        (float*)(p.ws + OFF_X2), smem, rep);
  }
  if (PH == 9) phase_norm<1>(p, (const float*)(p.ws + OFF_X2), p.final_norm, rep);
}

#define RUN_PHASE(k)                                   \
  if ((PHASE_MASK >> k) & 1) {                         \
    if (lo <= k && k <= hi) {                          \
      run_phase<k>(p, smem, wvs);                      \
      if (k < hi) { xcd_barrier(xb, wvs); if ((p.dup >> 30) & 1) { xcd_barrier(xb, wvs); xcd_barrier(xb, wvs); } } \
    }                                                  \
  }

__global__ void __launch_bounds__(NTHR) fwd_megakernel(Params p) {
  __shared__ __attribute__((aligned(16))) unsigned char smem[LDS_BYTES];
  cg::grid_group grid = cg::this_grid();
  const int lo = (int)p.phase_lo, hi = (int)p.phase_hi;
  if (lo > 1000) grid.sync();
  volatile LAS unsigned* xst = (volatile LAS unsigned*)(smem + LDS_BYTES - 16);
  const int wvs = __builtin_amdgcn_readfirstlane((int)(threadIdx.x >> 6));
  if (threadIdx.x == 0) { xst[0] = 0u; xst[1] = 0u; }
  __syncthreads();
  const XcdBarrier xb = xcd_barrier_post((unsigned*)(p.ws + OFF_BAR), xst, (int)threadIdx.x);
  RUN_PHASE(0)
  RUN_PHASE(1)
  RUN_PHASE(2)
  RUN_PHASE(3)
  RUN_PHASE(4)
  RUN_PHASE(5)
  RUN_PHASE(6)
  RUN_PHASE(7)
  RUN_PHASE(8)
  RUN_PHASE(9)
}

#ifndef ONE_LAUNCH
#define ONE_LAUNCH 1
#endif

extern "C" void kernel_launch(void* const* d_in, const int* in_sizes, int n_in, void* d_out, int out_size, void* d_ws,
                              size_t ws_size, hipStream_t stream) {
  static int grid_blocks = 0;
  if (!grid_blocks) {
    int dev = 0, cus = 0, per_cu = 0;
    hipGetDevice(&dev);
    hipDeviceGetAttribute(&cus, hipDeviceAttributeMultiprocessorCount, dev);
    hipOccupancyMaxActiveBlocksPerMultiprocessor(&per_cu, fwd_megakernel, NTHR, 0);
    if (per_cu < 1) per_cu = 1;
    if (per_cu > 1) per_cu = 1;
    grid_blocks = cus * per_cu;
  }
  Params p{};
  const float** pf = (const float**)&p;
  for (int i = 0; i < 19; ++i) pf[i] = (const float*)d_in[i];
  p.out = (float*)d_out;
  p.ws = (unsigned char*)d_ws;
#if ONE_LAUNCH
  hipMemsetAsync((unsigned char*)d_ws + OFF_BAR, 0, XCD_BAR_WORDS * 4, stream);
  p.phase_lo = 0; p.phase_hi = 9; p.dup = DUP_MASK;
  void* args[] = {&p};
  hipError_t e = hipLaunchCooperativeKernel((void*)fwd_megakernel, dim3(grid_blocks), dim3(NTHR), args, 0, stream);
  if (e != hipSuccess) fprintf(stderr, "cooperative launch failed: %s (grid %d)\n", hipGetErrorString(e), grid_blocks);
#else
  for (int ph = 0; ph <= 9; ++ph) {
    p.phase_lo = ph; p.phase_hi = ph;
    void* args[] = {&p};
    hipLaunchCooperativeKernel((void*)fwd_megakernel, dim3(grid_blocks), dim3(NTHR), args, 0, stream);
  }
#endif
}
```

```cpp
#include <hip/hip_runtime.h>
#include <hip/hip_cooperative_groups.h>
#include <stdint.h>
#include <stdio.h>
namespace cg = cooperative_groups;

typedef __attribute__((ext_vector_type(8))) short bf16x8;
typedef __attribute__((ext_vector_type(4))) short s16x4;
typedef __attribute__((ext_vector_type(4))) float f32x4;
typedef unsigned short u16;
typedef __attribute__((ext_vector_type(4))) unsigned int u32x4;
typedef __attribute__((ext_vector_type(2))) unsigned int u32x2;

#define NTHR 512
#define T_TOK 17408
#define NPROMPT 16384
#define LDS_BYTES 143360
#define PROJ_LD 6208

constexpr size_t OFF_WT0 = 0;
constexpr size_t OFF_WT1 = OFF_WT0 + (size_t)6144 * 1024 * 2;
constexpr size_t OFF_WT2 = OFF_WT1 + (size_t)1024 * 2048 * 2;
constexpr size_t OFF_WT3 = OFF_WT2 + (size_t)6272 * 1024 * 2;
constexpr size_t OFF_ROPE = OFF_WT3 + (size_t)1024 * 2048 * 2;
constexpr size_t OFF_H = OFF_ROPE + (size_t)2056 * 128 * 8;
constexpr size_t OFF_PROJ = OFF_H + (size_t)T_TOK * 1024 * 2;
constexpr size_t OFF_A2 = OFF_PROJ + (size_t)T_TOK * PROJ_LD * 2;
constexpr size_t OFF_PARTS = OFF_A2 + (size_t)T_TOK * 2048 * 2;
constexpr size_t OFF_X1 = OFF_PARTS + (size_t)T_TOK * 64 * 4;
constexpr size_t OFF_X2 = OFF_X1 + (size_t)T_TOK * 1024 * 4;
constexpr size_t OFF_XBCC = OFF_X2 + (size_t)T_TOK * 1024 * 4;
constexpr size_t OFF_DTRAW = OFF_XBCC + (size_t)T_TOK * 4096 * 2;
constexpr size_t OFF_DT = OFF_DTRAW + (size_t)T_TOK * 32 * 4;
constexpr size_t OFF_CUM = OFF_DT + (size_t)T_TOK * 32 * 4;
constexpr size_t OFF_BAR = OFF_CUM + (size_t)T_TOK * 32 * 4;

constexpr size_t OUT_Y = 0;
constexpr size_t OUT_RETP = 17825792;
constexpr size_t OUT_RETS = 22020096;
constexpr size_t OUT_SSMP = 89128960;
constexpr size_t OUT_SSMS = 91226112;
constexpr size_t OUT_CONVP = 124780544;
constexpr size_t OUT_CONVS = 124878848;

struct Params {
  const float *x_prompt, *x_sample, *state_ret, *state_ssm, *state_conv, *ret_norm, *ret_w_in, *ret_head_norm,
      *ret_w_out, *ssm_norm, *ssm_w_in, *ssm_conv_w, *ssm_conv_b, *ssm_dt_bias, *ssm_a_log, *ssm_d, *ssm_gate_norm,
      *ssm_w_out, *final_norm;
  float* out;
  unsigned char* ws;
  long long phase_lo, phase_hi, dup, tidx, wv;
};

typedef __bf16 bf16x2_t __attribute__((ext_vector_type(2)));
typedef float f32x2_t __attribute__((ext_vector_type(2)));
__device__ __forceinline__ u16 f2bf(float f) {
  __bf16 r = (__bf16)f;
  return __builtin_bit_cast(u16, r);
}
__device__ __forceinline__ float bf2f(u16 h) { return __uint_as_float(((uint32_t)h) << 16); }
__device__ __forceinline__ uint32_t pack2(float a, float b) {
  f32x2_t v = {a, b};
  bf16x2_t r = __builtin_convertvector(v, bf16x2_t);
  return __builtin_bit_cast(uint32_t, r);
}
__device__ __forceinline__ float ex2(float x) { return __builtin_amdgcn_exp2f(x); }
__device__ __forceinline__ float silu(float x) { return x * __builtin_amdgcn_rcpf(1.0f + __expf(-x)); }
__device__ __forceinline__ float row16_sum(float v) {
  v += __builtin_bit_cast(float, __builtin_amdgcn_update_dpp(0, __builtin_bit_cast(int, v), 0xB1, 0xF, 0xF, true));
  v += __builtin_bit_cast(float, __builtin_amdgcn_update_dpp(0, __builtin_bit_cast(int, v), 0x4E, 0xF, 0xF, true));
  v += __builtin_bit_cast(float, __builtin_amdgcn_update_dpp(0, __builtin_bit_cast(int, v), 0x124, 0xF, 0xF, true));
  v += __builtin_bit_cast(float, __builtin_amdgcn_update_dpp(0, __builtin_bit_cast(int, v), 0x128, 0xF, 0xF, true));
  return v;
}
__device__ __forceinline__ float wave_sum(float v) {
#pragma unroll
  for (int o = 32; o > 0; o >>= 1) v += __shfl_xor(v, o);
  return v;
}
__device__ __forceinline__ const float* xrow(const Params& p, int r) {
  return r < NPROMPT ? p.x_prompt + (size_t)r * 1024 : p.x_sample + (size_t)(r - NPROMPT) * 1024;
}
__device__ __forceinline__ s16x4 trread(const unsigned char* ptr) {
  return __builtin_amdgcn_ds_read_tr16_b64_v4i16((s16x4 __attribute__((address_space(3)))*)ptr);
}
__device__ __forceinline__ bf16x8 cat8(s16x4 a, s16x4 b) {
  bf16x8 r;
  r[0] = a[0]; r[1] = a[1]; r[2] = a[2]; r[3] = a[3];
  r[4] = b[0]; r[5] = b[1]; r[6] = b[2]; r[7] = b[3];
  return r;
}
__device__ __forceinline__ bf16x8 trfrag(const unsigned char* img, int rs, int kbase, int nbase, int lane) {
  const int g = lane >> 4, q = (lane & 15) >> 2, pp = lane & 3;
  const unsigned char* a = img + (kbase + 8 * g + q) * rs + (nbase + 4 * pp) * 2;
  s16x4 t0 = trread(a);
  s16x4 t1 = trread(a + 4 * rs);
  return cat8(t0, t1);
}

__device__ __forceinline__ int colmap_retin(int p) {
  if (p < 2048) {
    int hb = p & ~255, pp = p & 255;
    int gi = pp >> 5, half = (pp >> 4) & 1, c = pp & 15;
    return hb + half * 128 + gi * 16 + c;
  }
  return p;
}

__device__ void transpose_tile(const float* __restrict__ W, u16* __restrict__ Wt, int K, int N, int mode, int nt, int kt,
                               unsigned char* smem, const int tid) {
  float* tile = (float*)smem;
#pragma unroll
  for (int i = 0; i < 8; ++i) {
    int idx = tid + NTHR * i;
    int kk = idx >> 6, nn = idx & 63;
    int n = nt * 64 + nn;
    int src = (mode == 1) ? colmap_retin(n) : n;
    float v = 0.f;
    if (src < N) v = W[(size_t)(kt * 64 + kk) * N + src];
    tile[kk * 65 + nn] = v;
  }
  __syncthreads();
  {
    int n = tid >> 3, kc = tid & 7;
    float v[8];
#pragma unroll
    for (int j = 0; j < 8; ++j) v[j] = tile[(kc * 8 + j) * 65 + n];
    u32x4 o;
    o.x = pack2(v[0], v[1]); o.y = pack2(v[2], v[3]); o.z = pack2(v[4], v[5]); o.w = pack2(v[6], v[7]);
    *(u32x4*)(Wt + (size_t)(nt * 64 + n) * K + kt * 64 + kc * 8) = o;
  }
  __syncthreads();
}

__device__ void phase_prep(const Params& p, unsigned char* smem, const int rep) {
  const int tid = (int)p.tidx;
  for (int rr = 0; rr < rep; ++rr) {
  u16* Wt0 = (u16*)(p.ws + OFF_WT0);
  for (int t = blockIdx.x; t < 1536; t += gridDim.x)
    transpose_tile(p.ret_w_in, Wt0, 1024, 6144, 1, t >> 4, t & 15, smem, tid);
  float2* rope = (float2*)(p.ws + OFF_ROPE);
  const int gtid = blockIdx.x * NTHR + tid, gn = gridDim.x * NTHR;
  for (int idx = gtid; idx < 2056 * 128; idx += gn) {
    int pi = idx >> 7, i = idx & 127;
    int pos = pi < 2048 ? pi : 16384 + (pi - 2048);
    float freq = (float)exp2(-(double)i * (13.287712379549449 / 128.0));
    float ang = (float)pos * freq;
    float sn, cs;
    sincosf(ang, &sn, &cs);
    rope[idx] = make_float2(cs, sn);
  }
  u16* H = (u16*)(p.ws + OFF_H);
  const int lane = tid & 63, w = (int)p.wv;
  for (int row = blockIdx.x * 8 + w; row < T_TOK; row += gridDim.x * 8) {
    const float* xr = xrow(p, row);
    float4 v[4];
    float ss = 0.f;
#pragma unroll
    for (int i = 0; i < 4; ++i) {
      v[i] = *(const float4*)(xr + i * 256 + lane * 4);
      ss += v[i].x * v[i].x + v[i].y * v[i].y + v[i].z * v[i].z + v[i].w * v[i].w;
    }
    ss = wave_sum(ss);
    float rstd = rsqrtf(ss * (1.0f / 1024.0f) + 1e-6f);
#pragma unroll
    for (int i = 0; i < 4; ++i) {
      float4 gg = *(const float4*)(p.ret_norm + i * 256 + lane * 4);
      u32x2 o;
      o.x = pack2(v[i].x * rstd * gg.x, v[i].y * rstd * gg.y);
      o.y = pack2(v[i].z * rstd * gg.z, v[i].w * rstd * gg.w);
      *(u32x2*)(H + (size_t)row * 1024 + i * 256 + lane * 4) = o;
    }
  }
  }
}

__device__ void transpose_later_weights(const Params& p, unsigned char* smem, const int first_blk) {
  const int tid = (int)p.tidx;
  u16* Wt1 = (u16*)(p.ws + OFF_WT1);
  u16* Wt2 = (u16*)(p.ws + OFF_WT2);
  u16* Wt3 = (u16*)(p.ws + OFF_WT3);
  const int n1 = 512, n2 = 1568, n3 = 512;
  if ((int)blockIdx.x < first_blk) return;
  const int nb = (int)gridDim.x - first_blk;
  for (int t = (int)blockIdx.x - first_blk; t < n1 + n2 + n3; t += nb) {
    if (t < n1) {
      transpose_tile(p.ret_w_out, Wt1, 2048, 1024, 0, t >> 5, t & 31, smem, tid);
    } else if (t < n1 + n2) {
      int u = t - n1;
      transpose_tile(p.ssm_w_in, Wt2, 1024, 6176, 0, u >> 4, u & 15, smem, tid);
    } else {
      int u = t - n1 - n2;
      transpose_tile(p.ssm_w_out, Wt3, 2048, 1024, 0, u >> 5, u & 31, smem, tid);
    }
  }
}

template <int MODE>
__device__ void phase_norm(const Params& p, const float* __restrict__ X, const float* __restrict__ gain, const int rep) {
  const int tid = (int)p.tidx, lane = tid & 63, w = (int)p.wv;
  u16* H = (u16*)(p.ws + OFF_H);
  for (int row0 = blockIdx.x * 8 + w; row0 < T_TOK * rep; row0 += gridDim.x * 8) {
    const int row = row0 % T_TOK;
    const float* xr = X + (size_t)row * 1024;
    float4 v[4];
    float ss = 0.f;
#pragma unroll
    for (int i = 0; i < 4; ++i) {
      v[i] = *(const float4*)(xr + i * 256 + lane * 4);
      ss += v[i].x * v[i].x + v[i].y * v[i].y + v[i].z * v[i].z + v[i].w * v[i].w;
    }
    ss = wave_sum(ss);
    float rstd = rsqrtf(ss * (1.0f / 1024.0f) + 1e-6f);
#pragma unroll
    for (int i = 0; i < 4; ++i) {
      float4 gg = *(const float4*)(gain + i * 256 + lane * 4);
      if (MODE == 0) {
        u32x2 o;
        o.x = pack2(v[i].x * rstd * gg.x, v[i].y * rstd * gg.y);
        o.y = pack2(v[i].z * rstd * gg.z, v[i].w * rstd * gg.w);
        *(u32x2*)(H + (size_t)row * 1024 + i * 256 + lane * 4) = o;
      } else {
        float4 o = make_float4(v[i].x * rstd * gg.x, v[i].y * rstd * gg.y, v[i].z * rstd * gg.z, v[i].w * rstd * gg.w);
        *(float4*)(p.out + OUT_Y + (size_t)row * 1024 + i * 256 + lane * 4) = o;
      }
    }
  }
}

template <int EPI, int NH>
__device__ void gemm_phase(const Params& p, const u16* __restrict__ A, const u16* __restrict__ Bt, const int K, const int NT,
                           const float* __restrict__ resid, float* __restrict__ outf, unsigned char* smem, const int rep,
                           const int mtiles, const int nt0 = 0, const bool rev = false) {
  constexpr int BM = 256, BN = 128, BK = 64, LR = 144;
  constexpr int BUFB = (BM + BN) * LR;
  float* rstdS = (float*)(smem + 2 * BUFB);
  const int tid = (int)p.tidx, lane = tid & 63, w = (int)p.wv;
  const int wm = w >> 1, wn = w & 1, l15 = lane & 15, g = lane >> 4;
  const int KT = K / BK;
  const int ntiles = mtiles * NT;
  const float* parts = (const float*)(p.ws + OFF_PARTS);
  const int srow = tid >> 3, skc = tid & 7;

  for (int tile0 = rev ? (int)(gridDim.x - 1 - blockIdx.x) : (int)blockIdx.x; tile0 < ntiles * rep; tile0 += gridDim.x) {
    const int tile = tile0 % ntiles;
    const int mt = tile / NT, nt = tile - mt * NT + nt0;
    const int m0 = mt * BM, n0 = nt * BN;
    const bool skip_mma = (EPI == 2) && (n0 >= 6144) && (wn == 1);
    if (NH > 0) {
      for (int idx = tid; idx < BM * NH; idx += NTHR) {
        int row = idx / NH, h = idx % NH;
        const float* pp = parts + (size_t)(m0 + row) * 64 + h * (64 / NH);
        float s = 0.f;
#pragma unroll
        for (int q = 0; q < 64 / NH; ++q) s += pp[q];
        rstdS[idx] = rsqrtf(s / (float)(K / NH) + 1e-6f);
      }
    }
    u32x4 ra[2][4], rb[2][2];
    const u16* ap = A + (size_t)(m0 + srow) * K + skc * 8;
    const u16* bp = Bt + (size_t)(n0 + srow) * K + skc * 8;
#pragma unroll
    for (int i = 0; i < 4; ++i) ra[0][i] = *(const u32x4*)(ap + (size_t)(64 * i) * K);
#pragma unroll
    for (int i = 0; i < 2; ++i) rb[0][i] = *(const u32x4*)(bp + (size_t)(64 * i) * K);
#pragma unroll
    for (int i = 0; i < 4; ++i) ra[1][i] = *(const u32x4*)(ap + (size_t)(64 * i) * K + BK);
#pragma unroll
    for (int i = 0; i < 2; ++i) rb[1][i] = *(const u32x4*)(bp + (size_t)(64 * i) * K + BK);
    {
      unsigned char* base = smem;
#pragma unroll
      for (int i = 0; i < 4; ++i) *(u32x4*)(base + (srow + 64 * i) * LR + skc * 16) = ra[0][i];
#pragma unroll
      for (int i = 0; i < 2; ++i) *(u32x4*)(base + BM * LR + (srow + 64 * i) * LR + skc * 16) = rb[0][i];
    }
    __syncthreads();

    f32x4 acc[4][4];
    f32x4 accT[4][4];
#pragma unroll
    for (int i = 0; i < 4; ++i)
#pragma unroll
      for (int j = 0; j < 4; ++j) {
        acc[i][j] = (f32x4){0.f, 0.f, 0.f, 0.f};
        accT[i][j] = (f32x4){0.f, 0.f, 0.f, 0.f};
      }

    for (int kt2 = 0; kt2 < KT; kt2 += 2) {
#pragma unroll
     for (int par = 0; par < 2; ++par) {
      const int kt = kt2 + par;
      if (kt + 2 < KT) {
#pragma unroll
        for (int i = 0; i < 4; ++i) ra[par][i] = *(const u32x4*)(ap + (size_t)(64 * i) * K + (kt + 2) * BK);
#pragma unroll
        for (int i = 0; i < 2; ++i) rb[par][i] = *(const u32x4*)(bp + (size_t)(64 * i) * K + (kt + 2) * BK);
      }
      const unsigned char* abase = smem + par * BUFB + (wm * 64 + l15) * LR + g * 16;
      const unsigned char* bbase = smem + par * BUFB + BM * LR + (wn * 64 + l15) * LR + g * 16;
      if (!skip_mma)
#pragma unroll
      for (int ks = 0; ks < 2; ++ks) {
        bf16x8 af[4], bfr[2];
#pragma unroll
        for (int mf = 0; mf < 4; ++mf) af[mf] = *(const bf16x8*)(abase + mf * 16 * LR + ks * 64);
#pragma unroll
        for (int nh = 0; nh < 2; ++nh) {
#pragma unroll
          for (int n2 = 0; n2 < 2; ++n2) bfr[n2] = *(const bf16x8*)(bbase + (nh * 2 + n2) * 16 * LR + ks * 64);
#pragma unroll
          for (int mf = 0; mf < 4; ++mf)
#pragma unroll
            for (int n2 = 0; n2 < 2; ++n2)
              acc[mf][nh * 2 + n2] = __builtin_amdgcn_mfma_f32_16x16x32_bf16(af[mf], bfr[n2], acc[mf][nh * 2 + n2], 0, 0, 0);
        }
      }
      if (NH > 0) {
        const int per = KT / NH;
        if (((kt + 1) % per) == 0) {
          const int h = (kt + 1) / per - 1;
#pragma unroll
          for (int mf = 0; mf < 4; ++mf)
#pragma unroll
            for (int r = 0; r < 4; ++r) {
              float s = rstdS[(wm * 64 + mf * 16 + 4 * g + r) * NH + h];
#pragma unroll
              for (int nf = 0; nf < 4; ++nf) {
                accT[mf][nf][r] += s * acc[mf][nf][r];
                acc[mf][nf][r] = 0.f;
              }
            }
        }
      }
      if (kt + 1 < KT) {
        unsigned char* base = smem + (par ^ 1) * BUFB;
#pragma unroll
        for (int i = 0; i < 4; ++i) *(u32x4*)(base + (srow + 64 * i) * LR + skc * 16) = ra[par ^ 1][i];
#pragma unroll
        for (int i = 0; i < 2; ++i) *(u32x4*)(base + BM * LR + (srow + 64 * i) * LR + skc * 16) = rb[par ^ 1][i];
      }
      __syncthreads();
     }
    }

#pragma unroll
    for (int mf = 0; mf < 4; ++mf) {
      __builtin_amdgcn_sched_barrier(0);
      float rvv[4][4];
      if (EPI == 1) {
#pragma unroll
        for (int r = 0; r < 4; ++r) {
          const int row = m0 + wm * 64 + mf * 16 + 4 * g + r;
#pragma unroll
          for (int nf = 0; nf < 4; ++nf) {
            const int col = n0 + wn * 64 + nf * 16 + l15;
            rvv[r][nf] = resid ? resid[(size_t)row * 1024 + col] : xrow(p, row)[col];
          }
        }
      }
#pragma unroll
      for (int r = 0; r < 4; ++r) {
        const int row = m0 + wm * 64 + mf * 16 + 4 * g + r;
        if (EPI == 0) {
          u16* proj = (u16*)(p.ws + OFF_PROJ) + (size_t)row * PROJ_LD;
          if (n0 < 2048) {
            const float2* rope = (const float2*)(p.ws + OFF_ROPE);
            const int pi = row < NPROMPT ? (row & 2047) : 2048 + ((row - NPROMPT) & 7);
#pragma unroll
            for (int np = 0; np < 2; ++np) {
              const int pc = n0 + wn * 64 + np * 32;
              const int i = ((pc & 255) >> 5) * 16 + l15;
              const float2 cs = rope[pi * 128 + i];
              const float x1 = acc[mf][2 * np][r], x2 = acc[mf][2 * np + 1][r];
              float y1 = x1 * cs.x - x2 * cs.y, y2 = x1 * cs.y + x2 * cs.x;
              if (pc >= 1024) { y1 *= 0.0625f; y2 *= 0.0625f; }
              const int f1 = (pc & ~255) + i;
              proj[f1] = f2bf(y1);
              proj[f1 + 128] = f2bf(y2);
            }
          } else {
#pragma unroll
            for (int nf = 0; nf < 4; ++nf) proj[n0 + wn * 64 + nf * 16 + l15] = f2bf(acc[mf][nf][r]);
          }
        } else if (EPI == 1) {
#pragma unroll
          for (int nf = 0; nf < 4; ++nf) {
            const int col = n0 + wn * 64 + nf * 16 + l15;
            const float a = (NH > 0) ? accT[mf][nf][r] : acc[mf][nf][r];
            outf[(size_t)row * 1024 + col] = rvv[r][nf] + a;
          }
        } else {
          u16* proj = (u16*)(p.ws + OFF_PROJ) + (size_t)row * PROJ_LD;
          float* dtraw = (float*)(p.ws + OFF_DTRAW) + (size_t)row * 32;
          float* cvo = nullptr;
          if (row < NPROMPT) {
            const int t = row & 2047;
            if (t >= 2045) cvo = p.out + OUT_CONVP + ((size_t)(row >> 11) * 3 + (t - 2045)) * 4096;
          } else {
            const int rs = row - NPROMPT, t = rs & 7;
            if (t >= 5) cvo = p.out + OUT_CONVS + ((size_t)(rs >> 3) * 3 + (t - 5)) * 4096;
          }
#pragma unroll
          for (int nf = 0; nf < 4; ++nf) {
            const int col = n0 + wn * 64 + nf * 16 + l15;
            const float a = acc[mf][nf][r];
            if (col < 6144) {
              proj[col] = f2bf(a);
              if (col >= 2048 && cvo) cvo[col - 2048] = a;
            } else if (col < 6176) {
              dtraw[col - 6144] = a;
            }
          }
        }
      }
    }
  }
}


template <int NH>
__device__ void gemm_sample_rows(const Params& p, const u16* __restrict__ A, const u16* __restrict__ Bt,
                                 const float* __restrict__ resid, float* __restrict__ outf, unsigned char* smem, const int rep) {
  constexpr int K = 2048, RS = 65;
  float* red = (float*)smem;
  float* rstdS = red + 8 * 64 * RS;
  const int tid = (int)p.tidx, lane = tid & 63, w = (int)p.wv, l15 = lane & 15, g = lane >> 4;
  const float* parts = (const float*)(p.ws + OFF_PARTS);
  for (int item0 = blockIdx.x; item0 < 256 * rep; item0 += gridDim.x) {
    const int item = item0 & 255;
    const int m0 = NPROMPT + (item >> 4) * 64, n0 = (item & 15) * 64;
    for (int idx = tid; idx < 64 * NH; idx += NTHR) {
      const int row = idx / NH, h = idx % NH;
      const float* pp = parts + (size_t)(m0 + row) * 64 + h * (64 / NH);
      float sm = 0.f;
#pragma unroll
      for (int q = 0; q < 64 / NH; ++q) sm += pp[q];
      rstdS[idx] = rsqrtf(sm / (float)(K / NH) + 1e-6f);
    }
    f32x4 acc[4][4];
#pragma unroll
    for (int i = 0; i < 4; ++i)
#pragma unroll
      for (int j = 0; j < 4; ++j) acc[i][j] = (f32x4){0.f, 0.f, 0.f, 0.f};
    const u16* ap = A + (size_t)(m0 + l15) * K + w * 256 + 8 * g;
    const u16* bp = Bt + (size_t)(n0 + l15) * K + w * 256 + 8 * g;
#pragma unroll 2
    for (int ks = 0; ks < 8; ++ks) {
      bf16x8 af[4], bfr[4];
#pragma unroll
      for (int mf = 0; mf < 4; ++mf) af[mf] = *(const bf16x8*)(ap + (size_t)(mf * 16) * K + ks * 32);
#pragma unroll
      for (int nf = 0; nf < 4; ++nf) bfr[nf] = *(const bf16x8*)(bp + (size_t)(nf * 16) * K + ks * 32);
#pragma unroll
      for (int mf = 0; mf < 4; ++mf)
#pragma unroll
        for (int nf = 0; nf < 4; ++nf)
          acc[mf][nf] = __builtin_amdgcn_mfma_f32_16x16x32_bf16(af[mf], bfr[nf], acc[mf][nf], 0, 0, 0);
    }
    __syncthreads();
    {
      const int h = (w * 256) / (K / NH);
#pragma unroll
      for (int mf = 0; mf < 4; ++mf)
#pragma unroll
        for (int r = 0; r < 4; ++r) {
          const int row = mf * 16 + 4 * g + r;
          const float sc = rstdS[row * NH + h];
#pragma unroll
          for (int nf = 0; nf < 4; ++nf) red[(w * 64 + row) * RS + nf * 16 + l15] = acc[mf][nf][r] * sc;
        }
    }
    __syncthreads();
    {
      const int row = tid >> 3, c0 = (tid & 7) * 8;
      float o[8];
      const size_t gidx = (size_t)(m0 + row) * 1024 + n0 + c0;
      const float* rp = resid ? resid + gidx : p.x_sample + (size_t)(m0 - NPROMPT + row) * 1024 + n0 + c0;
      const float4 r0 = *(const float4*)rp, r1 = *(const float4*)(rp + 4);
      o[0] = r0.x; o[1] = r0.y; o[2] = r0.z; o[3] = r0.w; o[4] = r1.x; o[5] = r1.y; o[6] = r1.z; o[7] = r1.w;
#pragma unroll
      for (int ww = 0; ww < 8; ++ww)
#pragma unroll
        for (int j = 0; j < 8; ++j) o[j] += red[(ww * 64 + row) * RS + c0 + j];
      *(float4*)(outf + gidx) = make_float4(o[0], o[1], o[2], o[3]);
      *(float4*)(outf + gidx + 4) = make_float4(o[4], o[5], o[6], o[7]);
    }
    __syncthreads();
  }
}

__device__ __forceinline__ int lds_byte(int r, int c) {
  int st = (r >> 4) * 2 + (c >> 5), rr = r & 15, cc = c & 31, ob = rr * 64 + cc * 2;
  return st * 1024 + (ob ^ (((ob >> 9) & 1) << 5));
}
__device__ __forceinline__ void stage_rc(int b, int& R, int& C) {
  int st = b / 1024, sb = b % 1024, swz = sb ^ (((sb >> 9) & 1) << 5);
  R = (st >> 1) * 16 + swz / 64;
  C = (st & 1) * 32 + (swz % 64) / 2;
}

template <int EPI>
__device__ void gemm8_phase(const Params& p, const u16* __restrict__ A, const u16* __restrict__ Bt, const int K, const int nN,
                            unsigned char* smem, const int rep) {
  constexpr int BM8 = 256, BK8 = 64, HALF = 128, NXCD = 8, WGM = 8, HT = HALF * BK8;
  u16* shm = (u16*)smem;
#define SA(b, h) (shm + ((b) * 2 + (h)) * HT)
#define SB(b, h) (shm + (4 + (b) * 2 + (h)) * HT)
#define STAGE(P, BASE, br, kt)                                                                            \
  do {                                                                                                    \
    const int _so = ((br) * K + (kt) * BK8) * 2;                                                          \
    __builtin_amdgcn_raw_ptr_buffer_load_lds(rsrc_##BASE, (__attribute__((address_space(3))) unsigned*)((char*)(P) + (int)p.tidx * 16), 16, voff0, _so, 0, 0); \
    __builtin_amdgcn_raw_ptr_buffer_load_lds(rsrc_##BASE, (__attribute__((address_space(3))) unsigned*)((char*)(P) + (int)p.tidx * 16 + 8192), 16, voff1, _so, 0, 0); \
  } while (0)
#define LDA(dst, b, h)                                                                                    \
  for (int m = 0; m < 4; ++m)                                                                             \
    for (int k = 0; k < 2; ++k)                                                                           \
      dst[m][k] = *reinterpret_cast<const bf16x8*>((char*)SA(b, h) + lds_byte(wr * 64 + m * 16 + fr, k * 32 + fq * 8))
#define LDB(dst, b, h)                                                                                    \
  for (int n = 0; n < 2; ++n)                                                                             \
    for (int k = 0; k < 2; ++k)                                                                           \
      dst[n][k] = *reinterpret_cast<const bf16x8*>((char*)SB(b, h) + lds_byte(wc * 32 + n * 16 + fr, k * 32 + fq * 8))
#define MMA(ai, bj, At, Bx)                                                                               \
  do {                                                                                                    \
    __builtin_amdgcn_s_setprio(1);                                                                        \
    for (int m = 0; m < 4; ++m)                                                                           \
      for (int n = 0; n < 2; ++n)                                                                         \
        for (int k = 0; k < 2; ++k)                                                                       \
          acc[ai][bj][m][n] = __builtin_amdgcn_mfma_f32_16x16x32_bf16(At[m][k], Bx[n][k], acc[ai][bj][m][n], 0, 0, 0); \
    __builtin_amdgcn_s_setprio(0);                                                                        \
  } while (0)
#define WAIT_V(n) asm volatile("s_waitcnt vmcnt(" #n ")" ::: "memory")
#define WAIT_L(n) asm volatile("s_waitcnt lgkmcnt(" #n ")" ::: "memory")
#define BAR __builtin_amdgcn_s_barrier()
#define SCHED __builtin_amdgcn_sched_barrier(0)

  const int nM = T_TOK / BM8, nwg = nM * nN;
  const int wid = (int)p.wv, lane = (int)p.tidx & 63, wr = wid >> 2, wc = wid & 3, fr = lane & 15, fq = lane >> 4;
  const int nt = K / BK8;
  const __amdgpu_buffer_rsrc_t rsrc_A = __builtin_amdgcn_make_buffer_rsrc((void*)A, (short)0, T_TOK * K * 2, 0x00020000);
  const __amdgpu_buffer_rsrc_t rsrc_Bt = __builtin_amdgcn_make_buffer_rsrc((void*)Bt, (short)0, nN * 256 * K * 2, 0x00020000);
  int voff0, voff1;
  {
    int r_, c_;
    stage_rc((int)p.tidx * 16, r_, c_);
    voff0 = (r_ * K + c_) * 2;
    stage_rc((int)p.tidx * 16 + 8192, r_, c_);
    voff1 = (r_ * K + c_) * 2;
  }

  for (int tile0 = blockIdx.x; tile0 < nwg * rep; tile0 += gridDim.x) {
    const int tile = tile0 % nwg;
    int wgid = tile;
    {
      int q = nwg / NXCD, r = nwg % NXCD, xcd = wgid % NXCD, off = wgid / NXCD;
      wgid = (xcd < r ? xcd * (q + 1) : r * (q + 1) + (xcd - r) * q) + off;
    }
    const int nig = WGM * nN, gid = wgid / nig, fm = gid * WGM, gsz = min(nM - fm, WGM);
    const int pm = fm + ((wgid % nig) % gsz), pn = (wgid % nig) / gsz, brow = pm * BM8, bcol = pn * BM8;

    f32x4 acc[2][2][4][2];
#pragma unroll
    for (int a = 0; a < 2; ++a)
#pragma unroll
      for (int b = 0; b < 2; ++b)
#pragma unroll
        for (int m = 0; m < 4; ++m)
#pragma unroll
          for (int n = 0; n < 2; ++n) acc[a][b][m][n] = (f32x4){0.f, 0.f, 0.f, 0.f};
    bf16x8 At[4][2], B0[2][2], B1[2][2];

    STAGE(SB(0, 0), Bt, bcol, 0); STAGE(SA(0, 0), A, brow, 0);
    STAGE(SB(0, 1), Bt, bcol + HALF, 0); STAGE(SA(0, 1), A, brow + HALF, 0);
    if (wr == 1) BAR;
    WAIT_V(4); BAR;
    STAGE(SB(1, 0), Bt, bcol, 1); STAGE(SA(1, 0), A, brow, 1); STAGE(SB(1, 1), Bt, bcol + HALF, 1);
    WAIT_V(6); BAR;
    for (int t = 0; t < nt - 2; t += 2) {
      LDB(B0, 0, 0); SCHED; LDA(At, 0, 0); STAGE(SA(1, 1), A, brow + HALF, t + 1);
      WAIT_L(8); BAR; WAIT_L(0); MMA(0, 0, At, B0); BAR; SCHED;
      LDB(B1, 0, 1); STAGE(SB(0, 0), Bt, bcol, t + 2);
      BAR; WAIT_L(0); MMA(0, 1, At, B1); BAR;
      LDA(At, 0, 1); STAGE(SA(0, 0), A, brow, t + 2);
      BAR; WAIT_L(0); MMA(1, 0, At, B0); BAR; SCHED;
      STAGE(SB(0, 1), Bt, bcol + HALF, t + 2);
      WAIT_V(6); BAR; MMA(1, 1, At, B1); BAR;
      LDB(B0, 1, 0); SCHED; LDA(At, 1, 0); STAGE(SA(0, 1), A, brow + HALF, t + 2);
      WAIT_L(8); BAR; WAIT_L(0); MMA(0, 0, At, B0); BAR; SCHED;
      LDB(B1, 1, 1); STAGE(SB(1, 0), Bt, bcol, t + 3);
      BAR; WAIT_L(0); MMA(0, 1, At, B1); BAR;
      LDA(At, 1, 1); STAGE(SA(1, 0), A, brow, t + 3);
      BAR; WAIT_L(0); MMA(1, 0, At, B0); BAR; SCHED;
      STAGE(SB(1, 1), Bt, bcol + HALF, t + 3);
      WAIT_V(6); BAR; MMA(1, 1, At, B1); BAR;
    }
    {
      LDB(B0, 0, 0); LDA(At, 0, 0); STAGE(SA(1, 1), A, brow + HALF, nt - 1);
      BAR; WAIT_L(0); MMA(0, 0, At, B0); BAR; SCHED;
      LDB(B1, 0, 1); BAR; WAIT_L(0); MMA(0, 1, At, B1); BAR; SCHED;
      LDA(At, 0, 1); WAIT_V(4); BAR; WAIT_L(0); MMA(1, 0, At, B0); MMA(1, 1, At, B1); BAR; SCHED;
    }
    {
      LDB(B0, 1, 0); LDA(At, 1, 0); WAIT_V(2); BAR; WAIT_L(0); MMA(0, 0, At, B0); BAR; SCHED;
      LDB(B1, 1, 1); WAIT_V(0); BAR; WAIT_L(0); MMA(0, 1, At, B1); BAR; SCHED;
      LDA(At, 1, 1); BAR; WAIT_L(0); MMA(1, 0, At, B0); MMA(1, 1, At, B1); BAR; SCHED;
    }
    if (wr == 0) BAR;

    u16* projb = (u16*)(p.ws + OFF_PROJ);
#pragma unroll
    for (int ai = 0; ai < 2; ++ai)
#pragma unroll
      for (int m = 0; m < 4; ++m) {
        if (EPI == 0 && bcol < 2048) {
          const float2* rope = (const float2*)(p.ws + OFF_ROPE);
#pragma unroll
          for (int bj = 0; bj < 2; ++bj) {
            __builtin_amdgcn_sched_barrier(0);
            const int pc = bcol + bj * HALF + wc * 32;
            const int i = ((pc & 255) >> 5) * 16 + fr;
            const int f1 = (pc & ~255) + i;
            float2 csv[4];
#pragma unroll
            for (int j = 0; j < 4; ++j) {
              const int row = brow + ai * HALF + wr * 64 + m * 16 + fq * 4 + j;
              const int pi = row < NPROMPT ? (row & 2047) : 2048 + ((row - NPROMPT) & 7);
              csv[j] = rope[pi * 128 + i];
            }
#pragma unroll
            for (int j = 0; j < 4; ++j) {
              const int row = brow + ai * HALF + wr * 64 + m * 16 + fq * 4 + j;
              u16* proj = projb + (size_t)row * PROJ_LD;
              const float2 cs = csv[j];
              const float x1 = acc[ai][bj][m][0][j], x2 = acc[ai][bj][m][1][j];
              float y1 = x1 * cs.x - x2 * cs.y, y2 = x1 * cs.y + x2 * cs.x;
              if (pc >= 1024) { y1 *= 0.0625f; y2 *= 0.0625f; }
              proj[f1] = f2bf(y1);
              proj[f1 + 128] = f2bf(y2);
            }
          }
        } else {
#pragma unroll
          for (int j = 0; j < 4; ++j) {
            __builtin_amdgcn_sched_barrier(0);
            const int row = brow + ai * HALF + wr * 64 + m * 16 + fq * 4 + j;
            u16* proj = projb + (size_t)row * PROJ_LD;
            float* cvo = nullptr;
            if (EPI == 2 && bcol >= 2048) {
              if (row < NPROMPT) {
                const int t = row & 2047;
                if (t >= 2045) cvo = p.out + OUT_CONVP + ((size_t)(row >> 11) * 3 + (t - 2045)) * 4096;
              } else {
                const int rs = row - NPROMPT, t = rs & 7;
                if (t >= 5) cvo = p.out + OUT_CONVS + ((size_t)(rs >> 3) * 3 + (t - 5)) * 4096;
              }
            }
#pragma unroll
            for (int bj = 0; bj < 2; ++bj)
#pragma unroll
              for (int n = 0; n < 2; ++n) {
                const int col = bcol + bj * HALF + wc * 32 + n * 16 + fr;
                const float a = acc[ai][bj][m][n][j];
                proj[col] = f2bf(a);
                if (EPI == 2 && cvo) cvo[col - 2048] = a;
              }
          }
        }
      }
  }
#undef SA
#undef SB
#undef STAGE
#undef LDA
#undef LDB
#undef MMA
#undef WAIT_V
#undef WAIT_L
#undef BAR
#undef SCHED
}

__device__ __forceinline__ void unpack8(const u32x4 u, float* xv) {
  xv[0] = bf2f((u16)(u.x & 0xffff)); xv[1] = bf2f((u16)(u.x >> 16));
  xv[2] = bf2f((u16)(u.y & 0xffff)); xv[3] = bf2f((u16)(u.y >> 16));
  xv[4] = bf2f((u16)(u.z & 0xffff)); xv[5] = bf2f((u16)(u.z >> 16));
  xv[6] = bf2f((u16)(u.w & 0xffff)); xv[7] = bf2f((u16)(u.w >> 16));
}

__device__ void phase_conv(const Params& p, unsigned char* smem, const int rep) {
  const int tid = (int)p.tidx;
  const float* dtraw = (const float*)(p.ws + OFF_DTRAW);
  float* dtv = (float*)(p.ws + OFF_DT);
  float* cumv = (float*)(p.ws + OFF_CUM);
  {
    float* laS = (float*)smem;
    const int tok = tid >> 3, h0 = (tid & 7) * 4;
    const float4 bias = *(const float4*)(p.ssm_dt_bias + h0);
    const float4 al = *(const float4*)(p.ssm_a_log + h0);
    const float4 an = make_float4(-expf(al.x), -expf(al.y), -expf(al.z), -expf(al.w));
    for (int sc = blockIdx.x; sc < 384; sc += gridDim.x) {
      int row0, len;
      if (sc < 256) { row0 = sc * 64; len = 64; } else { row0 = NPROMPT + (sc - 256) * 8; len = 8; }
      if (tok < len) {
        const float4 x = *(const float4*)(dtraw + (size_t)(row0 + tok) * 32 + h0);
        float4 dt;
        { float v = x.x + bias.x; dt.x = v > 20.f ? v : log1pf(expf(v)); }
        { float v = x.y + bias.y; dt.y = v > 20.f ? v : log1pf(expf(v)); }
        { float v = x.z + bias.z; dt.z = v > 20.f ? v : log1pf(expf(v)); }
        { float v = x.w + bias.w; dt.w = v > 20.f ? v : log1pf(expf(v)); }
        *(float4*)(dtv + (size_t)(row0 + tok) * 32 + h0) = dt;
        *(float4*)(laS + tok * 32 + h0) = make_float4(dt.x * an.x * 1.4426950408889634f, dt.y * an.y * 1.4426950408889634f,
                                                      dt.z * an.z * 1.4426950408889634f, dt.w * an.w * 1.4426950408889634f);
      }
      __syncthreads();
      if (tok < len) {
        float4 c = make_float4(0.f, 0.f, 0.f, 0.f);
        for (int t = 0; t <= tok; ++t) {
          const float4 v = *(const float4*)(laS + t * 32 + h0);
          c.x += v.x; c.y += v.y; c.z += v.z; c.w += v.w;
        }
        *(float4*)(cumv + (size_t)(row0 + tok) * 32 + h0) = c;
      }
      __syncthreads();
    }
  }
  const u16* proj = (const u16*)(p.ws + OFF_PROJ);
  u16* xbcc = (u16*)(p.ws + OFF_XBCC);
  const int gtid = blockIdx.x * NTHR + tid;
  const int ch0 = (gtid & 511) * 8, rb = gtid >> 9;
  float wgt[4][8], bs[8];
#pragma unroll
  for (int wv = 0; wv < 4; ++wv) {
    const float4 w0 = *(const float4*)(p.ssm_conv_w + (size_t)wv * 4096 + ch0);
    const float4 w1 = *(const float4*)(p.ssm_conv_w + (size_t)wv * 4096 + ch0 + 4);
    wgt[wv][0] = w0.x; wgt[wv][1] = w0.y; wgt[wv][2] = w0.z; wgt[wv][3] = w0.w;
    wgt[wv][4] = w1.x; wgt[wv][5] = w1.y; wgt[wv][6] = w1.z; wgt[wv][7] = w1.w;
  }
  {
    const float4 b0 = *(const float4*)(p.ssm_conv_b + ch0), b1 = *(const float4*)(p.ssm_conv_b + ch0 + 4);
    bs[0] = b0.x; bs[1] = b0.y; bs[2] = b0.z; bs[3] = b0.w; bs[4] = b1.x; bs[5] = b1.y; bs[6] = b1.z; bs[7] = b1.w;
  }
  const int rows_per = T_TOK / (int)(gridDim.x * NTHR / 512);
  for (int rr = 0; rr < rep; ++rr) {
    float hm3[8], hm2[8], hm1[8];
    const int rbeg = rb * rows_per;
    u32x4 cur[4], nxt[4];
#pragma unroll
    for (int q = 0; q < 4; ++q) cur[q] = *(const u32x4*)(proj + (size_t)(rbeg + q) * PROJ_LD + 2048 + ch0);
    for (int r4 = 0; r4 < rows_per; r4 += 4) {
#pragma unroll
      for (int q = 0; q < 4; ++q) {
        nxt[q] = cur[q];
        if (r4 + 4 + q < rows_per) nxt[q] = *(const u32x4*)(proj + (size_t)(rbeg + r4 + 4 + q) * PROJ_LD + 2048 + ch0);
      }
#pragma unroll
      for (int q4 = 0; q4 < 4; ++q4) {
        const int r = r4 + q4;
        const int row = rbeg + r;
        const bool samp = row >= NPROMPT;
        const int t = samp ? ((row - NPROMPT) & 7) : (row & 2047);
        const int b = samp ? ((row - NPROMPT) >> 3) : (row >> 11);
        if (r == 0 || t == 0) {
#pragma unroll
          for (int k = 1; k <= 3; ++k) {
            float hv[8];
            if (t - k >= 0) {
              unpack8(*(const u32x4*)(proj + (size_t)(row - k) * PROJ_LD + 2048 + ch0), hv);
            } else if (samp) {
              const float* sp = p.state_conv + ((size_t)b * 3 + (t - k + 3)) * 4096 + ch0;
              const float4 s0 = *(const float4*)sp, s1 = *(const float4*)(sp + 4);
              hv[0] = s0.x; hv[1] = s0.y; hv[2] = s0.z; hv[3] = s0.w; hv[4] = s1.x; hv[5] = s1.y; hv[6] = s1.z; hv[7] = s1.w;
            } else {
#pragma unroll
              for (int q = 0; q < 8; ++q) hv[q] = 0.f;
            }
#pragma unroll
            for (int q = 0; q < 8; ++q) {
              if (k == 1) hm1[q] = hv[q];
              if (k == 2) hm2[q] = hv[q];
              if (k == 3) hm3[q] = hv[q];
            }
          }
        }
        float xc[8], o[8];
        unpack8(cur[q4], xc);
#pragma unroll
        for (int q = 0; q < 8; ++q) {
          const float a = bs[q] + hm3[q] * wgt[0][q] + hm2[q] * wgt[1][q] + hm1[q] * wgt[2][q] + xc[q] * wgt[3][q];
          o[q] = silu(a);
          hm3[q] = hm2[q]; hm2[q] = hm1[q]; hm1[q] = xc[q];
        }
        u32x4 ov;
        ov.x = pack2(o[0], o[1]); ov.y = pack2(o[2], o[3]); ov.z = pack2(o[4], o[5]); ov.w = pack2(o[6], o[7]);
        *(u32x4*)(xbcc + (size_t)row * 4096 + ch0) = ov;
      }
#pragma unroll
      for (int q = 0; q < 4; ++q) cur[q] = nxt[q];
    }
  }
}

template <int DK, int MODE>
__device__ void rec_prompt_item(const Params& p, const int item, unsigned char* smem) {
  constexpr int QS = (DK + 16) * 2;
  constexpr int VS = 160, PS = 144;
  constexpr int MF = DK / 128;
  constexpr int KS = DK / 32;
  constexpr int KUNR = (MODE == 1) ? 2 : 4;
  constexpr int NQ = DK / 64;
  constexpr int CPR = DK / 8;
  unsigned char* Qs = smem;
  unsigned char* Ks = Qs + 64 * QS;
  unsigned char* STs = Ks + 64 * QS;
  unsigned char* Vs = STs + 64 * QS;
  unsigned char* Vts = Vs + 64 * VS;
  unsigned char* Ps = Vts + 64 * VS;
  float* cumS = (float*)(Ps + 64 * PS);
  float* uS = cumS + 64;

  const int tid = (int)p.tidx, lane = tid & 63, w = tid >> 6;
  const int l15 = lane & 15, g = lane >> 4;
  const int b = item >> 5;
  const int h = (MODE == 0) ? ((item >> 3) & 3) : (item & 31);
  const int s = (MODE == 0) ? (item & 7) : 0;
  const int row0 = b * 2048;

  const u16* src;
  int sstride, qcol, kcol, vcol;
  if (MODE == 0) {
    src = (const u16*)(p.ws + OFF_PROJ); sstride = PROJ_LD;
    qcol = h * 256; kcol = 1024 + h * 256; vcol = 2048 + h * 512 + s * 64;
  } else {
    src = (const u16*)(p.ws + OFF_XBCC); sstride = 4096;
    qcol = 3072 + (h >> 2) * 128; kcol = 2048 + (h >> 2) * 128; vcol = h * 64;
  }
  const float* dtv = (const float*)(p.ws + OFF_DT);
  const float* cumv = (const float*)(p.ws + OFF_CUM);
  const float lg = (MODE == 0) ? log2f(1.0f - exp2f(-5.0f - (float)h)) : 0.f;

  const int vrow = tid >> 3, vkc = tid & 7;
  const int jt = tid & 63;

  constexpr int NSET = (MODE == 1) ? 2 : 1;
  u32x4 rq[2][NQ], rk[2][NQ], rv[2];
  float pcj[2] = {0.f, 0.f}, puj[2] = {1.f, 1.f}, pclast[2] = {0.f, 0.f}, pct[2] = {0.f, 0.f}, put[2] = {1.f, 1.f};
  u16 gz[2][2][4];
  const u16* gsrc = (const u16*)(p.ws + OFF_PROJ);
  const int gcol = (MODE == 0) ? (4096 + h * 512 + s * 64) : (h * 64);
  const int fi = w >> 1, fe0 = 2 * (w & 1);
  const int fis = (int)p.wv >> 1, fe0s = 2 * ((int)p.wv & 1);
  const int dw = w * (DK / 8);

  unsigned qoff[NQ], goff[4], aoff[4];
#pragma unroll
  for (int i = 0; i < NQ; ++i) {
    const int c_ = tid + NTHR * i;
    qoff[i] = (unsigned)(((c_ / CPR) * sstride + qcol + (c_ % CPR) * 8) * 2);
  }
  const unsigned voffv = (unsigned)((vrow * sstride + vcol + vkc * 8) * 2);
#pragma unroll
  for (int r = 0; r < 4; ++r) {
    goff[r] = (unsigned)(((16 * fi + 4 * g + r) * PROJ_LD + gcol + 16 * fe0 + l15) * 2);
    aoff[r] = (unsigned)(((16 * fi + 4 * g + r) * 2048 + ((MODE == 0) ? (h * 512 + s * 64) : (h * 64)) + 16 * fe0 + l15) * 2);
  }
  const int kdelta = (kcol - qcol) * 2;

#define PF_ISSUE(SET, RBASE)                                                                       \
  {                                                                                                \
    const int rb_ = (RBASE);                                                                       \
    if (true) {                                                                                    \
      const char* sb_ = (const char*)src + (size_t)rb_ * (size_t)(sstride * 2);                    \
      const char* gb_ = (const char*)gsrc + (size_t)rb_ * (size_t)(PROJ_LD * 2);                   \
      _Pragma("unroll") for (int i = 0; i < NQ; ++i) {                                             \
        rq[SET][i] = *(const u32x4*)(sb_ + qoff[i]);                                               \
        rk[SET][i] = *(const u32x4*)(sb_ + kdelta + qoff[i]);                                      \
      }                                                                                            \
      rv[SET] = *(const u32x4*)(sb_ + voffv);                                                      \
      if (MODE == 1) {                                                                             \
        pcj[SET] = cumv[(size_t)(rb_ + vrow) * 32 + h]; puj[SET] = dtv[(size_t)(rb_ + vrow) * 32 + h]; \
        pclast[SET] = cumv[(size_t)(rb_ + 63) * 32 + h];                                           \
        pct[SET] = cumv[(size_t)(rb_ + jt) * 32 + h]; put[SET] = dtv[(size_t)(rb_ + jt) * 32 + h]; \
      }                                                                                            \
      _Pragma("unroll") for (int x = 0; x < 2; ++x)                                                \
        _Pragma("unroll") for (int r = 0; r < 4; ++r)                                              \
          gz[SET][x][r] = *(const u16*)(gb_ + 32 * x + goff[r]);                                   \
    } else {                                                                                       \
      _Pragma("unroll") for (int i = 0; i < NQ; ++i) {                                             \
        int c_ = tid + NTHR * i, rr_ = c_ / CPR, kc_ = c_ % CPR;                                   \
        rq[SET][i] = *(const u32x4*)(src + (size_t)(rb_ + rr_) * sstride + qcol + kc_ * 8);        \
        rk[SET][i] = *(const u32x4*)(src + (size_t)(rb_ + rr_) * sstride + kcol + kc_ * 8);        \
      }                                                                                            \
      rv[SET] = *(const u32x4*)(src + (size_t)(rb_ + vrow) * sstride + vcol + vkc * 8);            \
      _Pragma("unroll") for (int x = 0; x < 2; ++x)                                                \
        _Pragma("unroll") for (int r = 0; r < 4; ++r)                                              \
          gz[SET][x][r] = gsrc[(size_t)(rb_ + 16 * fi + 4 * g + r) * PROJ_LD + gcol + 16 * (fe0 + x) + l15]; \
    }                                                                                              \
  }

  f32x4 S[MF][4];
#pragma unroll
  for (int i = 0; i < MF; ++i)
#pragma unroll
    for (int j = 0; j < 4; ++j) S[i][j] = (f32x4){0.f, 0.f, 0.f, 0.f};

  float gnv[2];
  const float dsk = (MODE == 1) ? p.ssm_d[h] : 0.f;
#pragma unroll
  for (int x = 0; x < 2; ++x) {
    const int e = 16 * (fe0 + x) + l15;
    gnv[x] = (MODE == 0) ? p.ret_head_norm[h * 512 + s * 64 + e] : p.ssm_gate_norm[h * 64 + e];
  }

  PF_ISSUE(0, row0)
  if (NSET == 2) PF_ISSUE(1, row0 + 64)

  for (int c2 = 0; c2 < 32; c2 += 2) {
#pragma unroll
   for (int par2 = 0; par2 < 2; ++par2) {
    const int par = par2 & (NSET - 1);
    const int c = c2 + par2;
    const int r0 = row0 + c * 64;
#pragma unroll
    for (int i = 0; i < NQ; ++i) {
      int cc = tid + NTHR * i, rr = cc / CPR, kc = cc % CPR;
      *(u32x4*)(Qs + rr * QS + kc * 16) = rq[par][i];
      *(u32x4*)(Ks + rr * QS + kc * 16) = rk[par][i];
    }
    {
      const u32x4 rvv = rv[par];
      *(u32x4*)(Vs + vrow * VS + vkc * 16) = rvv;
      float cj, uj, cl;
      if (MODE == 0) { cj = (float)(vrow + 1) * lg; uj = 1.f; cl = 64.f * lg; } else { cj = pcj[par]; uj = puj[par]; cl = pclast[par]; }
      const float wj = uj * ex2(cl - cj);
      u32x4 o;
      o.x = pack2(bf2f((u16)(rvv.x & 0xffff)) * wj, bf2f((u16)(rvv.x >> 16)) * wj);
      o.y = pack2(bf2f((u16)(rvv.y & 0xffff)) * wj, bf2f((u16)(rvv.y >> 16)) * wj);
      o.z = pack2(bf2f((u16)(rvv.z & 0xffff)) * wj, bf2f((u16)(rvv.z >> 16)) * wj);
      o.w = pack2(bf2f((u16)(rvv.w & 0xffff)) * wj, bf2f((u16)(rvv.w >> 16)) * wj);
      *(u32x4*)(Vts + vrow * VS + vkc * 16) = o;
    }
    if (tid < 64) {
      if (MODE == 0) { cumS[tid] = (float)(tid + 1) * lg; uS[tid] = 1.f; } else { cumS[tid] = pct[par]; uS[tid] = put[par]; }
    }
#pragma unroll
    for (int mf = 0; mf < MF; ++mf)
#pragma unroll
      for (int nf = 0; nf < 4; ++nf) {
        u32x2 o;
        o.x = pack2(S[mf][nf][0], S[mf][nf][1]);
        o.y = pack2(S[mf][nf][2], S[mf][nf][3]);
        *(u32x2*)(STs + (16 * nf + l15) * QS + (dw + 16 * mf + 4 * g) * 2) = o;
      }
    u16 gzc[2][4];
#pragma unroll
    for (int x = 0; x < 2; ++x)
#pragma unroll
      for (int r = 0; r < 4; ++r) gzc[x][r] = gz[par][x][r];
    __syncthreads();
    if (c + NSET < 32) PF_ISSUE(par, r0 + 64 * NSET)
    f32x4 sc[2], cr[2];
#pragma unroll
    for (int x = 0; x < 2; ++x) { sc[x] = (f32x4){0.f, 0.f, 0.f, 0.f}; cr[x] = (f32x4){0.f, 0.f, 0.f, 0.f}; }
#pragma unroll KUNR
    for (int ks = 0; ks < KS; ++ks) {
      const bf16x8 a = *(const bf16x8*)(Qs + (16 * fi + l15) * QS + ks * 64 + g * 16);
      bf16x8 bk[2], bs[2];
#pragma unroll
      for (int x = 0; x < 2; ++x) {
        bk[x] = *(const bf16x8*)(Ks + (16 * (fe0 + x) + l15) * QS + ks * 64 + g * 16);
        bs[x] = *(const bf16x8*)(STs + (16 * (fe0 + x) + l15) * QS + ks * 64 + g * 16);
      }
#pragma unroll
      for (int x = 0; x < 2; ++x) {
        sc[x] = __builtin_amdgcn_mfma_f32_16x16x32_bf16(a, bk[x], sc[x], 0, 0, 0);
        cr[x] = __builtin_amdgcn_mfma_f32_16x16x32_bf16(a, bs[x], cr[x], 0, 0, 0);
      }
    }
    float ci[4];
#pragma unroll
    for (int r = 0; r < 4; ++r) ci[r] = cumS[16 * fi + 4 * g + r];
#pragma unroll
    for (int x = 0; x < 2; ++x) {
      const int fj = fe0 + x;
      const int j = 16 * fj + l15;
      const float cj = cumS[j], uj = uS[j];
#pragma unroll
      for (int r = 0; r < 4; ++r) {
        const int i = 16 * fi + 4 * g + r;
        float v = 0.f;
        if (j <= i) v = sc[x][r] * ex2(ci[r] - cj) * uj;
        *(u16*)(Ps + i * PS + j * 2) = f2bf(v);
      }
    }
    {
      const float atot = ex2(cumS[63]);
#pragma unroll
      for (int mf = 0; mf < MF; ++mf)
#pragma unroll
        for (int nf = 0; nf < 4; ++nf)
#pragma unroll
          for (int r = 0; r < 4; ++r) S[mf][nf][r] *= atot;
#pragma unroll
      for (int ks = 0; ks < 2; ++ks) {
        bf16x8 af[MF], bfv[4];
#pragma unroll
        for (int mf = 0; mf < MF; ++mf) af[mf] = trfrag(Ks, QS, 32 * ks, dw + 16 * mf, lane);
#pragma unroll
        for (int nf = 0; nf < 4; ++nf) bfv[nf] = trfrag(Vts, VS, 32 * ks, 16 * nf, lane);
#pragma unroll
        for (int mf = 0; mf < MF; ++mf)
#pragma unroll
          for (int nf = 0; nf < 4; ++nf)
            S[mf][nf] = __builtin_amdgcn_mfma_f32_16x16x32_bf16(af[mf], bfv[nf], S[mf][nf], 0, 0, 0);
      }
    }
    __syncthreads();
    f32x4 in[2];
#pragma unroll
    for (int x = 0; x < 2; ++x) in[x] = (f32x4){0.f, 0.f, 0.f, 0.f};
#pragma unroll
    for (int ks = 0; ks < 2; ++ks) {
      const bf16x8 a = *(const bf16x8*)(Ps + (16 * fi + l15) * PS + ks * 64 + g * 16);
      bf16x8 bv[2];
#pragma unroll
      for (int x = 0; x < 2; ++x) bv[x] = trfrag(Vs, VS, 32 * ks, 16 * (fe0 + x), lane);
#pragma unroll
      for (int x = 0; x < 2; ++x) in[x] = __builtin_amdgcn_mfma_f32_16x16x32_bf16(a, bv[x], in[x], 0, 0, 0);
    }
    {
      float ss[4] = {0.f, 0.f, 0.f, 0.f};
      u16* aout = (u16*)(p.ws + OFF_A2);
      float* parts = (float*)(p.ws + OFF_PARTS);
#pragma unroll
      for (int x = 0; x < 2; ++x) {
        const int e = 16 * (fe0 + x) + l15;
        const float gn = gnv[x];
        const int ocol = (MODE == 0) ? (h * 512 + s * 64 + e) : (h * 64 + e);
#pragma unroll
        for (int r = 0; r < 4; ++r) {
          const int i = 16 * fi + 4 * g + r;
          float o = in[x][r] + cr[x][r] * ex2(ci[r]);
          const float gv = bf2f(gzc[x][r]);
          float val;
          if (MODE == 0) {
            ss[r] += o * o;
            val = o * gn * silu(gv);
          } else {
            const float xs = bf2f(*(const u16*)(Vs + i * VS + e * 2));
            const float y = o + xs * dsk;
            const float gg = y * silu(gv);
            ss[r] += gg * gg;
            val = gg * gn;
          }
          *(u16*)((char*)aout + (size_t)r0 * 4096 + 32 * x + aoff[r]) = f2bf(val);
        }
      }
#pragma unroll
      for (int r = 0; r < 4; ++r) {
        const float v = row16_sum(ss[r]);
        if (l15 == 0) {
          const int i = 16 * fi + 4 * g + r;
          const int slot = (MODE == 0) ? (h * 16 + s * 2 + (w & 1)) : ((h >> 2) * 8 + (h & 3) * 2 + (w & 1));
          parts[(size_t)(r0 + i) * 64 + slot] = v;
        }
      }
    }
    __syncthreads();
   }
  }
#undef PF_ISSUE
  {
    float* so;
    int pitch;
    if (MODE == 0) { so = p.out + OUT_RETP + ((size_t)(b * 4 + h) * 256) * 512 + s * 64; pitch = 512; }
    else { so = p.out + OUT_SSMP + ((size_t)(b * 32 + h) * 128) * 64; pitch = 64; }
#pragma unroll
    for (int mf = 0; mf < MF; ++mf)
#pragma unroll
      for (int nf = 0; nf < 4; ++nf)
#pragma unroll
        for (int r = 0; r < 4; ++r)
          so[(size_t)(dw + 16 * mf + 4 * g + r) * pitch + 16 * nf + l15] = S[mf][nf][r];
  }
}

#define SAMPLE_DECODE(ITEM, B_, H_, S_)                              \
  const int B_ = (ITEM) >> 5;                                        \
  const int H_ = (MODE == 0) ? (((ITEM) >> 3) & 3) : ((ITEM) & 31);  \
  const int S_ = (MODE == 0) ? ((ITEM) & 7) : 0;

#define SAMPLE_ISSUE(SET, ITEM)                                                                                     \
  {                                                                                                                \
    SAMPLE_DECODE(ITEM, b_, h_, s_)                                                                                \
    const int row0_ = NPROMPT + b_ * 8;                                                                            \
    int qcol_, kcol_, vcol_;                                                                                       \
    if (MODE == 0) { qcol_ = h_ * 256; kcol_ = 1024 + h_ * 256; vcol_ = 2048 + h_ * 512 + s_ * 64; }               \
    else { qcol_ = 3072 + (h_ >> 2) * 128; kcol_ = 2048 + (h_ >> 2) * 128; vcol_ = h_ * 64; }                      \
    const float* s0_ = (MODE == 0) ? p.state_ret + ((size_t)(b_ * 4 + h_) * 256) * 512 + s_ * 64                   \
                                   : p.state_ssm + ((size_t)(b_ * 32 + h_) * 128) * 64;                            \
    _Pragma("unroll") for (int db = 0; db < NB; ++db)                                                              \
      _Pragma("unroll") for (int eb = 0; eb < 4; ++eb)                                                             \
        _Pragma("unroll") for (int r = 0; r < 4; ++r)                                                              \
          sv[SET][db][eb][r] = s0_[(size_t)(dbase + 16 * db + 4 * g + r) * pitch + 16 * eb + l15];                \
    if (tid < 2 * DK) {                                                                                            \
      const int which_ = tid / DK, c_ = tid % DK;                                                                  \
      rqk[SET] = *(const u32x4*)(src + (size_t)(row0_ + c_ / CPR) * sstride + (which_ ? kcol_ : qcol_) + (c_ % CPR) * 8); \
    }                                                                                                              \
    if (tid < 64) {                                                                                                \
      rv[SET] = *(const u32x4*)(src + (size_t)(row0_ + (tid >> 3)) * sstride + vcol_ + (tid & 7) * 8);             \
      if (MODE == 1) {                                                                                             \
        pvc[SET] = cumv[(size_t)(row0_ + (tid >> 3)) * 32 + h_];                                                   \
        pvu[SET] = dtv[(size_t)(row0_ + (tid >> 3)) * 32 + h_];                                                    \
        pvl[SET] = cumv[(size_t)(row0_ + 7) * 32 + h_];                                                            \
      }                                                                                                            \
    }                                                                                                              \
    gzs[SET] = gsrc[(size_t)(row0_ + w) * PROJ_LD + ((MODE == 0) ? (4096 + h_ * 512 + s_ * 64) : (h_ * 64)) + lane]; \
    if (MODE == 1 && tid < 16)                                                                                     \
      pcu[SET] = (tid < 8) ? cumv[(size_t)(row0_ + tid) * 32 + h_] : dtv[(size_t)(row0_ + tid - 8) * 32 + h_];     \
  }

template <int DK, int MODE>
__device__ void rec_sample_loop(const Params& p, unsigned char* smem, const int rep) {
  constexpr int SET_FLOATS = 8 * DK + 8 * DK + 512 + 64 + 4096 + 64 + (DK * 8 + 64 * 8) / 2;
  const int tid = (int)p.tidx, lane = tid & 63, w = tid >> 6;
  const int l15 = lane & 15, g = lane >> 4;
  constexpr int CPR = DK / 8;
  constexpr int DPW = DK / 8;
  constexpr int NB = DPW / 16;
  const int dbase = w * DPW;
  const int pitch = (MODE == 0) ? 512 : 64;
  int vz;
  asm volatile("v_mov_b32 %0, 0" : "=v"(vz));
  const u16* src = ((MODE == 0) ? (const u16*)(p.ws + OFF_PROJ) : (const u16*)(p.ws + OFF_XBCC)) + vz;
  const int sstride = (MODE == 0) ? PROJ_LD : 4096;
  const u16* gsrc = (const u16*)(p.ws + OFF_PROJ) + vz;
  const float* dtv = (const float*)(p.ws + OFF_DT) + vz;
  const float* cumv = (const float*)(p.ws + OFF_CUM) + vz;
  u16* aout = (u16*)(p.ws + OFF_A2);
  float* parts = (float*)(p.ws + OFF_PARTS);

  u32x4 rqk[2] = {(u32x4){0u, 0u, 0u, 0u}, (u32x4){0u, 0u, 0u, 0u}}, rv[2] = {(u32x4){0u, 0u, 0u, 0u}, (u32x4){0u, 0u, 0u, 0u}};
  f32x4 sv[2][NB][4];
  u16 gzs[2] = {0, 0};
  float pcu[2] = {0.f, 0.f}, pvc[2] = {0.f, 0.f}, pvu[2] = {1.f, 1.f}, pvl[2] = {0.f, 0.f};
  const int nitems = 4096 * rep;
  const int G = (int)gridDim.x;
  if ((int)blockIdx.x < nitems) SAMPLE_ISSUE(0, ((int)blockIdx.x & 4095) + vz)
  for (int itb = blockIdx.x; itb < nitems; itb += 2 * G) {
#pragma unroll
   for (int par = 0; par < 2; ++par) {
    const int item0 = itb + par * G;
    if (item0 < nitems) {
    if (item0 + G < nitems) SAMPLE_ISSUE(par ^ 1, ((item0 + G) & 4095) + vz)
    __builtin_amdgcn_sched_barrier(0);
    const int item = (item0 & 4095) + vz;
    SAMPLE_DECODE(item, b, h, s)
    const int row0 = NPROMPT + b * 8;
    const u16 gzv = gzs[par];
    const u32x4 rqkc = rqk[par], rvc = rv[par];
    float* qS = (float*)smem + par * SET_FLOATS;
    float* kS = qS + 8 * DK;
    float* vS = kS + 8 * DK;
    float* scS = vS + 512;
    float* redS = scS + 64;
    float* cuS = redS + 4096;
    u16* kTb = (u16*)(cuS + 64);
    u16* vwTb = kTb + DK * 8;
    const float lgh = (MODE == 0) ? log2f(1.0f - exp2f(-5.0f - (float)h)) : 0.f;
    if (tid < 2 * DK) {
      const int which = tid / DK, c = tid % DK;
      float* dst = (which ? kS : qS) + (c / CPR) * DK + (c % CPR) * 8;
      dst[0] = bf2f((u16)(rqkc.x & 0xffff)); dst[1] = bf2f((u16)(rqkc.x >> 16));
      dst[2] = bf2f((u16)(rqkc.y & 0xffff)); dst[3] = bf2f((u16)(rqkc.y >> 16));
      dst[4] = bf2f((u16)(rqkc.z & 0xffff)); dst[5] = bf2f((u16)(rqkc.z >> 16));
      dst[6] = bf2f((u16)(rqkc.w & 0xffff)); dst[7] = bf2f((u16)(rqkc.w >> 16));
      if (which) {
        u16* dT = kTb + ((c % CPR) * 8) * 8 + (c / CPR);
        dT[0 * 8] = (u16)(rqkc.x & 0xffff); dT[1 * 8] = (u16)(rqkc.x >> 16);
        dT[2 * 8] = (u16)(rqkc.y & 0xffff); dT[3 * 8] = (u16)(rqkc.y >> 16);
        dT[4 * 8] = (u16)(rqkc.z & 0xffff); dT[5 * 8] = (u16)(rqkc.z >> 16);
        dT[6 * 8] = (u16)(rqkc.w & 0xffff); dT[7 * 8] = (u16)(rqkc.w >> 16);
      }
    }
    if (tid < 64) {
      const int t = tid >> 3, kc = tid & 7;
      float vv[8];
      vv[0] = bf2f((u16)(rvc.x & 0xffff)); vv[1] = bf2f((u16)(rvc.x >> 16));
      vv[2] = bf2f((u16)(rvc.y & 0xffff)); vv[3] = bf2f((u16)(rvc.y >> 16));
      vv[4] = bf2f((u16)(rvc.z & 0xffff)); vv[5] = bf2f((u16)(rvc.z >> 16));
      vv[6] = bf2f((u16)(rvc.w & 0xffff)); vv[7] = bf2f((u16)(rvc.w >> 16));
      float* dst = vS + t * 64 + kc * 8;
      const float wt = (MODE == 0) ? ex2((float)(7 - t) * lgh) : pvu[par] * ex2(pvl[par] - pvc[par]);
      u16* dT = vwTb + (kc * 8) * 8 + t;
#pragma unroll
      for (int x = 0; x < 8; ++x) { dst[x] = vv[x]; dT[x * 8] = f2bf(vv[x] * wt); }
    }
    if (MODE == 1 && tid < 16) cuS[tid] = pcu[par];
    __syncthreads();
    float cum[8], u[8];
    if (MODE == 0) {
#pragma unroll
      for (int t = 0; t < 8; ++t) { cum[t] = (float)(t + 1) * lgh; u[t] = 1.f; }
    } else {
#pragma unroll
      for (int t = 0; t < 8; ++t) { cum[t] = cuS[t]; u[t] = cuS[8 + t]; }
    }
    if (w == 0) {
      f32x4 sacc = (f32x4){0.f, 0.f, 0.f, 0.f};
#pragma unroll
      for (int ks = 0; ks < DK / 32; ++ks) {
        const float* qp = qS + (l15 & 7) * DK + ks * 32 + 8 * g;
        const float* kp = kS + (l15 & 7) * DK + ks * 32 + 8 * g;
        const float4 a0 = *(const float4*)qp, a1 = *(const float4*)(qp + 4);
        const float4 b0 = *(const float4*)kp, b1 = *(const float4*)(kp + 4);
        u32x4 qa_, kb_;
        qa_.x = pack2(a0.x, a0.y); qa_.y = pack2(a0.z, a0.w); qa_.z = pack2(a1.x, a1.y); qa_.w = pack2(a1.z, a1.w);
        kb_.x = pack2(b0.x, b0.y); kb_.y = pack2(b0.z, b0.w); kb_.z = pack2(b1.x, b1.y); kb_.w = pack2(b1.z, b1.w);
        sacc = __builtin_amdgcn_mfma_f32_16x16x32_bf16(__builtin_bit_cast(bf16x8, qa_), __builtin_bit_cast(bf16x8, kb_), sacc, 0, 0, 0);
      }
      if (g < 2 && l15 < 8) {
        float cj = 0.f, uj = 0.f;
#pragma unroll
        for (int t = 0; t < 8; ++t) if (t == l15) { cj = cum[t]; uj = u[t]; }
#pragma unroll
        for (int r = 0; r < 4; ++r) {
          const int i = 4 * g + r;
          float ci = 0.f;
#pragma unroll
          for (int t = 0; t < 8; ++t) if (t == i) ci = cum[t];
          scS[i * 8 + l15] = (l15 <= i) ? sacc[r] * ex2(ci - cj) * uj : 0.f;
        }
      }
    }
    {
      float* s1 = (MODE == 0) ? p.out + OUT_RETS + ((size_t)(b * 4 + h) * 256) * 512 + s * 64
                              : p.out + OUT_SSMS + ((size_t)(b * 32 + h) * 128) * 64;
      const float atot = ex2(cum[7]);
      const bf16x8 zero8 = (bf16x8){0, 0, 0, 0, 0, 0, 0, 0};
      bf16x8 kA[NB], vB[4], qa;
#pragma unroll
      for (int db = 0; db < NB; ++db) {
        const bf16x8 t8 = *(const bf16x8*)(kTb + (dbase + 16 * db + l15) * 8);
        kA[db] = (g == 0) ? t8 : zero8;
      }
#pragma unroll
      for (int eb = 0; eb < 4; ++eb) {
        const bf16x8 t8 = *(const bf16x8*)(vwTb + (16 * eb + l15) * 8);
        vB[eb] = (g == 0) ? t8 : zero8;
      }
      {
        const float* qrow = qS + (l15 & 7) * DK + dbase + 4 * g;
        const float4 q0 = *(const float4*)qrow;
        float4 q1 = make_float4(0.f, 0.f, 0.f, 0.f);
        if (NB == 2) q1 = *(const float4*)(qrow + 16);
        u32x4 qq;
        qq.x = pack2(q0.x, q0.y); qq.y = pack2(q0.z, q0.w); qq.z = pack2(q1.x, q1.y); qq.w = pack2(q1.z, q1.w);
        if (l15 >= 8) qq = (u32x4){0u, 0u, 0u, 0u};
        qa = __builtin_bit_cast(bf16x8, qq);
      }
#pragma unroll
      for (int eb = 0; eb < 4; ++eb) {
        u32x4 sb;
        sb.x = pack2(sv[par][0][eb][0], sv[par][0][eb][1]);
        sb.y = pack2(sv[par][0][eb][2], sv[par][0][eb][3]);
        if (NB == 2) {
          sb.z = pack2(sv[par][NB - 1][eb][0], sv[par][NB - 1][eb][1]);
          sb.w = pack2(sv[par][NB - 1][eb][2], sv[par][NB - 1][eb][3]);
        } else { sb.z = 0u; sb.w = 0u; }
        const f32x4 o3 = __builtin_amdgcn_mfma_f32_16x16x32_bf16(qa, __builtin_bit_cast(bf16x8, sb),
                                                                 (f32x4){0.f, 0.f, 0.f, 0.f}, 0, 0, 0);
        if (g < 2) {
#pragma unroll
          for (int r = 0; r < 4; ++r) redS[(w * 8 + 4 * g + r) * 64 + 16 * eb + l15] = o3[r];
        }
#pragma unroll
        for (int db = 0; db < NB; ++db) {
          f32x4 c = sv[par][db][eb];
          c[0] *= atot; c[1] *= atot; c[2] *= atot; c[3] *= atot;
          const f32x4 dn = __builtin_amdgcn_mfma_f32_16x16x32_bf16(kA[db], vB[eb], c, 0, 0, 0);
#pragma unroll
          for (int r = 0; r < 4; ++r) s1[(size_t)(dbase + 16 * db + 4 * g + r) * pitch + 16 * eb + l15] = dn[r];
        }
      }
    }
    __syncthreads();
    {
      const int i = w, e = lane;
      float o = 0.f;
#pragma unroll
      for (int ww = 0; ww < 8; ++ww) o += redS[(ww * 8 + i) * 64 + e];
      float ci = 0.f;
#pragma unroll
      for (int t = 0; t < 8; ++t) if (t == i) ci = cum[t];
      o *= ex2(ci);
#pragma unroll
      for (int jj = 0; jj < 8; ++jj) if (jj <= i) o += scS[i * 8 + jj] * vS[jj * 64 + e];
      const int row = row0 + i;
      const float gv = bf2f(gzv);
      if (MODE == 0) {
        const float ssq = wave_sum(o * o);
        const float val = o * p.ret_head_norm[h * 512 + s * 64 + e] * silu(gv);
        aout[(size_t)row * 2048 + h * 512 + s * 64 + e] = f2bf(val);
        if (lane < 2) parts[(size_t)row * 64 + h * 16 + s * 2 + lane] = lane == 0 ? ssq : 0.f;
      } else {
        const float y = o + vS[i * 64 + e] * p.ssm_d[h];
        const float gg = y * silu(gv);
        const float ssq = wave_sum(gg * gg);
        aout[(size_t)row * 2048 + h * 64 + e] = f2bf(gg * p.ssm_gate_norm[h * 64 + e]);
        if (lane < 2) parts[(size_t)row * 64 + (h >> 2) * 8 + (h & 3) * 2 + lane] = lane == 0 ? ssq : 0.f;
      }
    }
    }
   }
  }
  __syncthreads();
}

template <int DK, int MODE>
__device__ void phase_rec(const Params& p, unsigned char* smem, const int rep_p, const int rep_s) {
  for (int item = blockIdx.x; item < 256 * rep_p; item += gridDim.x) rec_prompt_item<DK, MODE>(p, item & 255, smem);
  rec_sample_loop<DK, MODE>(p, smem, rep_s);
}

#ifndef PHASE_MASK
#define PHASE_MASK 0x3ff
#endif
#ifndef DUP_MASK
#define DUP_MASK 0x000
#endif
#define XB_TMO      128
#define XB_XCNT(j)  (256  + 64 * (j))
#define XB_XSUB(j)  (1280 + 64 * (j))
#define XB_XGEN(j)  (2304 + 64 * (j))
#define XB_TOP      3328
#define XB_TOPGEN   3392
#define XCD_BAR_WORDS 3456
#define XB_SPIN_CAP (1u << 20)
#define LAS __attribute__((address_space(3)))
__device__ __forceinline__ unsigned xb_ld(unsigned* p) { return __hip_atomic_load(p, __ATOMIC_RELAXED, __HIP_MEMORY_SCOPE_AGENT); }
__device__ __forceinline__ unsigned xb_add(unsigned* p, unsigned v) { return __hip_atomic_fetch_add(p, v, __ATOMIC_RELAXED, __HIP_MEMORY_SCOPE_AGENT); }
__device__ __forceinline__ unsigned xb_xcc_id() { return (unsigned)__builtin_amdgcn_s_getreg((3 << 11) | 20) & 0xFu; }
#define XB_SPIN(cond, bar) do { unsigned _sp = 0; while (cond) { __builtin_amdgcn_s_sleep(1); \
    if ((++_sp & 255u) == 0u) { if (xb_ld(&(bar)[XB_TMO])) break; if (_sp > XB_SPIN_CAP) { atomicAdd(&(bar)[XB_TMO], 1u); break; } } } } while (0)
struct XcdBarrier {
  unsigned* bar; unsigned x;
  volatile LAS unsigned* st;
};
__device__ __forceinline__ XcdBarrier xcd_barrier_post(unsigned* bar, volatile LAS unsigned* st, const int tid) {
  XcdBarrier b; b.bar = bar; b.x = xb_xcc_id(); b.st = st;
  if (tid == 0) (void)xb_add(&bar[XB_XCNT(b.x)], 1u);
  return b;
}
__device__ __forceinline__ void xcd_barrier_complete(unsigned* bar, unsigned x, unsigned& nloc, unsigned& nx) {
  const unsigned G = gridDim.x * gridDim.y * gridDim.z;
  unsigned sum, cnt, mine, sp = 0u;
  for (;;) {
    sum = 0u; cnt = 0u; mine = 0u;
#pragma unroll
    for (unsigned j = 0; j < 16; ++j) { const unsigned c = xb_ld(&bar[XB_XCNT(j)]); sum += c; cnt += (c > 0u) ? 1u : 0u; mine = (j == x) ? c : mine; }
    if (sum == G) break;
    __builtin_amdgcn_s_sleep(1);
    if ((++sp & 255u) == 0u) { if (xb_ld(&bar[XB_TMO])) break; if (sp > XB_SPIN_CAP) { atomicAdd(&bar[XB_TMO], 1u); break; } }
  }
  nloc = mine > 0u ? mine : 1u; nx = cnt > 0u ? cnt : 1u;
}
__device__ __forceinline__ void xcd_barrier(const XcdBarrier& b, const int wvs) {
  int wvl_ = wvs;
  asm volatile("" : "+s"(wvl_));
  const int tid = wvl_ * 64 + (int)__builtin_amdgcn_mbcnt_hi(~0u, __builtin_amdgcn_mbcnt_lo(~0u, 0u));
  asm volatile("s_waitcnt vmcnt(0)" ::: "memory");
  __syncthreads();
  if (tid == 0) {
    unsigned* bar = b.bar;
    __builtin_amdgcn_s_waitcnt(0);
    unsigned nloc = b.st[0], nx = b.st[1];
    if (nloc == 0u) { xcd_barrier_complete(bar, b.x, nloc, nx); b.st[0] = nloc; b.st[1] = nx; }
    const unsigned old = xb_add(&bar[XB_XSUB(b.x)], 1u);
    const unsigned gen = old / nloc;
    if (old + 1u == (gen + 1u) * nloc) {
      __builtin_amdgcn_fence(__ATOMIC_RELEASE, "agent");
      asm volatile("s_waitcnt vmcnt(0)" ::: "memory");
      const unsigned og = xb_add(&bar[XB_TOP], 1u);
      const unsigned tg = og / nx;
      if (og + 1u == (tg + 1u) * nx) xb_add(&bar[XB_TOPGEN], 1u);
      else XB_SPIN(xb_ld(&bar[XB_TOPGEN]) == tg, bar);
      __builtin_amdgcn_fence(__ATOMIC_ACQUIRE, "agent");
      xb_add(&bar[XB_XGEN(b.x)], 1u);
      asm volatile("s_waitcnt vmcnt(0)" ::: "memory");
    } else {
      XB_SPIN(xb_ld(&bar[XB_XGEN(b.x)]) == gen, bar);
      __builtin_amdgcn_fence(__ATOMIC_ACQUIRE, "agent");
      asm volatile("s_waitcnt vmcnt(0)" ::: "memory");
    }
  }
  __syncthreads();
}

template <typename T>
__device__ __forceinline__ T* as_global(T* q) {
  return (T*)(__attribute__((address_space(1))) T*)q;
}

template <int PH>
__device__ __forceinline__ void run_phase(Params p, unsigned char* smem, const int wvs) {
  {
    long long z_ = 0;
    asm volatile("" : "+s"(z_));
    p.ws += z_; p.out += z_;
  }
  {
    int wvl_ = wvs;
    asm volatile("" : "+s"(wvl_));
    p.tidx = wvl_ * 64 + (int)__builtin_amdgcn_mbcnt_hi(~0u, __builtin_amdgcn_mbcnt_lo(~0u, 0u));
    p.wv = wvl_;
  }
  const int rep = 1 + (int)((p.dup >> PH) & 1);
  if (PH == 0) phase_prep(p, smem, rep);
  if (PH == 1) {
    gemm8_phase<0>(p, (const u16*)(p.ws + OFF_H), (const u16*)(p.ws + OFF_WT0), 1024, 24, smem, rep);
    __syncthreads();
    transpose_later_weights(p, smem, (68 * 24) % (int)gridDim.x);
  }
  if (PH == 2) phase_rec<256, 0>(p, smem, rep, 1 + (int)((p.dup >> (PH + 16)) & 1));
  if (PH == 3)
  {
    gemm_phase<1, 4>(p, (const u16*)(p.ws + OFF_A2), (const u16*)(p.ws + OFF_WT1), 2048, 8, nullptr,
                     (float*)(p.ws + OFF_X1), smem, rep, 64);
    __syncthreads();
    gemm_sample_rows<4>(p, (const u16*)(p.ws + OFF_A2), (const u16*)(p.ws + OFF_WT1), nullptr, (float*)(p.ws + OFF_X1), smem, rep);
  }
  if (PH == 4) phase_norm<0>(p, (const float*)(p.ws + OFF_X1), p.ssm_norm, rep);
  if (PH == 5) {
    gemm8_phase<2>(p, (const u16*)(p.ws + OFF_H), (const u16*)(p.ws + OFF_WT2), 1024, 24, smem, rep);
    __syncthreads();
    gemm_phase<2, 0>(p, (const u16*)(p.ws + OFF_H), (const u16*)(p.ws + OFF_WT2), 1024, 1, nullptr, nullptr, smem, 1, 68, 48, true);
  }
  if (PH == 6) phase_conv(p, smem, rep);
  if (PH == 7) phase_rec<128, 1>(p, smem, rep, 1 + (int)((p.dup >> (PH + 16)) & 1));
  if (PH == 8)
  {
    gemm_phase<1, 8>(p, (const u16*)(p.ws + OFF_A2), (const u16*)(p.ws + OFF_WT3), 2048, 8,
                     (const float*)(p.ws + OFF_X1), (float*)(p.ws + OFF_X2), smem, rep, 64);
    __syncthreads();
    gemm_sample_rows<8>(p, (const u16*)(p.ws + OFF_A2), (const u16*)(p.ws + OFF_WT3), (const float*)(p.ws + OFF_X1),
                        (float*)(p.ws + OFF_X2), smem, rep);
  }
  if (PH == 9) phase_norm<1>(p, (const float*)(p.ws + OFF_X2), p.final_norm, rep);
}

#define RUN_PHASE(k)                                   \
  if ((PHASE_MASK >> k) & 1) {                         \
    if (lo <= k && k <= hi) {                          \
      run_phase<k>(p, smem, wvs);                      \
      if (k < hi) { xcd_barrier(xb, wvs); if ((p.dup >> 30) & 1) { xcd_barrier(xb, wvs); xcd_barrier(xb, wvs); } } \
    }                                                  \
  }

__global__ void __launch_bounds__(NTHR) fwd_megakernel(Params p) {
  __shared__ __attribute__((aligned(16))) unsigned char smem[LDS_BYTES];
  cg::grid_group grid = cg::this_grid();
  const int lo = (int)p.phase_lo, hi = (int)p.phase_hi;
  if (lo > 1000) grid.sync();
  volatile LAS unsigned* xst = (volatile LAS unsigned*)(smem + LDS_BYTES - 16);
  const int wvs = __builtin_amdgcn_readfirstlane((int)(threadIdx.x >> 6));
  if (threadIdx.x == 0) { xst[0] = 0u; xst[1] = 0u; }
  __syncthreads();
  const XcdBarrier xb = xcd_barrier_post((unsigned*)(p.ws + OFF_BAR), xst, (int)threadIdx.x);
  RUN_PHASE(0)
  RUN_PHASE(1)
  RUN_PHASE(2)
  RUN_PHASE(3)
  RUN_PHASE(4)
  RUN_PHASE(5)
  RUN_PHASE(6)
  RUN_PHASE(7)
  RUN_PHASE(8)
  RUN_PHASE(9)
}

#ifndef ONE_LAUNCH
#define ONE_LAUNCH 1
#endif

extern "C" void kernel_launch(void* const* d_in, const int* in_sizes, int n_in, void* d_out, int out_size, void* d_ws,
                              size_t ws_size, hipStream_t stream) {
  static int grid_blocks = 0;
  if (!grid_blocks) {
    int dev = 0, cus = 0, per_cu = 0;
    hipGetDevice(&dev);
    hipDeviceGetAttribute(&cus, hipDeviceAttributeMultiprocessorCount, dev);
    hipOccupancyMaxActiveBlocksPerMultiprocessor(&per_cu, fwd_megakernel, NTHR, 0);
    if (per_cu < 1) per_cu = 1;
    if (per_cu > 1) per_cu = 1;
    grid_blocks = cus * per_cu;
  }
  Params p{};
  const float** pf = (const float**)&p;
  for (int i = 0; i < 19; ++i) pf[i] = (const float*)d_in[i];
  p.out = (float*)d_out;
  p.ws = (unsigned char*)d_ws;
#if ONE_LAUNCH
  hipMemsetAsync((unsigned char*)d_ws + OFF_BAR, 0, XCD_BAR_WORDS * 4, stream);
  p.phase_lo = 0; p.phase_hi = 9; p.dup = DUP_MASK;
  void* args[] = {&p};
  hipError_t e = hipLaunchCooperativeKernel((void*)fwd_megakernel, dim3(grid_blocks), dim3(NTHR), args, 0, stream);
  if (e != hipSuccess) fprintf(stderr, "cooperative launch failed: %s (grid %d)\n", hipGetErrorString(e), grid_blocks);
#else
  for (int ph = 0; ph <= 9; ++ph) {
    p.phase_lo = ph; p.phase_hi = ph;
    void* args[] = {&p};
    hipLaunchCooperativeKernel((void*)fwd_megakernel, dim3(grid_blocks), dim3(NTHR), args, 0, stream);
  }
#endif
}
```

```cpp
#include <hip/hip_runtime.h>
#include <hip/hip_cooperative_groups.h>
#include <stdint.h>
#include <stdio.h>
namespace cg = cooperative_groups;

typedef __attribute__((ext_vector_type(8))) short bf16x8;
typedef __attribute__((ext_vector_type(4))) short s16x4;
typedef __attribute__((ext_vector_type(4))) float f32x4;
typedef unsigned short u16;
typedef __attribute__((ext_vector_type(4))) unsigned int u32x4;
typedef __attribute__((ext_vector_type(2))) unsigned int u32x2;

#define NTHR 512
#define T_TOK 17408
#define NPROMPT 16384
#define LDS_BYTES 143360
#define PROJ_LD 6208

constexpr size_t OFF_WT0 = 0;
constexpr size_t OFF_WT1 = OFF_WT0 + (size_t)6144 * 1024 * 2;
constexpr size_t OFF_WT2 = OFF_WT1 + (size_t)1024 * 2048 * 2;
constexpr size_t OFF_WT3 = OFF_WT2 + (size_t)6272 * 1024 * 2;
constexpr size_t OFF_ROPE = OFF_WT3 + (size_t)1024 * 2048 * 2;
constexpr size_t OFF_H = OFF_ROPE + (size_t)2056 * 128 * 8;
constexpr size_t OFF_PROJ = OFF_H + (size_t)T_TOK * 1024 * 2;
constexpr size_t OFF_A2 = OFF_PROJ + (size_t)T_TOK * PROJ_LD * 2;
constexpr size_t OFF_PARTS = OFF_A2 + (size_t)T_TOK * 2048 * 2;
constexpr size_t OFF_X1 = OFF_PARTS + (size_t)T_TOK * 64 * 4;
constexpr size_t OFF_X2 = OFF_X1 + (size_t)T_TOK * 1024 * 4;
constexpr size_t OFF_XBCC = OFF_X2 + (size_t)T_TOK * 1024 * 4;
constexpr size_t OFF_DTRAW = OFF_XBCC + (size_t)T_TOK * 4096 * 2;
constexpr size_t OFF_DT = OFF_DTRAW + (size_t)T_TOK * 32 * 4;
constexpr size_t OFF_CUM = OFF_DT + (size_t)T_TOK * 32 * 4;
constexpr size_t OFF_BAR = OFF_CUM + (size_t)T_TOK * 32 * 4;

constexpr size_t OUT_Y = 0;
constexpr size_t OUT_RETP = 17825792;
constexpr size_t OUT_RETS = 22020096;
constexpr size_t OUT_SSMP = 89128960;
constexpr size_t OUT_SSMS = 91226112;
constexpr size_t OUT_CONVP = 124780544;
constexpr size_t OUT_CONVS = 124878848;

struct Params {
  const float *x_prompt, *x_sample, *state_ret, *state_ssm, *state_conv, *ret_norm, *ret_w_in, *ret_head_norm,
      *ret_w_out, *ssm_norm, *ssm_w_in, *ssm_conv_w, *ssm_conv_b, *ssm_dt_bias, *ssm_a_log, *ssm_d, *ssm_gate_norm,
      *ssm_w_out, *final_norm;
  float* out;
  unsigned char* ws;
  long long phase_lo, phase_hi, dup, tidx, wv;
};

typedef __bf16 bf16x2_t __attribute__((ext_vector_type(2)));
typedef float f32x2_t __attribute__((ext_vector_type(2)));
__device__ __forceinline__ u16 f2bf(float f) {
  __bf16 r = (__bf16)f;
  return __builtin_bit_cast(u16, r);
}
__device__ __forceinline__ float bf2f(u16 h) { return __uint_as_float(((uint32_t)h) << 16); }
__device__ __forceinline__ uint32_t pack2(float a, float b) {
  f32x2_t v = {a, b};
  bf16x2_t r = __builtin_convertvector(v, bf16x2_t);
  return __builtin_bit_cast(uint32_t, r);
}
__device__ __forceinline__ float ex2(float x) { return __builtin_amdgcn_exp2f(x); }
__device__ __forceinline__ float silu(float x) { return x * __builtin_amdgcn_rcpf(1.0f + __expf(-x)); }
__device__ __forceinline__ float row16_sum(float v) {
  v += __builtin_bit_cast(float, __builtin_amdgcn_update_dpp(0, __builtin_bit_cast(int, v), 0xB1, 0xF, 0xF, true));
  v += __builtin_bit_cast(float, __builtin_amdgcn_update_dpp(0, __builtin_bit_cast(int, v), 0x4E, 0xF, 0xF, true));
  v += __builtin_bit_cast(float, __builtin_amdgcn_update_dpp(0, __builtin_bit_cast(int, v), 0x124, 0xF, 0xF, true));
  v += __builtin_bit_cast(float, __builtin_amdgcn_update_dpp(0, __builtin_bit_cast(int, v), 0x128, 0xF, 0xF, true));
  return v;
}
__device__ __forceinline__ float wave_sum(float v) {
#pragma unroll
  for (int o = 32; o > 0; o >>= 1) v += __shfl_xor(v, o);
  return v;
}
__device__ __forceinline__ const float* xrow(const Params& p, int r) {
  return r < NPROMPT ? p.x_prompt + (size_t)r * 1024 : p.x_sample + (size_t)(r - NPROMPT) * 1024;
}
__device__ __forceinline__ s16x4 trread(const unsigned char* ptr) {
  return __builtin_amdgcn_ds_read_tr16_b64_v4i16((s16x4 __attribute__((address_space(3)))*)ptr);
}
__device__ __forceinline__ bf16x8 cat8(s16x4 a, s16x4 b) {
  bf16x8 r;
  r[0] = a[0]; r[1] = a[1]; r[2] = a[2]; r[3] = a[3];
  r[4] = b[0]; r[5] = b[1]; r[6] = b[2]; r[7] = b[3];
  return r;
}
__device__ __forceinline__ bf16x8 trfrag(const unsigned char* img, int rs, int kbase, int nbase, int lane) {
  const int g = lane >> 4, q = (lane & 15) >> 2, pp = lane & 3;
  const unsigned char* a = img + (kbase + 8 * g + q) * rs + (nbase + 4 * pp) * 2;
  s16x4 t0 = trread(a);
  s16x4 t1 = trread(a + 4 * rs);
  return cat8(t0, t1);
}

__device__ __forceinline__ int colmap_retin(int p) {
  if (p < 2048) {
    int hb = p & ~255, pp = p & 255;
    int gi = pp >> 5, half = (pp >> 4) & 1, c = pp & 15;
    return hb + half * 128 + gi * 16 + c;
  }
  return p;
}

__device__ void transpose_tile(const float* __restrict__ W, u16* __restrict__ Wt, int K, int N, int mode, int nt, int kt,
                               unsigned char* smem, const int tid) {
  float* tile = (float*)smem;
#pragma unroll
  for (int i = 0; i < 8; ++i) {
    int idx = tid + NTHR * i;
    int kk = idx >> 6, nn = idx & 63;
    int n = nt * 64 + nn;
    int src = (mode == 1) ? colmap_retin(n) : n;
    float v = 0.f;
    if (src < N) v = W[(size_t)(kt * 64 + kk) * N + src];
    tile[kk * 65 + nn] = v;
  }
  __syncthreads();
  {
    int n = tid >> 3, kc = tid & 7;
    float v[8];
#pragma unroll
    for (int j = 0; j < 8; ++j) v[j] = tile[(kc * 8 + j) * 65 + n];
    u32x4 o;
    o.x = pack2(v[0], v[1]); o.y = pack2(v[2], v[3]); o.z = pack2(v[4], v[5]); o.w = pack2(v[6], v[7]);
    *(u32x4*)(Wt + (size_t)(nt * 64 + n) * K + kt * 64 + kc * 8) = o;
  }
  __syncthreads();
}

__device__ void phase_prep(const Params& p, unsigned char* smem, const int rep) {
  const int tid = (int)p.tidx;
  for (int rr = 0; rr < rep; ++rr) {
  u16* Wt0 = (u16*)(p.ws + OFF_WT0);
  for (int t = blockIdx.x; t < 1536; t += gridDim.x)
    transpose_tile(p.ret_w_in, Wt0, 1024, 6144, 1, t >> 4, t & 15, smem, tid);
  float2* rope = (float2*)(p.ws + OFF_ROPE);
  const int gtid = blockIdx.x * NTHR + tid, gn = gridDim.x * NTHR;
  for (int idx = gtid; idx < 2056 * 128; idx += gn) {
    int pi = idx >> 7, i = idx & 127;
    int pos = pi < 2048 ? pi : 16384 + (pi - 2048);
    float freq = (float)exp2(-(double)i * (13.287712379549449 / 128.0));
    float ang = (float)pos * freq;
    float sn, cs;
    sincosf(ang, &sn, &cs);
    rope[idx] = make_float2(cs, sn);
  }
  u16* H = (u16*)(p.ws + OFF_H);
  const int lane = tid & 63, w = (int)p.wv;
  for (int row = blockIdx.x * 8 + w; row < T_TOK; row += gridDim.x * 8) {
    const float* xr = xrow(p, row);
    float4 v[4];
    float ss = 0.f;
#pragma unroll
    for (int i = 0; i < 4; ++i) {
      v[i] = *(const float4*)(xr + i * 256 + lane * 4);
      ss += v[i].x * v[i].x + v[i].y * v[i].y + v[i].z * v[i].z + v[i].w * v[i].w;
    }
    ss = wave_sum(ss);
    float rstd = rsqrtf(ss * (1.0f / 1024.0f) + 1e-6f);
#pragma unroll
    for (int i = 0; i < 4; ++i) {
      float4 gg = *(const float4*)(p.ret_norm + i * 256 + lane * 4);
      u32x2 o;
      o.x = pack2(v[i].x * rstd * gg.x, v[i].y * rstd * gg.y);
      o.y = pack2(v[i].z * rstd * gg.z, v[i].w * rstd * gg.w);
      *(u32x2*)(H + (size_t)row * 1024 + i * 256 + lane * 4) = o;
    }
  }
  }
}

__device__ void transpose_later_weights(const Params& p, unsigned char* smem, const int first_blk) {
  const int tid = (int)p.tidx;
  u16* Wt1 = (u16*)(p.ws + OFF_WT1);
  u16* Wt2 = (u16*)(p.ws + OFF_WT2);
  u16* Wt3 = (u16*)(p.ws + OFF_WT3);
  const int n1 = 512, n2 = 1568, n3 = 512;
  if ((int)blockIdx.x < first_blk) return;
  const int nb = (int)gridDim.x - first_blk;
  for (int t = (int)blockIdx.x - first_blk; t < n1 + n2 + n3; t += nb) {
    if (t < n1) {
      transpose_tile(p.ret_w_out, Wt1, 2048, 1024, 0, t >> 5, t & 31, smem, tid);
    } else if (t < n1 + n2) {
      int u = t - n1;
      transpose_tile(p.ssm_w_in, Wt2, 1024, 6176, 0, u >> 4, u & 15, smem, tid);
    } else {
      int u = t - n1 - n2;
      transpose_tile(p.ssm_w_out, Wt3, 2048, 1024, 0, u >> 5, u & 31, smem, tid);
    }
  }
}

template <int MODE>
__device__ void phase_norm(const Params& p, const float* __restrict__ X, const float* __restrict__ gain, const int rep) {
  const int tid = (int)p.tidx, lane = tid & 63, w = (int)p.wv;
  u16* H = (u16*)(p.ws + OFF_H);
  for (int row0 = blockIdx.x * 8 + w; row0 < T_TOK * rep; row0 += gridDim.x * 8) {
    const int row = row0 % T_TOK;
    const float* xr = X + (size_t)row * 1024;
    float4 v[4];
    float ss = 0.f;
#pragma unroll
    for (int i = 0; i < 4; ++i) {
      v[i] = *(const float4*)(xr + i * 256 + lane * 4);
      ss += v[i].x * v[i].x + v[i].y * v[i].y + v[i].z * v[i].z + v[i].w * v[i].w;
    }
    ss = wave_sum(ss);
    float rstd = rsqrtf(ss * (1.0f / 1024.0f) + 1e-6f);
#pragma unroll
    for (int i = 0; i < 4; ++i) {
      float4 gg = *(const float4*)(gain + i * 256 + lane * 4);
      if (MODE == 0) {
        u32x2 o;
        o.x = pack2(v[i].x * rstd * gg.x, v[i].y * rstd * gg.y);
        o.y = pack2(v[i].z * rstd * gg.z, v[i].w * rstd * gg.w);
        *(u32x2*)(H + (size_t)row * 1024 + i * 256 + lane * 4) = o;
      } else {
        float4 o = make_float4(v[i].x * rstd * gg.x, v[i].y * rstd * gg.y, v[i].z * rstd * gg.z, v[i].w * rstd * gg.w);
        *(float4*)(p.out + OUT_Y + (size_t)row * 1024 + i * 256 + lane * 4) = o;
      }
    }
  }
}

template <int EPI, int NH>
__device__ void gemm_phase(const Params& p, const u16* __restrict__ A, const u16* __restrict__ Bt, const int K, const int NT,
                           const float* __restrict__ resid, float* __restrict__ outf, unsigned char* smem, const int rep,
                           const int mtiles, const int nt0 = 0, const bool rev = false) {
  constexpr int BM = 256, BN = 128, BK = 64, LR = 144;
  constexpr int BUFB = (BM + BN) * LR;
  float* rstdS = (float*)(smem + 2 * BUFB);
  const int tid = (int)p.tidx, lane = tid & 63, w = (int)p.wv;
  const int wm = w >> 1, wn = w & 1, l15 = lane & 15, g = lane >> 4;
  const int KT = K / BK;
  const int ntiles = mtiles * NT;
  const float* parts = (const float*)(p.ws + OFF_PARTS);
  const int srow = tid >> 3, skc = tid & 7;

  for (int tile0 = rev ? (int)(gridDim.x - 1 - blockIdx.x) : (int)blockIdx.x; tile0 < ntiles * rep; tile0 += gridDim.x) {
    const int tile = tile0 % ntiles;
    const int mt = tile / NT, nt = tile - mt * NT + nt0;
    const int m0 = mt * BM, n0 = nt * BN;
    const bool skip_mma = (EPI == 2) && (n0 >= 6144) && (wn == 1);
    if (NH > 0) {
      for (int idx = tid; idx < BM * NH; idx += NTHR) {
        int row = idx / NH, h = idx % NH;
        const float* pp = parts + (size_t)(m0 + row) * 64 + h * (64 / NH);
        float s = 0.f;
#pragma unroll
        for (int q = 0; q < 64 / NH; ++q) s += pp[q];
        rstdS[idx] = rsqrtf(s / (float)(K / NH) + 1e-6f);
      }
    }
    u32x4 ra[2][4], rb[2][2];
    const u16* ap = A + (size_t)(m0 + srow) * K + skc * 8;
    const u16* bp = Bt + (size_t)(n0 + srow) * K + skc * 8;
#pragma unroll
    for (int i = 0; i < 4; ++i) ra[0][i] = *(const u32x4*)(ap + (size_t)(64 * i) * K);
#pragma unroll
    for (int i = 0; i < 2; ++i) rb[0][i] = *(const u32x4*)(bp + (size_t)(64 * i) * K);
#pragma unroll
    for (int i = 0; i < 4; ++i) ra[1][i] = *(const u32x4*)(ap + (size_t)(64 * i) * K + BK);
#pragma unroll
    for (int i = 0; i < 2; ++i) rb[1][i] = *(const u32x4*)(bp + (size_t)(64 * i) * K + BK);
    {
      unsigned char* base = smem;
#pragma unroll
      for (int i = 0; i < 4; ++i) *(u32x4*)(base + (srow + 64 * i) * LR + skc * 16) = ra[0][i];
#pragma unroll
      for (int i = 0; i < 2; ++i) *(u32x4*)(base + BM * LR + (srow + 64 * i) * LR + skc * 16) = rb[0][i];
    }
    __syncthreads();

    f32x4 acc[4][4];
    f32x4 accT[4][4];
#pragma unroll
    for (int i = 0; i < 4; ++i)
#pragma unroll
      for (int j = 0; j < 4; ++j) {
        acc[i][j] = (f32x4){0.f, 0.f, 0.f, 0.f};
        accT[i][j] = (f32x4){0.f, 0.f, 0.f, 0.f};
      }

    for (int kt2 = 0; kt2 < KT; kt2 += 2) {
#pragma unroll
     for (int par = 0; par < 2; ++par) {
      const int kt = kt2 + par;
      if (kt + 2 < KT) {
#pragma unroll
        for (int i = 0; i < 4; ++i) ra[par][i] = *(const u32x4*)(ap + (size_t)(64 * i) * K + (kt + 2) * BK);
#pragma unroll
        for (int i = 0; i < 2; ++i) rb[par][i] = *(const u32x4*)(bp + (size_t)(64 * i) * K + (kt + 2) * BK);
      }
      const unsigned char* abase = smem + par * BUFB + (wm * 64 + l15) * LR + g * 16;
      const unsigned char* bbase = smem + par * BUFB + BM * LR + (wn * 64 + l15) * LR + g * 16;
      if (!skip_mma)
#pragma unroll
      for (int ks = 0; ks < 2; ++ks) {
        bf16x8 af[4], bfr[2];
#pragma unroll
        for (int mf = 0; mf < 4; ++mf) af[mf] = *(const bf16x8*)(abase + mf * 16 * LR + ks * 64);
#pragma unroll
        for (int nh = 0; nh < 2; ++nh) {
#pragma unroll
          for (int n2 = 0; n2 < 2; ++n2) bfr[n2] = *(const bf16x8*)(bbase + (nh * 2 + n2) * 16 * LR + ks * 64);
#pragma unroll
          for (int mf = 0; mf < 4; ++mf)
#pragma unroll
            for (int n2 = 0; n2 < 2; ++n2)
              acc[mf][nh * 2 + n2] = __builtin_amdgcn_mfma_f32_16x16x32_bf16(af[mf], bfr[n2], acc[mf][nh * 2 + n2], 0, 0, 0);
        }
      }
      if (NH > 0) {
        const int per = KT / NH;
        if (((kt + 1) % per) == 0) {
          const int h = (kt + 1) / per - 1;
#pragma unroll
          for (int mf = 0; mf < 4; ++mf)
#pragma unroll
            for (int r = 0; r < 4; ++r) {
              float s = rstdS[(wm * 64 + mf * 16 + 4 * g + r) * NH + h];
#pragma unroll
              for (int nf = 0; nf < 4; ++nf) {
                accT[mf][nf][r] += s * acc[mf][nf][r];
                acc[mf][nf][r] = 0.f;
              }
            }
        }
      }
      if (kt + 1 < KT) {
        unsigned char* base = smem + (par ^ 1) * BUFB;
#pragma unroll
        for (int i = 0; i < 4; ++i) *(u32x4*)(base + (srow + 64 * i) * LR + skc * 16) = ra[par ^ 1][i];
#pragma unroll
        for (int i = 0; i < 2; ++i) *(u32x4*)(base + BM * LR + (srow + 64 * i) * LR + skc * 16) = rb[par ^ 1][i];
      }
      __syncthreads();
     }
    }

#pragma unroll
    for (int mf = 0; mf < 4; ++mf) {
      __builtin_amdgcn_sched_barrier(0);
      float rvv[4][4];
      if (EPI == 1) {
#pragma unroll
        for (int r = 0; r < 4; ++r) {
          const int row = m0 + wm * 64 + mf * 16 + 4 * g + r;
#pragma unroll
          for (int nf = 0; nf < 4; ++nf) {
            const int col = n0 + wn * 64 + nf * 16 + l15;
            rvv[r][nf] = resid ? resid[(size_t)row * 1024 + col] : xrow(p, row)[col];
          }
        }
      }
#pragma unroll
      for (int r = 0; r < 4; ++r) {
        const int row = m0 + wm * 64 + mf * 16 + 4 * g + r;
        if (EPI == 0) {
          u16* proj = (u16*)(p.ws + OFF_PROJ) + (size_t)row * PROJ_LD;
          if (n0 < 2048) {
            const float2* rope = (const float2*)(p.ws + OFF_ROPE);
            const int pi = row < NPROMPT ? (row & 2047) : 2048 + ((row - NPROMPT) & 7);
#pragma unroll
            for (int np = 0; np < 2; ++np) {
              const int pc = n0 + wn * 64 + np * 32;
              const int i = ((pc & 255) >> 5) * 16 + l15;
              const float2 cs = rope[pi * 128 + i];
              const float x1 = acc[mf][2 * np][r], x2 = acc[mf][2 * np + 1][r];
              float y1 = x1 * cs.x - x2 * cs.y, y2 = x1 * cs.y + x2 * cs.x;
              if (pc >= 1024) { y1 *= 0.0625f; y2 *= 0.0625f; }
              const int f1 = (pc & ~255) + i;
              proj[f1] = f2bf(y1);
              proj[f1 + 128] = f2bf(y2);
            }
          } else {
#pragma unroll
            for (int nf = 0; nf < 4; ++nf) proj[n0 + wn * 64 + nf * 16 + l15] = f2bf(acc[mf][nf][r]);
          }
        } else if (EPI == 1) {
#pragma unroll
          for (int nf = 0; nf < 4; ++nf) {
            const int col = n0 + wn * 64 + nf * 16 + l15;
            const float a = (NH > 0) ? accT[mf][nf][r] : acc[mf][nf][r];
            outf[(size_t)row * 1024 + col] = rvv[r][nf] + a;
          }
        } else {
          u16* proj = (u16*)(p.ws + OFF_PROJ) + (size_t)row * PROJ_LD;
          float* dtraw = (float*)(p.ws + OFF_DTRAW) + (size_t)row * 32;
          float* cvo = nullptr;
          if (row < NPROMPT) {
            const int t = row & 2047;
            if (t >= 2045) cvo = p.out + OUT_CONVP + ((size_t)(row >> 11) * 3 + (t - 2045)) * 4096;
          } else {
            const int rs = row - NPROMPT, t = rs & 7;
            if (t >= 5) cvo = p.out + OUT_CONVS + ((size_t)(rs >> 3) * 3 + (t - 5)) * 4096;
          }
#pragma unroll
          for (int nf = 0; nf < 4; ++nf) {
            const int col = n0 + wn * 64 + nf * 16 + l15;
            const float a = acc[mf][nf][r];
            if (col < 6144) {
              proj[col] = f2bf(a);
              if (col >= 2048 && cvo) cvo[col - 2048] = a;
            } else if (col < 6176) {
              dtraw[col - 6144] = a;
            }
          }
        }
      }
    }
  }
}


template <int NH>
__device__ void gemm_sample_rows(const Params& p, const u16* __restrict__ A, const u16* __restrict__ Bt,
                                 const float* __restrict__ resid, float* __restrict__ outf, unsigned char* smem, const int rep) {
  constexpr int K = 2048, RS = 65;
  float* red = (float*)smem;
  float* rstdS = red + 8 * 64 * RS;
  const int tid = (int)p.tidx, lane = tid & 63, w = (int)p.wv, l15 = lane & 15, g = lane >> 4;
  const float* parts = (const float*)(p.ws + OFF_PARTS);
  for (int item0 = blockIdx.x; item0 < 256 * rep; item0 += gridDim.x) {
    const int item = item0 & 255;
    const int m0 = NPROMPT + (item >> 4) * 64, n0 = (item & 15) * 64;
    for (int idx = tid; idx < 64 * NH; idx += NTHR) {
      const int row = idx / NH, h = idx % NH;
      const float* pp = parts + (size_t)(m0 + row) * 64 + h * (64 / NH);
      float sm = 0.f;
#pragma unroll
      for (int q = 0; q < 64 / NH; ++q) sm += pp[q];
      rstdS[idx] = rsqrtf(sm / (float)(K / NH) + 1e-6f);
    }
    f32x4 acc[4][4];
#pragma unroll
    for (int i = 0; i < 4; ++i)
#pragma unroll
      for (int j = 0; j < 4; ++j) acc[i][j] = (f32x4){0.f, 0.f, 0.f, 0.f};
    const u16* ap = A + (size_t)(m0 + l15) * K + w * 256 + 8 * g;
    const u16* bp = Bt + (size_t)(n0 + l15) * K + w * 256 + 8 * g;
#pragma unroll 2
    for (int ks = 0; ks < 8; ++ks) {
      bf16x8 af[4], bfr[4];
#pragma unroll
      for (int mf = 0; mf < 4; ++mf) af[mf] = *(const bf16x8*)(ap + (size_t)(mf * 16) * K + ks * 32);
#pragma unroll
      for (int nf = 0; nf < 4; ++nf) bfr[nf] = *(const bf16x8*)(bp + (size_t)(nf * 16) * K + ks * 32);
#pragma unroll
      for (int mf = 0; mf < 4; ++mf)
#pragma unroll
        for (int nf = 0; nf < 4; ++nf)
          acc[mf][nf] = __builtin_amdgcn_mfma_f32_16x16x32_bf16(af[mf], bfr[nf], acc[mf][nf], 0, 0, 0);
    }
    __syncthreads();
    {
      const int h = (w * 256) / (K / NH);
#pragma unroll
      for (int mf = 0; mf < 4; ++mf)
#pragma unroll
        for (int r = 0; r < 4; ++r) {
          const int row = mf * 16 + 4 * g + r;
          const float sc = rstdS[row * NH + h];
#pragma unroll
          for (int nf = 0; nf < 4; ++nf) red[(w * 64 + row) * RS + nf * 16 + l15] = acc[mf][nf][r] * sc;
        }
    }
    __syncthreads();
    {
      const int row = tid >> 3, c0 = (tid & 7) * 8;
      float o[8];
      const size_t gidx = (size_t)(m0 + row) * 1024 + n0 + c0;
      const float* rp = resid ? resid + gidx : p.x_sample + (size_t)(m0 - NPROMPT + row) * 1024 + n0 + c0;
      const float4 r0 = *(const float4*)rp, r1 = *(const float4*)(rp + 4);
      o[0] = r0.x; o[1] = r0.y; o[2] = r0.z; o[3] = r0.w; o[4] = r1.x; o[5] = r1.y; o[6] = r1.z; o[7] = r1.w;
#pragma unroll
      for (int ww = 0; ww < 8; ++ww)
#pragma unroll
        for (int j = 0; j < 8; ++j) o[j] += red[(ww * 64 + row) * RS + c0 + j];
      *(float4*)(outf + gidx) = make_float4(o[0], o[1], o[2], o[3]);
      *(float4*)(outf + gidx + 4) = make_float4(o[4], o[5], o[6], o[7]);
    }
    __syncthreads();
  }
}

__device__ __forceinline__ int lds_byte(int r, int c) {
  int st = (r >> 4) * 2 + (c >> 5), rr = r & 15, cc = c & 31, ob = rr * 64 + cc * 2;
  return st * 1024 + (ob ^ (((ob >> 9) & 1) << 5));
}
__device__ __forceinline__ void stage_rc(int b, int& R, int& C) {
  int st = b / 1024, sb = b % 1024, swz = sb ^ (((sb >> 9) & 1) << 5);
  R = (st >> 1) * 16 + swz / 64;
  C = (st & 1) * 32 + (swz % 64) / 2;
}

template <int EPI>
__device__ void gemm8_phase(const Params& p, const u16* __restrict__ A, const u16* __restrict__ Bt, const int K, const int nN,
                            unsigned char* smem, const int rep) {
  constexpr int BM8 = 256, BK8 = 64, HALF = 128, NXCD = 8, WGM = 8, HT = HALF * BK8;
  u16* shm = (u16*)smem;
#define SA(b, h) (shm + ((b) * 2 + (h)) * HT)
#define SB(b, h) (shm + (4 + (b) * 2 + (h)) * HT)
#define STAGE(P, BASE, br, kt)                                                                            \
  do {                                                                                                    \
    const int _so = ((br) * K + (kt) * BK8) * 2;                                                          \
    __builtin_amdgcn_raw_ptr_buffer_load_lds(rsrc_##BASE, (__attribute__((address_space(3))) unsigned*)((char*)(P) + (int)p.tidx * 16), 16, voff0, _so, 0, 0); \
    __builtin_amdgcn_raw_ptr_buffer_load_lds(rsrc_##BASE, (__attribute__((address_space(3))) unsigned*)((char*)(P) + (int)p.tidx * 16 + 8192), 16, voff1, _so, 0, 0); \
  } while (0)
#define LDA(dst, b, h)                                                                                    \
  for (int m = 0; m < 4; ++m)                                                                             \
    for (int k = 0; k < 2; ++k)                                                                           \
      dst[m][k] = *reinterpret_cast<const bf16x8*>((char*)SA(b, h) + lds_byte(wr * 64 + m * 16 + fr, k * 32 + fq * 8))
#define LDB(dst, b, h)                                                                                    \
  for (int n = 0; n < 2; ++n)                                                                             \
    for (int k = 0; k < 2; ++k)                                                                           \
      dst[n][k] = *reinterpret_cast<const bf16x8*>((char*)SB(b, h) + lds_byte(wc * 32 + n * 16 + fr, k * 32 + fq * 8))
#define MMA(ai, bj, At, Bx)                                                                               \
  do {                                                                                                    \
    __builtin_amdgcn_s_setprio(1);                                                                        \
    for (int m = 0; m < 4; ++m)                                                                           \
      for (int n = 0; n < 2; ++n)                                                                         \
        for (int k = 0; k < 2; ++k)                                                                       \
          acc[ai][bj][m][n] = __builtin_amdgcn_mfma_f32_16x16x32_bf16(At[m][k], Bx[n][k], acc[ai][bj][m][n], 0, 0, 0); \
    __builtin_amdgcn_s_setprio(0);                                                                        \
  } while (0)
#define WAIT_V(n) asm volatile("s_waitcnt vmcnt(" #n ")" ::: "memory")
#define WAIT_L(n) asm volatile("s_waitcnt lgkmcnt(" #n ")" ::: "memory")
#define BAR __builtin_amdgcn_s_barrier()
#define SCHED __builtin_amdgcn_sched_barrier(0)

  const int nM = T_TOK / BM8, nwg = nM * nN;
  const int wid = (int)p.wv, lane = (int)p.tidx & 63, wr = wid >> 2, wc = wid & 3, fr = lane & 15, fq = lane >> 4;
  const int nt = K / BK8;
  const __amdgpu_buffer_rsrc_t rsrc_A = __builtin_amdgcn_make_buffer_rsrc((void*)A, (short)0, T_TOK * K * 2, 0x00020000);
  const __amdgpu_buffer_rsrc_t rsrc_Bt = __builtin_amdgcn_make_buffer_rsrc((void*)Bt, (short)0, nN * 256 * K * 2, 0x00020000);
  int voff0, voff1;
  {
    int r_, c_;
    stage_rc((int)p.tidx * 16, r_, c_);
    voff0 = (r_ * K + c_) * 2;
    stage_rc((int)p.tidx * 16 + 8192, r_, c_);
    voff1 = (r_ * K + c_) * 2;
  }

  for (int tile0 = blockIdx.x; tile0 < nwg * rep; tile0 += gridDim.x) {
    const int tile = tile0 % nwg;
    int wgid = tile;
    {
      int q = nwg / NXCD, r = nwg % NXCD, xcd = wgid % NXCD, off = wgid / NXCD;
      wgid = (xcd < r ? xcd * (q + 1) : r * (q + 1) + (xcd - r) * q) + off;
    }
    const int nig = WGM * nN, gid = wgid / nig, fm = gid * WGM, gsz = min(nM - fm, WGM);
    const int pm = fm + ((wgid % nig) % gsz), pn = (wgid % nig) / gsz, brow = pm * BM8, bcol = pn * BM8;

    f32x4 acc[2][2][4][2];
#pragma unroll
    for (int a = 0; a < 2; ++a)
#pragma unroll
      for (int b = 0; b < 2; ++b)
#pragma unroll
        for (int m = 0; m < 4; ++m)
#pragma unroll
          for (int n = 0; n < 2; ++n) acc[a][b][m][n] = (f32x4){0.f, 0.f, 0.f, 0.f};
    bf16x8 At[4][2], B0[2][2], B1[2][2];

    STAGE(SB(0, 0), Bt, bcol, 0); STAGE(SA(0, 0), A, brow, 0);
    STAGE(SB(0, 1), Bt, bcol + HALF, 0); STAGE(SA(0, 1), A, brow + HALF, 0);
    if (wr == 1) BAR;
    WAIT_V(4); BAR;
    STAGE(SB(1, 0), Bt, bcol, 1); STAGE(SA(1, 0), A, brow, 1); STAGE(SB(1, 1), Bt, bcol + HALF, 1);
    WAIT_V(6); BAR;
    for (int t = 0; t < nt - 2; t += 2) {
      LDB(B0, 0, 0); SCHED; LDA(At, 0, 0); STAGE(SA(1, 1), A, brow + HALF, t + 1);
      WAIT_L(8); BAR; WAIT_L(0); MMA(0, 0, At, B0); BAR; SCHED;
      LDB(B1, 0, 1); STAGE(SB(0, 0), Bt, bcol, t + 2);
      BAR; WAIT_L(0); MMA(0, 1, At, B1); BAR;
      LDA(At, 0, 1); STAGE(SA(0, 0), A, brow, t + 2);
      BAR; WAIT_L(0); MMA(1, 0, At, B0); BAR; SCHED;
      STAGE(SB(0, 1), Bt, bcol + HALF, t + 2);
      WAIT_V(6); BAR; MMA(1, 1, At, B1); BAR;
      LDB(B0, 1, 0); SCHED; LDA(At, 1, 0); STAGE(SA(0, 1), A, brow + HALF, t + 2);
      WAIT_L(8); BAR; WAIT_L(0); MMA(0, 0, At, B0); BAR; SCHED;
      LDB(B1, 1, 1); STAGE(SB(1, 0), Bt, bcol, t + 3);
      BAR; WAIT_L(0); MMA(0, 1, At, B1); BAR;
      LDA(At, 1, 1); STAGE(SA(1, 0), A, brow, t + 3);
      BAR; WAIT_L(0); MMA(1, 0, At, B0); BAR; SCHED;
      STAGE(SB(1, 1), Bt, bcol + HALF, t + 3);
      WAIT_V(6); BAR; MMA(1, 1, At, B1); BAR;
    }
    {
      LDB(B0, 0, 0); LDA(At, 0, 0); STAGE(SA(1, 1), A, brow + HALF, nt - 1);
      BAR; WAIT_L(0); MMA(0, 0, At, B0); BAR; SCHED;
      LDB(B1, 0, 1); BAR; WAIT_L(0); MMA(0, 1, At, B1); BAR; SCHED;
      LDA(At, 0, 1); WAIT_V(4); BAR; WAIT_L(0); MMA(1, 0, At, B0); MMA(1, 1, At, B1); BAR; SCHED;
    }
    {
      LDB(B0, 1, 0); LDA(At, 1, 0); WAIT_V(2); BAR; WAIT_L(0); MMA(0, 0, At, B0); BAR; SCHED;
      LDB(B1, 1, 1); WAIT_V(0); BAR; WAIT_L(0); MMA(0, 1, At, B1); BAR; SCHED;
      LDA(At, 1, 1); BAR; WAIT_L(0); MMA(1, 0, At, B0); MMA(1, 1, At, B1); BAR; SCHED;
    }
    if (wr == 0) BAR;

    u16* projb = (u16*)(p.ws + OFF_PROJ);
#pragma unroll
    for (int ai = 0; ai < 2; ++ai)
#pragma unroll
      for (int m = 0; m < 4; ++m) {
        if (EPI == 0 && bcol < 2048) {
          const float2* rope = (const float2*)(p.ws + OFF_ROPE);
#pragma unroll
          for (int bj = 0; bj < 2; ++bj) {
            __builtin_amdgcn_sched_barrier(0);
            const int pc = bcol + bj * HALF + wc * 32;
            const int i = ((pc & 255) >> 5) * 16 + fr;
            const int f1 = (pc & ~255) + i;
            float2 csv[4];
#pragma unroll
            for (int j = 0; j < 4; ++j) {
              const int row = brow + ai * HALF + wr * 64 + m * 16 + fq * 4 + j;
              const int pi = row < NPROMPT ? (row & 2047) : 2048 + ((row - NPROMPT) & 7);
              csv[j] = rope[pi * 128 + i];
            }
#pragma unroll
            for (int j = 0; j < 4; ++j) {
              const int row = brow + ai * HALF + wr * 64 + m * 16 + fq * 4 + j;
              u16* proj = projb + (size_t)row * PROJ_LD;
              const float2 cs = csv[j];
              const float x1 = acc[ai][bj][m][0][j], x2 = acc[ai][bj][m][1][j];
              float y1 = x1 * cs.x - x2 * cs.y, y2 = x1 * cs.y + x2 * cs.x;
              if (pc >= 1024) { y1 *= 0.0625f; y2 *= 0.0625f; }
              proj[f1] = f2bf(y1);
              proj[f1 + 128] = f2bf(y2);
            }
          }
        } else {
#pragma unroll
          for (int j = 0; j < 4; ++j) {
            __builtin_amdgcn_sched_barrier(0);
            const int row = brow + ai * HALF + wr * 64 + m * 16 + fq * 4 + j;
            u16* proj = projb + (size_t)row * PROJ_LD;
            float* cvo = nullptr;
            if (EPI == 2 && bcol >= 2048) {
              if (row < NPROMPT) {
                const int t = row & 2047;
                if (t >= 2045) cvo = p.out + OUT_CONVP + ((size_t)(row >> 11) * 3 + (t - 2045)) * 4096;
              } else {
                const int rs = row - NPROMPT, t = rs & 7;
                if (t >= 5) cvo = p.out + OUT_CONVS + ((size_t)(rs >> 3) * 3 + (t - 5)) * 4096;
              }
            }
#pragma unroll
            for (int bj = 0; bj < 2; ++bj)
#pragma unroll
              for (int n = 0; n < 2; ++n) {
                const int col = bcol + bj * HALF + wc * 32 + n * 16 + fr;
                const float a = acc[ai][bj][m][n][j];
                proj[col] = f2bf(a);
                if (EPI == 2 && cvo) cvo[col - 2048] = a;
              }
          }
        }
      }
  }
#undef SA
#undef SB
#undef STAGE
#undef LDA
#undef LDB
#undef MMA
#undef WAIT_V
#undef WAIT_L
#undef BAR
#undef SCHED
}

__device__ __forceinline__ void unpack8(const u32x4 u, float* xv) {
  xv[0] = bf2f((u16)(u.x & 0xffff)); xv[1] = bf2f((u16)(u.x >> 16));
  xv[2] = bf2f((u16)(u.y & 0xffff)); xv[3] = bf2f((u16)(u.y >> 16));
  xv[4] = bf2f((u16)(u.z & 0xffff)); xv[5] = bf2f((u16)(u.z >> 16));
  xv[6] = bf2f((u16)(u.w & 0xffff)); xv[7] = bf2f((u16)(u.w >> 16));
}

__device__ void phase_conv(const Params& p, unsigned char* smem, const int rep) {
  const int tid = (int)p.tidx;
  const float* dtraw = (const float*)(p.ws + OFF_DTRAW);
  float* dtv = (float*)(p.ws + OFF_DT);
  float* cumv = (float*)(p.ws + OFF_CUM);
  {
    float* laS = (float*)smem;
    const int tok = tid >> 3, h0 = (tid & 7) * 4;
    const float4 bias = *(const float4*)(p.ssm_dt_bias + h0);
    const float4 al = *(const float4*)(p.ssm_a_log + h0);
    const float4 an = make_float4(-expf(al.x), -expf(al.y), -expf(al.z), -expf(al.w));
    for (int sc = blockIdx.x; sc < 384; sc += gridDim.x) {
      int row0, len;
      if (sc < 256) { row0 = sc * 64; len = 64; } else { row0 = NPROMPT + (sc - 256) * 8; len = 8; }
      if (tok < len) {
        const float4 x = *(const float4*)(dtraw + (size_t)(row0 + tok) * 32 + h0);
        float4 dt;
        { float v = x.x + bias.x; dt.x = v > 20.f ? v : log1pf(expf(v)); }
        { float v = x.y + bias.y; dt.y = v > 20.f ? v : log1pf(expf(v)); }
        { float v = x.z + bias.z; dt.z = v > 20.f ? v : log1pf(expf(v)); }
        { float v = x.w + bias.w; dt.w = v > 20.f ? v : log1pf(expf(v)); }
        *(float4*)(dtv + (size_t)(row0 + tok) * 32 + h0) = dt;
        *(float4*)(laS + tok * 32 + h0) = make_float4(dt.x * an.x * 1.4426950408889634f, dt.y * an.y * 1.4426950408889634f,
                                                      dt.z * an.z * 1.4426950408889634f, dt.w * an.w * 1.4426950408889634f);
      }
      __syncthreads();
      if (tok < len) {
        float4 c = make_float4(0.f, 0.f, 0.f, 0.f);
        for (int t = 0; t <= tok; ++t) {
          const float4 v = *(const float4*)(laS + t * 32 + h0);
          c.x += v.x; c.y += v.y; c.z += v.z; c.w += v.w;
        }
        *(float4*)(cumv + (size_t)(row0 + tok) * 32 + h0) = c;
      }
      __syncthreads();
    }
  }
  const u16* proj = (const u16*)(p.ws + OFF_PROJ);
  u16* xbcc = (u16*)(p.ws + OFF_XBCC);
  const int gtid = blockIdx.x * NTHR + tid;
  const int ch0 = (gtid & 511) * 8, rb = gtid >> 9;
  float wgt[4][8], bs[8];
#pragma unroll
  for (int wv = 0; wv < 4; ++wv) {
    const float4 w0 = *(const float4*)(p.ssm_conv_w + (size_t)wv * 4096 + ch0);
    const float4 w1 = *(const float4*)(p.ssm_conv_w + (size_t)wv * 4096 + ch0 + 4);
    wgt[wv][0] = w0.x; wgt[wv][1] = w0.y; wgt[wv][2] = w0.z; wgt[wv][3] = w0.w;
    wgt[wv][4] = w1.x; wgt[wv][5] = w1.y; wgt[wv][6] = w1.z; wgt[wv][7] = w1.w;
  }
  {
    const float4 b0 = *(const float4*)(p.ssm_conv_b + ch0), b1 = *(const float4*)(p.ssm_conv_b + ch0 + 4);
    bs[0] = b0.x; bs[1] = b0.y; bs[2] = b0.z; bs[3] = b0.w; bs[4] = b1.x; bs[5] = b1.y; bs[6] = b1.z; bs[7] = b1.w;
  }
  const int rows_per = T_TOK / (int)(gridDim.x * NTHR / 512);
  for (int rr = 0; rr < rep; ++rr) {
    float hm3[8], hm2[8], hm1[8];
    const int rbeg = rb * rows_per;
    u32x4 cur[4], nxt[4];
#pragma unroll
    for (int q = 0; q < 4; ++q) cur[q] = *(const u32x4*)(proj + (size_t)(rbeg + q) * PROJ_LD + 2048 + ch0);
    for (int r4 = 0; r4 < rows_per; r4 += 4) {
#pragma unroll
      for (int q = 0; q < 4; ++q) {
        nxt[q] = cur[q];
        if (r4 + 4 + q < rows_per) nxt[q] = *(const u32x4*)(proj + (size_t)(rbeg + r4 + 4 + q) * PROJ_LD + 2048 + ch0);
      }
#pragma unroll
      for (int q4 = 0; q4 < 4; ++q4) {
        const int r = r4 + q4;
        const int row = rbeg + r;
        const bool samp = row >= NPROMPT;
        const int t = samp ? ((row - NPROMPT) & 7) : (row & 2047);
        const int b = samp ? ((row - NPROMPT) >> 3) : (row >> 11);
        if (r == 0 || t == 0) {
#pragma unroll
          for (int k = 1; k <= 3; ++k) {
            float hv[8];
            if (t - k >= 0) {
              unpack8(*(const u32x4*)(proj + (size_t)(row - k) * PROJ_LD + 2048 + ch0), hv);
            } else if (samp) {
              const float* sp = p.state_conv + ((size_t)b * 3 + (t - k + 3)) * 4096 + ch0;
              const float4 s0 = *(const float4*)sp, s1 = *(const float4*)(sp + 4);
              hv[0] = s0.x; hv[1] = s0.y; hv[2] = s0.z; hv[3] = s0.w; hv[4] = s1.x; hv[5] = s1.y; hv[6] = s1.z; hv[7] = s1.w;
            } else {
#pragma unroll
              for (int q = 0; q < 8; ++q) hv[q] = 0.f;
            }
#pragma unroll
            for (int q = 0; q < 8; ++q) {
              if (k == 1) hm1[q] = hv[q];
              if (k == 2) hm2[q] = hv[q];
              if (k == 3) hm3[q] = hv[q];
            }
          }
        }
        float xc[8], o[8];
        unpack8(cur[q4], xc);
#pragma unroll
        for (int q = 0; q < 8; ++q) {
          const float a = bs[q] + hm3[q] * wgt[0][q] + hm2[q] * wgt[1][q] + hm1[q] * wgt[2][q] + xc[q] * wgt[3][q];
          o[q] = silu(a);
          hm3[q] = hm2[q]; hm2[q] = hm1[q]; hm1[q] = xc[q];
        }
        u32x4 ov;
        ov.x = pack2(o[0], o[1]); ov.y = pack2(o[2], o[3]); ov.z = pack2(o[4], o[5]); ov.w = pack2(o[6], o[7]);
        *(u32x4*)(xbcc + (size_t)row * 4096 + ch0) = ov;
      }
#pragma unroll
      for (int q = 0; q < 4; ++q) cur[q] = nxt[q];
    }
  }
}

template <int DK, int MODE>
__device__ void rec_prompt_item(const Params& p, const int item, unsigned char* smem) {
  constexpr int QS = (DK + 16) * 2;
  constexpr int VS = 160, PS = 144;
  constexpr int MF = DK / 128;
  constexpr int KS = DK / 32;
  constexpr int KUNR = 4;
  constexpr int NQ = DK / 64;
  constexpr int CPR = DK / 8;
  unsigned char* Qs = smem;
  unsigned char* Ks = Qs + 64 * QS;
  unsigned char* STs = Ks + 64 * QS;
  unsigned char* Vs = STs + 64 * QS;
  unsigned char* Vts = Vs + 64 * VS;
  unsigned char* Ps = Vts + 64 * VS;
  float* cumS = (float*)(Ps + 64 * PS);
  float* uS = cumS + 64;

  const int tid = (int)p.tidx, lane = tid & 63, w = tid >> 6;
  const int l15 = lane & 15, g = lane >> 4;
  const int b = item >> 5;
  const int h = (MODE == 0) ? ((item >> 3) & 3) : (item & 31);
  const int s = (MODE == 0) ? (item & 7) : 0;
  const int row0 = b * 2048;

  const u16* src;
  int sstride, qcol, kcol, vcol;
  if (MODE == 0) {
    src = (const u16*)(p.ws + OFF_PROJ); sstride = PROJ_LD;
    qcol = h * 256; kcol = 1024 + h * 256; vcol = 2048 + h * 512 + s * 64;
  } else {
    src = (const u16*)(p.ws + OFF_XBCC); sstride = 4096;
    qcol = 3072 + (h >> 2) * 128; kcol = 2048 + (h >> 2) * 128; vcol = h * 64;
  }
  const float* dtv = (const float*)(p.ws + OFF_DT);
  const float* cumv = (const float*)(p.ws + OFF_CUM);
  const float lg = (MODE == 0) ? log2f(1.0f - exp2f(-5.0f - (float)h)) : 0.f;

  const int vrow = tid >> 3, vkc = tid & 7;
  const int jt = tid & 63;

  constexpr int NSET = (MODE == 1) ? 2 : 1;
  u32x4 rq[2][NQ], rk[2][NQ], rv[2];
  float pcj[2] = {0.f, 0.f}, puj[2] = {1.f, 1.f}, pclast[2] = {0.f, 0.f}, pct[2] = {0.f, 0.f}, put[2] = {1.f, 1.f};
  u16 gz[2][2][4];
  const u16* gsrc = (const u16*)(p.ws + OFF_PROJ);
  const int gcol = (MODE == 0) ? (4096 + h * 512 + s * 64) : (h * 64);
  const int fi = w >> 1, fe0 = 2 * (w & 1);
  const int fis = (int)p.wv >> 1, fe0s = 2 * ((int)p.wv & 1);
  const int dw = w * (DK / 8);

  unsigned qoff[NQ], goff[4], aoff[4];
#pragma unroll
  for (int i = 0; i < NQ; ++i) {
    const int c_ = tid + NTHR * i;
    qoff[i] = (unsigned)(((c_ / CPR) * sstride + qcol + (c_ % CPR) * 8) * 2);
  }
  const unsigned voffv = (unsigned)((vrow * sstride + vcol + vkc * 8) * 2);
#pragma unroll
  for (int r = 0; r < 4; ++r) {
    goff[r] = (unsigned)(((16 * fi + 4 * g + r) * PROJ_LD + gcol + 16 * fe0 + l15) * 2);
    aoff[r] = (unsigned)(((16 * fi + 4 * g + r) * 2048 + ((MODE == 0) ? (h * 512 + s * 64) : (h * 64)) + 16 * fe0 + l15) * 2);
  }
  const int kdelta = (kcol - qcol) * 2;

#define PF_ISSUE(SET, RBASE)                                                                       \
  {                                                                                                \
    const int rb_ = (RBASE);                                                                       \
    if (true) {                                                                                    \
      const char* sb_ = (const char*)src + (size_t)rb_ * (size_t)(sstride * 2);                    \
      const char* gb_ = (const char*)gsrc + (size_t)rb_ * (size_t)(PROJ_LD * 2);                   \
      _Pragma("unroll") for (int i = 0; i < NQ; ++i) {                                             \
        rq[SET][i] = *(const u32x4*)(sb_ + qoff[i]);                                               \
        rk[SET][i] = *(const u32x4*)(sb_ + kdelta + qoff[i]);                                      \
      }                                                                                            \
      rv[SET] = *(const u32x4*)(sb_ + voffv);                                                      \
      if (MODE == 1) {                                                                             \
        pcj[SET] = cumv[(size_t)(rb_ + vrow) * 32 + h]; puj[SET] = dtv[(size_t)(rb_ + vrow) * 32 + h]; \
        pclast[SET] = cumv[(size_t)(rb_ + 63) * 32 + h];                                           \
        pct[SET] = cumv[(size_t)(rb_ + jt) * 32 + h]; put[SET] = dtv[(size_t)(rb_ + jt) * 32 + h]; \
      }                                                                                            \
      _Pragma("unroll") for (int x = 0; x < 2; ++x)                                                \
        _Pragma("unroll") for (int r = 0; r < 4; ++r)                                              \
          gz[SET][x][r] = *(const u16*)(gb_ + 32 * x + goff[r]);                                   \
    } else {                                                                                       \
      _Pragma("unroll") for (int i = 0; i < NQ; ++i) {                                             \
        int c_ = tid + NTHR * i, rr_ = c_ / CPR, kc_ = c_ % CPR;                                   \
        rq[SET][i] = *(const u32x4*)(src + (size_t)(rb_ + rr_) * sstride + qcol + kc_ * 8);        \
        rk[SET][i] = *(const u32x4*)(src + (size_t)(rb_ + rr_) * sstride + kcol + kc_ * 8);        \
      }                                                                                            \
      rv[SET] = *(const u32x4*)(src + (size_t)(rb_ + vrow) * sstride + vcol + vkc * 8);            \
      _Pragma("unroll") for (int x = 0; x < 2; ++x)                                                \
        _Pragma("unroll") for (int r = 0; r < 4; ++r)                                              \
          gz[SET][x][r] = gsrc[(size_t)(rb_ + 16 * fi + 4 * g + r) * PROJ_LD + gcol + 16 * (fe0 + x) + l15]; \
    }                                                                                              \
  }

  f32x4 S[MF][4];
#pragma unroll
  for (int i = 0; i < MF; ++i)
#pragma unroll
    for (int j = 0; j < 4; ++j) S[i][j] = (f32x4){0.f, 0.f, 0.f, 0.f};

  float gnv[2];
  const float dsk = (MODE == 1) ? p.ssm_d[h] : 0.f;
#pragma unroll
  for (int x = 0; x < 2; ++x) {
    const int e = 16 * (fe0 + x) + l15;
    gnv[x] = (MODE == 0) ? p.ret_head_norm[h * 512 + s * 64 + e] : p.ssm_gate_norm[h * 64 + e];
  }

  PF_ISSUE(0, row0)
  if (NSET == 2) PF_ISSUE(1, row0 + 64)

  for (int c2 = 0; c2 < 32; c2 += 2) {
#pragma unroll
   for (int par2 = 0; par2 < 2; ++par2) {
    const int par = par2 & (NSET - 1);
    const int c = c2 + par2;
    const int r0 = row0 + c * 64;
#pragma unroll
    for (int i = 0; i < NQ; ++i) {
      int cc = tid + NTHR * i, rr = cc / CPR, kc = cc % CPR;
      *(u32x4*)(Qs + rr * QS + kc * 16) = rq[par][i];
      *(u32x4*)(Ks + rr * QS + kc * 16) = rk[par][i];
    }
    {
      const u32x4 rvv = rv[par];
      *(u32x4*)(Vs + vrow * VS + vkc * 16) = rvv;
      float cj, uj, cl;
      if (MODE == 0) { cj = (float)(vrow + 1) * lg; uj = 1.f; cl = 64.f * lg; } else { cj = pcj[par]; uj = puj[par]; cl = pclast[par]; }
      const float wj = uj * ex2(cl - cj);
      u32x4 o;
      o.x = pack2(bf2f((u16)(rvv.x & 0xffff)) * wj, bf2f((u16)(rvv.x >> 16)) * wj);
      o.y = pack2(bf2f((u16)(rvv.y & 0xffff)) * wj, bf2f((u16)(rvv.y >> 16)) * wj);
      o.z = pack2(bf2f((u16)(rvv.z & 0xffff)) * wj, bf2f((u16)(rvv.z >> 16)) * wj);
      o.w = pack2(bf2f((u16)(rvv.w & 0xffff)) * wj, bf2f((u16)(rvv.w >> 16)) * wj);
      *(u32x4*)(Vts + vrow * VS + vkc * 16) = o;
    }
    if (tid < 64) {
      if (MODE == 0) { cumS[tid] = (float)(tid + 1) * lg; uS[tid] = 1.f; } else { cumS[tid] = pct[par]; uS[tid] = put[par]; }
    }
#pragma unroll
    for (int mf = 0; mf < MF; ++mf)
#pragma unroll
      for (int nf = 0; nf < 4; ++nf) {
        u32x2 o;
        o.x = pack2(S[mf][nf][0], S[mf][nf][1]);
        o.y = pack2(S[mf][nf][2], S[mf][nf][3]);
        *(u32x2*)(STs + (16 * nf + l15) * QS + (dw + 16 * mf + 4 * g) * 2) = o;
      }
    u16 gzc[2][4];
#pragma unroll
    for (int x = 0; x < 2; ++x)
#pragma unroll
      for (int r = 0; r < 4; ++r) gzc[x][r] = gz[par][x][r];
    __syncthreads();
    if (c + NSET < 32) PF_ISSUE(par, r0 + 64 * NSET)
    f32x4 sc[2], cr[2];
#pragma unroll
    for (int x = 0; x < 2; ++x) { sc[x] = (f32x4){0.f, 0.f, 0.f, 0.f}; cr[x] = (f32x4){0.f, 0.f, 0.f, 0.f}; }
#pragma unroll KUNR
    for (int ks = 0; ks < KS; ++ks) {
      const bf16x8 a = *(const bf16x8*)(Qs + (16 * fi + l15) * QS + ks * 64 + g * 16);
      bf16x8 bk[2], bs[2];
#pragma unroll
      for (int x = 0; x < 2; ++x) {
        bk[x] = *(const bf16x8*)(Ks + (16 * (fe0 + x) + l15) * QS + ks * 64 + g * 16);
        bs[x] = *(const bf16x8*)(STs + (16 * (fe0 + x) + l15) * QS + ks * 64 + g * 16);
      }
#pragma unroll
      for (int x = 0; x < 2; ++x) {
        sc[x] = __builtin_amdgcn_mfma_f32_16x16x32_bf16(a, bk[x], sc[x], 0, 0, 0);
        cr[x] = __builtin_amdgcn_mfma_f32_16x16x32_bf16(a, bs[x], cr[x], 0, 0, 0);
      }
    }
    float ci[4];
#pragma unroll
    for (int r = 0; r < 4; ++r) ci[r] = cumS[16 * fi + 4 * g + r];
#pragma unroll
    for (int x = 0; x < 2; ++x) {
      const int fj = fe0 + x;
      const int j = 16 * fj + l15;
      const float cj = cumS[j], uj = uS[j];
#pragma unroll
      for (int r = 0; r < 4; ++r) {
        const int i = 16 * fi + 4 * g + r;
        float v = 0.f;
        if (j <= i) v = sc[x][r] * ex2(ci[r] - cj) * uj;
        *(u16*)(Ps + i * PS + j * 2) = f2bf(v);
      }
    }
    {
      const float atot = ex2(cumS[63]);
#pragma unroll
      for (int mf = 0; mf < MF; ++mf)
#pragma unroll
        for (int nf = 0; nf < 4; ++nf)
#pragma unroll
          for (int r = 0; r < 4; ++r) S[mf][nf][r] *= atot;
#pragma unroll
      for (int ks = 0; ks < 2; ++ks) {
        bf16x8 af[MF], bfv[4];
#pragma unroll
        for (int mf = 0; mf < MF; ++mf) af[mf] = trfrag(Ks, QS, 32 * ks, dw + 16 * mf, lane);
#pragma unroll
        for (int nf = 0; nf < 4; ++nf) bfv[nf] = trfrag(Vts, VS, 32 * ks, 16 * nf, lane);
#pragma unroll
        for (int mf = 0; mf < MF; ++mf)
#pragma unroll
          for (int nf = 0; nf < 4; ++nf)
            S[mf][nf] = __builtin_amdgcn_mfma_f32_16x16x32_bf16(af[mf], bfv[nf], S[mf][nf], 0, 0, 0);
      }
    }
    __syncthreads();
    f32x4 in[2];
#pragma unroll
    for (int x = 0; x < 2; ++x) in[x] = (f32x4){0.f, 0.f, 0.f, 0.f};
#pragma unroll
    for (int ks = 0; ks < 2; ++ks) {
      const bf16x8 a = *(const bf16x8*)(Ps + (16 * fi + l15) * PS + ks * 64 + g * 16);
      bf16x8 bv[2];
#pragma unroll
      for (int x = 0; x < 2; ++x) bv[x] = trfrag(Vs, VS, 32 * ks, 16 * (fe0 + x), lane);
#pragma unroll
      for (int x = 0; x < 2; ++x) in[x] = __builtin_amdgcn_mfma_f32_16x16x32_bf16(a, bv[x], in[x], 0, 0, 0);
    }
    {
      float ss[4] = {0.f, 0.f, 0.f, 0.f};
      u16* aout = (u16*)(p.ws + OFF_A2);
      float* parts = (float*)(p.ws + OFF_PARTS);
#pragma unroll
      for (int x = 0; x < 2; ++x) {
        const int e = 16 * (fe0 + x) + l15;
        const float gn = gnv[x];
        const int ocol = (MODE == 0) ? (h * 512 + s * 64 + e) : (h * 64 + e);
#pragma unroll
        for (int r = 0; r < 4; ++r) {
          const int i = 16 * fi + 4 * g + r;
          float o = in[x][r] + cr[x][r] * ex2(ci[r]);
          const float gv = bf2f(gzc[x][r]);
          float val;
          if (MODE == 0) {
            ss[r] += o * o;
            val = o * gn * silu(gv);
          } else {
            const float xs = bf2f(*(const u16*)(Vs + i * VS + e * 2));
            const float y = o + xs * dsk;
            const float gg = y * silu(gv);
            ss[r] += gg * gg;
            val = gg * gn;
          }
          *(u16*)((char*)aout + (size_t)r0 * 4096 + 32 * x + aoff[r]) = f2bf(val);
        }
      }
#pragma unroll
      for (int r = 0; r < 4; ++r) {
        const float v = row16_sum(ss[r]);
        if (l15 == 0) {
          const int i = 16 * fi + 4 * g + r;
          const int slot = (MODE == 0) ? (h * 16 + s * 2 + (w & 1)) : ((h >> 2) * 8 + (h & 3) * 2 + (w & 1));
          parts[(size_t)(r0 + i) * 64 + slot] = v;
        }
      }
    }
    __syncthreads();
   }
  }
#undef PF_ISSUE
  {
    float* so;
    int pitch;
    if (MODE == 0) { so = p.out + OUT_RETP + ((size_t)(b * 4 + h) * 256) * 512 + s * 64; pitch = 512; }
    else { so = p.out + OUT_SSMP + ((size_t)(b * 32 + h) * 128) * 64; pitch = 64; }
#pragma unroll
    for (int mf = 0; mf < MF; ++mf)
#pragma unroll
      for (int nf = 0; nf < 4; ++nf)
#pragma unroll
        for (int r = 0; r < 4; ++r)
          so[(size_t)(dw + 16 * mf + 4 * g + r) * pitch + 16 * nf + l15] = S[mf][nf][r];
  }
}

#define SAMPLE_DECODE(ITEM, B_, H_, S_)                              \
  const int B_ = (ITEM) >> 5;                                        \
  const int H_ = (MODE == 0) ? (((ITEM) >> 3) & 3) : ((ITEM) & 31);  \
  const int S_ = (MODE == 0) ? ((ITEM) & 7) : 0;

#define SAMPLE_ISSUE(SET, ITEM)                                                                                     \
  {                                                                                                                \
    SAMPLE_DECODE(ITEM, b_, h_, s_)                                                                                \
    const int row0_ = NPROMPT + b_ * 8;                                                                            \
    int qcol_, kcol_, vcol_;                                                                                       \
    if (MODE == 0) { qcol_ = h_ * 256; kcol_ = 1024 + h_ * 256; vcol_ = 2048 + h_ * 512 + s_ * 64; }               \
    else { qcol_ = 3072 + (h_ >> 2) * 128; kcol_ = 2048 + (h_ >> 2) * 128; vcol_ = h_ * 64; }                      \
    const float* s0_ = (MODE == 0) ? p.state_ret + ((size_t)(b_ * 4 + h_) * 256) * 512 + s_ * 64                   \
                                   : p.state_ssm + ((size_t)(b_ * 32 + h_) * 128) * 64;                            \
    _Pragma("unroll") for (int db = 0; db < NB; ++db)                                                              \
      _Pragma("unroll") for (int eb = 0; eb < 4; ++eb)                                                             \
        _Pragma("unroll") for (int r = 0; r < 4; ++r)                                                              \
          sv[SET][db][eb][r] = s0_[(size_t)(dbase + 16 * db + 4 * g + r) * pitch + 16 * eb + l15];                \
    if (tid < 2 * DK) {                                                                                            \
      const int which_ = tid / DK, c_ = tid % DK;                                                                  \
      rqk[SET] = *(const u32x4*)(src + (size_t)(row0_ + c_ / CPR) * sstride + (which_ ? kcol_ : qcol_) + (c_ % CPR) * 8); \
    }                                                                                                              \
    if (tid < 64) {                                                                                                \
      rv[SET] = *(const u32x4*)(src + (size_t)(row0_ + (tid >> 3)) * sstride + vcol_ + (tid & 7) * 8);             \
      if (MODE == 1) {                                                                                             \
        pvc[SET] = cumv[(size_t)(row0_ + (tid >> 3)) * 32 + h_];                                                   \
        pvu[SET] = dtv[(size_t)(row0_ + (tid >> 3)) * 32 + h_];                                                    \
        pvl[SET] = cumv[(size_t)(row0_ + 7) * 32 + h_];                                                            \
      }                                                                                                            \
    }                                                                                                              \
    gzs[SET] = gsrc[(size_t)(row0_ + w) * PROJ_LD + ((MODE == 0) ? (4096 + h_ * 512 + s_ * 64) : (h_ * 64)) + lane]; \
    if (MODE == 1 && tid < 16)                                                                                     \
      pcu[SET] = (tid < 8) ? cumv[(size_t)(row0_ + tid) * 32 + h_] : dtv[(size_t)(row0_ + tid - 8) * 32 + h_];     \
  }

template <int DK, int MODE>
__device__ void rec_sample_loop(const Params& p, unsigned char* smem, const int rep) {
  constexpr int SET_FLOATS = 8 * DK + 8 * DK + 512 + 64 + 4096 + 64 + (DK * 8 + 64 * 8) / 2;
  const int tid = (int)p.tidx, lane = tid & 63, w = tid >> 6;
  const int l15 = lane & 15, g = lane >> 4;
  constexpr int CPR = DK / 8;
  constexpr int DPW = DK / 8;
  constexpr int NB = DPW / 16;
  const int dbase = w * DPW;
  const int pitch = (MODE == 0) ? 512 : 64;
  int vz;
  asm volatile("v_mov_b32 %0, 0" : "=v"(vz));
  const u16* src = ((MODE == 0) ? (const u16*)(p.ws + OFF_PROJ) : (const u16*)(p.ws + OFF_XBCC)) + vz;
  const int sstride = (MODE == 0) ? PROJ_LD : 4096;
  const u16* gsrc = (const u16*)(p.ws + OFF_PROJ) + vz;
  const float* dtv = (const float*)(p.ws + OFF_DT) + vz;
  const float* cumv = (const float*)(p.ws + OFF_CUM) + vz;
  u16* aout = (u16*)(p.ws + OFF_A2);
  float* parts = (float*)(p.ws + OFF_PARTS);

  u32x4 rqk[2] = {(u32x4){0u, 0u, 0u, 0u}, (u32x4){0u, 0u, 0u, 0u}}, rv[2] = {(u32x4){0u, 0u, 0u, 0u}, (u32x4){0u, 0u, 0u, 0u}};
  f32x4 sv[2][NB][4];
  u16 gzs[2] = {0, 0};
  float pcu[2] = {0.f, 0.f}, pvc[2] = {0.f, 0.f}, pvu[2] = {1.f, 1.f}, pvl[2] = {0.f, 0.f};
  const int nitems = 4096 * rep;
  const int G = (int)gridDim.x;
  if ((int)blockIdx.x < nitems) SAMPLE_ISSUE(0, ((int)blockIdx.x & 4095) + vz)
  for (int itb = blockIdx.x; itb < nitems; itb += 2 * G) {
#pragma unroll
   for (int par = 0; par < 2; ++par) {
    const int item0 = itb + par * G;
    if (item0 < nitems) {
    if (item0 + G < nitems) SAMPLE_ISSUE(par ^ 1, ((item0 + G) & 4095) + vz)
    __builtin_amdgcn_sched_barrier(0);
    const int item = (item0 & 4095) + vz;
    SAMPLE_DECODE(item, b, h, s)
    const int row0 = NPROMPT + b * 8;
    const u16 gzv = gzs[par];
    const u32x4 rqkc = rqk[par], rvc = rv[par];
    float* qS = (float*)smem + par * SET_FLOATS;
    float* kS = qS + 8 * DK;
    float* vS = kS + 8 * DK;
    float* scS = vS + 512;
    float* redS = scS + 64;
    float* cuS = redS + 4096;
    u16* kTb = (u16*)(cuS + 64);
    u16* vwTb = kTb + DK * 8;
    const float lgh = (MODE == 0) ? log2f(1.0f - exp2f(-5.0f - (float)h)) : 0.f;
    if (tid < 2 * DK) {
      const int which = tid / DK, c = tid % DK;
      float* dst = (which ? kS : qS) + (c / CPR) * DK + (c % CPR) * 8;
      dst[0] = bf2f((u16)(rqkc.x & 0xffff)); dst[1] = bf2f((u16)(rqkc.x >> 16));
      dst[2] = bf2f((u16)(rqkc.y & 0xffff)); dst[3] = bf2f((u16)(rqkc.y >> 16));
      dst[4] = bf2f((u16)(rqkc.z & 0xffff)); dst[5] = bf2f((u16)(rqkc.z >> 16));
      dst[6] = bf2f((u16)(rqkc.w & 0xffff)); dst[7] = bf2f((u16)(rqkc.w >> 16));
      if (which) {
        u16* dT = kTb + ((c % CPR) * 8) * 8 + (c / CPR);
        dT[0 * 8] = (u16)(rqkc.x & 0xffff); dT[1 * 8] = (u16)(rqkc.x >> 16);
        dT[2 * 8] = (u16)(rqkc.y & 0xffff); dT[3 * 8] = (u16)(rqkc.y >> 16);
        dT[4 * 8] = (u16)(rqkc.z & 0xffff); dT[5 * 8] = (u16)(rqkc.z >> 16);
        dT[6 * 8] = (u16)(rqkc.w & 0xffff); dT[7 * 8] = (u16)(rqkc.w >> 16);
      }
    }
    if (tid < 64) {
      const int t = tid >> 3, kc = tid & 7;
      float vv[8];
      vv[0] = bf2f((u16)(rvc.x & 0xffff)); vv[1] = bf2f((u16)(rvc.x >> 16));
      vv[2] = bf2f((u16)(rvc.y & 0xffff)); vv[3] = bf2f((u16)(rvc.y >> 16));
      vv[4] = bf2f((u16)(rvc.z & 0xffff)); vv[5] = bf2f((u16)(rvc.z >> 16));
      vv[6] = bf2f((u16)(rvc.w & 0xffff)); vv[7] = bf2f((u16)(rvc.w >> 16));
      float* dst = vS + t * 64 + kc * 8;
      const float wt = (MODE == 0) ? ex2((float)(7 - t) * lgh) : pvu[par] * ex2(pvl[par] - pvc[par]);
      u16* dT = vwTb + (kc * 8) * 8 + t;
#pragma unroll
      for (int x = 0; x < 8; ++x) { dst[x] = vv[x]; dT[x * 8] = f2bf(vv[x] * wt); }
    }
    if (MODE == 1 && tid < 16) cuS[tid] = pcu[par];
    __syncthreads();
    float cum[8], u[8];
    if (MODE == 0) {
#pragma unroll
      for (int t = 0; t < 8; ++t) { cum[t] = (float)(t + 1) * lgh; u[t] = 1.f; }
    } else {
#pragma unroll
      for (int t = 0; t < 8; ++t) { cum[t] = cuS[t]; u[t] = cuS[8 + t]; }
    }
    if (w == 0) {
      f32x4 sacc = (f32x4){0.f, 0.f, 0.f, 0.f};
#pragma unroll
      for (int ks = 0; ks < DK / 32; ++ks) {
        const float* qp = qS + (l15 & 7) * DK + ks * 32 + 8 * g;
        const float* kp = kS + (l15 & 7) * DK + ks * 32 + 8 * g;
        const float4 a0 = *(const float4*)qp, a1 = *(const float4*)(qp + 4);
        const float4 b0 = *(const float4*)kp, b1 = *(const float4*)(kp + 4);
        u32x4 qa_, kb_;
        qa_.x = pack2(a0.x, a0.y); qa_.y = pack2(a0.z, a0.w); qa_.z = pack2(a1.x, a1.y); qa_.w = pack2(a1.z, a1.w);
        kb_.x = pack2(b0.x, b0.y); kb_.y = pack2(b0.z, b0.w); kb_.z = pack2(b1.x, b1.y); kb_.w = pack2(b1.z, b1.w);
        sacc = __builtin_amdgcn_mfma_f32_16x16x32_bf16(__builtin_bit_cast(bf16x8, qa_), __builtin_bit_cast(bf16x8, kb_), sacc, 0, 0, 0);
      }
      if (g < 2 && l15 < 8) {
        float cj = 0.f, uj = 0.f;
#pragma unroll
        for (int t = 0; t < 8; ++t) if (t == l15) { cj = cum[t]; uj = u[t]; }
#pragma unroll
        for (int r = 0; r < 4; ++r) {
          const int i = 4 * g + r;
          float ci = 0.f;
#pragma unroll
          for (int t = 0; t < 8; ++t) if (t == i) ci = cum[t];
          scS[i * 8 + l15] = (l15 <= i) ? sacc[r] * ex2(ci - cj) * uj : 0.f;
        }
      }
    }
    {
      float* s1 = (MODE == 0) ? p.out + OUT_RETS + ((size_t)(b * 4 + h) * 256) * 512 + s * 64
                              : p.out + OUT_SSMS + ((size_t)(b * 32 + h) * 128) * 64;
      const float atot = ex2(cum[7]);
      const bf16x8 zero8 = (bf16x8){0, 0, 0, 0, 0, 0, 0, 0};
      bf16x8 kA[NB], vB[4], qa;
#pragma unroll
      for (int db = 0; db < NB; ++db) {
        const bf16x8 t8 = *(const bf16x8*)(kTb + (dbase + 16 * db + l15) * 8);
        kA[db] = (g == 0) ? t8 : zero8;
      }
#pragma unroll
      for (int eb = 0; eb < 4; ++eb) {
        const bf16x8 t8 = *(const bf16x8*)(vwTb + (16 * eb + l15) * 8);
        vB[eb] = (g == 0) ? t8 : zero8;
      }
      {
        const float* qrow = qS + (l15 & 7) * DK + dbase + 4 * g;
        const float4 q0 = *(const float4*)qrow;
        float4 q1 = make_float4(0.f, 0.f, 0.f, 0.f);
        if (NB == 2) q1 = *(const float4*)(qrow + 16);
        u32x4 qq;
        qq.x = pack2(q0.x, q0.y); qq.y = pack2(q0.z, q0.w); qq.z = pack2(q1.x, q1.y); qq.w = pack2(q1.z, q1.w);
        if (l15 >= 8) qq = (u32x4){0u, 0u, 0u, 0u};
        qa = __builtin_bit_cast(bf16x8, qq);
      }
#pragma unroll
      for (int eb = 0; eb < 4; ++eb) {
        u32x4 sb;
        sb.x = pack2(sv[par][0][eb][0], sv[par][0][eb][1]);
        sb.y = pack2(sv[par][0][eb][2], sv[par][0][eb][3]);
        if (NB == 2) {
          sb.z = pack2(sv[par][NB - 1][eb][0], sv[par][NB - 1][eb][1]);
          sb.w = pack2(sv[par][NB - 1][eb][2], sv[par][NB - 1][eb][3]);
        } else { sb.z = 0u; sb.w = 0u; }
        const f32x4 o3 = __builtin_amdgcn_mfma_f32_16x16x32_bf16(qa, __builtin_bit_cast(bf16x8, sb),
                                                                 (f32x4){0.f, 0.f, 0.f, 0.f}, 0, 0, 0);
        if (g < 2) {
#pragma unroll
          for (int r = 0; r < 4; ++r) redS[(w * 8 + 4 * g + r) * 64 + 16 * eb + l15] = o3[r];
        }
#pragma unroll
        for (int db = 0; db < NB; ++db) {
          f32x4 c = sv[par][db][eb];
          c[0] *= atot; c[1] *= atot; c[2] *= atot; c[3] *= atot;
          const f32x4 dn = __builtin_amdgcn_mfma_f32_16x16x32_bf16(kA[db], vB[eb], c, 0, 0, 0);
#pragma unroll
          for (int r = 0; r < 4; ++r) s1[(size_t)(dbase + 16 * db + 4 * g + r) * pitch + 16 * eb + l15] = dn[r];
        }
      }
    }
    __syncthreads();
    {
      const int i = w, e = lane;
      float o = 0.f;
#pragma unroll
      for (int ww = 0; ww < 8; ++ww) o += redS[(ww * 8 + i) * 64 + e];
      float ci = 0.f;
#pragma unroll
      for (int t = 0; t < 8; ++t) if (t == i) ci = cum[t];
      o *= ex2(ci);
#pragma unroll
      for (int jj = 0; jj < 8; ++jj) if (jj <= i) o += scS[i * 8 + jj] * vS[jj * 64 + e];
      const int row = row0 + i;
      const float gv = bf2f(gzv);
      if (MODE == 0) {
        const float ssq = wave_sum(o * o);
        const float val = o * p.ret_head_norm[h * 512 + s * 64 + e] * silu(gv);
        aout[(size_t)row * 2048 + h * 512 + s * 64 + e] = f2bf(val);
        if (lane < 2) parts[(size_t)row * 64 + h * 16 + s * 2 + lane] = lane == 0 ? ssq : 0.f;
      } else {
        const float y = o + vS[i * 64 + e] * p.ssm_d[h];
        const float gg = y * silu(gv);
        const float ssq = wave_sum(gg * gg);
        aout[(size_t)row * 2048 + h * 64 + e] = f2bf(gg * p.ssm_gate_norm[h * 64 + e]);
        if (lane < 2) parts[(size_t)row * 64 + (h >> 2) * 8 + (h & 3) * 2 + lane] = lane == 0 ? ssq : 0.f;
      }
    }
    }
   }
  }
  __syncthreads();
}

template <int DK, int MODE>
__device__ void phase_rec(const Params& p, unsigned char* smem, const int rep_p, const int rep_s) {
  for (int item = blockIdx.x; item < 256 * rep_p; item += gridDim.x) rec_prompt_item<DK, MODE>(p, item & 255, smem);
  rec_sample_loop<DK, MODE>(p, smem, rep_s);
}

#ifndef PHASE_MASK
#define PHASE_MASK 0x3ff
#endif
#ifndef DUP_MASK
#define DUP_MASK 0x000
#endif
#define XB_TMO      128
#define XB_XCNT(j)  (256  + 64 * (j))
#define XB_XSUB(j)  (1280 + 64 * (j))
#define XB_XGEN(j)  (2304 + 64 * (j))
#define XB_TOP      3328
#define XB_TOPGEN   3392
#define XCD_BAR_WORDS 3456
#define XB_SPIN_CAP (1u << 20)
#define LAS __attribute__((address_space(3)))
__device__ __forceinline__ unsigned xb_ld(unsigned* p) { return __hip_atomic_load(p, __ATOMIC_RELAXED, __HIP_MEMORY_SCOPE_AGENT); }
__device__ __forceinline__ unsigned xb_add(unsigned* p, unsigned v) { return __hip_atomic_fetch_add(p, v, __ATOMIC_RELAXED, __HIP_MEMORY_SCOPE_AGENT); }
__device__ __forceinline__ unsigned xb_xcc_id() { return (unsigned)__builtin_amdgcn_s_getreg((3 << 11) | 20) & 0xFu; }
#define XB_SPIN(cond, bar) do { unsigned _sp = 0; while (cond) { __builtin_amdgcn_s_sleep(1); \
    if ((++_sp & 255u) == 0u) { if (xb_ld(&(bar)[XB_TMO])) break; if (_sp > XB_SPIN_CAP) { atomicAdd(&(bar)[XB_TMO], 1u); break; } } } } while (0)
struct XcdBarrier {
  unsigned* bar; unsigned x;
  volatile LAS unsigned* st;
};
__device__ __forceinline__ XcdBarrier xcd_barrier_post(unsigned* bar, volatile LAS unsigned* st, const int tid) {
  XcdBarrier b; b.bar = bar; b.x = xb_xcc_id(); b.st = st;
  if (tid == 0) (void)xb_add(&bar[XB_XCNT(b.x)], 1u);
  return b;
}
__device__ __forceinline__ void xcd_barrier_complete(unsigned* bar, unsigned x, unsigned& nloc, unsigned& nx) {
  const unsigned G = gridDim.x * gridDim.y * gridDim.z;
  unsigned sum, cnt, mine, sp = 0u;
  for (;;) {
    sum = 0u; cnt = 0u; mine = 0u;
#pragma unroll
    for (unsigned j = 0; j < 16; ++j) { const unsigned c = xb_ld(&bar[XB_XCNT(j)]); sum += c; cnt += (c > 0u) ? 1u : 0u; mine = (j == x) ? c : mine; }
    if (sum == G) break;
    __builtin_amdgcn_s_sleep(1);
    if ((++sp & 255u) == 0u) { if (xb_ld(&bar[XB_TMO])) break; if (sp > XB_SPIN_CAP) { atomicAdd(&bar[XB_TMO], 1u); break; } }
  }
  nloc = mine > 0u ? mine : 1u; nx = cnt > 0u ? cnt : 1u;
}
__device__ __forceinline__ void xcd_barrier(const XcdBarrier& b, const int wvs) {
  int wvl_ = wvs;
  asm volatile("" : "+s"(wvl_));
  const int tid = wvl_ * 64 + (int)__builtin_amdgcn_mbcnt_hi(~0u, __builtin_amdgcn_mbcnt_lo(~0u, 0u));
  asm volatile("s_waitcnt vmcnt(0)" ::: "memory");
  __syncthreads();
  if (tid == 0) {
    unsigned* bar = b.bar;
    __builtin_amdgcn_s_waitcnt(0);
    unsigned nloc = b.st[0], nx = b.st[1];
    if (nloc == 0u) { xcd_barrier_complete(bar, b.x, nloc, nx); b.st[0] = nloc; b.st[1] = nx; }
    const unsigned old = xb_add(&bar[XB_XSUB(b.x)], 1u);
    const unsigned gen = old / nloc;
    if (old + 1u == (gen + 1u) * nloc) {
      __builtin_amdgcn_fence(__ATOMIC_RELEASE, "agent");
      asm volatile("s_waitcnt vmcnt(0)" ::: "memory");
      const unsigned og = xb_add(&bar[XB_TOP], 1u);
      const unsigned tg = og / nx;
      if (og + 1u == (tg + 1u) * nx) xb_add(&bar[XB_TOPGEN], 1u);
      else XB_SPIN(xb_ld(&bar[XB_TOPGEN]) == tg, bar);
      __builtin_amdgcn_fence(__ATOMIC_ACQUIRE, "agent");
      xb_add(&bar[XB_XGEN(b.x)], 1u);
      asm volatile("s_waitcnt vmcnt(0)" ::: "memory");
    } else {
      XB_SPIN(xb_ld(&bar[XB_XGEN(b.x)]) == gen, bar);
      __builtin_amdgcn_fence(__ATOMIC_ACQUIRE, "agent");
      asm volatile("s_waitcnt vmcnt(0)" ::: "memory");
    }
  }
  __syncthreads();
}

template <typename T>
__device__ __forceinline__ T* as_global(T* q) {
  return (T*)(__attribute__((address_space(1))) T*)q;
}

template <int PH>
__device__ __forceinline__ void run_phase(Params p, unsigned char* smem, const int wvs) {
  {
    long long z_ = 0;
    asm volatile("" : "+s"(z_));
    p.ws += z_; p.out += z_;
  }
  {
    int wvl_ = wvs;
    asm volatile("" : "+s"(wvl_));
    p.tidx = wvl_ * 64 + (int)__builtin_amdgcn_mbcnt_hi(~0u, __builtin_amdgcn_mbcnt_lo(~0u, 0u));
    p.wv = wvl_;
  }
  const int rep = 1 + (int)((p.dup >> PH) & 1);
  if (PH == 0) phase_prep(p, smem, rep);
  if (PH == 1) {
    gemm8_phase<0>(p, (const u16*)(p.ws + OFF_H), (const u16*)(p.ws + OFF_WT0), 1024, 24, smem, rep);
    __syncthreads();
    transpose_later_weights(p, smem, (68 * 24) % (int)gridDim.x);
  }
  if (PH == 2) phase_rec<256, 0>(p, smem, rep, 1 + (int)((p.dup >> (PH + 16)) & 1));
  if (PH == 3)
  {
    gemm_phase<1, 4>(p, (const u16*)(p.ws + OFF_A2), (const u16*)(p.ws + OFF_WT1), 2048, 8, nullptr,
                     (float*)(p.ws + OFF_X1), smem, rep, 64);
    __syncthreads();
    gemm_sample_rows<4>(p, (const u16*)(p.ws + OFF_A2), (const u16*)(p.ws + OFF_WT1), nullptr, (float*)(p.ws + OFF_X1), smem, rep);
  }
  if (PH == 4) phase_norm<0>(p, (const float*)(p.ws + OFF_X1), p.ssm_norm, rep);
  if (PH == 5) {
    gemm8_phase<2>(p, (const u16*)(p.ws + OFF_H), (const u16*)(p.ws + OFF_WT2), 1024, 24, smem, rep);
    __syncthreads();
    gemm_phase<2, 0>(p, (const u16*)(p.ws + OFF_H), (const u16*)(p.ws + OFF_WT2), 1024, 1, nullptr, nullptr, smem, 1, 68, 48, true);
  }
  if (PH == 6) phase_conv(p, smem, rep);
  if (PH == 7) phase_rec<128, 1>(p, smem, rep, 1 + (int)((p.dup >> (PH + 16)) & 1));
  if (PH == 8)
  {
    gemm_phase<1, 8>(p, (const u16*)(p.ws + OFF_A2), (const u16*)(p.ws + OFF_WT3), 2048, 8,
                     (const float*)(p.ws + OFF_X1), (float*)(p.ws + OFF_X2), smem, rep, 64);
    __syncthreads();
    gemm_sample_rows<8>(p, (const u16*)(p.ws + OFF_A2), (const u16*)(p.ws + OFF_WT3), (const float*)(p.ws + OFF_X1),
                        (float*)(p.ws + OFF_X2), smem, rep);
  }
  if (PH == 9) phase_norm<1>(p, (const float*)(p.ws + OFF_X2), p.final_norm, rep);
}

#define RUN_PHASE(k)                                   \
  if ((PHASE_MASK >> k) & 1) {                         \
    if (lo <= k && k <= hi) {                          \
      run_phase<k>(p, smem, wvs);                      \
      if (k < hi) { xcd_barrier(xb, wvs); if ((p.dup >> 30) & 1) { xcd_barrier(xb, wvs); xcd_barrier(xb, wvs); } } \
    }                                                  \
  }

__global__ void __launch_bounds__(NTHR) fwd_megakernel(Params p) {
  __shared__ __attribute__((aligned(16))) unsigned char smem[LDS_BYTES];
  cg::grid_group grid = cg::this_grid();
  const int lo = (int)p.phase_lo, hi = (int)p.phase_hi;
  if (lo > 1000) grid.sync();
  volatile LAS unsigned* xst = (volatile LAS unsigned*)(smem + LDS_BYTES - 16);
  const int wvs = __builtin_amdgcn_readfirstlane((int)(threadIdx.x >> 6));
  if (threadIdx.x == 0) { xst[0] = 0u; xst[1] = 0u; }
  __syncthreads();
  const XcdBarrier xb = xcd_barrier_post((unsigned*)(p.ws + OFF_BAR), xst, (int)threadIdx.x);
  RUN_PHASE(0)
  RUN_PHASE(1)
  RUN_PHASE(2)
  RUN_PHASE(3)
  RUN_PHASE(4)
  RUN_PHASE(5)
  RUN_PHASE(6)
  RUN_PHASE(7)
  RUN_PHASE(8)
  RUN_PHASE(9)
}

#ifndef ONE_LAUNCH
#define ONE_LAUNCH 1
#endif

extern "C" void kernel_launch(void* const* d_in, const int* in_sizes, int n_in, void* d_out, int out_size, void* d_ws,
                              size_t ws_size, hipStream_t stream) {
  static int grid_blocks = 0;
  if (!grid_blocks) {
    int dev = 0, cus = 0, per_cu = 0;
    hipGetDevice(&dev);
    hipDeviceGetAttribute(&cus, hipDeviceAttributeMultiprocessorCount, dev);
    hipOccupancyMaxActiveBlocksPerMultiprocessor(&per_cu, fwd_megakernel, NTHR, 0);
    if (per_cu < 1) per_cu = 1;
    if (per_cu > 1) per_cu = 1;
    grid_blocks = cus * per_cu;
  }
  Params p{};
  const float** pf = (const float**)&p;
  for (int i = 0; i < 19; ++i) pf[i] = (const float*)d_in[i];
  p.out = (float*)d_out;
  p.ws = (unsigned char*)d_ws;
#if ONE_LAUNCH
  hipMemsetAsync((unsigned char*)d_ws + OFF_BAR, 0, XCD_BAR_WORDS * 4, stream);
  p.phase_lo = 0; p.phase_hi = 9; p.dup = DUP_MASK;
  void* args[] = {&p};
  hipError_t e = hipLaunchCooperativeKernel((void*)fwd_megakernel, dim3(grid_blocks), dim3(NTHR), args, 0, stream);
  if (e != hipSuccess) fprintf(stderr, "cooperative launch failed: %s (grid %d)\n", hipGetErrorString(e), grid_blocks);
#else
  for (int ph = 0; ph <= 9; ++ph) {
    p.phase_lo = ph; p.phase_hi = ph;
    void* args[] = {&p};
    hipLaunchCooperativeKernel((void*)fwd_megakernel, dim3(grid_blocks), dim3(NTHR), args, 0, stream);
  }
#endif
}
```

```cpp
#include <hip/hip_runtime.h>
#include <hip/hip_cooperative_groups.h>
#include <stdint.h>
#include <stdio.h>
namespace cg = cooperative_groups;

typedef __attribute__((ext_vector_type(8))) short bf16x8;
typedef __attribute__((ext_vector_type(4))) short s16x4;
typedef __attribute__((ext_vector_type(4))) float f32x4;
typedef unsigned short u16;
typedef __attribute__((ext_vector_type(4))) unsigned int u32x4;
typedef __attribute__((ext_vector_type(2))) unsigned int u32x2;

#define NTHR 512
#define T_TOK 17408
#define NPROMPT 16384
#define LDS_BYTES 143360
#define PROJ_LD 6208

constexpr size_t OFF_WT0 = 0;
constexpr size_t OFF_WT1 = OFF_WT0 + (size_t)6144 * 1024 * 2;
constexpr size_t OFF_WT2 = OFF_WT1 + (size_t)1024 * 2048 * 2;
constexpr size_t OFF_WT3 = OFF_WT2 + (size_t)6272 * 1024 * 2;
constexpr size_t OFF_ROPE = OFF_WT3 + (size_t)1024 * 2048 * 2;
constexpr size_t OFF_H = OFF_ROPE + (size_t)2056 * 128 * 8;
constexpr size_t OFF_PROJ = OFF_H + (size_t)T_TOK * 1024 * 2;
constexpr size_t OFF_A2 = OFF_PROJ + (size_t)T_TOK * PROJ_LD * 2;
constexpr size_t OFF_PARTS = OFF_A2 + (size_t)T_TOK * 2048 * 2;
constexpr size_t OFF_X1 = OFF_PARTS + (size_t)T_TOK * 64 * 4;
constexpr size_t OFF_X2 = OFF_X1 + (size_t)T_TOK * 1024 * 4;
constexpr size_t OFF_XBCC = OFF_X2 + (size_t)T_TOK * 1024 * 4;
constexpr size_t OFF_DTRAW = OFF_XBCC + (size_t)T_TOK * 4096 * 2;
constexpr size_t OFF_DT = OFF_DTRAW + (size_t)T_TOK * 32 * 4;
constexpr size_t OFF_CUM = OFF_DT + (size_t)T_TOK * 32 * 4;
constexpr size_t OFF_BAR = OFF_CUM + (size_t)T_TOK * 32 * 4;

constexpr size_t OUT_Y = 0;
constexpr size_t OUT_RETP = 17825792;
constexpr size_t OUT_RETS = 22020096;
constexpr size_t OUT_SSMP = 89128960;
constexpr size_t OUT_SSMS = 91226112;
constexpr size_t OUT_CONVP = 124780544;
constexpr size_t OUT_CONVS = 124878848;

struct Params {
  const float *x_prompt, *x_sample, *state_ret, *state_ssm, *state_conv, *ret_norm, *ret_w_in, *ret_head_norm,
      *ret_w_out, *ssm_norm, *ssm_w_in, *ssm_conv_w, *ssm_conv_b, *ssm_dt_bias, *ssm_a_log, *ssm_d, *ssm_gate_norm,
      *ssm_w_out, *final_norm;
  float* out;
  unsigned char* ws;
  long long phase_lo, phase_hi, dup, tidx, wv;
};

typedef __bf16 bf16x2_t __attribute__((ext_vector_type(2)));
typedef float f32x2_t __attribute__((ext_vector_type(2)));
__device__ __forceinline__ u16 f2bf(float f) {
  __bf16 r = (__bf16)f;
  return __builtin_bit_cast(u16, r);
}
__device__ __forceinline__ float bf2f(u16 h) { return __uint_as_float(((uint32_t)h) << 16); }
__device__ __forceinline__ uint32_t pack2(float a, float b) {
  f32x2_t v = {a, b};
  bf16x2_t r = __builtin_convertvector(v, bf16x2_t);
  return __builtin_bit_cast(uint32_t, r);
}
__device__ __forceinline__ float ex2(float x) { return __builtin_amdgcn_exp2f(x); }
__device__ __forceinline__ float silu(float x) { return x * __builtin_amdgcn_rcpf(1.0f + __expf(-x)); }
__device__ __forceinline__ float row16_sum(float v) {
  v += __builtin_bit_cast(float, __builtin_amdgcn_update_dpp(0, __builtin_bit_cast(int, v), 0xB1, 0xF, 0xF, true));
  v += __builtin_bit_cast(float, __builtin_amdgcn_update_dpp(0, __builtin_bit_cast(int, v), 0x4E, 0xF, 0xF, true));
  v += __builtin_bit_cast(float, __builtin_amdgcn_update_dpp(0, __builtin_bit_cast(int, v), 0x124, 0xF, 0xF, true));
  v += __builtin_bit_cast(float, __builtin_amdgcn_update_dpp(0, __builtin_bit_cast(int, v), 0x128, 0xF, 0xF, true));
  return v;
}
__device__ __forceinline__ float wave_sum(float v) {
#pragma unroll
  for (int o = 32; o > 0; o >>= 1) v += __shfl_xor(v, o);
  return v;
}
__device__ __forceinline__ const float* xrow(const Params& p, int r) {
  return r < NPROMPT ? p.x_prompt + (size_t)r * 1024 : p.x_sample + (size_t)(r - NPROMPT) * 1024;
}
__device__ __forceinline__ s16x4 trread(const unsigned char* ptr) {
  return __builtin_amdgcn_ds_read_tr16_b64_v4i16((s16x4 __attribute__((address_space(3)))*)ptr);
}
__device__ __forceinline__ bf16x8 cat8(s16x4 a, s16x4 b) {
  bf16x8 r;
  r[0] = a[0]; r[1] = a[1]; r[2] = a[2]; r[3] = a[3];
  r[4] = b[0]; r[5] = b[1]; r[6] = b[2]; r[7] = b[3];
  return r;
}
__device__ __forceinline__ bf16x8 trfrag(const unsigned char* img, int rs, int kbase, int nbase, int lane) {
  const int g = lane >> 4, q = (lane & 15) >> 2, pp = lane & 3;
  const unsigned char* a = img + (kbase + 8 * g + q) * rs + (nbase + 4 * pp) * 2;
  s16x4 t0 = trread(a);
  s16x4 t1 = trread(a + 4 * rs);
  return cat8(t0, t1);
}

__device__ __forceinline__ int colmap_retin(int p) {
  if (p < 2048) {
    int hb = p & ~255, pp = p & 255;
    int gi = pp >> 5, half = (pp >> 4) & 1, c = pp & 15;
    return hb + half * 128 + gi * 16 + c;
  }
  return p;
}

__device__ void transpose_tile(const float* __restrict__ W, u16* __restrict__ Wt, int K, int N, int mode, int nt, int kt,
                               unsigned char* smem, const int tid) {
  float* tile = (float*)smem;
#pragma unroll
  for (int i = 0; i < 8; ++i) {
    int idx = tid + NTHR * i;
    int kk = idx >> 6, nn = idx & 63;
    int n = nt * 64 + nn;
    int src = (mode == 1) ? colmap_retin(n) : n;
    float v = 0.f;
    if (src < N) v = W[(size_t)(kt * 64 + kk) * N + src];
    tile[kk * 65 + nn] = v;
  }
  __syncthreads();
  {
    int n = tid >> 3, kc = tid & 7;
    float v[8];
#pragma unroll
    for (int j = 0; j < 8; ++j) v[j] = tile[(kc * 8 + j) * 65 + n];
    u32x4 o;
    o.x = pack2(v[0], v[1]); o.y = pack2(v[2], v[3]); o.z = pack2(v[4], v[5]); o.w = pack2(v[6], v[7]);
    *(u32x4*)(Wt + (size_t)(nt * 64 + n) * K + kt * 64 + kc * 8) = o;
  }
  __syncthreads();
}

__device__ void phase_prep(const Params& p, unsigned char* smem, const int rep) {
  const int tid = (int)p.tidx;
  for (int rr = 0; rr < rep; ++rr) {
  u16* Wt0 = (u16*)(p.ws + OFF_WT0);
  for (int t = blockIdx.x; t < 1536; t += gridDim.x)
    transpose_tile(p.ret_w_in, Wt0, 1024, 6144, 1, t >> 4, t & 15, smem, tid);
  float2* rope = (float2*)(p.ws + OFF_ROPE);
  const int gtid = blockIdx.x * NTHR + tid, gn = gridDim.x * NTHR;
  for (int idx = gtid; idx < 2056 * 128; idx += gn) {
    int pi = idx >> 7, i = idx & 127;
    int pos = pi < 2048 ? pi : 16384 + (pi - 2048);
    float freq = (float)exp2(-(double)i * (13.287712379549449 / 128.0));
    float ang = (float)pos * freq;
    float sn, cs;
    sincosf(ang, &sn, &cs);
    rope[idx] = make_float2(cs, sn);
  }
  u16* H = (u16*)(p.ws + OFF_H);
  const int lane = tid & 63, w = (int)p.wv;
  for (int row = blockIdx.x * 8 + w; row < T_TOK; row += gridDim.x * 8) {
    const float* xr = xrow(p, row);
    float4 v[4];
    float ss = 0.f;
#pragma unroll
    for (int i = 0; i < 4; ++i) {
      v[i] = *(const float4*)(xr + i * 256 + lane * 4);
      ss += v[i].x * v[i].x + v[i].y * v[i].y + v[i].z * v[i].z + v[i].w * v[i].w;
    }
    ss = wave_sum(ss);
    float rstd = rsqrtf(ss * (1.0f / 1024.0f) + 1e-6f);
#pragma unroll
    for (int i = 0; i < 4; ++i) {
      float4 gg = *(const float4*)(p.ret_norm + i * 256 + lane * 4);
      u32x2 o;
      o.x = pack2(v[i].x * rstd * gg.x, v[i].y * rstd * gg.y);
      o.y = pack2(v[i].z * rstd * gg.z, v[i].w * rstd * gg.w);
      *(u32x2*)(H + (size_t)row * 1024 + i * 256 + lane * 4) = o;
    }
  }
  }
}

__device__ void transpose_later_weights(const Params& p, unsigned char* smem, const int first_blk) {
  const int tid = (int)p.tidx;
  u16* Wt1 = (u16*)(p.ws + OFF_WT1);
  u16* Wt2 = (u16*)(p.ws + OFF_WT2);
  u16* Wt3 = (u16*)(p.ws + OFF_WT3);
  const int n1 = 512, n2 = 1568, n3 = 512;
  if ((int)blockIdx.x < first_blk) return;
  const int nb = (int)gridDim.x - first_blk;
  for (int t = (int)blockIdx.x - first_blk; t < n1 + n2 + n3; t += nb) {
    if (t < n1) {
      transpose_tile(p.ret_w_out, Wt1, 2048, 1024, 0, t >> 5, t & 31, smem, tid);
    } else if (t < n1 + n2) {
      int u = t - n1;
      transpose_tile(p.ssm_w_in, Wt2, 1024, 6176, 0, u >> 4, u & 15, smem, tid);
    } else {
      int u = t - n1 - n2;
      transpose_tile(p.ssm_w_out, Wt3, 2048, 1024, 0, u >> 5, u & 31, smem, tid);
    }
  }
}

template <int MODE>
__device__ void phase_norm(const Params& p, const float* __restrict__ X, const float* __restrict__ gain, const int rep) {
  const int tid = (int)p.tidx, lane = tid & 63, w = (int)p.wv;
  u16* H = (u16*)(p.ws + OFF_H);
  for (int row0 = blockIdx.x * 8 + w; row0 < T_TOK * rep; row0 += gridDim.x * 8) {
    const int row = row0 % T_TOK;
    const float* xr = X + (size_t)row * 1024;
    float4 v[4];
    float ss = 0.f;
#pragma unroll
    for (int i = 0; i < 4; ++i) {
      v[i] = *(const float4*)(xr + i * 256 + lane * 4);
      ss += v[i].x * v[i].x + v[i].y * v[i].y + v[i].z * v[i].z + v[i].w * v[i].w;
    }
    ss = wave_sum(ss);
    float rstd = rsqrtf(ss * (1.0f / 1024.0f) + 1e-6f);
#pragma unroll
    for (int i = 0; i < 4; ++i) {
      float4 gg = *(const float4*)(gain + i * 256 + lane * 4);
      if (MODE == 0) {
        u32x2 o;
        o.x = pack2(v[i].x * rstd * gg.x, v[i].y * rstd * gg.y);
        o.y = pack2(v[i].z * rstd * gg.z, v[i].w * rstd * gg.w);
        *(u32x2*)(H + (size_t)row * 1024 + i * 256 + lane * 4) = o;
      } else {
        float4 o = make_float4(v[i].x * rstd * gg.x, v[i].y * rstd * gg.y, v[i].z * rstd * gg.z, v[i].w * rstd * gg.w);
        *(float4*)(p.out + OUT_Y + (size_t)row * 1024 + i * 256 + lane * 4) = o;
      }
    }
  }
}

template <int EPI, int NH>
__device__ void gemm_phase(const Params& p, const u16* __restrict__ A, const u16* __restrict__ Bt, const int K, const int NT,
                           const float* __restrict__ resid, float* __restrict__ outf, unsigned char* smem, const int rep,
                           const int mtiles, const int nt0 = 0, const bool rev = false) {
  constexpr int BM = 256, BN = 128, BK = 64, LR = 144;
  constexpr int BUFB = (BM + BN) * LR;
  float* rstdS = (float*)(smem + 2 * BUFB);
  const int tid = (int)p.tidx, lane = tid & 63, w = (int)p.wv;
  const int wm = w >> 1, wn = w & 1, l15 = lane & 15, g = lane >> 4;
  const int KT = K / BK;
  const int ntiles = mtiles * NT;
  const float* parts = (const float*)(p.ws + OFF_PARTS);
  const int srow = tid >> 3, skc = tid & 7;

  for (int tile0 = rev ? (int)(gridDim.x - 1 - blockIdx.x) : (int)blockIdx.x; tile0 < ntiles * rep; tile0 += gridDim.x) {
    const int tile = tile0 % ntiles;
    int mt = tile / NT, nt = tile - mt * NT + nt0;
    if (EPI == 1 && NT == 8 && mtiles == 64 && gridDim.x == 256) {
      const int blk = tile & 255, rnd = tile >> 8;
      mt = rnd * 32 + (blk & 7) * 4 + (blk >> 6);
      nt = (blk >> 3) & 7;
    }
    const int m0 = mt * BM, n0 = nt * BN;
    const bool skip_mma = (EPI == 2) && (n0 >= 6144) && (wn == 1);
    if (NH > 0) {
      for (int idx = tid; idx < BM * NH; idx += NTHR) {
        int row = idx / NH, h = idx % NH;
        const float* pp = parts + (size_t)(m0 + row) * 64 + h * (64 / NH);
        float s = 0.f;
#pragma unroll
        for (int q = 0; q < 64 / NH; ++q) s += pp[q];
        rstdS[idx] = rsqrtf(s / (float)(K / NH) + 1e-6f);
      }
    }
    u32x4 ra[2][4], rb[2][2];
    const u16* ap = A + (size_t)(m0 + srow) * K + skc * 8;
    const u16* bp = Bt + (size_t)(n0 + srow) * K + skc * 8;
#pragma unroll
    for (int i = 0; i < 4; ++i) ra[0][i] = *(const u32x4*)(ap + (size_t)(64 * i) * K);
#pragma unroll
    for (int i = 0; i < 2; ++i) rb[0][i] = *(const u32x4*)(bp + (size_t)(64 * i) * K);
#pragma unroll
    for (int i = 0; i < 4; ++i) ra[1][i] = *(const u32x4*)(ap + (size_t)(64 * i) * K + BK);
#pragma unroll
    for (int i = 0; i < 2; ++i) rb[1][i] = *(const u32x4*)(bp + (size_t)(64 * i) * K + BK);
    {
      unsigned char* base = smem;
#pragma unroll
      for (int i = 0; i < 4; ++i) *(u32x4*)(base + (srow + 64 * i) * LR + skc * 16) = ra[0][i];
#pragma unroll
      for (int i = 0; i < 2; ++i) *(u32x4*)(base + BM * LR + (srow + 64 * i) * LR + skc * 16) = rb[0][i];
    }
    __syncthreads();

    f32x4 acc[4][4];
    f32x4 accT[4][4];
#pragma unroll
    for (int i = 0; i < 4; ++i)
#pragma unroll
      for (int j = 0; j < 4; ++j) {
        acc[i][j] = (f32x4){0.f, 0.f, 0.f, 0.f};
        accT[i][j] = (f32x4){0.f, 0.f, 0.f, 0.f};
      }

    for (int kt2 = 0; kt2 < KT; kt2 += 2) {
#pragma unroll
     for (int par = 0; par < 2; ++par) {
      const int kt = kt2 + par;
      if (kt + 2 < KT) {
#pragma unroll
        for (int i = 0; i < 4; ++i) ra[par][i] = *(const u32x4*)(ap + (size_t)(64 * i) * K + (kt + 2) * BK);
#pragma unroll
        for (int i = 0; i < 2; ++i) rb[par][i] = *(const u32x4*)(bp + (size_t)(64 * i) * K + (kt + 2) * BK);
      }
      const unsigned char* abase = smem + par * BUFB + (wm * 64 + l15) * LR + g * 16;
      const unsigned char* bbase = smem + par * BUFB + BM * LR + (wn * 64 + l15) * LR + g * 16;
      if (!skip_mma)
#pragma unroll
      for (int ks = 0; ks < 2; ++ks) {
        bf16x8 af[4], bfr[2];
#pragma unroll
        for (int mf = 0; mf < 4; ++mf) af[mf] = *(const bf16x8*)(abase + mf * 16 * LR + ks * 64);
#pragma unroll
        for (int nh = 0; nh < 2; ++nh) {
#pragma unroll
          for (int n2 = 0; n2 < 2; ++n2) bfr[n2] = *(const bf16x8*)(bbase + (nh * 2 + n2) * 16 * LR + ks * 64);
#pragma unroll
          for (int mf = 0; mf < 4; ++mf)
#pragma unroll
            for (int n2 = 0; n2 < 2; ++n2)
              acc[mf][nh * 2 + n2] = __builtin_amdgcn_mfma_f32_16x16x32_bf16(af[mf], bfr[n2], acc[mf][nh * 2 + n2], 0, 0, 0);
        }
      }
      if (NH > 0) {
        const int per = KT / NH;
        if (((kt + 1) % per) == 0) {
          const int h = (kt + 1) / per - 1;
#pragma unroll
          for (int mf = 0; mf < 4; ++mf)
#pragma unroll
            for (int r = 0; r < 4; ++r) {
              float s = rstdS[(wm * 64 + mf * 16 + 4 * g + r) * NH + h];
#pragma unroll
              for (int nf = 0; nf < 4; ++nf) {
                accT[mf][nf][r] += s * acc[mf][nf][r];
                acc[mf][nf][r] = 0.f;
              }
            }
        }
      }
      if (kt + 1 < KT) {
        unsigned char* base = smem + (par ^ 1) * BUFB;
#pragma unroll
        for (int i = 0; i < 4; ++i) *(u32x4*)(base + (srow + 64 * i) * LR + skc * 16) = ra[par ^ 1][i];
#pragma unroll
        for (int i = 0; i < 2; ++i) *(u32x4*)(base + BM * LR + (srow + 64 * i) * LR + skc * 16) = rb[par ^ 1][i];
      }
      __syncthreads();
     }
    }

#pragma unroll
    for (int mf = 0; mf < 4; ++mf) {
      __builtin_amdgcn_sched_barrier(0);
      float rvv[4][4];
      if (EPI == 1) {
#pragma unroll
        for (int r = 0; r < 4; ++r) {
          const int row = m0 + wm * 64 + mf * 16 + 4 * g + r;
#pragma unroll
          for (int nf = 0; nf < 4; ++nf) {
            const int col = n0 + wn * 64 + nf * 16 + l15;
            rvv[r][nf] = resid ? resid[(size_t)row * 1024 + col] : xrow(p, row)[col];
          }
        }
      }
#pragma unroll
      for (int r = 0; r < 4; ++r) {
        const int row = m0 + wm * 64 + mf * 16 + 4 * g + r;
        if (EPI == 0) {
          u16* proj = (u16*)(p.ws + OFF_PROJ) + (size_t)row * PROJ_LD;
          if (n0 < 2048) {
            const float2* rope = (const float2*)(p.ws + OFF_ROPE);
            const int pi = row < NPROMPT ? (row & 2047) : 2048 + ((row - NPROMPT) & 7);
#pragma unroll
            for (int np = 0; np < 2; ++np) {
              const int pc = n0 + wn * 64 + np * 32;
              const int i = ((pc & 255) >> 5) * 16 + l15;
              const float2 cs = rope[pi * 128 + i];
              const float x1 = acc[mf][2 * np][r], x2 = acc[mf][2 * np + 1][r];
              float y1 = x1 * cs.x - x2 * cs.y, y2 = x1 * cs.y + x2 * cs.x;
              if (pc >= 1024) { y1 *= 0.0625f; y2 *= 0.0625f; }
              const int f1 = (pc & ~255) + i;
              proj[f1] = f2bf(y1);
              proj[f1 + 128] = f2bf(y2);
            }
          } else {
#pragma unroll
            for (int nf = 0; nf < 4; ++nf) proj[n0 + wn * 64 + nf * 16 + l15] = f2bf(acc[mf][nf][r]);
          }
        } else if (EPI == 1) {
#pragma unroll
          for (int nf = 0; nf < 4; ++nf) {
            const int col = n0 + wn * 64 + nf * 16 + l15;
            const float a = (NH > 0) ? accT[mf][nf][r] : acc[mf][nf][r];
            outf[(size_t)row * 1024 + col] = rvv[r][nf] + a;
          }
        } else {
          u16* proj = (u16*)(p.ws + OFF_PROJ) + (size_t)row * PROJ_LD;
          float* dtraw = (float*)(p.ws + OFF_DTRAW) + (size_t)row * 32;
          float* cvo = nullptr;
          if (row < NPROMPT) {
            const int t = row & 2047;
            if (t >= 2045) cvo = p.out + OUT_CONVP + ((size_t)(row >> 11) * 3 + (t - 2045)) * 4096;
          } else {
            const int rs = row - NPROMPT, t = rs & 7;
            if (t >= 5) cvo = p.out + OUT_CONVS + ((size_t)(rs >> 3) * 3 + (t - 5)) * 4096;
          }
#pragma unroll
          for (int nf = 0; nf < 4; ++nf) {
            const int col = n0 + wn * 64 + nf * 16 + l15;
            const float a = acc[mf][nf][r];
            if (col < 6144) {
              proj[col] = f2bf(a);
              if (col >= 2048 && cvo) cvo[col - 2048] = a;
            } else if (col < 6176) {
              dtraw[col - 6144] = a;
            }
          }
        }
      }
    }
  }
}


template <int NH>
__device__ void gemm_sample_rows(const Params& p, const u16* __restrict__ A, const u16* __restrict__ Bt,
                                 const float* __restrict__ resid, float* __restrict__ outf, unsigned char* smem, const int rep) {
  constexpr int K = 2048, RS = 65;
  float* red = (float*)smem;
  float* rstdS = red + 8 * 64 * RS;
  const int tid = (int)p.tidx, lane = tid & 63, w = (int)p.wv, l15 = lane & 15, g = lane >> 4;
  const float* parts = (const float*)(p.ws + OFF_PARTS);
  for (int item0 = blockIdx.x; item0 < 256 * rep; item0 += gridDim.x) {
    const int item = item0 & 255;
    const int m0 = NPROMPT + (item >> 4) * 64, n0 = (item & 15) * 64;
    for (int idx = tid; idx < 64 * NH; idx += NTHR) {
      const int row = idx / NH, h = idx % NH;
      const float* pp = parts + (size_t)(m0 + row) * 64 + h * (64 / NH);
      float sm = 0.f;
#pragma unroll
      for (int q = 0; q < 64 / NH; ++q) sm += pp[q];
      rstdS[idx] = rsqrtf(sm / (float)(K / NH) + 1e-6f);
    }
    f32x4 acc[4][4];
#pragma unroll
    for (int i = 0; i < 4; ++i)
#pragma unroll
      for (int j = 0; j < 4; ++j) acc[i][j] = (f32x4){0.f, 0.f, 0.f, 0.f};
    const u16* ap = A + (size_t)(m0 + l15) * K + w * 256 + 8 * g;
    const u16* bp = Bt + (size_t)(n0 + l15) * K + w * 256 + 8 * g;
#pragma unroll 2
    for (int ks = 0; ks < 8; ++ks) {
      bf16x8 af[4], bfr[4];
#pragma unroll
      for (int mf = 0; mf < 4; ++mf) af[mf] = *(const bf16x8*)(ap + (size_t)(mf * 16) * K + ks * 32);
#pragma unroll
      for (int nf = 0; nf < 4; ++nf) bfr[nf] = *(const bf16x8*)(bp + (size_t)(nf * 16) * K + ks * 32);
#pragma unroll
      for (int mf = 0; mf < 4; ++mf)
#pragma unroll
        for (int nf = 0; nf < 4; ++nf)
          acc[mf][nf] = __builtin_amdgcn_mfma_f32_16x16x32_bf16(af[mf], bfr[nf], acc[mf][nf], 0, 0, 0);
    }
    __syncthreads();
    {
      const int h = (w * 256) / (K / NH);
#pragma unroll
      for (int mf = 0; mf < 4; ++mf)
#pragma unroll
        for (int r = 0; r < 4; ++r) {
          const int row = mf * 16 + 4 * g + r;
          const float sc = rstdS[row * NH + h];
#pragma unroll
          for (int nf = 0; nf < 4; ++nf) red[(w * 64 + row) * RS + nf * 16 + l15] = acc[mf][nf][r] * sc;
        }
    }
    __syncthreads();
    {
      const int row = tid >> 3, c0 = (tid & 7) * 8;
      float o[8];
      const size_t gidx = (size_t)(m0 + row) * 1024 + n0 + c0;
      const float* rp = resid ? resid + gidx : p.x_sample + (size_t)(m0 - NPROMPT + row) * 1024 + n0 + c0;
      const float4 r0 = *(const float4*)rp, r1 = *(const float4*)(rp + 4);
      o[0] = r0.x; o[1] = r0.y; o[2] = r0.z; o[3] = r0.w; o[4] = r1.x; o[5] = r1.y; o[6] = r1.z; o[7] = r1.w;
#pragma unroll
      for (int ww = 0; ww < 8; ++ww)
#pragma unroll
        for (int j = 0; j < 8; ++j) o[j] += red[(ww * 64 + row) * RS + c0 + j];
      *(float4*)(outf + gidx) = make_float4(o[0], o[1], o[2], o[3]);
      *(float4*)(outf + gidx + 4) = make_float4(o[4], o[5], o[6], o[7]);
    }
    __syncthreads();
  }
}

__device__ __forceinline__ int lds_byte(int r, int c) {
  int st = (r >> 4) * 2 + (c >> 5), rr = r & 15, cc = c & 31, ob = rr * 64 + cc * 2;
  return st * 1024 + (ob ^ (((ob >> 9) & 1) << 5));
}
__device__ __forceinline__ void stage_rc(int b, int& R, int& C) {
  int st = b / 1024, sb = b % 1024, swz = sb ^ (((sb >> 9) & 1) << 5);
  R = (st >> 1) * 16 + swz / 64;
  C = (st & 1) * 32 + (swz % 64) / 2;
}

template <int EPI>
__device__ void gemm8_phase(const Params& p, const u16* __restrict__ A, const u16* __restrict__ Bt, const int K, const int nN,
                            unsigned char* smem, const int rep) {
  constexpr int BM8 = 256, BK8 = 64, HALF = 128, NXCD = 8, WGM = 8, HT = HALF * BK8;
  u16* shm = (u16*)smem;
#define SA(b, h) (shm + ((b) * 2 + (h)) * HT)
#define SB(b, h) (shm + (4 + (b) * 2 + (h)) * HT)
#define STAGE(P, BASE, br, kt)                                                                            \
  do {                                                                                                    \
    const int _so = ((br) * K + (kt) * BK8) * 2;                                                          \
    __builtin_amdgcn_raw_ptr_buffer_load_lds(rsrc_##BASE, (__attribute__((address_space(3))) unsigned*)((char*)(P) + (int)p.tidx * 16), 16, voff0, _so, 0, 0); \
    __builtin_amdgcn_raw_ptr_buffer_load_lds(rsrc_##BASE, (__attribute__((address_space(3))) unsigned*)((char*)(P) + (int)p.tidx * 16 + 8192), 16, voff1, _so, 0, 0); \
  } while (0)
#define LDA(dst, b, h)                                                                                    \
  for (int m = 0; m < 4; ++m)                                                                             \
    for (int k = 0; k < 2; ++k)                                                                           \
      dst[m][k] = *reinterpret_cast<const bf16x8*>((char*)SA(b, h) + lds_byte(wr * 64 + m * 16 + fr, k * 32 + fq * 8))
#define LDB(dst, b, h)                                                                                    \
  for (int n = 0; n < 2; ++n)                                                                             \
    for (int k = 0; k < 2; ++k)                                                                           \
      dst[n][k] = *reinterpret_cast<const bf16x8*>((char*)SB(b, h) + lds_byte(wc * 32 + n * 16 + fr, k * 32 + fq * 8))
#define MMA(ai, bj, At, Bx)                                                                               \
  do {                                                                                                    \
    __builtin_amdgcn_s_setprio(1);                                                                        \
    for (int m = 0; m < 4; ++m)                                                                           \
      for (int n = 0; n < 2; ++n)                                                                         \
        for (int k = 0; k < 2; ++k)                                                                       \
          acc[ai][bj][m][n] = __builtin_amdgcn_mfma_f32_16x16x32_bf16(At[m][k], Bx[n][k], acc[ai][bj][m][n], 0, 0, 0); \
    __builtin_amdgcn_s_setprio(0);                                                                        \
  } while (0)
#define WAIT_V(n) asm volatile("s_waitcnt vmcnt(" #n ")" ::: "memory")
#define WAIT_L(n) asm volatile("s_waitcnt lgkmcnt(" #n ")" ::: "memory")
#define BAR __builtin_amdgcn_s_barrier()
#define SCHED __builtin_amdgcn_sched_barrier(0)

  const int nM = T_TOK / BM8, nwg = nM * nN;
  const int wid = (int)p.wv, lane = (int)p.tidx & 63, wr = wid >> 2, wc = wid & 3, fr = lane & 15, fq = lane >> 4;
  const int nt = K / BK8;
  const __amdgpu_buffer_rsrc_t rsrc_A = __builtin_amdgcn_make_buffer_rsrc((void*)A, (short)0, T_TOK * K * 2, 0x00020000);
  const __amdgpu_buffer_rsrc_t rsrc_Bt = __builtin_amdgcn_make_buffer_rsrc((void*)Bt, (short)0, nN * 256 * K * 2, 0x00020000);
  int voff0, voff1;
  {
    int r_, c_;
    stage_rc((int)p.tidx * 16, r_, c_);
    voff0 = (r_ * K + c_) * 2;
    stage_rc((int)p.tidx * 16 + 8192, r_, c_);
    voff1 = (r_ * K + c_) * 2;
  }

  for (int tile0 = blockIdx.x; tile0 < nwg * rep; tile0 += gridDim.x) {
    const int tile = tile0 % nwg;
    int wgid = tile;
    {
      int q = nwg / NXCD, r = nwg % NXCD, xcd = wgid % NXCD, off = wgid / NXCD;
      wgid = (xcd < r ? xcd * (q + 1) : r * (q + 1) + (xcd - r) * q) + off;
    }
    const int nig = WGM * nN, gid = wgid / nig, fm = gid * WGM, gsz = min(nM - fm, WGM);
    const int pm = fm + ((wgid % nig) % gsz), pn = (wgid % nig) / gsz, brow = pm * BM8, bcol = pn * BM8;

    f32x4 acc[2][2][4][2];
#pragma unroll
    for (int a = 0; a < 2; ++a)
#pragma unroll
      for (int b = 0; b < 2; ++b)
#pragma unroll
        for (int m = 0; m < 4; ++m)
#pragma unroll
          for (int n = 0; n < 2; ++n) acc[a][b][m][n] = (f32x4){0.f, 0.f, 0.f, 0.f};
    bf16x8 At[4][2], B0[2][2], B1[2][2];

    STAGE(SB(0, 0), Bt, bcol, 0); STAGE(SA(0, 0), A, brow, 0);
    STAGE(SB(0, 1), Bt, bcol + HALF, 0); STAGE(SA(0, 1), A, brow + HALF, 0);
    if (wr == 1) BAR;
    WAIT_V(4); BAR;
    STAGE(SB(1, 0), Bt, bcol, 1); STAGE(SA(1, 0), A, brow, 1); STAGE(SB(1, 1), Bt, bcol + HALF, 1);
    WAIT_V(6); BAR;
    for (int t = 0; t < nt - 2; t += 2) {
      LDB(B0, 0, 0); SCHED; LDA(At, 0, 0); STAGE(SA(1, 1), A, brow + HALF, t + 1);
      WAIT_L(8); BAR; WAIT_L(0); MMA(0, 0, At, B0); BAR; SCHED;
      LDB(B1, 0, 1); STAGE(SB(0, 0), Bt, bcol, t + 2);
      BAR; WAIT_L(0); MMA(0, 1, At, B1); BAR;
      LDA(At, 0, 1); STAGE(SA(0, 0), A, brow, t + 2);
      BAR; WAIT_L(0); MMA(1, 0, At, B0); BAR; SCHED;
      STAGE(SB(0, 1), Bt, bcol + HALF, t + 2);
      WAIT_V(6); BAR; MMA(1, 1, At, B1); BAR;
      LDB(B0, 1, 0); SCHED; LDA(At, 1, 0); STAGE(SA(0, 1), A, brow + HALF, t + 2);
      WAIT_L(8); BAR; WAIT_L(0); MMA(0, 0, At, B0); BAR; SCHED;
      LDB(B1, 1, 1); STAGE(SB(1, 0), Bt, bcol, t + 3);
      BAR; WAIT_L(0); MMA(0, 1, At, B1); BAR;
      LDA(At, 1, 1); STAGE(SA(1, 0), A, brow, t + 3);
      BAR; WAIT_L(0); MMA(1, 0, At, B0); BAR; SCHED;
      STAGE(SB(1, 1), Bt, bcol + HALF, t + 3);
      WAIT_V(6); BAR; MMA(1, 1, At, B1); BAR;
    }
    {
      LDB(B0, 0, 0); LDA(At, 0, 0); STAGE(SA(1, 1), A, brow + HALF, nt - 1);
      BAR; WAIT_L(0); MMA(0, 0, At, B0); BAR; SCHED;
      LDB(B1, 0, 1); BAR; WAIT_L(0); MMA(0, 1, At, B1); BAR; SCHED;
      LDA(At, 0, 1); WAIT_V(4); BAR; WAIT_L(0); MMA(1, 0, At, B0); MMA(1, 1, At, B1); BAR; SCHED;
    }
    {
      LDB(B0, 1, 0); LDA(At, 1, 0); WAIT_V(2); BAR; WAIT_L(0); MMA(0, 0, At, B0); BAR; SCHED;
      LDB(B1, 1, 1); WAIT_V(0); BAR; WAIT_L(0); MMA(0, 1, At, B1); BAR; SCHED;
      LDA(At, 1, 1); BAR; WAIT_L(0); MMA(1, 0, At, B0); MMA(1, 1, At, B1); BAR; SCHED;
    }
    if (wr == 0) BAR;

    u16* projb = (u16*)(p.ws + OFF_PROJ);
#pragma unroll
    for (int ai = 0; ai < 2; ++ai)
#pragma unroll
      for (int m = 0; m < 4; ++m) {
        if (EPI == 0 && bcol < 2048) {
          const float2* rope = (const float2*)(p.ws + OFF_ROPE);
#pragma unroll
          for (int bj = 0; bj < 2; ++bj) {
            __builtin_amdgcn_sched_barrier(0);
            const int pc = bcol + bj * HALF + wc * 32;
            const int i = ((pc & 255) >> 5) * 16 + fr;
            const int f1 = (pc & ~255) + i;
            float2 csv[4];
#pragma unroll
            for (int j = 0; j < 4; ++j) {
              const int row = brow + ai * HALF + wr * 64 + m * 16 + fq * 4 + j;
              const int pi = row < NPROMPT ? (row & 2047) : 2048 + ((row - NPROMPT) & 7);
              csv[j] = rope[pi * 128 + i];
            }
#pragma unroll
            for (int j = 0; j < 4; ++j) {
              const int row = brow + ai * HALF + wr * 64 + m * 16 + fq * 4 + j;
              u16* proj = projb + (size_t)row * PROJ_LD;
              const float2 cs = csv[j];
              const float x1 = acc[ai][bj][m][0][j], x2 = acc[ai][bj][m][1][j];
              float y1 = x1 * cs.x - x2 * cs.y, y2 = x1 * cs.y + x2 * cs.x;
              if (pc >= 1024) { y1 *= 0.0625f; y2 *= 0.0625f; }
              proj[f1] = f2bf(y1);
              proj[f1 + 128] = f2bf(y2);
            }
          }
        } else {
#pragma unroll
          for (int j = 0; j < 4; ++j) {
            __builtin_amdgcn_sched_barrier(0);
            const int row = brow + ai * HALF + wr * 64 + m * 16 + fq * 4 + j;
            u16* proj = projb + (size_t)row * PROJ_LD;
            float* cvo = nullptr;
            if (EPI == 2 && bcol >= 2048) {
              if (row < NPROMPT) {
                const int t = row & 2047;
                if (t >= 2045) cvo = p.out + OUT_CONVP + ((size_t)(row >> 11) * 3 + (t - 2045)) * 4096;
              } else {
                const int rs = row - NPROMPT, t = rs & 7;
                if (t >= 5) cvo = p.out + OUT_CONVS + ((size_t)(rs >> 3) * 3 + (t - 5)) * 4096;
              }
            }
#pragma unroll
            for (int bj = 0; bj < 2; ++bj)
#pragma unroll
              for (int n = 0; n < 2; ++n) {
                const int col = bcol + bj * HALF + wc * 32 + n * 16 + fr;
                const float a = acc[ai][bj][m][n][j];
                proj[col] = f2bf(a);
                if (EPI == 2 && cvo) cvo[col - 2048] = a;
              }
          }
        }
      }
  }
#undef SA
#undef SB
#undef STAGE
#undef LDA
#undef LDB
#undef MMA
#undef WAIT_V
#undef WAIT_L
#undef BAR
#undef SCHED
}

__device__ __forceinline__ void unpack8(const u32x4 u, float* xv) {
  xv[0] = bf2f((u16)(u.x & 0xffff)); xv[1] = bf2f((u16)(u.x >> 16));
  xv[2] = bf2f((u16)(u.y & 0xffff)); xv[3] = bf2f((u16)(u.y >> 16));
  xv[4] = bf2f((u16)(u.z & 0xffff)); xv[5] = bf2f((u16)(u.z >> 16));
  xv[6] = bf2f((u16)(u.w & 0xffff)); xv[7] = bf2f((u16)(u.w >> 16));
}

__device__ void phase_conv(const Params& p, unsigned char* smem, const int rep) {
  const int tid = (int)p.tidx;
  const float* dtraw = (const float*)(p.ws + OFF_DTRAW);
  float* dtv = (float*)(p.ws + OFF_DT);
  float* cumv = (float*)(p.ws + OFF_CUM);
  {
    float* laS = (float*)smem;
    const int tok = tid >> 3, h0 = (tid & 7) * 4;
    const float4 bias = *(const float4*)(p.ssm_dt_bias + h0);
    const float4 al = *(const float4*)(p.ssm_a_log + h0);
    const float4 an = make_float4(-expf(al.x), -expf(al.y), -expf(al.z), -expf(al.w));
    for (int sc = blockIdx.x; sc < 384; sc += gridDim.x) {
      int row0, len;
      if (sc < 256) { row0 = sc * 64; len = 64; } else { row0 = NPROMPT + (sc - 256) * 8; len = 8; }
      if (tok < len) {
        const float4 x = *(const float4*)(dtraw + (size_t)(row0 + tok) * 32 + h0);
        float4 dt;
        { float v = x.x + bias.x; dt.x = v > 20.f ? v : log1pf(expf(v)); }
        { float v = x.y + bias.y; dt.y = v > 20.f ? v : log1pf(expf(v)); }
        { float v = x.z + bias.z; dt.z = v > 20.f ? v : log1pf(expf(v)); }
        { float v = x.w + bias.w; dt.w = v > 20.f ? v : log1pf(expf(v)); }
        *(float4*)(dtv + (size_t)(row0 + tok) * 32 + h0) = dt;
        *(float4*)(laS + tok * 32 + h0) = make_float4(dt.x * an.x * 1.4426950408889634f, dt.y * an.y * 1.4426950408889634f,
                                                      dt.z * an.z * 1.4426950408889634f, dt.w * an.w * 1.4426950408889634f);
      }
      __syncthreads();
      if (tok < len) {
        float4 c = make_float4(0.f, 0.f, 0.f, 0.f);
        for (int t = 0; t <= tok; ++t) {
          const float4 v = *(const float4*)(laS + t * 32 + h0);
          c.x += v.x; c.y += v.y; c.z += v.z; c.w += v.w;
        }
        *(float4*)(cumv + (size_t)(row0 + tok) * 32 + h0) = c;
      }
      __syncthreads();
    }
  }
  const u16* proj = (const u16*)(p.ws + OFF_PROJ);
  u16* xbcc = (u16*)(p.ws + OFF_XBCC);
  const int gtid = blockIdx.x * NTHR + tid;
  const int ch0 = (gtid & 511) * 8, rb = gtid >> 9;
  float wgt[4][8], bs[8];
#pragma unroll
  for (int wv = 0; wv < 4; ++wv) {
    const float4 w0 = *(const float4*)(p.ssm_conv_w + (size_t)wv * 4096 + ch0);
    const float4 w1 = *(const float4*)(p.ssm_conv_w + (size_t)wv * 4096 + ch0 + 4);
    wgt[wv][0] = w0.x; wgt[wv][1] = w0.y; wgt[wv][2] = w0.z; wgt[wv][3] = w0.w;
    wgt[wv][4] = w1.x; wgt[wv][5] = w1.y; wgt[wv][6] = w1.z; wgt[wv][7] = w1.w;
  }
  {
    const float4 b0 = *(const float4*)(p.ssm_conv_b + ch0), b1 = *(const float4*)(p.ssm_conv_b + ch0 + 4);
    bs[0] = b0.x; bs[1] = b0.y; bs[2] = b0.z; bs[3] = b0.w; bs[4] = b1.x; bs[5] = b1.y; bs[6] = b1.z; bs[7] = b1.w;
  }
  const int rows_per = T_TOK / (int)(gridDim.x * NTHR / 512);
  for (int rr = 0; rr < rep; ++rr) {
    float hm3[8], hm2[8], hm1[8];
    const int rbeg = rb * rows_per;
    u32x4 cur[4], nxt[4];
#pragma unroll
    for (int q = 0; q < 4; ++q) cur[q] = *(const u32x4*)(proj + (size_t)(rbeg + q) * PROJ_LD + 2048 + ch0);
    for (int r4 = 0; r4 < rows_per; r4 += 4) {
#pragma unroll
      for (int q = 0; q < 4; ++q) {
        nxt[q] = cur[q];
        if (r4 + 4 + q < rows_per) nxt[q] = *(const u32x4*)(proj + (size_t)(rbeg + r4 + 4 + q) * PROJ_LD + 2048 + ch0);
      }
#pragma unroll
      for (int q4 = 0; q4 < 4; ++q4) {
        const int r = r4 + q4;
        const int row = rbeg + r;
        const bool samp = row >= NPROMPT;
        const int t = samp ? ((row - NPROMPT) & 7) : (row & 2047);
        const int b = samp ? ((row - NPROMPT) >> 3) : (row >> 11);
        if (r == 0 || t == 0) {
#pragma unroll
          for (int k = 1; k <= 3; ++k) {
            float hv[8];
            if (t - k >= 0) {
              unpack8(*(const u32x4*)(proj + (size_t)(row - k) * PROJ_LD + 2048 + ch0), hv);
            } else if (samp) {
              const float* sp = p.state_conv + ((size_t)b * 3 + (t - k + 3)) * 4096 + ch0;
              const float4 s0 = *(const float4*)sp, s1 = *(const float4*)(sp + 4);
              hv[0] = s0.x; hv[1] = s0.y; hv[2] = s0.z; hv[3] = s0.w; hv[4] = s1.x; hv[5] = s1.y; hv[6] = s1.z; hv[7] = s1.w;
            } else {
#pragma unroll
              for (int q = 0; q < 8; ++q) hv[q] = 0.f;
            }
#pragma unroll
            for (int q = 0; q < 8; ++q) {
              if (k == 1) hm1[q] = hv[q];
              if (k == 2) hm2[q] = hv[q];
              if (k == 3) hm3[q] = hv[q];
            }
          }
        }
        float xc[8], o[8];
        unpack8(cur[q4], xc);
#pragma unroll
        for (int q = 0; q < 8; ++q) {
          const float a = bs[q] + hm3[q] * wgt[0][q] + hm2[q] * wgt[1][q] + hm1[q] * wgt[2][q] + xc[q] * wgt[3][q];
          o[q] = silu(a);
          hm3[q] = hm2[q]; hm2[q] = hm1[q]; hm1[q] = xc[q];
        }
        u32x4 ov;
        ov.x = pack2(o[0], o[1]); ov.y = pack2(o[2], o[3]); ov.z = pack2(o[4], o[5]); ov.w = pack2(o[6], o[7]);
        *(u32x4*)(xbcc + (size_t)row * 4096 + ch0) = ov;
      }
#pragma unroll
      for (int q = 0; q < 4; ++q) cur[q] = nxt[q];
    }
  }
}

template <int DK, int MODE>
__device__ void rec_prompt_item(const Params& p, const int item, unsigned char* smem) {
  constexpr int QS = (DK + 16) * 2;
  constexpr int VS = 160, PS = 144;
  constexpr int MF = DK / 128;
  constexpr int KS = DK / 32;
  constexpr int KUNR = 4;
  constexpr int NQ = DK / 64;
  constexpr int CPR = DK / 8;
  unsigned char* Qs = smem;
  unsigned char* Ks = Qs + 64 * QS;
  unsigned char* STs = Ks + 64 * QS;
  unsigned char* Vs = STs + 64 * QS;
  unsigned char* Vts = Vs + 64 * VS;
  unsigned char* Ps = Vts + 64 * VS;
  float* cumS = (float*)(Ps + 64 * PS);
  float* uS = cumS + 64;

  const int tid = (int)p.tidx, lane = tid & 63, w = tid >> 6;
  const int l15 = lane & 15, g = lane >> 4;
  const int b = item >> 5;
  const int h = (MODE == 0) ? ((item >> 3) & 3) : (item & 31);
  const int s = (MODE == 0) ? (item & 7) : 0;
  const int row0 = b * 2048;

  const u16* src;
  int sstride, qcol, kcol, vcol;
  if (MODE == 0) {
    src = (const u16*)(p.ws + OFF_PROJ); sstride = PROJ_LD;
    qcol = h * 256; kcol = 1024 + h * 256; vcol = 2048 + h * 512 + s * 64;
  } else {
    src = (const u16*)(p.ws + OFF_XBCC); sstride = 4096;
    qcol = 3072 + (h >> 2) * 128; kcol = 2048 + (h >> 2) * 128; vcol = h * 64;
  }
  const float* dtv = (const float*)(p.ws + OFF_DT);
  const float* cumv = (const float*)(p.ws + OFF_CUM);
  const float lg = (MODE == 0) ? log2f(1.0f - exp2f(-5.0f - (float)h)) : 0.f;

  const int vrow = tid >> 3, vkc = tid & 7;
  const int jt = tid & 63;

  constexpr int NSET = (MODE == 1) ? 2 : 1;
  u32x4 rq[2][NQ], rk[2][NQ], rv[2];
  float pcj[2] = {0.f, 0.f}, puj[2] = {1.f, 1.f}, pclast[2] = {0.f, 0.f}, pct[2] = {0.f, 0.f}, put[2] = {1.f, 1.f};
  u16 gz[2][2][4];
  const u16* gsrc = (const u16*)(p.ws + OFF_PROJ);
  const int gcol = (MODE == 0) ? (4096 + h * 512 + s * 64) : (h * 64);
  const int fi = w >> 1, fe0 = 2 * (w & 1);
  const int fis = (int)p.wv >> 1, fe0s = 2 * ((int)p.wv & 1);
  const int dw = w * (DK / 8);

  unsigned qoff[NQ], goff[4], aoff[4];
#pragma unroll
  for (int i = 0; i < NQ; ++i) {
    const int c_ = tid + NTHR * i;
    qoff[i] = (unsigned)(((c_ / CPR) * sstride + qcol + (c_ % CPR) * 8) * 2);
  }
  const unsigned voffv = (unsigned)((vrow * sstride + vcol + vkc * 8) * 2);
#pragma unroll
  for (int r = 0; r < 4; ++r) {
    goff[r] = (unsigned)(((16 * fi + 4 * g + r) * PROJ_LD + gcol + 16 * fe0 + l15) * 2);
    aoff[r] = (unsigned)(((16 * fi + 4 * g + r) * 2048 + ((MODE == 0) ? (h * 512 + s * 64) : (h * 64)) + 16 * fe0 + l15) * 2);
  }
  const int kdelta = (kcol - qcol) * 2;

#define PF_ISSUE(SET, RBASE)                                                                       \
  {                                                                                                \
    const int rb_ = (RBASE);                                                                       \
    if (true) {                                                                                    \
      const char* sb_ = (const char*)src + (size_t)rb_ * (size_t)(sstride * 2);                    \
      const char* gb_ = (const char*)gsrc + (size_t)rb_ * (size_t)(PROJ_LD * 2);                   \
      _Pragma("unroll") for (int i = 0; i < NQ; ++i) {                                             \
        rq[SET][i] = *(const u32x4*)(sb_ + qoff[i]);                                               \
        rk[SET][i] = *(const u32x4*)(sb_ + kdelta + qoff[i]);                                      \
      }                                                                                            \
      rv[SET] = *(const u32x4*)(sb_ + voffv);                                                      \
      if (MODE == 1) {                                                                             \
        pcj[SET] = cumv[(size_t)(rb_ + vrow) * 32 + h]; puj[SET] = dtv[(size_t)(rb_ + vrow) * 32 + h]; \
        pclast[SET] = cumv[(size_t)(rb_ + 63) * 32 + h];                                           \
        pct[SET] = cumv[(size_t)(rb_ + jt) * 32 + h]; put[SET] = dtv[(size_t)(rb_ + jt) * 32 + h]; \
      }                                                                                            \
      _Pragma("unroll") for (int x = 0; x < 2; ++x)                                                \
        _Pragma("unroll") for (int r = 0; r < 4; ++r)                                              \
          gz[SET][x][r] = *(const u16*)(gb_ + 32 * x + goff[r]);                                   \
    } else {                                                                                       \
      _Pragma("unroll") for (int i = 0; i < NQ; ++i) {                                             \
        int c_ = tid + NTHR * i, rr_ = c_ / CPR, kc_ = c_ % CPR;                                   \
        rq[SET][i] = *(const u32x4*)(src + (size_t)(rb_ + rr_) * sstride + qcol + kc_ * 8);        \
        rk[SET][i] = *(const u32x4*)(src + (size_t)(rb_ + rr_) * sstride + kcol + kc_ * 8);        \
      }                                                                                            \
      rv[SET] = *(const u32x4*)(src + (size_t)(rb_ + vrow) * sstride + vcol + vkc * 8);            \
      _Pragma("unroll") for (int x = 0; x < 2; ++x)                                                \
        _Pragma("unroll") for (int r = 0; r < 4; ++r)                                              \
          gz[SET][x][r] = gsrc[(size_t)(rb_ + 16 * fi + 4 * g + r) * PROJ_LD + gcol + 16 * (fe0 + x) + l15]; \
    }                                                                                              \
  }

  f32x4 S[MF][4];
#pragma unroll
  for (int i = 0; i < MF; ++i)
#pragma unroll
    for (int j = 0; j < 4; ++j) S[i][j] = (f32x4){0.f, 0.f, 0.f, 0.f};

  float gnv[2];
  const float dsk = (MODE == 1) ? p.ssm_d[h] : 0.f;
#pragma unroll
  for (int x = 0; x < 2; ++x) {
    const int e = 16 * (fe0 + x) + l15;
    gnv[x] = (MODE == 0) ? p.ret_head_norm[h * 512 + s * 64 + e] : p.ssm_gate_norm[h * 64 + e];
  }

  PF_ISSUE(0, row0)
  if (NSET == 2) PF_ISSUE(1, row0 + 64)

  for (int c2 = 0; c2 < 32; c2 += 2) {
#pragma unroll
   for (int par2 = 0; par2 < 2; ++par2) {
    const int par = par2 & (NSET - 1);
    const int c = c2 + par2;
    const int r0 = row0 + c * 64;
#pragma unroll
    for (int i = 0; i < NQ; ++i) {
      int cc = tid + NTHR * i, rr = cc / CPR, kc = cc % CPR;
      *(u32x4*)(Qs + rr * QS + kc * 16) = rq[par][i];
      *(u32x4*)(Ks + rr * QS + kc * 16) = rk[par][i];
    }
    {
      const u32x4 rvv = rv[par];
      *(u32x4*)(Vs + vrow * VS + vkc * 16) = rvv;
      float cj, uj, cl;
      if (MODE == 0) { cj = (float)(vrow + 1) * lg; uj = 1.f; cl = 64.f * lg; } else { cj = pcj[par]; uj = puj[par]; cl = pclast[par]; }
      const float wj = uj * ex2(cl - cj);
      u32x4 o;
      o.x = pack2(bf2f((u16)(rvv.x & 0xffff)) * wj, bf2f((u16)(rvv.x >> 16)) * wj);
      o.y = pack2(bf2f((u16)(rvv.y & 0xffff)) * wj, bf2f((u16)(rvv.y >> 16)) * wj);
      o.z = pack2(bf2f((u16)(rvv.z & 0xffff)) * wj, bf2f((u16)(rvv.z >> 16)) * wj);
      o.w = pack2(bf2f((u16)(rvv.w & 0xffff)) * wj, bf2f((u16)(rvv.w >> 16)) * wj);
      *(u32x4*)(Vts + vrow * VS + vkc * 16) = o;
    }
    if (tid < 64) {
      if (MODE == 0) { cumS[tid] = (float)(tid + 1) * lg; uS[tid] = 1.f; } else { cumS[tid] = pct[par]; uS[tid] = put[par]; }
    }
#pragma unroll
    for (int mf = 0; mf < MF; ++mf)
#pragma unroll
      for (int nf = 0; nf < 4; ++nf) {
        u32x2 o;
        o.x = pack2(S[mf][nf][0], S[mf][nf][1]);
        o.y = pack2(S[mf][nf][2], S[mf][nf][3]);
        *(u32x2*)(STs + (16 * nf + l15) * QS + (dw + 16 * mf + 4 * g) * 2) = o;
      }
    u16 gzc[2][4];
#pragma unroll
    for (int x = 0; x < 2; ++x)
#pragma unroll
      for (int r = 0; r < 4; ++r) gzc[x][r] = gz[par][x][r];
    __syncthreads();
    if (c + NSET < 32) PF_ISSUE(par, r0 + 64 * NSET)
    f32x4 sc[2], cr[2];
#pragma unroll
    for (int x = 0; x < 2; ++x) { sc[x] = (f32x4){0.f, 0.f, 0.f, 0.f}; cr[x] = (f32x4){0.f, 0.f, 0.f, 0.f}; }
#pragma unroll KUNR
    for (int ks = 0; ks < KS; ++ks) {
      const bf16x8 a = *(const bf16x8*)(Qs + (16 * fi + l15) * QS + ks * 64 + g * 16);
      bf16x8 bk[2], bs[2];
#pragma unroll
      for (int x = 0; x < 2; ++x) {
        bk[x] = *(const bf16x8*)(Ks + (16 * (fe0 + x) + l15) * QS + ks * 64 + g * 16);
        bs[x] = *(const bf16x8*)(STs + (16 * (fe0 + x) + l15) * QS + ks * 64 + g * 16);
      }
#pragma unroll
      for (int x = 0; x < 2; ++x) {
        sc[x] = __builtin_amdgcn_mfma_f32_16x16x32_bf16(a, bk[x], sc[x], 0, 0, 0);
        cr[x] = __builtin_amdgcn_mfma_f32_16x16x32_bf16(a, bs[x], cr[x], 0, 0, 0);
      }
    }
    float ci[4];
#pragma unroll
    for (int r = 0; r < 4; ++r) ci[r] = cumS[16 * fi + 4 * g + r];
#pragma unroll
    for (int x = 0; x < 2; ++x) {
      const int fj = fe0 + x;
      const int j = 16 * fj + l15;
      const float cj = cumS[j], uj = uS[j];
#pragma unroll
      for (int r = 0; r < 4; ++r) {
        const int i = 16 * fi + 4 * g + r;
        float v = 0.f;
        if (j <= i) v = sc[x][r] * ex2(ci[r] - cj) * uj;
        *(u16*)(Ps + i * PS + j * 2) = f2bf(v);
      }
    }
    {
      const float atot = ex2(cumS[63]);
#pragma unroll
      for (int mf = 0; mf < MF; ++mf)
#pragma unroll
        for (int nf = 0; nf < 4; ++nf)
#pragma unroll
          for (int r = 0; r < 4; ++r) S[mf][nf][r] *= atot;
#pragma unroll
      for (int ks = 0; ks < 2; ++ks) {
        bf16x8 af[MF], bfv[4];
#pragma unroll
        for (int mf = 0; mf < MF; ++mf) af[mf] = trfrag(Ks, QS, 32 * ks, dw + 16 * mf, lane);
#pragma unroll
        for (int nf = 0; nf < 4; ++nf) bfv[nf] = trfrag(Vts, VS, 32 * ks, 16 * nf, lane);
#pragma unroll
        for (int mf = 0; mf < MF; ++mf)
#pragma unroll
          for (int nf = 0; nf < 4; ++nf)
            S[mf][nf] = __builtin_amdgcn_mfma_f32_16x16x32_bf16(af[mf], bfv[nf], S[mf][nf], 0, 0, 0);
      }
    }
    __syncthreads();
    f32x4 in[2];
#pragma unroll
    for (int x = 0; x < 2; ++x) in[x] = (f32x4){0.f, 0.f, 0.f, 0.f};
#pragma unroll
    for (int ks = 0; ks < 2; ++ks) {
      const bf16x8 a = *(const bf16x8*)(Ps + (16 * fi + l15) * PS + ks * 64 + g * 16);
      bf16x8 bv[2];
#pragma unroll
      for (int x = 0; x < 2; ++x) bv[x] = trfrag(Vs, VS, 32 * ks, 16 * (fe0 + x), lane);
#pragma unroll
      for (int x = 0; x < 2; ++x) in[x] = __builtin_amdgcn_mfma_f32_16x16x32_bf16(a, bv[x], in[x], 0, 0, 0);
    }
    {
      float ss[4] = {0.f, 0.f, 0.f, 0.f};
      u16* aout = (u16*)(p.ws + OFF_A2);
      float* parts = (float*)(p.ws + OFF_PARTS);
#pragma unroll
      for (int x = 0; x < 2; ++x) {
        const int e = 16 * (fe0 + x) + l15;
        const float gn = gnv[x];
        const int ocol = (MODE == 0) ? (h * 512 + s * 64 + e) : (h * 64 + e);
#pragma unroll
        for (int r = 0; r < 4; ++r) {
          const int i = 16 * fi + 4 * g + r;
          float o = in[x][r] + cr[x][r] * ex2(ci[r]);
          const float gv = bf2f(gzc[x][r]);
          float val;
          if (MODE == 0) {
            ss[r] += o * o;
            val = o * gn * silu(gv);
          } else {
            const float xs = bf2f(*(const u16*)(Vs + i * VS + e * 2));
            const float y = o + xs * dsk;
            const float gg = y * silu(gv);
            ss[r] += gg * gg;
            val = gg * gn;
          }
          *(u16*)((char*)aout + (size_t)r0 * 4096 + 32 * x + aoff[r]) = f2bf(val);
        }
      }
#pragma unroll
      for (int r = 0; r < 4; ++r) {
        const float v = row16_sum(ss[r]);
        if (l15 == 0) {
          const int i = 16 * fi + 4 * g + r;
          const int slot = (MODE == 0) ? (h * 16 + s * 2 + (w & 1)) : ((h >> 2) * 8 + (h & 3) * 2 + (w & 1));
          parts[(size_t)(r0 + i) * 64 + slot] = v;
        }
      }
    }
    __syncthreads();
   }
  }
#undef PF_ISSUE
  {
    float* so;
    int pitch;
    if (MODE == 0) { so = p.out + OUT_RETP + ((size_t)(b * 4 + h) * 256) * 512 + s * 64; pitch = 512; }
    else { so = p.out + OUT_SSMP + ((size_t)(b * 32 + h) * 128) * 64; pitch = 64; }
#pragma unroll
    for (int mf = 0; mf < MF; ++mf)
#pragma unroll
      for (int nf = 0; nf < 4; ++nf)
#pragma unroll
        for (int r = 0; r < 4; ++r)
          so[(size_t)(dw + 16 * mf + 4 * g + r) * pitch + 16 * nf + l15] = S[mf][nf][r];
  }
}

#define SAMPLE_DECODE(ITEM, B_, H_, S_)                              \
  const int B_ = (ITEM) >> 5;                                        \
  const int H_ = (MODE == 0) ? (((ITEM) >> 3) & 3) : ((ITEM) & 31);  \
  const int S_ = (MODE == 0) ? ((ITEM) & 7) : 0;

#define SAMPLE_ISSUE(SET, ITEM)                                                                                     \
  {                                                                                                                \
    SAMPLE_DECODE(ITEM, b_, h_, s_)                                                                                \
    const int row0_ = NPROMPT + b_ * 8;                                                                            \
    int qcol_, kcol_, vcol_;                                                                                       \
    if (MODE == 0) { qcol_ = h_ * 256; kcol_ = 1024 + h_ * 256; vcol_ = 2048 + h_ * 512 + s_ * 64; }               \
    else { qcol_ = 3072 + (h_ >> 2) * 128; kcol_ = 2048 + (h_ >> 2) * 128; vcol_ = h_ * 64; }                      \
    const float* s0_ = (MODE == 0) ? p.state_ret + ((size_t)(b_ * 4 + h_) * 256) * 512 + s_ * 64                   \
                                   : p.state_ssm + ((size_t)(b_ * 32 + h_) * 128) * 64;                            \
    _Pragma("unroll") for (int db = 0; db < NB; ++db)                                                              \
      _Pragma("unroll") for (int eb = 0; eb < 4; ++eb)                                                             \
        _Pragma("unroll") for (int r = 0; r < 4; ++r)                                                              \
          sv[SET][db][eb][r] = s0_[(size_t)(dbase + 16 * db + 4 * g + r) * pitch + 16 * eb + l15];                \
    if (tid < 2 * DK) {                                                                                            \
      const int which_ = tid / DK, c_ = tid % DK;                                                                  \
      rqk[SET] = *(const u32x4*)(src + (size_t)(row0_ + c_ / CPR) * sstride + (which_ ? kcol_ : qcol_) + (c_ % CPR) * 8); \
    }                                                                                                              \
    if (tid < 64) {                                                                                                \
      rv[SET] = *(const u32x4*)(src + (size_t)(row0_ + (tid >> 3)) * sstride + vcol_ + (tid & 7) * 8);             \
      if (MODE == 1) {                                                                                             \
        pvc[SET] = cumv[(size_t)(row0_ + (tid >> 3)) * 32 + h_];                                                   \
        pvu[SET] = dtv[(size_t)(row0_ + (tid >> 3)) * 32 + h_];                                                    \
        pvl[SET] = cumv[(size_t)(row0_ + 7) * 32 + h_];                                                            \
      }                                                                                                            \
    }                                                                                                              \
    gzs[SET] = gsrc[(size_t)(row0_ + w) * PROJ_LD + ((MODE == 0) ? (4096 + h_ * 512 + s_ * 64) : (h_ * 64)) + lane]; \
    if (MODE == 1 && tid < 16)                                                                                     \
      pcu[SET] = (tid < 8) ? cumv[(size_t)(row0_ + tid) * 32 + h_] : dtv[(size_t)(row0_ + tid - 8) * 32 + h_];     \
  }

template <int DK, int MODE>
__device__ void rec_sample_loop(const Params& p, unsigned char* smem, const int rep) {
  constexpr int SET_FLOATS = 8 * DK + 8 * DK + 512 + 64 + 4096 + 64 + (DK * 8 + 64 * 8) / 2;
  const int tid = (int)p.tidx, lane = tid & 63, w = tid >> 6;
  const int l15 = lane & 15, g = lane >> 4;
  constexpr int CPR = DK / 8;
  constexpr int DPW = DK / 8;
  constexpr int NB = DPW / 16;
  const int dbase = w * DPW;
  const int pitch = (MODE == 0) ? 512 : 64;
  int vz;
  asm volatile("v_mov_b32 %0, 0" : "=v"(vz));
  const u16* src = ((MODE == 0) ? (const u16*)(p.ws + OFF_PROJ) : (const u16*)(p.ws + OFF_XBCC)) + vz;
  const int sstride = (MODE == 0) ? PROJ_LD : 4096;
  const u16* gsrc = (const u16*)(p.ws + OFF_PROJ) + vz;
  const float* dtv = (const float*)(p.ws + OFF_DT) + vz;
  const float* cumv = (const float*)(p.ws + OFF_CUM) + vz;
  u16* aout = (u16*)(p.ws + OFF_A2);
  float* parts = (float*)(p.ws + OFF_PARTS);

  u32x4 rqk[2] = {(u32x4){0u, 0u, 0u, 0u}, (u32x4){0u, 0u, 0u, 0u}}, rv[2] = {(u32x4){0u, 0u, 0u, 0u}, (u32x4){0u, 0u, 0u, 0u}};
  f32x4 sv[2][NB][4];
  u16 gzs[2] = {0, 0};
  float pcu[2] = {0.f, 0.f}, pvc[2] = {0.f, 0.f}, pvu[2] = {1.f, 1.f}, pvl[2] = {0.f, 0.f};
  const int nitems = 4096 * rep;
  const int G = (int)gridDim.x;
  if ((int)blockIdx.x < nitems) SAMPLE_ISSUE(0, ((int)blockIdx.x & 4095) + vz)
  for (int itb = blockIdx.x; itb < nitems; itb += 2 * G) {
#pragma unroll
   for (int par = 0; par < 2; ++par) {
    const int item0 = itb + par * G;
    if (item0 < nitems) {
    if (item0 + G < nitems) SAMPLE_ISSUE(par ^ 1, ((item0 + G) & 4095) + vz)
    __builtin_amdgcn_sched_barrier(0);
    const int item = (item0 & 4095) + vz;
    SAMPLE_DECODE(item, b, h, s)
    const int row0 = NPROMPT + b * 8;
    const u16 gzv = gzs[par];
    const u32x4 rqkc = rqk[par], rvc = rv[par];
    float* qS = (float*)smem + par * SET_FLOATS;
    float* kS = qS + 8 * DK;
    float* vS = kS + 8 * DK;
    float* scS = vS + 512;
    float* redS = scS + 64;
    float* cuS = redS + 4096;
    u16* kTb = (u16*)(cuS + 64);
    u16* vwTb = kTb + DK * 8;
    const float lgh = (MODE == 0) ? log2f(1.0f - exp2f(-5.0f - (float)h)) : 0.f;
    if (tid < 2 * DK) {
      const int which = tid / DK, c = tid % DK;
      float* dst = (which ? kS : qS) + (c / CPR) * DK + (c % CPR) * 8;
      dst[0] = bf2f((u16)(rqkc.x & 0xffff)); dst[1] = bf2f((u16)(rqkc.x >> 16));
      dst[2] = bf2f((u16)(rqkc.y & 0xffff)); dst[3] = bf2f((u16)(rqkc.y >> 16));
      dst[4] = bf2f((u16)(rqkc.z & 0xffff)); dst[5] = bf2f((u16)(rqkc.z >> 16));
      dst[6] = bf2f((u16)(rqkc.w & 0xffff)); dst[7] = bf2f((u16)(rqkc.w >> 16));
      if (which) {
        u16* dT = kTb + ((c % CPR) * 8) * 8 + (c / CPR);
        dT[0 * 8] = (u16)(rqkc.x & 0xffff); dT[1 * 8] = (u16)(rqkc.x >> 16);
        dT[2 * 8] = (u16)(rqkc.y & 0xffff); dT[3 * 8] = (u16)(rqkc.y >> 16);
        dT[4 * 8] = (u16)(rqkc.z & 0xffff); dT[5 * 8] = (u16)(rqkc.z >> 16);
        dT[6 * 8] = (u16)(rqkc.w & 0xffff); dT[7 * 8] = (u16)(rqkc.w >> 16);
      }
    }
    if (tid < 64) {
      const int t = tid >> 3, kc = tid & 7;
      float vv[8];
      vv[0] = bf2f((u16)(rvc.x & 0xffff)); vv[1] = bf2f((u16)(rvc.x >> 16));
      vv[2] = bf2f((u16)(rvc.y & 0xffff)); vv[3] = bf2f((u16)(rvc.y >> 16));
      vv[4] = bf2f((u16)(rvc.z & 0xffff)); vv[5] = bf2f((u16)(rvc.z >> 16));
      vv[6] = bf2f((u16)(rvc.w & 0xffff)); vv[7] = bf2f((u16)(rvc.w >> 16));
      float* dst = vS + t * 64 + kc * 8;
      const float wt = (MODE == 0) ? ex2((float)(7 - t) * lgh) : pvu[par] * ex2(pvl[par] - pvc[par]);
      u16* dT = vwTb + (kc * 8) * 8 + t;
#pragma unroll
      for (int x = 0; x < 8; ++x) { dst[x] = vv[x]; dT[x * 8] = f2bf(vv[x] * wt); }
    }
    if (MODE == 1 && tid < 16) cuS[tid] = pcu[par];
    __syncthreads();
    float cum[8], u[8];
    if (MODE == 0) {
#pragma unroll
      for (int t = 0; t < 8; ++t) { cum[t] = (float)(t + 1) * lgh; u[t] = 1.f; }
    } else {
#pragma unroll
      for (int t = 0; t < 8; ++t) { cum[t] = cuS[t]; u[t] = cuS[8 + t]; }
    }
    if (w == 0) {
      f32x4 sacc = (f32x4){0.f, 0.f, 0.f, 0.f};
#pragma unroll
      for (int ks = 0; ks < DK / 32; ++ks) {
        const float* qp = qS + (l15 & 7) * DK + ks * 32 + 8 * g;
        const float* kp = kS + (l15 & 7) * DK + ks * 32 + 8 * g;
        const float4 a0 = *(const float4*)qp, a1 = *(const float4*)(qp + 4);
        const float4 b0 = *(const float4*)kp, b1 = *(const float4*)(kp + 4);
        u32x4 qa_, kb_;
        qa_.x = pack2(a0.x, a0.y); qa_.y = pack2(a0.z, a0.w); qa_.z = pack2(a1.x, a1.y); qa_.w = pack2(a1.z, a1.w);
        kb_.x = pack2(b0.x, b0.y); kb_.y = pack2(b0.z, b0.w); kb_.z = pack2(b1.x, b1.y); kb_.w = pack2(b1.z, b1.w);
        sacc = __builtin_amdgcn_mfma_f32_16x16x32_bf16(__builtin_bit_cast(bf16x8, qa_), __builtin_bit_cast(bf16x8, kb_), sacc, 0, 0, 0);
      }
      if (g < 2 && l15 < 8) {
        float cj = 0.f, uj = 0.f;
#pragma unroll
        for (int t = 0; t < 8; ++t) if (t == l15) { cj = cum[t]; uj = u[t]; }
#pragma unroll
        for (int r = 0; r < 4; ++r) {
          const int i = 4 * g + r;
          float ci = 0.f;
#pragma unroll
          for (int t = 0; t < 8; ++t) if (t == i) ci = cum[t];
          scS[i * 8 + l15] = (l15 <= i) ? sacc[r] * ex2(ci - cj) * uj : 0.f;
        }
      }
    }
    {
      float* s1 = (MODE == 0) ? p.out + OUT_RETS + ((size_t)(b * 4 + h) * 256) * 512 + s * 64
                              : p.out + OUT_SSMS + ((size_t)(b * 32 + h) * 128) * 64;
      const float atot = ex2(cum[7]);
      const bf16x8 zero8 = (bf16x8){0, 0, 0, 0, 0, 0, 0, 0};
      bf16x8 kA[NB], vB[4], qa;
#pragma unroll
      for (int db = 0; db < NB; ++db) {
        const bf16x8 t8 = *(const bf16x8*)(kTb + (dbase + 16 * db + l15) * 8);
        kA[db] = (g == 0) ? t8 : zero8;
      }
#pragma unroll
      for (int eb = 0; eb < 4; ++eb) {
        const bf16x8 t8 = *(const bf16x8*)(vwTb + (16 * eb + l15) * 8);
        vB[eb] = (g == 0) ? t8 : zero8;
      }
      {
        const float* qrow = qS + (l15 & 7) * DK + dbase + 4 * g;
        const float4 q0 = *(const float4*)qrow;
        float4 q1 = make_float4(0.f, 0.f, 0.f, 0.f);
        if (NB == 2) q1 = *(const float4*)(qrow + 16);
        u32x4 qq;
        qq.x = pack2(q0.x, q0.y); qq.y = pack2(q0.z, q0.w); qq.z = pack2(q1.x, q1.y); qq.w = pack2(q1.z, q1.w);
        if (l15 >= 8) qq = (u32x4){0u, 0u, 0u, 0u};
        qa = __builtin_bit_cast(bf16x8, qq);
      }
#pragma unroll
      for (int eb = 0; eb < 4; ++eb) {
        u32x4 sb;
        sb.x = pack2(sv[par][0][eb][0], sv[par][0][eb][1]);
        sb.y = pack2(sv[par][0][eb][2], sv[par][0][eb][3]);
        if (NB == 2) {
          sb.z = pack2(sv[par][NB - 1][eb][0], sv[par][NB - 1][eb][1]);
          sb.w = pack2(sv[par][NB - 1][eb][2], sv[par][NB - 1][eb][3]);
        } else { sb.z = 0u; sb.w = 0u; }
        const f32x4 o3 = __builtin_amdgcn_mfma_f32_16x16x32_bf16(qa, __builtin_bit_cast(bf16x8, sb),
                                                                 (f32x4){0.f, 0.f, 0.f, 0.f}, 0, 0, 0);
        if (g < 2) {
#pragma unroll
          for (int r = 0; r < 4; ++r) redS[(w * 8 + 4 * g + r) * 64 + 16 * eb + l15] = o3[r];
        }
#pragma unroll
        for (int db = 0; db < NB; ++db) {
          f32x4 c = sv[par][db][eb];
          c[0] *= atot; c[1] *= atot; c[2] *= atot; c[3] *= atot;
          const f32x4 dn = __builtin_amdgcn_mfma_f32_16x16x32_bf16(kA[db], vB[eb], c, 0, 0, 0);
#pragma unroll
          for (int r = 0; r < 4; ++r) s1[(size_t)(dbase + 16 * db + 4 * g + r) * pitch + 16 * eb + l15] = dn[r];
        }
      }
    }
    __syncthreads();
    {
      const int i = w, e = lane;
      float o = 0.f;
#pragma unroll
      for (int ww = 0; ww < 8; ++ww) o += redS[(ww * 8 + i) * 64 + e];
      float ci = 0.f;
#pragma unroll
      for (int t = 0; t < 8; ++t) if (t == i) ci = cum[t];
      o *= ex2(ci);
#pragma unroll
      for (int jj = 0; jj < 8; ++jj) if (jj <= i) o += scS[i * 8 + jj] * vS[jj * 64 + e];
      const int row = row0 + i;
      const float gv = bf2f(gzv);
      if (MODE == 0) {
        const float ssq = wave_sum(o * o);
        const float val = o * p.ret_head_norm[h * 512 + s * 64 + e] * silu(gv);
        aout[(size_t)row * 2048 + h * 512 + s * 64 + e] = f2bf(val);
        if (lane < 2) parts[(size_t)row * 64 + h * 16 + s * 2 + lane] = lane == 0 ? ssq : 0.f;
      } else {
        const float y = o + vS[i * 64 + e] * p.ssm_d[h];
        const float gg = y * silu(gv);
        const float ssq = wave_sum(gg * gg);
        aout[(size_t)row * 2048 + h * 64 + e] = f2bf(gg * p.ssm_gate_norm[h * 64 + e]);
        if (lane < 2) parts[(size_t)row * 64 + (h >> 2) * 8 + (h & 3) * 2 + lane] = lane == 0 ? ssq : 0.f;
      }
    }
    }
   }
  }
  __syncthreads();
}

template <int DK, int MODE>
__device__ void phase_rec(const Params& p, unsigned char* smem, const int rep_p, const int rep_s) {
  for (int it0 = blockIdx.x; it0 < 256 * rep_p; it0 += gridDim.x) {
    const int blk = it0 & 255;
    const int item = (MODE == 0) ? (((blk & 7) * 4 + (blk >> 6)) * 8 + ((blk >> 3) & 7))
                                 : (((blk & 7) * 8 + (blk >> 5)) * 4 + ((blk >> 3) & 3));
    rec_prompt_item<DK, MODE>(p, item, smem);
  }
  rec_sample_loop<DK, MODE>(p, smem, rep_s);
}

#ifndef PHASE_MASK
#define PHASE_MASK 0x3ff
#endif
#ifndef DUP_MASK
#define DUP_MASK 0x000
#endif
#define XB_TMO      128
#define XB_XCNT(j)  (256  + 64 * (j))
#define XB_XSUB(j)  (1280 + 64 * (j))
#define XB_XGEN(j)  (2304 + 64 * (j))
#define XB_TOP      3328
#define XB_TOPGEN   3392
#define XCD_BAR_WORDS 3456
#define XB_SPIN_CAP (1u << 20)
#define LAS __attribute__((address_space(3)))
__device__ __forceinline__ unsigned xb_ld(unsigned* p) { return __hip_atomic_load(p, __ATOMIC_RELAXED, __HIP_MEMORY_SCOPE_AGENT); }
__device__ __forceinline__ unsigned xb_add(unsigned* p, unsigned v) { return __hip_atomic_fetch_add(p, v, __ATOMIC_RELAXED, __HIP_MEMORY_SCOPE_AGENT); }
__device__ __forceinline__ unsigned xb_xcc_id() { return (unsigned)__builtin_amdgcn_s_getreg((3 << 11) | 20) & 0xFu; }
#define XB_SPIN(cond, bar) do { unsigned _sp = 0; while (cond) { __builtin_amdgcn_s_sleep(1); \
    if ((++_sp & 255u) == 0u) { if (xb_ld(&(bar)[XB_TMO])) break; if (_sp > XB_SPIN_CAP) { atomicAdd(&(bar)[XB_TMO], 1u); break; } } } } while (0)
struct XcdBarrier {
  unsigned* bar; unsigned x;
  volatile LAS unsigned* st;
};
__device__ __forceinline__ XcdBarrier xcd_barrier_post(unsigned* bar, volatile LAS unsigned* st, const int tid) {
  XcdBarrier b; b.bar = bar; b.x = xb_xcc_id(); b.st = st;
  if (tid == 0) (void)xb_add(&bar[XB_XCNT(b.x)], 1u);
  return b;
}
__device__ __forceinline__ void xcd_barrier_complete(unsigned* bar, unsigned x, unsigned& nloc, unsigned& nx) {
  const unsigned G = gridDim.x * gridDim.y * gridDim.z;
  unsigned sum, cnt, mine, sp = 0u;
  for (;;) {
    sum = 0u; cnt = 0u; mine = 0u;
#pragma unroll
    for (unsigned j = 0; j < 16; ++j) { const unsigned c = xb_ld(&bar[XB_XCNT(j)]); sum += c; cnt += (c > 0u) ? 1u : 0u; mine = (j == x) ? c : mine; }
    if (sum == G) break;
    __builtin_amdgcn_s_sleep(1);
    if ((++sp & 255u) == 0u) { if (xb_ld(&bar[XB_TMO])) break; if (sp > XB_SPIN_CAP) { atomicAdd(&bar[XB_TMO], 1u); break; } }
  }
  nloc = mine > 0u ? mine : 1u; nx = cnt > 0u ? cnt : 1u;
}
__device__ __forceinline__ void xcd_barrier(const XcdBarrier& b, const int wvs) {
  int wvl_ = wvs;
  asm volatile("" : "+s"(wvl_));
  const int tid = wvl_ * 64 + (int)__builtin_amdgcn_mbcnt_hi(~0u, __builtin_amdgcn_mbcnt_lo(~0u, 0u));
  asm volatile("s_waitcnt vmcnt(0)" ::: "memory");
  __syncthreads();
  if (tid == 0) {
    unsigned* bar = b.bar;
    __builtin_amdgcn_s_waitcnt(0);
    unsigned nloc = b.st[0], nx = b.st[1];
    if (nloc == 0u) { xcd_barrier_complete(bar, b.x, nloc, nx); b.st[0] = nloc; b.st[1] = nx; }
    const unsigned old = xb_add(&bar[XB_XSUB(b.x)], 1u);
    const unsigned gen = old / nloc;
    if (old + 1u == (gen + 1u) * nloc) {
      __builtin_amdgcn_fence(__ATOMIC_RELEASE, "agent");
      asm volatile("s_waitcnt vmcnt(0)" ::: "memory");
      const unsigned og = xb_add(&bar[XB_TOP], 1u);
      const unsigned tg = og / nx;
      if (og + 1u == (tg + 1u) * nx) xb_add(&bar[XB_TOPGEN], 1u);
      else XB_SPIN(xb_ld(&bar[XB_TOPGEN]) == tg, bar);
      __builtin_amdgcn_fence(__ATOMIC_ACQUIRE, "agent");
      xb_add(&bar[XB_XGEN(b.x)], 1u);
      asm volatile("s_waitcnt vmcnt(0)" ::: "memory");
    } else {
      XB_SPIN(xb_ld(&bar[XB_XGEN(b.x)]) == gen, bar);
      __builtin_amdgcn_fence(__ATOMIC_ACQUIRE, "agent");
      asm volatile("s_waitcnt vmcnt(0)" ::: "memory");
    }
  }
  __syncthreads();
}

template <typename T>
__device__ __forceinline__ T* as_global(T* q) {
  return (T*)(__attribute__((address_space(1))) T*)q;
}

template <int PH>
__device__ __forceinline__ void run_phase(Params p, unsigned char* smem, const int wvs) {
  {
    long long z_ = 0;
    asm volatile("" : "+s"(z_));
    p.ws += z_; p.out += z_;
  }
  {
    int wvl_ = wvs;
    asm volatile("" : "+s"(wvl_));
    p.tidx = wvl_ * 64 + (int)__builtin_amdgcn_mbcnt_hi(~0u, __builtin_amdgcn_mbcnt_lo(~0u, 0u));
    p.wv = wvl_;
  }
  const int rep = 1 + (int)((p.dup >> PH) & 1);
  if (PH == 0) phase_prep(p, smem, rep);
  if (PH == 1) {
    gemm8_phase<0>(p, (const u16*)(p.ws + OFF_H), (const u16*)(p.ws + OFF_WT0), 1024, 24, smem, rep);
    __syncthreads();
    transpose_later_weights(p, smem, (68 * 24) % (int)gridDim.x);
  }
  if (PH == 2) phase_rec<256, 0>(p, smem, rep, 1 + (int)((p.dup >> (PH + 16)) & 1));
  if (PH == 3)
  {
    gemm_phase<1, 4>(p, (const u16*)(p.ws + OFF_A2), (const u16*)(p.ws + OFF_WT1), 2048, 8, nullptr,
                     (float*)(p.ws + OFF_X1), smem, rep, 64);
    __syncthreads();
    gemm_sample_rows<4>(p, (const u16*)(p.ws + OFF_A2), (const u16*)(p.ws + OFF_WT1), nullptr, (float*)(p.ws + OFF_X1), smem, rep);
  }
  if (PH == 4) phase_norm<0>(p, (const float*)(p.ws + OFF_X1), p.ssm_norm, rep);
  if (PH == 5) {
    gemm8_phase<2>(p, (const u16*)(p.ws + OFF_H), (const u16*)(p.ws + OFF_WT2), 1024, 24, smem, rep);
    __syncthreads();
    gemm_phase<2, 0>(p, (const u16*)(p.ws + OFF_H), (const u16*)(p.ws + OFF_WT2), 1024, 1, nullptr, nullptr, smem, 1, 68, 48, true);
  }
  if (PH == 6) phase_conv(p, smem, rep);
  if (PH == 7) phase_rec<128, 1>(p, smem, rep, 1 + (int)((p.dup >> (PH + 16)) & 1));
  if (PH == 8)
  {
    gemm_phase<1, 8>(p, (const u16*)(p.ws + OFF_A2), (const u16*)(p.ws + OFF_WT3), 2048, 8,
                     (const float*)(p.ws + OFF_X1), (float*)(p.ws + OFF_X2), smem, rep, 64);
    __syncthreads();
    gemm_sample_rows<8>(p, (const u16*)(p.ws + OFF_A2), (const u16*)(p.ws + OFF_WT3), (const float*)(p.ws + OFF_X1),
                        (float*)(p.ws + OFF_X2), smem, rep);
  }
  if (PH == 9) phase_norm<1>(p, (const float*)(p.ws + OFF_X2), p.final_norm, rep);
}

#define RUN_PHASE(k)                                   \
  if ((PHASE_MASK >> k) & 1) {                         \
    if (lo <= k && k <= hi) {                          \
      run_phase<k>(p, smem, wvs);                      \
      if (k < hi) { xcd_barrier(xb, wvs); if ((p.dup >> 30) & 1) { xcd_barrier(xb, wvs); xcd_barrier(xb, wvs); } } \
    }                                                  \
  }

__global__ void __launch_bounds__(NTHR) fwd_megakernel(Params p) {
  __shared__ __attribute__((aligned(16))) unsigned char smem[LDS_BYTES];
  cg::grid_group grid = cg::this_grid();
  const int lo = (int)p.phase_lo, hi = (int)p.phase_hi;
  if (lo > 1000) grid.sync();
  volatile LAS unsigned* xst = (volatile LAS unsigned*)(smem + LDS_BYTES - 16);
  const int wvs = __builtin_amdgcn_readfirstlane((int)(threadIdx.x >> 6));
  if (threadIdx.x == 0) { xst[0] = 0u; xst[1] = 0u; }
  __syncthreads();
  const XcdBarrier xb = xcd_barrier_post((unsigned*)(p.ws + OFF_BAR), xst, (int)threadIdx.x);
  RUN_PHASE(0)
  RUN_PHASE(1)
  RUN_PHASE(2)
  RUN_PHASE(3)
  RUN_PHASE(4)
  RUN_PHASE(5)
  RUN_PHASE(6)
  RUN_PHASE(7)
  RUN_PHASE(8)
  RUN_PHASE(9)
}

#ifndef ONE_LAUNCH
#define ONE_LAUNCH 1
#endif

extern "C" void kernel_launch(void* const* d_in, const int* in_sizes, int n_in, void* d_out, int out_size, void* d_ws,
                              size_t ws_size, hipStream_t stream) {
  static int grid_blocks = 0;
  if (!grid_blocks) {
    int dev = 0, cus = 0, per_cu = 0;
    hipGetDevice(&dev);
    hipDeviceGetAttribute(&cus, hipDeviceAttributeMultiprocessorCount, dev);
    hipOccupancyMaxActiveBlocksPerMultiprocessor(&per_cu, fwd_megakernel, NTHR, 0);
    if (per_cu < 1) per_cu = 1;
    if (per_cu > 1) per_cu = 1;
    grid_blocks = cus * per_cu;
  }
  Params p{};
  const float** pf = (const float**)&p;
  for (int i = 0; i < 19; ++i) pf[i] = (const float*)d_in[i];
  p.out = (float*)d_out;
  p.ws = (unsigned char*)d_ws;
#if ONE_LAUNCH
  hipMemsetAsync((unsigned char*)d_ws + OFF_BAR, 0, XCD_BAR_WORDS * 4, stream);
  p.phase_lo = 0; p.phase_hi = 9; p.dup = DUP_MASK;
  void* args[] = {&p};
  hipError_t e = hipLaunchCooperativeKernel((void*)fwd_megakernel, dim3(grid_blocks), dim3(NTHR), args, 0, stream);
  if (e != hipSuccess) fprintf(stderr, "cooperative launch failed: %s (grid %d)\n", hipGetErrorString(e), grid_blocks);
#else
  for (int ph = 0; ph <= 9; ++ph) {
    p.phase_lo = ph; p.phase_hi = ph;
    void* args[] = {&p};
    hipLaunchCooperativeKernel((void*)fwd_megakernel, dim3(grid_blocks), dim3(NTHR), args, 0, stream);
  }
#endif
}
```

```cpp
#include <hip/hip_runtime.h>
#include <hip/hip_cooperative_groups.h>
#include <stdint.h>
#include <stdio.h>
namespace cg = cooperative_groups;

typedef __attribute__((ext_vector_type(8))) short bf16x8;
typedef __attribute__((ext_vector_type(4))) short s16x4;
typedef __attribute__((ext_vector_type(4))) float f32x4;
typedef unsigned short u16;
typedef __attribute__((ext_vector_type(4))) unsigned int u32x4;
typedef __attribute__((ext_vector_type(2))) unsigned int u32x2;

#define NTHR 512
#define T_TOK 17408
#define NPROMPT 16384
#define LDS_BYTES 143360
#define PROJ_LD 6208

constexpr size_t OFF_WT0 = 0;
constexpr size_t OFF_WT1 = OFF_WT0 + (size_t)6144 * 1024 * 2;
constexpr size_t OFF_WT2 = OFF_WT1 + (size_t)1024 * 2048 * 2;
constexpr size_t OFF_WT3 = OFF_WT2 + (size_t)6272 * 1024 * 2;
constexpr size_t OFF_ROPE = OFF_WT3 + (size_t)1024 * 2048 * 2;
constexpr size_t OFF_H = OFF_ROPE + (size_t)2056 * 128 * 8;
constexpr size_t OFF_PROJ = OFF_H + (size_t)T_TOK * 1024 * 2;
constexpr size_t OFF_A2 = OFF_PROJ + (size_t)T_TOK * PROJ_LD * 2;
constexpr size_t OFF_PARTS = OFF_A2 + (size_t)T_TOK * 2048 * 2;
constexpr size_t OFF_X1 = OFF_PARTS + (size_t)T_TOK * 64 * 4;
constexpr size_t OFF_X2 = OFF_X1 + (size_t)T_TOK * 1024 * 4;
constexpr size_t OFF_XBCC = OFF_X2 + (size_t)T_TOK * 1024 * 4;
constexpr size_t OFF_DTRAW = OFF_XBCC + (size_t)T_TOK * 4096 * 2;
constexpr size_t OFF_DT = OFF_DTRAW + (size_t)T_TOK * 32 * 4;
constexpr size_t OFF_CUM = OFF_DT + (size_t)T_TOK * 32 * 4;
constexpr size_t OFF_BAR = OFF_CUM + (size_t)T_TOK * 32 * 4;

constexpr size_t OUT_Y = 0;
constexpr size_t OUT_RETP = 17825792;
constexpr size_t OUT_RETS = 22020096;
constexpr size_t OUT_SSMP = 89128960;
constexpr size_t OUT_SSMS = 91226112;
constexpr size_t OUT_CONVP = 124780544;
constexpr size_t OUT_CONVS = 124878848;

struct Params {
  const float *x_prompt, *x_sample, *state_ret, *state_ssm, *state_conv, *ret_norm, *ret_w_in, *ret_head_norm,
      *ret_w_out, *ssm_norm, *ssm_w_in, *ssm_conv_w, *ssm_conv_b, *ssm_dt_bias, *ssm_a_log, *ssm_d, *ssm_gate_norm,
      *ssm_w_out, *final_norm;
  float* out;
  unsigned char* ws;
  long long phase_lo, phase_hi, dup, tidx, wv;
};

typedef __bf16 bf16x2_t __attribute__((ext_vector_type(2)));
typedef float f32x2_t __attribute__((ext_vector_type(2)));
__device__ __forceinline__ u16 f2bf(float f) {
  __bf16 r = (__bf16)f;
  return __builtin_bit_cast(u16, r);
}
__device__ __forceinline__ float bf2f(u16 h) { return __uint_as_float(((uint32_t)h) << 16); }
__device__ __forceinline__ uint32_t pack2(float a, float b) {
  f32x2_t v = {a, b};
  bf16x2_t r = __builtin_convertvector(v, bf16x2_t);
  return __builtin_bit_cast(uint32_t, r);
}
__device__ __forceinline__ float ex2(float x) { return __builtin_amdgcn_exp2f(x); }
__device__ __forceinline__ float silu(float x) { return x * __builtin_amdgcn_rcpf(1.0f + __expf(-x)); }
__device__ __forceinline__ float row16_sum(float v) {
  v += __builtin_bit_cast(float, __builtin_amdgcn_update_dpp(0, __builtin_bit_cast(int, v), 0xB1, 0xF, 0xF, true));
  v += __builtin_bit_cast(float, __builtin_amdgcn_update_dpp(0, __builtin_bit_cast(int, v), 0x4E, 0xF, 0xF, true));
  v += __builtin_bit_cast(float, __builtin_amdgcn_update_dpp(0, __builtin_bit_cast(int, v), 0x124, 0xF, 0xF, true));
  v += __builtin_bit_cast(float, __builtin_amdgcn_update_dpp(0, __builtin_bit_cast(int, v), 0x128, 0xF, 0xF, true));
  return v;
}
__device__ __forceinline__ float wave_sum(float v) {
#pragma unroll
  for (int o = 32; o > 0; o >>= 1) v += __shfl_xor(v, o);
  return v;
}
__device__ __forceinline__ const float* xrow(const Params& p, int r) {
  return r < NPROMPT ? p.x_prompt + (size_t)r * 1024 : p.x_sample + (size_t)(r - NPROMPT) * 1024;
}
__device__ __forceinline__ s16x4 trread(const unsigned char* ptr) {
  return __builtin_amdgcn_ds_read_tr16_b64_v4i16((s16x4 __attribute__((address_space(3)))*)ptr);
}
__device__ __forceinline__ bf16x8 cat8(s16x4 a, s16x4 b) {
  bf16x8 r;
  r[0] = a[0]; r[1] = a[1]; r[2] = a[2]; r[3] = a[3];
  r[4] = b[0]; r[5] = b[1]; r[6] = b[2]; r[7] = b[3];
  return r;
}
__device__ __forceinline__ bf16x8 trfrag(const unsigned char* img, int rs, int kbase, int nbase, int lane) {
  const int g = lane >> 4, q = (lane & 15) >> 2, pp = lane & 3;
  const unsigned char* a = img + (kbase + 8 * g + q) * rs + (nbase + 4 * pp) * 2;
  s16x4 t0 = trread(a);
  s16x4 t1 = trread(a + 4 * rs);
  return cat8(t0, t1);
}

__device__ __forceinline__ int colmap_retin(int p) {
  if (p < 2048) {
    int hb = p & ~255, pp = p & 255;
    int gi = pp >> 5, half = (pp >> 4) & 1, c = pp & 15;
    return hb + half * 128 + gi * 16 + c;
  }
  return p;
}

__device__ void transpose_tile(const float* __restrict__ W, u16* __restrict__ Wt, int K, int N, int mode, int nt, int kt,
                               unsigned char* smem, const int tid) {
  float* tile = (float*)smem;
#pragma unroll
  for (int i = 0; i < 8; ++i) {
    int idx = tid + NTHR * i;
    int kk = idx >> 6, nn = idx & 63;
    int n = nt * 64 + nn;
    int src = (mode == 1) ? colmap_retin(n) : n;
    float v = 0.f;
    if (src < N) v = W[(size_t)(kt * 64 + kk) * N + src];
    tile[kk * 65 + nn] = v;
  }
  __syncthreads();
  {
    int n = tid >> 3, kc = tid & 7;
    float v[8];
#pragma unroll
    for (int j = 0; j < 8; ++j) v[j] = tile[(kc * 8 + j) * 65 + n];
    u32x4 o;
    o.x = pack2(v[0], v[1]); o.y = pack2(v[2], v[3]); o.z = pack2(v[4], v[5]); o.w = pack2(v[6], v[7]);
    *(u32x4*)(Wt + (size_t)(nt * 64 + n) * K + kt * 64 + kc * 8) = o;
  }
  __syncthreads();
}

__device__ void phase_prep(const Params& p, unsigned char* smem, const int rep) {
  const int tid = (int)p.tidx;
  for (int rr = 0; rr < rep; ++rr) {
  u16* Wt0 = (u16*)(p.ws + OFF_WT0);
  for (int t = blockIdx.x; t < 1536; t += gridDim.x)
    transpose_tile(p.ret_w_in, Wt0, 1024, 6144, 1, t >> 4, t & 15, smem, tid);
  float2* rope = (float2*)(p.ws + OFF_ROPE);
  const int gtid = blockIdx.x * NTHR + tid, gn = gridDim.x * NTHR;
  for (int idx = gtid; idx < 2056 * 128; idx += gn) {
    int pi = idx >> 7, i = idx & 127;
    int pos = pi < 2048 ? pi : 16384 + (pi - 2048);
    float freq = (float)exp2(-(double)i * (13.287712379549449 / 128.0));
    float ang = (float)pos * freq;
    float sn, cs;
    sincosf(ang, &sn, &cs);
    rope[idx] = make_float2(cs, sn);
  }
  u16* H = (u16*)(p.ws + OFF_H);
  const int lane = tid & 63, w = (int)p.wv;
  for (int row = blockIdx.x * 8 + w; row < T_TOK; row += gridDim.x * 8) {
    const float* xr = xrow(p, row);
    float4 v[4];
    float ss = 0.f;
#pragma unroll
    for (int i = 0; i < 4; ++i) {
      v[i] = *(const float4*)(xr + i * 256 + lane * 4);
      ss += v[i].x * v[i].x + v[i].y * v[i].y + v[i].z * v[i].z + v[i].w * v[i].w;
    }
    ss = wave_sum(ss);
    float rstd = rsqrtf(ss * (1.0f / 1024.0f) + 1e-6f);
#pragma unroll
    for (int i = 0; i < 4; ++i) {
      float4 gg = *(const float4*)(p.ret_norm + i * 256 + lane * 4);
      u32x2 o;
      o.x = pack2(v[i].x * rstd * gg.x, v[i].y * rstd * gg.y);
      o.y = pack2(v[i].z * rstd * gg.z, v[i].w * rstd * gg.w);
      *(u32x2*)(H + (size_t)row * 1024 + i * 256 + lane * 4) = o;
    }
  }
  }
}

__device__ void transpose_later_weights(const Params& p, unsigned char* smem, const int first_blk) {
  const int tid = (int)p.tidx;
  u16* Wt1 = (u16*)(p.ws + OFF_WT1);
  u16* Wt2 = (u16*)(p.ws + OFF_WT2);
  u16* Wt3 = (u16*)(p.ws + OFF_WT3);
  const int n1 = 512, n2 = 1568, n3 = 512;
  if ((int)blockIdx.x < first_blk) return;
  const int nb = (int)gridDim.x - first_blk;
  for (int t = (int)blockIdx.x - first_blk; t < n1 + n2 + n3; t += nb) {
    if (t < n1) {
      transpose_tile(p.ret_w_out, Wt1, 2048, 1024, 0, t >> 5, t & 31, smem, tid);
    } else if (t < n1 + n2) {
      int u = t - n1;
      transpose_tile(p.ssm_w_in, Wt2, 1024, 6176, 0, u >> 4, u & 15, smem, tid);
    } else {
      int u = t - n1 - n2;
      transpose_tile(p.ssm_w_out, Wt3, 2048, 1024, 0, u >> 5, u & 31, smem, tid);
    }
  }
}

template <int MODE>
__device__ void phase_norm(const Params& p, const float* __restrict__ X, const float* __restrict__ gain, const int rep) {
  const int tid = (int)p.tidx, lane = tid & 63, w = (int)p.wv;
  u16* H = (u16*)(p.ws + OFF_H);
  for (int row0 = blockIdx.x * 8 + w; row0 < T_TOK * rep; row0 += gridDim.x * 8) {
    const int row = row0 % T_TOK;
    const float* xr = X + (size_t)row * 1024;
    float4 v[4];
    float ss = 0.f;
#pragma unroll
    for (int i = 0; i < 4; ++i) {
      v[i] = *(const float4*)(xr + i * 256 + lane * 4);
      ss += v[i].x * v[i].x + v[i].y * v[i].y + v[i].z * v[i].z + v[i].w * v[i].w;
    }
    ss = wave_sum(ss);
    float rstd = rsqrtf(ss * (1.0f / 1024.0f) + 1e-6f);
#pragma unroll
    for (int i = 0; i < 4; ++i) {
      float4 gg = *(const float4*)(gain + i * 256 + lane * 4);
      if (MODE == 0) {
        u32x2 o;
        o.x = pack2(v[i].x * rstd * gg.x, v[i].y * rstd * gg.y);
        o.y = pack2(v[i].z * rstd * gg.z, v[i].w * rstd * gg.w);
        *(u32x2*)(H + (size_t)row * 1024 + i * 256 + lane * 4) = o;
      } else {
        float4 o = make_float4(v[i].x * rstd * gg.x, v[i].y * rstd * gg.y, v[i].z * rstd * gg.z, v[i].w * rstd * gg.w);
        *(float4*)(p.out + OUT_Y + (size_t)row * 1024 + i * 256 + lane * 4) = o;
      }
    }
  }
}

template <int EPI, int NH>
__device__ void gemm_phase(const Params& p, const u16* __restrict__ A, const u16* __restrict__ Bt, const int K, const int NT,
                           const float* __restrict__ resid, float* __restrict__ outf, unsigned char* smem, const int rep,
                           const int mtiles, const int nt0 = 0, const bool rev = false) {
  constexpr int BM = 256, BN = 128, BK = 64, LR = 144;
  constexpr int BUFB = (BM + BN) * LR;
  float* rstdS = (float*)(smem + 2 * BUFB);
  const int tid = (int)p.tidx, lane = tid & 63, w = (int)p.wv;
  const int wm = w >> 1, wn = w & 1, l15 = lane & 15, g = lane >> 4;
  const int KT = K / BK;
  const int ntiles = mtiles * NT;
  const float* parts = (const float*)(p.ws + OFF_PARTS);
  const int srow = tid >> 3, skc = tid & 7;

  for (int tile0 = rev ? (int)(gridDim.x - 1 - blockIdx.x) : (int)blockIdx.x; tile0 < ntiles * rep; tile0 += gridDim.x) {
    const int tile = tile0 % ntiles;
    int mt = tile / NT, nt = tile - mt * NT + nt0;
    if (EPI == 1 && NT == 8 && mtiles == 64 && gridDim.x == 256) {
      const int blk = tile & 255, rnd = tile >> 8;
      mt = rnd * 32 + (blk & 7) * 4 + (blk >> 6);
      nt = (blk >> 3) & 7;
    }
    const int m0 = mt * BM, n0 = nt * BN;
    const bool skip_mma = (EPI == 2) && (n0 >= 6144) && (wn == 1);
    if (NH > 0) {
      for (int idx = tid; idx < BM * NH; idx += NTHR) {
        int row = idx / NH, h = idx % NH;
        const float* pp = parts + (size_t)(m0 + row) * 64 + h * (64 / NH);
        float s = 0.f;
#pragma unroll
        for (int q = 0; q < 64 / NH; ++q) s += pp[q];
        rstdS[idx] = rsqrtf(s / (float)(K / NH) + 1e-6f);
      }
    }
    u32x4 ra[2][4], rb[2][2];
    const u16* ap = A + (size_t)(m0 + srow) * K + skc * 8;
    const u16* bp = Bt + (size_t)(n0 + srow) * K + skc * 8;
#pragma unroll
    for (int i = 0; i < 4; ++i) ra[0][i] = *(const u32x4*)(ap + (size_t)(64 * i) * K);
#pragma unroll
    for (int i = 0; i < 2; ++i) rb[0][i] = *(const u32x4*)(bp + (size_t)(64 * i) * K);
#pragma unroll
    for (int i = 0; i < 4; ++i) ra[1][i] = *(const u32x4*)(ap + (size_t)(64 * i) * K + BK);
#pragma unroll
    for (int i = 0; i < 2; ++i) rb[1][i] = *(const u32x4*)(bp + (size_t)(64 * i) * K + BK);
    {
      unsigned char* base = smem;
#pragma unroll
      for (int i = 0; i < 4; ++i) *(u32x4*)(base + (srow + 64 * i) * LR + skc * 16) = ra[0][i];
#pragma unroll
      for (int i = 0; i < 2; ++i) *(u32x4*)(base + BM * LR + (srow + 64 * i) * LR + skc * 16) = rb[0][i];
    }
    __syncthreads();

    f32x4 acc[4][4];
    f32x4 accT[4][4];
#pragma unroll
    for (int i = 0; i < 4; ++i)
#pragma unroll
      for (int j = 0; j < 4; ++j) {
        acc[i][j] = (f32x4){0.f, 0.f, 0.f, 0.f};
        accT[i][j] = (f32x4){0.f, 0.f, 0.f, 0.f};
      }

    for (int kt2 = 0; kt2 < KT; kt2 += 2) {
#pragma unroll
     for (int par = 0; par < 2; ++par) {
      const int kt = kt2 + par;
      if (kt + 2 < KT) {
#pragma unroll
        for (int i = 0; i < 4; ++i) ra[par][i] = *(const u32x4*)(ap + (size_t)(64 * i) * K + (kt + 2) * BK);
#pragma unroll
        for (int i = 0; i < 2; ++i) rb[par][i] = *(const u32x4*)(bp + (size_t)(64 * i) * K + (kt + 2) * BK);
      }
      const unsigned char* abase = smem + par * BUFB + (wm * 64 + l15) * LR + g * 16;
      const unsigned char* bbase = smem + par * BUFB + BM * LR + (wn * 64 + l15) * LR + g * 16;
      if (!skip_mma)
#pragma unroll
      for (int ks = 0; ks < 2; ++ks) {
        bf16x8 af[4], bfr[2];
#pragma unroll
        for (int mf = 0; mf < 4; ++mf) af[mf] = *(const bf16x8*)(abase + mf * 16 * LR + ks * 64);
#pragma unroll
        for (int nh = 0; nh < 2; ++nh) {
#pragma unroll
          for (int n2 = 0; n2 < 2; ++n2) bfr[n2] = *(const bf16x8*)(bbase + (nh * 2 + n2) * 16 * LR + ks * 64);
#pragma unroll
          for (int mf = 0; mf < 4; ++mf)
#pragma unroll
            for (int n2 = 0; n2 < 2; ++n2)
              acc[mf][nh * 2 + n2] = __builtin_amdgcn_mfma_f32_16x16x32_bf16(af[mf], bfr[n2], acc[mf][nh * 2 + n2], 0, 0, 0);
        }
      }
      if (NH > 0) {
        const int per = KT / NH;
        if (((kt + 1) % per) == 0) {
          const int h = (kt + 1) / per - 1;
#pragma unroll
          for (int mf = 0; mf < 4; ++mf)
#pragma unroll
            for (int r = 0; r < 4; ++r) {
              float s = rstdS[(wm * 64 + mf * 16 + 4 * g + r) * NH + h];
#pragma unroll
              for (int nf = 0; nf < 4; ++nf) {
                accT[mf][nf][r] += s * acc[mf][nf][r];
                acc[mf][nf][r] = 0.f;
              }
            }
        }
      }
      if (kt + 1 < KT) {
        unsigned char* base = smem + (par ^ 1) * BUFB;
#pragma unroll
        for (int i = 0; i < 4; ++i) *(u32x4*)(base + (srow + 64 * i) * LR + skc * 16) = ra[par ^ 1][i];
#pragma unroll
        for (int i = 0; i < 2; ++i) *(u32x4*)(base + BM * LR + (srow + 64 * i) * LR + skc * 16) = rb[par ^ 1][i];
      }
      __syncthreads();
     }
    }

#pragma unroll
    for (int mf = 0; mf < 4; ++mf) {
      __builtin_amdgcn_sched_barrier(0);
      float rvv[4][4];
      if (EPI == 1) {
#pragma unroll
        for (int r = 0; r < 4; ++r) {
          const int row = m0 + wm * 64 + mf * 16 + 4 * g + r;
#pragma unroll
          for (int nf = 0; nf < 4; ++nf) {
            const int col = n0 + wn * 64 + nf * 16 + l15;
            rvv[r][nf] = resid ? resid[(size_t)row * 1024 + col] : xrow(p, row)[col];
          }
        }
      }
#pragma unroll
      for (int r = 0; r < 4; ++r) {
        const int row = m0 + wm * 64 + mf * 16 + 4 * g + r;
        if (EPI == 0) {
          u16* proj = (u16*)(p.ws + OFF_PROJ) + (size_t)row * PROJ_LD;
          if (n0 < 2048) {
            const float2* rope = (const float2*)(p.ws + OFF_ROPE);
            const int pi = row < NPROMPT ? (row & 2047) : 2048 + ((row - NPROMPT) & 7);
#pragma unroll
            for (int np = 0; np < 2; ++np) {
              const int pc = n0 + wn * 64 + np * 32;
              const int i = ((pc & 255) >> 5) * 16 + l15;
              const float2 cs = rope[pi * 128 + i];
              const float x1 = acc[mf][2 * np][r], x2 = acc[mf][2 * np + 1][r];
              float y1 = x1 * cs.x - x2 * cs.y, y2 = x1 * cs.y + x2 * cs.x;
              if (pc >= 1024) { y1 *= 0.0625f; y2 *= 0.0625f; }
              const int f1 = (pc & ~255) + i;
              proj[f1] = f2bf(y1);
              proj[f1 + 128] = f2bf(y2);
            }
          } else {
#pragma unroll
            for (int nf = 0; nf < 4; ++nf) proj[n0 + wn * 64 + nf * 16 + l15] = f2bf(acc[mf][nf][r]);
          }
        } else if (EPI == 1) {
#pragma unroll
          for (int nf = 0; nf < 4; ++nf) {
            const int col = n0 + wn * 64 + nf * 16 + l15;
            const float a = (NH > 0) ? accT[mf][nf][r] : acc[mf][nf][r];
            outf[(size_t)row * 1024 + col] = rvv[r][nf] + a;
          }
        } else {
          u16* proj = (u16*)(p.ws + OFF_PROJ) + (size_t)row * PROJ_LD;
          float* dtraw = (float*)(p.ws + OFF_DTRAW) + (size_t)row * 32;
          float* cvo = nullptr;
          if (row < NPROMPT) {
            const int t = row & 2047;
            if (t >= 2045) cvo = p.out + OUT_CONVP + ((size_t)(row >> 11) * 3 + (t - 2045)) * 4096;
          } else {
            const int rs = row - NPROMPT, t = rs & 7;
            if (t >= 5) cvo = p.out + OUT_CONVS + ((size_t)(rs >> 3) * 3 + (t - 5)) * 4096;
          }
#pragma unroll
          for (int nf = 0; nf < 4; ++nf) {
            const int col = n0 + wn * 64 + nf * 16 + l15;
            const float a = acc[mf][nf][r];
            if (col < 6144) {
              proj[col] = f2bf(a);
              if (col >= 2048 && cvo) cvo[col - 2048] = a;
            } else if (col < 6176) {
              dtraw[col - 6144] = a;
            }
          }
        }
      }
    }
  }
}


template <int NH>
__device__ void gemm_sample_rows(const Params& p, const u16* __restrict__ A, const u16* __restrict__ Bt,
                                 const float* __restrict__ resid, float* __restrict__ outf, unsigned char* smem, const int rep) {
  constexpr int K = 2048, RS = 65;
  float* red = (float*)smem;
  float* rstdS = red + 8 * 64 * RS;
  const int tid = (int)p.tidx, lane = tid & 63, w = (int)p.wv, l15 = lane & 15, g = lane >> 4;
  const float* parts = (const float*)(p.ws + OFF_PARTS);
  for (int item0 = blockIdx.x; item0 < 256 * rep; item0 += gridDim.x) {
    const int item = item0 & 255;
    const int m0 = NPROMPT + (item >> 4) * 64, n0 = (item & 15) * 64;
    for (int idx = tid; idx < 64 * NH; idx += NTHR) {
      const int row = idx / NH, h = idx % NH;
      const float* pp = parts + (size_t)(m0 + row) * 64 + h * (64 / NH);
      float sm = 0.f;
#pragma unroll
      for (int q = 0; q < 64 / NH; ++q) sm += pp[q];
      rstdS[idx] = rsqrtf(sm / (float)(K / NH) + 1e-6f);
    }
    f32x4 acc[4][4];
#pragma unroll
    for (int i = 0; i < 4; ++i)
#pragma unroll
      for (int j = 0; j < 4; ++j) acc[i][j] = (f32x4){0.f, 0.f, 0.f, 0.f};
    const u16* ap = A + (size_t)(m0 + l15) * K + w * 256 + 8 * g;
    const u16* bp = Bt + (size_t)(n0 + l15) * K + w * 256 + 8 * g;
#pragma unroll 2
    for (int ks = 0; ks < 8; ++ks) {
      bf16x8 af[4], bfr[4];
#pragma unroll
      for (int mf = 0; mf < 4; ++mf) af[mf] = *(const bf16x8*)(ap + (size_t)(mf * 16) * K + ks * 32);
#pragma unroll
      for (int nf = 0; nf < 4; ++nf) bfr[nf] = *(const bf16x8*)(bp + (size_t)(nf * 16) * K + ks * 32);
#pragma unroll
      for (int mf = 0; mf < 4; ++mf)
#pragma unroll
        for (int nf = 0; nf < 4; ++nf)
          acc[mf][nf] = __builtin_amdgcn_mfma_f32_16x16x32_bf16(af[mf], bfr[nf], acc[mf][nf], 0, 0, 0);
    }
    __syncthreads();
    {
      const int h = (w * 256) / (K / NH);
#pragma unroll
      for (int mf = 0; mf < 4; ++mf)
#pragma unroll
        for (int r = 0; r < 4; ++r) {
          const int row = mf * 16 + 4 * g + r;
          const float sc = rstdS[row * NH + h];
#pragma unroll
          for (int nf = 0; nf < 4; ++nf) red[(w * 64 + row) * RS + nf * 16 + l15] = acc[mf][nf][r] * sc;
        }
    }
    __syncthreads();
    {
      const int row = tid >> 3, c0 = (tid & 7) * 8;
      float o[8];
      const size_t gidx = (size_t)(m0 + row) * 1024 + n0 + c0;
      const float* rp = resid ? resid + gidx : p.x_sample + (size_t)(m0 - NPROMPT + row) * 1024 + n0 + c0;
      const float4 r0 = *(const float4*)rp, r1 = *(const float4*)(rp + 4);
      o[0] = r0.x; o[1] = r0.y; o[2] = r0.z; o[3] = r0.w; o[4] = r1.x; o[5] = r1.y; o[6] = r1.z; o[7] = r1.w;
#pragma unroll
      for (int ww = 0; ww < 8; ++ww)
#pragma unroll
        for (int j = 0; j < 8; ++j) o[j] += red[(ww * 64 + row) * RS + c0 + j];
      *(float4*)(outf + gidx) = make_float4(o[0], o[1], o[2], o[3]);
      *(float4*)(outf + gidx + 4) = make_float4(o[4], o[5], o[6], o[7]);
    }
    __syncthreads();
  }
}

__device__ __forceinline__ int lds_byte(int r, int c) {
  int st = (r >> 4) * 2 + (c >> 5), rr = r & 15, cc = c & 31, ob = rr * 64 + cc * 2;
  return st * 1024 + (ob ^ (((ob >> 9) & 1) << 5));
}
__device__ __forceinline__ void stage_rc(int b, int& R, int& C) {
  int st = b / 1024, sb = b % 1024, swz = sb ^ (((sb >> 9) & 1) << 5);
  R = (st >> 1) * 16 + swz / 64;
  C = (st & 1) * 32 + (swz % 64) / 2;
}

template <int EPI>
__device__ void gemm8_phase(const Params& p, const u16* __restrict__ A, const u16* __restrict__ Bt, const int K, const int nN,
                            unsigned char* smem, const int rep) {
  constexpr int BM8 = 256, BK8 = 64, HALF = 128, NXCD = 8, WGM = 8, HT = HALF * BK8;
  u16* shm = (u16*)smem;
#define SA(b, h) (shm + ((b) * 2 + (h)) * HT)
#define SB(b, h) (shm + (4 + (b) * 2 + (h)) * HT)
#define STAGE(P, BASE, br, kt)                                                                            \
  do {                                                                                                    \
    const int _so = ((br) * K + (kt) * BK8) * 2;                                                          \
    __builtin_amdgcn_raw_ptr_buffer_load_lds(rsrc_##BASE, (__attribute__((address_space(3))) unsigned*)((char*)(P) + (int)p.tidx * 16), 16, voff0, _so, 0, 0); \
    __builtin_amdgcn_raw_ptr_buffer_load_lds(rsrc_##BASE, (__attribute__((address_space(3))) unsigned*)((char*)(P) + (int)p.tidx * 16 + 8192), 16, voff1, _so, 0, 0); \
  } while (0)
#define LDA(dst, b, h)                                                                                    \
  for (int m = 0; m < 4; ++m)                                                                             \
    for (int k = 0; k < 2; ++k)                                                                           \
      dst[m][k] = *reinterpret_cast<const bf16x8*>((char*)SA(b, h) + lds_byte(wr * 64 + m * 16 + fr, k * 32 + fq * 8))
#define LDB(dst, b, h)                                                                                    \
  for (int n = 0; n < 2; ++n)                                                                             \
    for (int k = 0; k < 2; ++k)                                                                           \
      dst[n][k] = *reinterpret_cast<const bf16x8*>((char*)SB(b, h) + lds_byte(wc * 32 + n * 16 + fr, k * 32 + fq * 8))
#define MMA(ai, bj, At, Bx)                                                                               \
  do {                                                                                                    \
    __builtin_amdgcn_s_setprio(1);                                                                        \
    for (int m = 0; m < 4; ++m)                                                                           \
      for (int n = 0; n < 2; ++n)                                                                         \
        for (int k = 0; k < 2; ++k)                                                                       \
          acc[ai][bj][m][n] = __builtin_amdgcn_mfma_f32_16x16x32_bf16(At[m][k], Bx[n][k], acc[ai][bj][m][n], 0, 0, 0); \
    __builtin_amdgcn_s_setprio(0);                                                                        \
  } while (0)
#define WAIT_V(n) asm volatile("s_waitcnt vmcnt(" #n ")" ::: "memory")
#define WAIT_L(n) asm volatile("s_waitcnt lgkmcnt(" #n ")" ::: "memory")
#define BAR __builtin_amdgcn_s_barrier()
#define SCHED __builtin_amdgcn_sched_barrier(0)

  const int nM = T_TOK / BM8, nwg = nM * nN;
  const int wid = (int)p.wv, lane = (int)p.tidx & 63, wr = wid >> 2, wc = wid & 3, fr = lane & 15, fq = lane >> 4;
  const int nt = K / BK8;
  const __amdgpu_buffer_rsrc_t rsrc_A = __builtin_amdgcn_make_buffer_rsrc((void*)A, (short)0, T_TOK * K * 2, 0x00020000);
  const __amdgpu_buffer_rsrc_t rsrc_Bt = __builtin_amdgcn_make_buffer_rsrc((void*)Bt, (short)0, nN * 256 * K * 2, 0x00020000);
  int voff0, voff1;
  {
    int r_, c_;
    stage_rc((int)p.tidx * 16, r_, c_);
    voff0 = (r_ * K + c_) * 2;
    stage_rc((int)p.tidx * 16 + 8192, r_, c_);
    voff1 = (r_ * K + c_) * 2;
  }

  for (int tile0 = blockIdx.x; tile0 < nwg * rep; tile0 += gridDim.x) {
    const int tile = tile0 % nwg;
    int wgid = tile;
    {
      int q = nwg / NXCD, r = nwg % NXCD, xcd = wgid % NXCD, off = wgid / NXCD;
      wgid = (xcd < r ? xcd * (q + 1) : r * (q + 1) + (xcd - r) * q) + off;
    }
    const int nig = WGM * nN, gid = wgid / nig, fm = gid * WGM, gsz = min(nM - fm, WGM);
    const int pm = fm + ((wgid % nig) % gsz), pn = (wgid % nig) / gsz, brow = pm * BM8, bcol = pn * BM8;

    f32x4 acc[2][2][4][2];
#pragma unroll
    for (int a = 0; a < 2; ++a)
#pragma unroll
      for (int b = 0; b < 2; ++b)
#pragma unroll
        for (int m = 0; m < 4; ++m)
#pragma unroll
          for (int n = 0; n < 2; ++n) acc[a][b][m][n] = (f32x4){0.f, 0.f, 0.f, 0.f};
    bf16x8 At[4][2], B0[2][2], B1[2][2];

    STAGE(SB(0, 0), Bt, bcol, 0); STAGE(SA(0, 0), A, brow, 0);
    STAGE(SB(0, 1), Bt, bcol + HALF, 0); STAGE(SA(0, 1), A, brow + HALF, 0);
    if (wr == 1) BAR;
    WAIT_V(4); BAR;
    STAGE(SB(1, 0), Bt, bcol, 1); STAGE(SA(1, 0), A, brow, 1); STAGE(SB(1, 1), Bt, bcol + HALF, 1);
    WAIT_V(6); BAR;
    for (int t = 0; t < nt - 2; t += 2) {
      LDB(B0, 0, 0); SCHED; LDA(At, 0, 0); STAGE(SA(1, 1), A, brow + HALF, t + 1);
      WAIT_L(8); BAR; WAIT_L(0); MMA(0, 0, At, B0); BAR; SCHED;
      LDB(B1, 0, 1); STAGE(SB(0, 0), Bt, bcol, t + 2);
      BAR; WAIT_L(0); MMA(0, 1, At, B1); BAR;
      LDA(At, 0, 1); STAGE(SA(0, 0), A, brow, t + 2);
      BAR; WAIT_L(0); MMA(1, 0, At, B0); BAR; SCHED;
      STAGE(SB(0, 1), Bt, bcol + HALF, t + 2);
      WAIT_V(6); BAR; MMA(1, 1, At, B1); BAR;
      LDB(B0, 1, 0); SCHED; LDA(At, 1, 0); STAGE(SA(0, 1), A, brow + HALF, t + 2);
      WAIT_L(8); BAR; WAIT_L(0); MMA(0, 0, At, B0); BAR; SCHED;
      LDB(B1, 1, 1); STAGE(SB(1, 0), Bt, bcol, t + 3);
      BAR; WAIT_L(0); MMA(0, 1, At, B1); BAR;
      LDA(At, 1, 1); STAGE(SA(1, 0), A, brow, t + 3);
      BAR; WAIT_L(0); MMA(1, 0, At, B0); BAR; SCHED;
      STAGE(SB(1, 1), Bt, bcol + HALF, t + 3);
      WAIT_V(6); BAR; MMA(1, 1, At, B1); BAR;
    }
    {
      LDB(B0, 0, 0); LDA(At, 0, 0); STAGE(SA(1, 1), A, brow + HALF, nt - 1);
      BAR; WAIT_L(0); MMA(0, 0, At, B0); BAR; SCHED;
      LDB(B1, 0, 1); BAR; WAIT_L(0); MMA(0, 1, At, B1); BAR; SCHED;
      LDA(At, 0, 1); WAIT_V(4); BAR; WAIT_L(0); MMA(1, 0, At, B0); MMA(1, 1, At, B1); BAR; SCHED;
    }
    {
      LDB(B0, 1, 0); LDA(At, 1, 0); WAIT_V(2); BAR; WAIT_L(0); MMA(0, 0, At, B0); BAR; SCHED;
      LDB(B1, 1, 1); WAIT_V(0); BAR; WAIT_L(0); MMA(0, 1, At, B1); BAR; SCHED;
      LDA(At, 1, 1); BAR; WAIT_L(0); MMA(1, 0, At, B0); MMA(1, 1, At, B1); BAR; SCHED;
    }
    if (wr == 0) BAR;

    u16* projb = (u16*)(p.ws + OFF_PROJ);
#pragma unroll
    for (int ai = 0; ai < 2; ++ai)
#pragma unroll
      for (int m = 0; m < 4; ++m) {
        if (EPI == 0 && bcol < 2048) {
          const float2* rope = (const float2*)(p.ws + OFF_ROPE);
#pragma unroll
          for (int bj = 0; bj < 2; ++bj) {
            __builtin_amdgcn_sched_barrier(0);
            const int pc = bcol + bj * HALF + wc * 32;
            const int i = ((pc & 255) >> 5) * 16 + fr;
            const int f1 = (pc & ~255) + i;
            float2 csv[4];
#pragma unroll
            for (int j = 0; j < 4; ++j) {
              const int row = brow + ai * HALF + wr * 64 + m * 16 + fq * 4 + j;
              const int pi = row < NPROMPT ? (row & 2047) : 2048 + ((row - NPROMPT) & 7);
              csv[j] = rope[pi * 128 + i];
            }
#pragma unroll
            for (int j = 0; j < 4; ++j) {
              const int row = brow + ai * HALF + wr * 64 + m * 16 + fq * 4 + j;
              u16* proj = projb + (size_t)row * PROJ_LD;
              const float2 cs = csv[j];
              const float x1 = acc[ai][bj][m][0][j], x2 = acc[ai][bj][m][1][j];
              float y1 = x1 * cs.x - x2 * cs.y, y2 = x1 * cs.y + x2 * cs.x;
              if (pc >= 1024) { y1 *= 0.0625f; y2 *= 0.0625f; }
              proj[f1] = f2bf(y1);
              proj[f1 + 128] = f2bf(y2);
            }
          }
        } else {
#pragma unroll
          for (int j = 0; j < 4; ++j) {
            __builtin_amdgcn_sched_barrier(0);
            const int row = brow + ai * HALF + wr * 64 + m * 16 + fq * 4 + j;
            u16* proj = projb + (size_t)row * PROJ_LD;
            float* cvo = nullptr;
            if (EPI == 2 && bcol >= 2048) {
              if (row < NPROMPT) {
                const int t = row & 2047;
                if (t >= 2045) cvo = p.out + OUT_CONVP + ((size_t)(row >> 11) * 3 + (t - 2045)) * 4096;
              } else {
                const int rs = row - NPROMPT, t = rs & 7;
                if (t >= 5) cvo = p.out + OUT_CONVS + ((size_t)(rs >> 3) * 3 + (t - 5)) * 4096;
              }
            }
#pragma unroll
            for (int bj = 0; bj < 2; ++bj)
#pragma unroll
              for (int n = 0; n < 2; ++n) {
                const int col = bcol + bj * HALF + wc * 32 + n * 16 + fr;
                const float a = acc[ai][bj][m][n][j];
                proj[col] = f2bf(a);
                if (EPI == 2 && cvo) cvo[col - 2048] = a;
              }
          }
        }
      }
  }
#undef SA
#undef SB
#undef STAGE
#undef LDA
#undef LDB
#undef MMA
#undef WAIT_V
#undef WAIT_L
#undef BAR
#undef SCHED
}

__device__ __forceinline__ void unpack8(const u32x4 u, float* xv) {
  xv[0] = bf2f((u16)(u.x & 0xffff)); xv[1] = bf2f((u16)(u.x >> 16));
  xv[2] = bf2f((u16)(u.y & 0xffff)); xv[3] = bf2f((u16)(u.y >> 16));
  xv[4] = bf2f((u16)(u.z & 0xffff)); xv[5] = bf2f((u16)(u.z >> 16));
  xv[6] = bf2f((u16)(u.w & 0xffff)); xv[7] = bf2f((u16)(u.w >> 16));
}

__device__ void phase_conv(const Params& p, unsigned char* smem, const int rep) {
  const int tid = (int)p.tidx;
  const float* dtraw = (const float*)(p.ws + OFF_DTRAW);
  float* dtv = (float*)(p.ws + OFF_DT);
  float* cumv = (float*)(p.ws + OFF_CUM);
  {
    float* laS = (float*)smem;
    const int tok = tid >> 3, h0 = (tid & 7) * 4;
    const float4 bias = *(const float4*)(p.ssm_dt_bias + h0);
    const float4 al = *(const float4*)(p.ssm_a_log + h0);
    const float4 an = make_float4(-expf(al.x), -expf(al.y), -expf(al.z), -expf(al.w));
    for (int sc = blockIdx.x; sc < 384; sc += gridDim.x) {
      int row0, len;
      if (sc < 256) { row0 = sc * 64; len = 64; } else { row0 = NPROMPT + (sc - 256) * 8; len = 8; }
      if (tok < len) {
        const float4 x = *(const float4*)(dtraw + (size_t)(row0 + tok) * 32 + h0);
        float4 dt;
        { float v = x.x + bias.x; dt.x = v > 20.f ? v : log1pf(expf(v)); }
        { float v = x.y + bias.y; dt.y = v > 20.f ? v : log1pf(expf(v)); }
        { float v = x.z + bias.z; dt.z = v > 20.f ? v : log1pf(expf(v)); }
        { float v = x.w + bias.w; dt.w = v > 20.f ? v : log1pf(expf(v)); }
        *(float4*)(dtv + (size_t)(row0 + tok) * 32 + h0) = dt;
        *(float4*)(laS + tok * 32 + h0) = make_float4(dt.x * an.x * 1.4426950408889634f, dt.y * an.y * 1.4426950408889634f,
                                                      dt.z * an.z * 1.4426950408889634f, dt.w * an.w * 1.4426950408889634f);
      }
      __syncthreads();
      if (tok < len) {
        float4 c = make_float4(0.f, 0.f, 0.f, 0.f);
        for (int t = 0; t <= tok; ++t) {
          const float4 v = *(const float4*)(laS + t * 32 + h0);
          c.x += v.x; c.y += v.y; c.z += v.z; c.w += v.w;
        }
        *(float4*)(cumv + (size_t)(row0 + tok) * 32 + h0) = c;
      }
      __syncthreads();
    }
  }
  const u16* proj = (const u16*)(p.ws + OFF_PROJ);
  u16* xbcc = (u16*)(p.ws + OFF_XBCC);
  const int gtid = blockIdx.x * NTHR + tid;
  const int ch0 = (gtid & 511) * 8, rb = gtid >> 9;
  float wgt[4][8], bs[8];
#pragma unroll
  for (int wv = 0; wv < 4; ++wv) {
    const float4 w0 = *(const float4*)(p.ssm_conv_w + (size_t)wv * 4096 + ch0);
    const float4 w1 = *(const float4*)(p.ssm_conv_w + (size_t)wv * 4096 + ch0 + 4);
    wgt[wv][0] = w0.x; wgt[wv][1] = w0.y; wgt[wv][2] = w0.z; wgt[wv][3] = w0.w;
    wgt[wv][4] = w1.x; wgt[wv][5] = w1.y; wgt[wv][6] = w1.z; wgt[wv][7] = w1.w;
  }
  {
    const float4 b0 = *(const float4*)(p.ssm_conv_b + ch0), b1 = *(const float4*)(p.ssm_conv_b + ch0 + 4);
    bs[0] = b0.x; bs[1] = b0.y; bs[2] = b0.z; bs[3] = b0.w; bs[4] = b1.x; bs[5] = b1.y; bs[6] = b1.z; bs[7] = b1.w;
  }
  const int rows_per = T_TOK / (int)(gridDim.x * NTHR / 512);
  for (int rr = 0; rr < rep; ++rr) {
    float hm3[8], hm2[8], hm1[8];
    const int rbeg = rb * rows_per;
    u32x4 cur[4], nxt[4];
#pragma unroll
    for (int q = 0; q < 4; ++q) cur[q] = *(const u32x4*)(proj + (size_t)(rbeg + q) * PROJ_LD + 2048 + ch0);
    for (int r4 = 0; r4 < rows_per; r4 += 4) {
#pragma unroll
      for (int q = 0; q < 4; ++q) {
        nxt[q] = cur[q];
        if (r4 + 4 + q < rows_per) nxt[q] = *(const u32x4*)(proj + (size_t)(rbeg + r4 + 4 + q) * PROJ_LD + 2048 + ch0);
      }
#pragma unroll
      for (int q4 = 0; q4 < 4; ++q4) {
        const int r = r4 + q4;
        const int row = rbeg + r;
        const bool samp = row >= NPROMPT;
        const int t = samp ? ((row - NPROMPT) & 7) : (row & 2047);
        const int b = samp ? ((row - NPROMPT) >> 3) : (row >> 11);
        if (r == 0 || t == 0) {
#pragma unroll
          for (int k = 1; k <= 3; ++k) {
            float hv[8];
            if (t - k >= 0) {
              unpack8(*(const u32x4*)(proj + (size_t)(row - k) * PROJ_LD + 2048 + ch0), hv);
            } else if (samp) {
              const float* sp = p.state_conv + ((size_t)b * 3 + (t - k + 3)) * 4096 + ch0;
              const float4 s0 = *(const float4*)sp, s1 = *(const float4*)(sp + 4);
              hv[0] = s0.x; hv[1] = s0.y; hv[2] = s0.z; hv[3] = s0.w; hv[4] = s1.x; hv[5] = s1.y; hv[6] = s1.z; hv[7] = s1.w;
            } else {
#pragma unroll
              for (int q = 0; q < 8; ++q) hv[q] = 0.f;
            }
#pragma unroll
            for (int q = 0; q < 8; ++q) {
              if (k == 1) hm1[q] = hv[q];
              if (k == 2) hm2[q] = hv[q];
              if (k == 3) hm3[q] = hv[q];
            }
          }
        }
        float xc[8], o[8];
        unpack8(cur[q4], xc);
#pragma unroll
        for (int q = 0; q < 8; ++q) {
          const float a = bs[q] + hm3[q] * wgt[0][q] + hm2[q] * wgt[1][q] + hm1[q] * wgt[2][q] + xc[q] * wgt[3][q];
          o[q] = silu(a);
          hm3[q] = hm2[q]; hm2[q] = hm1[q]; hm1[q] = xc[q];
        }
        u32x4 ov;
        ov.x = pack2(o[0], o[1]); ov.y = pack2(o[2], o[3]); ov.z = pack2(o[4], o[5]); ov.w = pack2(o[6], o[7]);
        *(u32x4*)(xbcc + (size_t)row * 4096 + ch0) = ov;
      }
#pragma unroll
      for (int q = 0; q < 4; ++q) cur[q] = nxt[q];
    }
  }
}

template <int DK, int MODE>
__device__ void rec_prompt_item(const Params& p, const int item, unsigned char* smem) {
  constexpr int QS = (DK + 16) * 2;
  constexpr int VS = 160, PS = 144;
  constexpr int MF = DK / 128;
  constexpr int KS = DK / 32;
  constexpr int KUNR = 4;
  constexpr int NQ = DK / 64;
  constexpr int CPR = DK / 8;
  unsigned char* Qs = smem;
  unsigned char* Ks = Qs + 64 * QS;
  unsigned char* STs = Ks + 64 * QS;
  unsigned char* Vs = STs + 64 * QS;
  unsigned char* Vts = Vs + 64 * VS;
  unsigned char* Ps = Vts + 64 * VS;
  float* cumS = (float*)(Ps + 64 * PS);
  float* uS = cumS + 64;

  const int tid = (int)p.tidx, lane = tid & 63, w = tid >> 6;
  const int l15 = lane & 15, g = lane >> 4;
  const int b = item >> 5;
  const int h = (MODE == 0) ? ((item >> 3) & 3) : (item & 31);
  const int s = (MODE == 0) ? (item & 7) : 0;
  const int row0 = b * 2048;

  const u16* src;
  int sstride, qcol, kcol, vcol;
  if (MODE == 0) {
    src = (const u16*)(p.ws + OFF_PROJ); sstride = PROJ_LD;
    qcol = h * 256; kcol = 1024 + h * 256; vcol = 2048 + h * 512 + s * 64;
  } else {
    src = (const u16*)(p.ws + OFF_XBCC); sstride = 4096;
    qcol = 3072 + (h >> 2) * 128; kcol = 2048 + (h >> 2) * 128; vcol = h * 64;
  }
  const float* dtv = (const float*)(p.ws + OFF_DT);
  const float* cumv = (const float*)(p.ws + OFF_CUM);
  const float lg = (MODE == 0) ? log2f(1.0f - exp2f(-5.0f - (float)h)) : 0.f;

  const int vrow = tid >> 3, vkc = tid & 7;
  const int jt = tid & 63;

  constexpr int NSET = (MODE == 1) ? 2 : 1;
  u32x4 rq[2][NQ], rk[2][NQ], rv[2];
  float pcj[2] = {0.f, 0.f}, puj[2] = {1.f, 1.f}, pclast[2] = {0.f, 0.f}, pct[2] = {0.f, 0.f}, put[2] = {1.f, 1.f};
  u16 gz[2][2][4];
  const u16* gsrc = (const u16*)(p.ws + OFF_PROJ);
  const int gcol = (MODE == 0) ? (4096 + h * 512 + s * 64) : (h * 64);
  const int fi = w >> 1, fe0 = 2 * (w & 1);
  const int fis = (int)p.wv >> 1, fe0s = 2 * ((int)p.wv & 1);
  const int dw = w * (DK / 8);

  unsigned qoff[NQ], goff[4], aoff[4];
#pragma unroll
  for (int i = 0; i < NQ; ++i) {
    const int c_ = tid + NTHR * i;
    qoff[i] = (unsigned)(((c_ / CPR) * sstride + qcol + (c_ % CPR) * 8) * 2);
  }
  const unsigned voffv = (unsigned)((vrow * sstride + vcol + vkc * 8) * 2);
#pragma unroll
  for (int r = 0; r < 4; ++r) {
    goff[r] = (unsigned)(((16 * fi + 4 * g + r) * PROJ_LD + gcol + 16 * fe0 + l15) * 2);
    aoff[r] = (unsigned)(((16 * fi + 4 * g + r) * 2048 + ((MODE == 0) ? (h * 512 + s * 64) : (h * 64)) + 16 * fe0 + l15) * 2);
  }
  const int kdelta = (kcol - qcol) * 2;

#define PF_ISSUE(SET, RBASE)                                                                       \
  {                                                                                                \
    const int rb_ = (RBASE);                                                                       \
    if (true) {                                                                                    \
      const char* sb_ = (const char*)src + (size_t)rb_ * (size_t)(sstride * 2);                    \
      const char* gb_ = (const char*)gsrc + (size_t)rb_ * (size_t)(PROJ_LD * 2);                   \
      _Pragma("unroll") for (int i = 0; i < NQ; ++i) {                                             \
        rq[SET][i] = *(const u32x4*)(sb_ + qoff[i]);                                               \
        rk[SET][i] = *(const u32x4*)(sb_ + kdelta + qoff[i]);                                      \
      }                                                                                            \
      rv[SET] = *(const u32x4*)(sb_ + voffv);                                                      \
      if (MODE == 1) {                                                                             \
        pcj[SET] = cumv[(size_t)(rb_ + vrow) * 32 + h]; puj[SET] = dtv[(size_t)(rb_ + vrow) * 32 + h]; \
        pclast[SET] = cumv[(size_t)(rb_ + 63) * 32 + h];                                           \
        pct[SET] = cumv[(size_t)(rb_ + jt) * 32 + h]; put[SET] = dtv[(size_t)(rb_ + jt) * 32 + h]; \
      }                                                                                            \
      _Pragma("unroll") for (int x = 0; x < 2; ++x)                                                \
        _Pragma("unroll") for (int r = 0; r < 4; ++r)                                              \
          gz[SET][x][r] = *(const u16*)(gb_ + 32 * x + goff[r]);                                   \
    } else {                                                                                       \
      _Pragma("unroll") for (int i = 0; i < NQ; ++i) {                                             \
        int c_ = tid + NTHR * i, rr_ = c_ / CPR, kc_ = c_ % CPR;                                   \
        rq[SET][i] = *(const u32x4*)(src + (size_t)(rb_ + rr_) * sstride + qcol + kc_ * 8);        \
        rk[SET][i] = *(const u32x4*)(src + (size_t)(rb_ + rr_) * sstride + kcol + kc_ * 8);        \
      }                                                                                            \
      rv[SET] = *(const u32x4*)(src + (size_t)(rb_ + vrow) * sstride + vcol + vkc * 8);            \
      _Pragma("unroll") for (int x = 0; x < 2; ++x)                                                \
        _Pragma("unroll") for (int r = 0; r < 4; ++r)                                              \
          gz[SET][x][r] = gsrc[(size_t)(rb_ + 16 * fi + 4 * g + r) * PROJ_LD + gcol + 16 * (fe0 + x) + l15]; \
    }                                                                                              \
  }

  f32x4 S[MF][4];
#pragma unroll
  for (int i = 0; i < MF; ++i)
#pragma unroll
    for (int j = 0; j < 4; ++j) S[i][j] = (f32x4){0.f, 0.f, 0.f, 0.f};

  float gnv[2];
  const float dsk = (MODE == 1) ? p.ssm_d[h] : 0.f;
#pragma unroll
  for (int x = 0; x < 2; ++x) {
    const int e = 16 * (fe0 + x) + l15;
    gnv[x] = (MODE == 0) ? p.ret_head_norm[h * 512 + s * 64 + e] : p.ssm_gate_norm[h * 64 + e];
  }

  PF_ISSUE(0, row0)
  if (NSET == 2) PF_ISSUE(1, row0 + 64)

  for (int c2 = 0; c2 < 32; c2 += 2) {
#pragma unroll
   for (int par2 = 0; par2 < 2; ++par2) {
    const int par = par2 & (NSET - 1);
    const int c = c2 + par2;
    const int r0 = row0 + c * 64;
#pragma unroll
    for (int i = 0; i < NQ; ++i) {
      int cc = tid + NTHR * i, rr = cc / CPR, kc = cc % CPR;
      *(u32x4*)(Qs + rr * QS + kc * 16) = rq[par][i];
      *(u32x4*)(Ks + rr * QS + kc * 16) = rk[par][i];
    }
    {
      const u32x4 rvv = rv[par];
      *(u32x4*)(Vs + vrow * VS + vkc * 16) = rvv;
      float cj, uj, cl;
      if (MODE == 0) { cj = (float)(vrow + 1) * lg; uj = 1.f; cl = 64.f * lg; } else { cj = pcj[par]; uj = puj[par]; cl = pclast[par]; }
      const float wj = uj * ex2(cl - cj);
      u32x4 o;
      o.x = pack2(bf2f((u16)(rvv.x & 0xffff)) * wj, bf2f((u16)(rvv.x >> 16)) * wj);
      o.y = pack2(bf2f((u16)(rvv.y & 0xffff)) * wj, bf2f((u16)(rvv.y >> 16)) * wj);
      o.z = pack2(bf2f((u16)(rvv.z & 0xffff)) * wj, bf2f((u16)(rvv.z >> 16)) * wj);
      o.w = pack2(bf2f((u16)(rvv.w & 0xffff)) * wj, bf2f((u16)(rvv.w >> 16)) * wj);
      *(u32x4*)(Vts + vrow * VS + vkc * 16) = o;
    }
    if (tid < 64) {
      if (MODE == 0) { cumS[tid] = (float)(tid + 1) * lg; uS[tid] = 1.f; } else { cumS[tid] = pct[par]; uS[tid] = put[par]; }
    }
#pragma unroll
    for (int mf = 0; mf < MF; ++mf)
#pragma unroll
      for (int nf = 0; nf < 4; ++nf) {
        u32x2 o;
        o.x = pack2(S[mf][nf][0], S[mf][nf][1]);
        o.y = pack2(S[mf][nf][2], S[mf][nf][3]);
        *(u32x2*)(STs + (16 * nf + l15) * QS + (dw + 16 * mf + 4 * g) * 2) = o;
      }
    u16 gzc[2][4];
#pragma unroll
    for (int x = 0; x < 2; ++x)
#pragma unroll
      for (int r = 0; r < 4; ++r) gzc[x][r] = gz[par][x][r];
    __syncthreads();
    if (c + NSET < 32) PF_ISSUE(par, r0 + 64 * NSET)
    f32x4 sc[2], cr[2];
#pragma unroll
    for (int x = 0; x < 2; ++x) { sc[x] = (f32x4){0.f, 0.f, 0.f, 0.f}; cr[x] = (f32x4){0.f, 0.f, 0.f, 0.f}; }
#pragma unroll KUNR
    for (int ks = 0; ks < KS; ++ks) {
      const bf16x8 a = *(const bf16x8*)(Qs + (16 * fi + l15) * QS + ks * 64 + g * 16);
      bf16x8 bk[2], bs[2];
#pragma unroll
      for (int x = 0; x < 2; ++x) {
        bk[x] = *(const bf16x8*)(Ks + (16 * (fe0 + x) + l15) * QS + ks * 64 + g * 16);
        bs[x] = *(const bf16x8*)(STs + (16 * (fe0 + x) + l15) * QS + ks * 64 + g * 16);
      }
#pragma unroll
      for (int x = 0; x < 2; ++x) {
        sc[x] = __builtin_amdgcn_mfma_f32_16x16x32_bf16(a, bk[x], sc[x], 0, 0, 0);
        cr[x] = __builtin_amdgcn_mfma_f32_16x16x32_bf16(a, bs[x], cr[x], 0, 0, 0);
      }
    }
    float ci[4];
#pragma unroll
    for (int r = 0; r < 4; ++r) ci[r] = cumS[16 * fi + 4 * g + r];
#pragma unroll
    for (int x = 0; x < 2; ++x) {
      const int fj = fe0 + x;
      const int j = 16 * fj + l15;
      const float cj = cumS[j], uj = uS[j];
#pragma unroll
      for (int r = 0; r < 4; ++r) {
        const int i = 16 * fi + 4 * g + r;
        float v = 0.f;
        if (j <= i) v = sc[x][r] * ex2(ci[r] - cj) * uj;
        *(u16*)(Ps + i * PS + j * 2) = f2bf(v);
      }
    }
    {
      const float atot = ex2(cumS[63]);
#pragma unroll
      for (int mf = 0; mf < MF; ++mf)
#pragma unroll
        for (int nf = 0; nf < 4; ++nf)
#pragma unroll
          for (int r = 0; r < 4; ++r) S[mf][nf][r] *= atot;
#pragma unroll
      for (int ks = 0; ks < 2; ++ks) {
        bf16x8 af[MF], bfv[4];
#pragma unroll
        for (int mf = 0; mf < MF; ++mf) af[mf] = trfrag(Ks, QS, 32 * ks, dw + 16 * mf, lane);
#pragma unroll
        for (int nf = 0; nf < 4; ++nf) bfv[nf] = trfrag(Vts, VS, 32 * ks, 16 * nf, lane);
#pragma unroll
        for (int mf = 0; mf < MF; ++mf)
#pragma unroll
          for (int nf = 0; nf < 4; ++nf)
            S[mf][nf] = __builtin_amdgcn_mfma_f32_16x16x32_bf16(af[mf], bfv[nf], S[mf][nf], 0, 0, 0);
      }
    }
    __syncthreads();
    f32x4 in[2];
#pragma unroll
    for (int x = 0; x < 2; ++x) in[x] = (f32x4){0.f, 0.f, 0.f, 0.f};
#pragma unroll
    for (int ks = 0; ks < 2; ++ks) {
      const bf16x8 a = *(const bf16x8*)(Ps + (16 * fi + l15) * PS + ks * 64 + g * 16);
      bf16x8 bv[2];
#pragma unroll
      for (int x = 0; x < 2; ++x) bv[x] = trfrag(Vs, VS, 32 * ks, 16 * (fe0 + x), lane);
#pragma unroll
      for (int x = 0; x < 2; ++x) in[x] = __builtin_amdgcn_mfma_f32_16x16x32_bf16(a, bv[x], in[x], 0, 0, 0);
    }
    {
      float ss[4] = {0.f, 0.f, 0.f, 0.f};
      u16* aout = (u16*)(p.ws + OFF_A2);
      float* parts = (float*)(p.ws + OFF_PARTS);
#pragma unroll
      for (int x = 0; x < 2; ++x) {
        const int e = 16 * (fe0 + x) + l15;
        const float gn = gnv[x];
        const int ocol = (MODE == 0) ? (h * 512 + s * 64 + e) : (h * 64 + e);
#pragma unroll
        for (int r = 0; r < 4; ++r) {
          const int i = 16 * fi + 4 * g + r;
          float o = in[x][r] + cr[x][r] * ex2(ci[r]);
          const float gv = bf2f(gzc[x][r]);
          float val;
          if (MODE == 0) {
            ss[r] += o * o;
            val = o * gn * silu(gv);
          } else {
            const float xs = bf2f(*(const u16*)(Vs + i * VS + e * 2));
            const float y = o + xs * dsk;
            const float gg = y * silu(gv);
            ss[r] += gg * gg;
            val = gg * gn;
          }
          *(u16*)((char*)aout + (size_t)r0 * 4096 + 32 * x + aoff[r]) = f2bf(val);
        }
      }
#pragma unroll
      for (int r = 0; r < 4; ++r) {
        const float v = row16_sum(ss[r]);
        if (l15 == 0) {
          const int i = 16 * fi + 4 * g + r;
          const int slot = (MODE == 0) ? (h * 16 + s * 2 + (w & 1)) : ((h >> 2) * 8 + (h & 3) * 2 + (w & 1));
          parts[(size_t)(r0 + i) * 64 + slot] = v;
        }
      }
    }
    __syncthreads();
   }
  }
#undef PF_ISSUE
  {
    float* so;
    int pitch;
    if (MODE == 0) { so = p.out + OUT_RETP + ((size_t)(b * 4 + h) * 256) * 512 + s * 64; pitch = 512; }
    else { so = p.out + OUT_SSMP + ((size_t)(b * 32 + h) * 128) * 64; pitch = 64; }
#pragma unroll
    for (int mf = 0; mf < MF; ++mf)
#pragma unroll
      for (int nf = 0; nf < 4; ++nf)
#pragma unroll
        for (int r = 0; r < 4; ++r)
          so[(size_t)(dw + 16 * mf + 4 * g + r) * pitch + 16 * nf + l15] = S[mf][nf][r];
  }
}

#define SAMPLE_DECODE(ITEM, B_, H_, S_)                              \
  const int B_ = (ITEM) >> 5;                                        \
  const int H_ = (MODE == 0) ? (((ITEM) >> 3) & 3) : ((ITEM) & 31);  \
  const int S_ = (MODE == 0) ? ((ITEM) & 7) : 0;

#define SAMPLE_ISSUE(SET, ITEM)                                                                                     \
  {                                                                                                                \
    SAMPLE_DECODE(ITEM, b_, h_, s_)                                                                                \
    const int row0_ = NPROMPT + b_ * 8;                                                                            \
    int qcol_, kcol_, vcol_;                                                                                       \
    if (MODE == 0) { qcol_ = h_ * 256; kcol_ = 1024 + h_ * 256; vcol_ = 2048 + h_ * 512 + s_ * 64; }               \
    else { qcol_ = 3072 + (h_ >> 2) * 128; kcol_ = 2048 + (h_ >> 2) * 128; vcol_ = h_ * 64; }                      \
    const float* s0_ = (MODE == 0) ? p.state_ret + ((size_t)(b_ * 4 + h_) * 256) * 512 + s_ * 64                   \
                                   : p.state_ssm + ((size_t)(b_ * 32 + h_) * 128) * 64;                            \
    _Pragma("unroll") for (int db = 0; db < NB; ++db)                                                              \
      _Pragma("unroll") for (int eb = 0; eb < 4; ++eb)                                                             \
        _Pragma("unroll") for (int r = 0; r < 4; ++r)                                                              \
          sv[SET][db][eb][r] = s0_[(size_t)(dbase + 16 * db + 4 * g + r) * pitch + 16 * eb + l15];                \
    if (tid < 2 * DK) {                                                                                            \
      const int which_ = tid / DK, c_ = tid % DK;                                                                  \
      rqk[SET] = *(const u32x4*)(src + (size_t)(row0_ + c_ / CPR) * sstride + (which_ ? kcol_ : qcol_) + (c_ % CPR) * 8); \
    }                                                                                                              \
    if (tid < 64) {                                                                                                \
      rv[SET] = *(const u32x4*)(src + (size_t)(row0_ + (tid >> 3)) * sstride + vcol_ + (tid & 7) * 8);             \
      if (MODE == 1) {                                                                                             \
        pvc[SET] = cumv[(size_t)(row0_ + (tid >> 3)) * 32 + h_];                                                   \
        pvu[SET] = dtv[(size_t)(row0_ + (tid >> 3)) * 32 + h_];                                                    \
        pvl[SET] = cumv[(size_t)(row0_ + 7) * 32 + h_];                                                            \
      }                                                                                                            \
    }                                                                                                              \
    gzs[SET] = gsrc[(size_t)(row0_ + w) * PROJ_LD + ((MODE == 0) ? (4096 + h_ * 512 + s_ * 64) : (h_ * 64)) + lane]; \
    if (MODE == 1 && tid < 16)                                                                                     \
      pcu[SET] = (tid < 8) ? cumv[(size_t)(row0_ + tid) * 32 + h_] : dtv[(size_t)(row0_ + tid - 8) * 32 + h_];     \
  }

#define SAMPLE_REMAP(I0)                                                                                   \
  ((((I0) & 4095) & ~255) |                                                                                \
   ((MODE == 0) ? ((((I0) & 7) * 4 + (((I0) & 255) >> 6)) * 8 + ((((I0) & 255) >> 3) & 7))                 \
                : ((((I0) & 7) * 8 + (((I0) & 255) >> 5)) * 4 + ((((I0) & 255) >> 3) & 3))))

template <int DK, int MODE>
__device__ void rec_sample_loop(const Params& p, unsigned char* smem, const int rep) {
  constexpr int SET_FLOATS = 8 * DK + 8 * DK + 512 + 64 + 4096 + 64 + (DK * 8 + 64 * 8) / 2;
  const int tid = (int)p.tidx, lane = tid & 63, w = tid >> 6;
  const int l15 = lane & 15, g = lane >> 4;
  constexpr int CPR = DK / 8;
  constexpr int DPW = DK / 8;
  constexpr int NB = DPW / 16;
  const int dbase = w * DPW;
  const int pitch = (MODE == 0) ? 512 : 64;
  int vz;
  asm volatile("v_mov_b32 %0, 0" : "=v"(vz));
  const u16* src = ((MODE == 0) ? (const u16*)(p.ws + OFF_PROJ) : (const u16*)(p.ws + OFF_XBCC)) + vz;
  const int sstride = (MODE == 0) ? PROJ_LD : 4096;
  const u16* gsrc = (const u16*)(p.ws + OFF_PROJ) + vz;
  const float* dtv = (const float*)(p.ws + OFF_DT) + vz;
  const float* cumv = (const float*)(p.ws + OFF_CUM) + vz;
  u16* aout = (u16*)(p.ws + OFF_A2);
  float* parts = (float*)(p.ws + OFF_PARTS);

  u32x4 rqk[2] = {(u32x4){0u, 0u, 0u, 0u}, (u32x4){0u, 0u, 0u, 0u}}, rv[2] = {(u32x4){0u, 0u, 0u, 0u}, (u32x4){0u, 0u, 0u, 0u}};
  f32x4 sv[2][NB][4];
  u16 gzs[2] = {0, 0};
  float pcu[2] = {0.f, 0.f}, pvc[2] = {0.f, 0.f}, pvu[2] = {1.f, 1.f}, pvl[2] = {0.f, 0.f};
  const int nitems = 4096 * rep;
  const int G = (int)gridDim.x;
  if ((int)blockIdx.x < nitems) SAMPLE_ISSUE(0, SAMPLE_REMAP((int)blockIdx.x) + vz)
  for (int itb = blockIdx.x; itb < nitems; itb += 2 * G) {
#pragma unroll
   for (int par = 0; par < 2; ++par) {
    const int item0 = itb + par * G;
    if (item0 < nitems) {
    if (item0 + G < nitems) SAMPLE_ISSUE(par ^ 1, SAMPLE_REMAP(item0 + G) + vz)
    __builtin_amdgcn_sched_barrier(0);
    const int item = SAMPLE_REMAP(item0) + vz;
    SAMPLE_DECODE(item, b, h, s)
    const int row0 = NPROMPT + b * 8;
    const u16 gzv = gzs[par];
    const u32x4 rqkc = rqk[par], rvc = rv[par];
    float* qS = (float*)smem + par * SET_FLOATS;
    float* kS = qS + 8 * DK;
    float* vS = kS + 8 * DK;
    float* scS = vS + 512;
    float* redS = scS + 64;
    float* cuS = redS + 4096;
    u16* kTb = (u16*)(cuS + 64);
    u16* vwTb = kTb + DK * 8;
    const float lgh = (MODE == 0) ? log2f(1.0f - exp2f(-5.0f - (float)h)) : 0.f;
    if (tid < 2 * DK) {
      const int which = tid / DK, c = tid % DK;
      float* dst = (which ? kS : qS) + (c / CPR) * DK + (c % CPR) * 8;
      dst[0] = bf2f((u16)(rqkc.x & 0xffff)); dst[1] = bf2f((u16)(rqkc.x >> 16));
      dst[2] = bf2f((u16)(rqkc.y & 0xffff)); dst[3] = bf2f((u16)(rqkc.y >> 16));
      dst[4] = bf2f((u16)(rqkc.z & 0xffff)); dst[5] = bf2f((u16)(rqkc.z >> 16));
      dst[6] = bf2f((u16)(rqkc.w & 0xffff)); dst[7] = bf2f((u16)(rqkc.w >> 16));
      if (which) {
        u16* dT = kTb + ((c % CPR) * 8) * 8 + (c / CPR);
        dT[0 * 8] = (u16)(rqkc.x & 0xffff); dT[1 * 8] = (u16)(rqkc.x >> 16);
        dT[2 * 8] = (u16)(rqkc.y & 0xffff); dT[3 * 8] = (u16)(rqkc.y >> 16);
        dT[4 * 8] = (u16)(rqkc.z & 0xffff); dT[5 * 8] = (u16)(rqkc.z >> 16);
        dT[6 * 8] = (u16)(rqkc.w & 0xffff); dT[7 * 8] = (u16)(rqkc.w >> 16);
      }
    }
    if (tid < 64) {
      const int t = tid >> 3, kc = tid & 7;
      float vv[8];
      vv[0] = bf2f((u16)(rvc.x & 0xffff)); vv[1] = bf2f((u16)(rvc.x >> 16));
      vv[2] = bf2f((u16)(rvc.y & 0xffff)); vv[3] = bf2f((u16)(rvc.y >> 16));
      vv[4] = bf2f((u16)(rvc.z & 0xffff)); vv[5] = bf2f((u16)(rvc.z >> 16));
      vv[6] = bf2f((u16)(rvc.w & 0xffff)); vv[7] = bf2f((u16)(rvc.w >> 16));
      float* dst = vS + t * 64 + kc * 8;
      const float wt = (MODE == 0) ? ex2((float)(7 - t) * lgh) : pvu[par] * ex2(pvl[par] - pvc[par]);
      u16* dT = vwTb + (kc * 8) * 8 + t;
#pragma unroll
      for (int x = 0; x < 8; ++x) { dst[x] = vv[x]; dT[x * 8] = f2bf(vv[x] * wt); }
    }
    if (MODE == 1 && tid < 16) cuS[tid] = pcu[par];
    __syncthreads();
    float cum[8], u[8];
    if (MODE == 0) {
#pragma unroll
      for (int t = 0; t < 8; ++t) { cum[t] = (float)(t + 1) * lgh; u[t] = 1.f; }
    } else {
#pragma unroll
      for (int t = 0; t < 8; ++t) { cum[t] = cuS[t]; u[t] = cuS[8 + t]; }
    }
    if (w == 0) {
      f32x4 sacc = (f32x4){0.f, 0.f, 0.f, 0.f};
#pragma unroll
      for (int ks = 0; ks < DK / 32; ++ks) {
        const float* qp = qS + (l15 & 7) * DK + ks * 32 + 8 * g;
        const float* kp = kS + (l15 & 7) * DK + ks * 32 + 8 * g;
        const float4 a0 = *(const float4*)qp, a1 = *(const float4*)(qp + 4);
        const float4 b0 = *(const float4*)kp, b1 = *(const float4*)(kp + 4);
        u32x4 qa_, kb_;
        qa_.x = pack2(a0.x, a0.y); qa_.y = pack2(a0.z, a0.w); qa_.z = pack2(a1.x, a1.y); qa_.w = pack2(a1.z, a1.w);
        kb_.x = pack2(b0.x, b0.y); kb_.y = pack2(b0.z, b0.w); kb_.z = pack2(b1.x, b1.y); kb_.w = pack2(b1.z, b1.w);
        sacc = __builtin_amdgcn_mfma_f32_16x16x32_bf16(__builtin_bit_cast(bf16x8, qa_), __builtin_bit_cast(bf16x8, kb_), sacc, 0, 0, 0);
      }
      if (g < 2 && l15 < 8) {
        float cj = 0.f, uj = 0.f;
#pragma unroll
        for (int t = 0; t < 8; ++t) if (t == l15) { cj = cum[t]; uj = u[t]; }
#pragma unroll
        for (int r = 0; r < 4; ++r) {
          const int i = 4 * g + r;
          float ci = 0.f;
#pragma unroll
          for (int t = 0; t < 8; ++t) if (t == i) ci = cum[t];
          scS[i * 8 + l15] = (l15 <= i) ? sacc[r] * ex2(ci - cj) * uj : 0.f;
        }
      }
    }
    {
      float* s1 = (MODE == 0) ? p.out + OUT_RETS + ((size_t)(b * 4 + h) * 256) * 512 + s * 64
                              : p.out + OUT_SSMS + ((size_t)(b * 32 + h) * 128) * 64;
      const float atot = ex2(cum[7]);
      const bf16x8 zero8 = (bf16x8){0, 0, 0, 0, 0, 0, 0, 0};
      bf16x8 kA[NB], vB[4], qa;
#pragma unroll
      for (int db = 0; db < NB; ++db) {
        const bf16x8 t8 = *(const bf16x8*)(kTb + (dbase + 16 * db + l15) * 8);
        kA[db] = (g == 0) ? t8 : zero8;
      }
#pragma unroll
      for (int eb = 0; eb < 4; ++eb) {
        const bf16x8 t8 = *(const bf16x8*)(vwTb + (16 * eb + l15) * 8);
        vB[eb] = (g == 0) ? t8 : zero8;
      }
      {
        const float* qrow = qS + (l15 & 7) * DK + dbase + 4 * g;
        const float4 q0 = *(const float4*)qrow;
        float4 q1 = make_float4(0.f, 0.f, 0.f, 0.f);
        if (NB == 2) q1 = *(const float4*)(qrow + 16);
        u32x4 qq;
        qq.x = pack2(q0.x, q0.y); qq.y = pack2(q0.z, q0.w); qq.z = pack2(q1.x, q1.y); qq.w = pack2(q1.z, q1.w);
        if (l15 >= 8) qq = (u32x4){0u, 0u, 0u, 0u};
        qa = __builtin_bit_cast(bf16x8, qq);
      }
#pragma unroll
      for (int eb = 0; eb < 4; ++eb) {
        u32x4 sb;
        sb.x = pack2(sv[par][0][eb][0], sv[par][0][eb][1]);
        sb.y = pack2(sv[par][0][eb][2], sv[par][0][eb][3]);
        if (NB == 2) {
          sb.z = pack2(sv[par][NB - 1][eb][0], sv[par][NB - 1][eb][1]);
          sb.w = pack2(sv[par][NB - 1][eb][2], sv[par][NB - 1][eb][3]);
        } else { sb.z = 0u; sb.w = 0u; }
        const f32x4 o3 = __builtin_amdgcn_mfma_f32_16x16x32_bf16(qa, __builtin_bit_cast(bf16x8, sb),
                                                                 (f32x4){0.f, 0.f, 0.f, 0.f}, 0, 0, 0);
        if (g < 2) {
#pragma unroll
          for (int r = 0; r < 4; ++r) redS[(w * 8 + 4 * g + r) * 64 + 16 * eb + l15] = o3[r];
        }
#pragma unroll
        for (int db = 0; db < NB; ++db) {
          f32x4 c = sv[par][db][eb];
          c[0] *= atot; c[1] *= atot; c[2] *= atot; c[3] *= atot;
          const f32x4 dn = __builtin_amdgcn_mfma_f32_16x16x32_bf16(kA[db], vB[eb], c, 0, 0, 0);
#pragma unroll
          for (int r = 0; r < 4; ++r) s1[(size_t)(dbase + 16 * db + 4 * g + r) * pitch + 16 * eb + l15] = dn[r];
        }
      }
    }
    __syncthreads();
    {
      const int i = w, e = lane;
      float o = 0.f;
#pragma unroll
      for (int ww = 0; ww < 8; ++ww) o += redS[(ww * 8 + i) * 64 + e];
      float ci = 0.f;
#pragma unroll
      for (int t = 0; t < 8; ++t) if (t == i) ci = cum[t];
      o *= ex2(ci);
#pragma unroll
      for (int jj = 0; jj < 8; ++jj) if (jj <= i) o += scS[i * 8 + jj] * vS[jj * 64 + e];
      const int row = row0 + i;
      const float gv = bf2f(gzv);
      if (MODE == 0) {
        const float ssq = wave_sum(o * o);
        const float val = o * p.ret_head_norm[h * 512 + s * 64 + e] * silu(gv);
        aout[(size_t)row * 2048 + h * 512 + s * 64 + e] = f2bf(val);
        if (lane < 2) parts[(size_t)row * 64 + h * 16 + s * 2 + lane] = lane == 0 ? ssq : 0.f;
      } else {
        const float y = o + vS[i * 64 + e] * p.ssm_d[h];
        const float gg = y * silu(gv);
        const float ssq = wave_sum(gg * gg);
        aout[(size_t)row * 2048 + h * 64 + e] = f2bf(gg * p.ssm_gate_norm[h * 64 + e]);
        if (lane < 2) parts[(size_t)row * 64 + (h >> 2) * 8 + (h & 3) * 2 + lane] = lane == 0 ? ssq : 0.f;
      }
    }
    }
   }
  }
  __syncthreads();
}

template <int DK, int MODE>
__device__ void phase_rec(const Params& p, unsigned char* smem, const int rep_p, const int rep_s) {
  for (int it0 = blockIdx.x; it0 < 256 * rep_p; it0 += gridDim.x) {
    const int blk = it0 & 255;
    const int item = (MODE == 0) ? (((blk & 7) * 4 + (blk >> 6)) * 8 + ((blk >> 3) & 7))
                                 : (((blk & 7) * 8 + (blk >> 5)) * 4 + ((blk >> 3) & 3));
    rec_prompt_item<DK, MODE>(p, item, smem);
  }
  rec_sample_loop<DK, MODE>(p, smem, rep_s);
}

#ifndef PHASE_MASK
#define PHASE_MASK 0x3ff
#endif
#ifndef DUP_MASK
#define DUP_MASK 0x000
#endif
#define XB_TMO      128
#define XB_XCNT(j)  (256  + 64 * (j))
#define XB_XSUB(j)  (1280 + 64 * (j))
#define XB_XGEN(j)  (2304 + 64 * (j))
#define XB_TOP      3328
#define XB_TOPGEN   3392
#define XCD_BAR_WORDS 3456
#define XB_SPIN_CAP (1u << 20)
#define LAS __attribute__((address_space(3)))
__device__ __forceinline__ unsigned xb_ld(unsigned* p) { return __hip_atomic_load(p, __ATOMIC_RELAXED, __HIP_MEMORY_SCOPE_AGENT); }
__device__ __forceinline__ unsigned xb_add(unsigned* p, unsigned v) { return __hip_atomic_fetch_add(p, v, __ATOMIC_RELAXED, __HIP_MEMORY_SCOPE_AGENT); }
__device__ __forceinline__ unsigned xb_xcc_id() { return (unsigned)__builtin_amdgcn_s_getreg((3 << 11) | 20) & 0xFu; }
#define XB_SPIN(cond, bar) do { unsigned _sp = 0; while (cond) { __builtin_amdgcn_s_sleep(1); \
    if ((++_sp & 255u) == 0u) { if (xb_ld(&(bar)[XB_TMO])) break; if (_sp > XB_SPIN_CAP) { atomicAdd(&(bar)[XB_TMO], 1u); break; } } } } while (0)
struct XcdBarrier {
  unsigned* bar; unsigned x;
  volatile LAS unsigned* st;
};
__device__ __forceinline__ XcdBarrier xcd_barrier_post(unsigned* bar, volatile LAS unsigned* st, const int tid) {
  XcdBarrier b; b.bar = bar; b.x = xb_xcc_id(); b.st = st;
  if (tid == 0) (void)xb_add(&bar[XB_XCNT(b.x)], 1u);
  return b;
}
__device__ __forceinline__ void xcd_barrier_complete(unsigned* bar, unsigned x, unsigned& nloc, unsigned& nx) {
  const unsigned G = gridDim.x * gridDim.y * gridDim.z;
  unsigned sum, cnt, mine, sp = 0u;
  for (;;) {
    sum = 0u; cnt = 0u; mine = 0u;
#pragma unroll
    for (unsigned j = 0; j < 16; ++j) { const unsigned c = xb_ld(&bar[XB_XCNT(j)]); sum += c; cnt += (c > 0u) ? 1u : 0u; mine = (j == x) ? c : mine; }
    if (sum == G) break;
    __builtin_amdgcn_s_sleep(1);
    if ((++sp & 255u) == 0u) { if (xb_ld(&bar[XB_TMO])) break; if (sp > XB_SPIN_CAP) { atomicAdd(&bar[XB_TMO], 1u); break; } }
  }
  nloc = mine > 0u ? mine : 1u; nx = cnt > 0u ? cnt : 1u;
}
__device__ __forceinline__ void xcd_barrier(const XcdBarrier& b, const int wvs) {
  int wvl_ = wvs;
  asm volatile("" : "+s"(wvl_));
  const int tid = wvl_ * 64 + (int)__builtin_amdgcn_mbcnt_hi(~0u, __builtin_amdgcn_mbcnt_lo(~0u, 0u));
  asm volatile("s_waitcnt vmcnt(0)" ::: "memory");
  __syncthreads();
  if (tid == 0) {
    unsigned* bar = b.bar;
    __builtin_amdgcn_s_waitcnt(0);
    unsigned nloc = b.st[0], nx = b.st[1];
    if (nloc == 0u) { xcd_barrier_complete(bar, b.x, nloc, nx); b.st[0] = nloc; b.st[1] = nx; }
    const unsigned old = xb_add(&bar[XB_XSUB(b.x)], 1u);
    const unsigned gen = old / nloc;
    if (old + 1u == (gen + 1u) * nloc) {
      __builtin_amdgcn_fence(__ATOMIC_RELEASE, "agent");
      asm volatile("s_waitcnt vmcnt(0)" ::: "memory");
      const unsigned og = xb_add(&bar[XB_TOP], 1u);
      const unsigned tg = og / nx;
      if (og + 1u == (tg + 1u) * nx) xb_add(&bar[XB_TOPGEN], 1u);
      else XB_SPIN(xb_ld(&bar[XB_TOPGEN]) == tg, bar);
      __builtin_amdgcn_fence(__ATOMIC_ACQUIRE, "agent");
      xb_add(&bar[XB_XGEN(b.x)], 1u);
      asm volatile("s_waitcnt vmcnt(0)" ::: "memory");
    } else {
      XB_SPIN(xb_ld(&bar[XB_XGEN(b.x)]) == gen, bar);
      __builtin_amdgcn_fence(__ATOMIC_ACQUIRE, "agent");
      asm volatile("s_waitcnt vmcnt(0)" ::: "memory");
    }
  }
  __syncthreads();
}

template <typename T>
__device__ __forceinline__ T* as_global(T* q) {
  return (T*)(__attribute__((address_space(1))) T*)q;
}

template <int PH>
__device__ __forceinline__ void run_phase(Params p, unsigned char* smem, const int wvs) {
  {
    long long z_ = 0;
    asm volatile("" : "+s"(z_));
    p.ws += z_; p.out += z_;
  }
  {
    int wvl_ = wvs;
    asm volatile("" : "+s"(wvl_));
    p.tidx = wvl_ * 64 + (int)__builtin_amdgcn_mbcnt_hi(~0u, __builtin_amdgcn_mbcnt_lo(~0u, 0u));
    p.wv = wvl_;
  }
  const int rep = 1 + (int)((p.dup >> PH) & 1);
  if (PH == 0) phase_prep(p, smem, rep);
  if (PH == 1) {
    gemm8_phase<0>(p, (const u16*)(p.ws + OFF_H), (const u16*)(p.ws + OFF_WT0), 1024, 24, smem, rep);
    __syncthreads();
    transpose_later_weights(p, smem, (68 * 24) % (int)gridDim.x);
  }
  if (PH == 2) phase_rec<256, 0>(p, smem, rep, 1 + (int)((p.dup >> (PH + 16)) & 1));
  if (PH == 3)
  {
    gemm_phase<1, 4>(p, (const u16*)(p.ws + OFF_A2), (const u16*)(p.ws + OFF_WT1), 2048, 8, nullptr,
                     (float*)(p.ws + OFF_X1), smem, rep, 64);
    __syncthreads();
    gemm_sample_rows<4>(p, (const u16*)(p.ws + OFF_A2), (const u16*)(p.ws + OFF_WT1), nullptr, (float*)(p.ws + OFF_X1), smem, rep);
  }
  if (PH == 4) phase_norm<0>(p, (const float*)(p.ws + OFF_X1), p.ssm_norm, rep);
  if (PH == 5) {
    gemm8_phase<2>(p, (const u16*)(p.ws + OFF_H), (const u16*)(p.ws + OFF_WT2), 1024, 24, smem, rep);
    __syncthreads();
    gemm_phase<2, 0>(p, (const u16*)(p.ws + OFF_H), (const u16*)(p.ws + OFF_WT2), 1024, 1, nullptr, nullptr, smem, 1, 68, 48, true);
  }
  if (PH == 6) phase_conv(p, smem, rep);
  if (PH == 7) phase_rec<128, 1>(p, smem, rep, 1 + (int)((p.dup >> (PH + 16)) & 1));
  if (PH == 8)
  {
    gemm_phase<1, 8>(p, (const u16*)(p.ws + OFF_A2), (const u16*)(p.ws + OFF_WT3), 2048, 8,
                     (const float*)(p.ws + OFF_X1), (float*)(p.ws + OFF_X2), smem, rep, 64);
    __syncthreads();
    gemm_sample_rows<8>(p, (const u16*)(p.ws + OFF_A2), (const u16*)(p.ws + OFF_WT3), (const float*)(p.ws + OFF_X1),
                        (float*)(p.ws + OFF_X2), smem, rep);
  }
  if (PH == 9) phase_norm<1>(p, (const float*)(p.ws + OFF_X2), p.final_norm, rep);
}

#define RUN_PHASE(k)                                   \
  if ((PHASE_MASK >> k) & 1) {                         \
    if (lo <= k && k <= hi) {                          \
      run_phase<k>(p, smem, wvs);                      \
      if (k < hi) { xcd_barrier(xb, wvs); if ((p.dup >> 30) & 1) { xcd_barrier(xb, wvs); xcd_barrier(xb, wvs); } } \
    }                                                  \
  }

__global__ void __launch_bounds__(NTHR) fwd_megakernel(Params p) {
  __shared__ __attribute__((aligned(16))) unsigned char smem[LDS_BYTES];
  cg::grid_group grid = cg::this_grid();
  const int lo = (int)p.phase_lo, hi = (int)p.phase_hi;
  if (lo > 1000) grid.sync();
  volatile LAS unsigned* xst = (volatile LAS unsigned*)(smem + LDS_BYTES - 16);
  const int wvs = __builtin_amdgcn_readfirstlane((int)(threadIdx.x >> 6));
  if (threadIdx.x == 0) { xst[0] = 0u; xst[1] = 0u; }
  __syncthreads();
  const XcdBarrier xb = xcd_barrier_post((unsigned*)(p.ws + OFF_BAR), xst, (int)threadIdx.x);
  RUN_PHASE(0)
  RUN_PHASE(1)
  RUN_PHASE(2)
  RUN_PHASE(3)
  RUN_PHASE(4)
  RUN_PHASE(5)
  RUN_PHASE(6)
  RUN_PHASE(7)
  RUN_PHASE(8)
  RUN_PHASE(9)
}

#ifndef ONE_LAUNCH
#define ONE_LAUNCH 1
#endif

extern "C" void kernel_launch(void* const* d_in, const int* in_sizes, int n_in, void* d_out, int out_size, void* d_ws,
                              size_t ws_size, hipStream_t stream) {
  static int grid_blocks = 0;
  if (!grid_blocks) {
    int dev = 0, cus = 0, per_cu = 0;
    hipGetDevice(&dev);
    hipDeviceGetAttribute(&cus, hipDeviceAttributeMultiprocessorCount, dev);
    hipOccupancyMaxActiveBlocksPerMultiprocessor(&per_cu, fwd_megakernel, NTHR, 0);
    if (per_cu < 1) per_cu = 1;
    if (per_cu > 1) per_cu = 1;
    grid_blocks = cus * per_cu;
  }
  Params p{};
  const float** pf = (const float**)&p;
  for (int i = 0; i < 19; ++i) pf[i] = (const float*)d_in[i];
  p.out = (float*)d_out;
  p.ws = (unsigned char*)d_ws;
#if ONE_LAUNCH
  hipMemsetAsync((unsigned char*)d_ws + OFF_BAR, 0, XCD_BAR_WORDS * 4, stream);
  p.phase_lo = 0; p.phase_hi = 9; p.dup = DUP_MASK;
  void* args[] = {&p};
  hipError_t e = hipLaunchCooperativeKernel((void*)fwd_megakernel, dim3(grid_blocks), dim3(NTHR), args, 0, stream);
  if (e != hipSuccess) fprintf(stderr, "cooperative launch failed: %s (grid %d)\n", hipGetErrorString(e), grid_blocks);
#else
  for (int ph = 0; ph <= 9; ++ph) {
    p.phase_lo = ph; p.phase_hi = ph;
    void* args[] = {&p};
    hipLaunchCooperativeKernel((void*)fwd_megakernel, dim3(grid_blocks), dim3(NTHR), args, 0, stream);
  }
#endif
}
```

```cpp
#include <hip/hip_runtime.h>
#include <hip/hip_cooperative_groups.h>
#include <stdint.h>
#include <stdio.h>
namespace cg = cooperative_groups;

typedef __attribute__((ext_vector_type(8))) short bf16x8;
typedef __attribute__((ext_vector_type(4))) short s16x4;
typedef __attribute__((ext_vector_type(4))) float f32x4;
typedef unsigned short u16;
typedef __attribute__((ext_vector_type(4))) unsigned int u32x4;
typedef __attribute__((ext_vector_type(2))) unsigned int u32x2;

#define NTHR 512
#define T_TOK 17408
#define NPROMPT 16384
#define LDS_BYTES 143360
#define PROJ_LD 6208

constexpr size_t OFF_WT0 = 0;
constexpr size_t OFF_WT1 = OFF_WT0 + (size_t)6144 * 1024 * 2;
constexpr size_t OFF_WT2 = OFF_WT1 + (size_t)1024 * 2048 * 2;
constexpr size_t OFF_WT3 = OFF_WT2 + (size_t)6272 * 1024 * 2;
constexpr size_t OFF_ROPE = OFF_WT3 + (size_t)1024 * 2048 * 2;
constexpr size_t OFF_H = OFF_ROPE + (size_t)2056 * 128 * 8;
constexpr size_t OFF_PROJ = OFF_H + (size_t)T_TOK * 1024 * 2;
constexpr size_t OFF_A2 = OFF_PROJ + (size_t)T_TOK * PROJ_LD * 2;
constexpr size_t OFF_PARTS = OFF_A2 + (size_t)T_TOK * 2048 * 2;
constexpr size_t OFF_X1 = OFF_PARTS + (size_t)T_TOK * 64 * 4;
constexpr size_t OFF_X2 = OFF_X1 + (size_t)T_TOK * 1024 * 4;
constexpr size_t OFF_XBCC = OFF_X2 + (size_t)T_TOK * 1024 * 4;
constexpr size_t OFF_DTRAW = OFF_XBCC + (size_t)T_TOK * 4096 * 2;
constexpr size_t OFF_DT = OFF_DTRAW + (size_t)T_TOK * 32 * 4;
constexpr size_t OFF_CUM = OFF_DT + (size_t)T_TOK * 32 * 4;
constexpr size_t OFF_BAR = OFF_CUM + (size_t)T_TOK * 32 * 4;

constexpr size_t OUT_Y = 0;
constexpr size_t OUT_RETP = 17825792;
constexpr size_t OUT_RETS = 22020096;
constexpr size_t OUT_SSMP = 89128960;
constexpr size_t OUT_SSMS = 91226112;
constexpr size_t OUT_CONVP = 124780544;
constexpr size_t OUT_CONVS = 124878848;

struct Params {
  const float *x_prompt, *x_sample, *state_ret, *state_ssm, *state_conv, *ret_norm, *ret_w_in, *ret_head_norm,
      *ret_w_out, *ssm_norm, *ssm_w_in, *ssm_conv_w, *ssm_conv_b, *ssm_dt_bias, *ssm_a_log, *ssm_d, *ssm_gate_norm,
      *ssm_w_out, *final_norm;
  float* out;
  unsigned char* ws;
  long long phase_lo, phase_hi, dup, tidx, wv;
};

typedef __bf16 bf16x2_t __attribute__((ext_vector_type(2)));
typedef float f32x2_t __attribute__((ext_vector_type(2)));
__device__ __forceinline__ u16 f2bf(float f) {
  __bf16 r = (__bf16)f;
  return __builtin_bit_cast(u16, r);
}
__device__ __forceinline__ float bf2f(u16 h) { return __uint_as_float(((uint32_t)h) << 16); }
__device__ __forceinline__ uint32_t pack2(float a, float b) {
  f32x2_t v = {a, b};
  bf16x2_t r = __builtin_convertvector(v, bf16x2_t);
  return __builtin_bit_cast(uint32_t, r);
}
__device__ __forceinline__ float ex2(float x) { return __builtin_amdgcn_exp2f(x); }
__device__ __forceinline__ float silu(float x) { return x * __builtin_amdgcn_rcpf(1.0f + __expf(-x)); }
__device__ __forceinline__ float row16_sum(float v) {
  v += __builtin_bit_cast(float, __builtin_amdgcn_update_dpp(0, __builtin_bit_cast(int, v), 0xB1, 0xF, 0xF, true));
  v += __builtin_bit_cast(float, __builtin_amdgcn_update_dpp(0, __builtin_bit_cast(int, v), 0x4E, 0xF, 0xF, true));
  v += __builtin_bit_cast(float, __builtin_amdgcn_update_dpp(0, __builtin_bit_cast(int, v), 0x124, 0xF, 0xF, true));
  v += __builtin_bit_cast(float, __builtin_amdgcn_update_dpp(0, __builtin_bit_cast(int, v), 0x128, 0xF, 0xF, true));
  return v;
}
__device__ __forceinline__ float wave_sum(float v) {
#pragma unroll
  for (int o = 32; o > 0; o >>= 1) v += __shfl_xor(v, o);
  return v;
}
__device__ __forceinline__ const float* xrow(const Params& p, int r) {
  return r < NPROMPT ? p.x_prompt + (size_t)r * 1024 : p.x_sample + (size_t)(r - NPROMPT) * 1024;
}
__device__ __forceinline__ s16x4 trread(const unsigned char* ptr) {
  return __builtin_amdgcn_ds_read_tr16_b64_v4i16((s16x4 __attribute__((address_space(3)))*)ptr);
}
__device__ __forceinline__ bf16x8 cat8(s16x4 a, s16x4 b) {
  bf16x8 r;
  r[0] = a[0]; r[1] = a[1]; r[2] = a[2]; r[3] = a[3];
  r[4] = b[0]; r[5] = b[1]; r[6] = b[2]; r[7] = b[3];
  return r;
}
__device__ __forceinline__ bf16x8 trfrag(const unsigned char* img, int rs, int kbase, int nbase, int lane) {
  const int g = lane >> 4, q = (lane & 15) >> 2, pp = lane & 3;
  const unsigned char* a = img + (kbase + 8 * g + q) * rs + (nbase + 4 * pp) * 2;
  s16x4 t0 = trread(a);
  s16x4 t1 = trread(a + 4 * rs);
  return cat8(t0, t1);
}

__device__ __forceinline__ int colmap_retin(int p) {
  if (p < 2048) {
    int hb = p & ~255, pp = p & 255;
    int gi = pp >> 5, half = (pp >> 4) & 1, c = pp & 15;
    return hb + half * 128 + gi * 16 + c;
  }
  return p;
}

__device__ void transpose_tile(const float* __restrict__ W, u16* __restrict__ Wt, int K, int N, int mode, int nt, int kt,
                               unsigned char* smem, const int tid) {
  float* tile = (float*)smem;
#pragma unroll
  for (int i = 0; i < 8; ++i) {
    int idx = tid + NTHR * i;
    int kk = idx >> 6, nn = idx & 63;
    int n = nt * 64 + nn;
    int src = (mode == 1) ? colmap_retin(n) : n;
    float v = 0.f;
    if (src < N) v = W[(size_t)(kt * 64 + kk) * N + src];
    tile[kk * 65 + nn] = v;
  }
  __syncthreads();
  {
    int n = tid >> 3, kc = tid & 7;
    float v[8];
#pragma unroll
    for (int j = 0; j < 8; ++j) v[j] = tile[(kc * 8 + j) * 65 + n];
    u32x4 o;
    o.x = pack2(v[0], v[1]); o.y = pack2(v[2], v[3]); o.z = pack2(v[4], v[5]); o.w = pack2(v[6], v[7]);
    *(u32x4*)(Wt + (size_t)(nt * 64 + n) * K + kt * 64 + kc * 8) = o;
  }
  __syncthreads();
}

__device__ void phase_prep(const Params& p, unsigned char* smem, const int rep) {
  const int tid = (int)p.tidx;
  for (int rr = 0; rr < rep; ++rr) {
  u16* Wt0 = (u16*)(p.ws + OFF_WT0);
  for (int t = blockIdx.x; t < 1536; t += gridDim.x)
    transpose_tile(p.ret_w_in, Wt0, 1024, 6144, 1, t >> 4, t & 15, smem, tid);
  float2* rope = (float2*)(p.ws + OFF_ROPE);
  const int gtid = blockIdx.x * NTHR + tid, gn = gridDim.x * NTHR;
  for (int idx = gtid; idx < 2056 * 128; idx += gn) {
    int pi = idx >> 7, i = idx & 127;
    int pos = pi < 2048 ? pi : 16384 + (pi - 2048);
    float freq = (float)exp2(-(double)i * (13.287712379549449 / 128.0));
    float ang = (float)pos * freq;
    float sn, cs;
    sincosf(ang, &sn, &cs);
    rope[idx] = make_float2(cs, sn);
  }
  u16* H = (u16*)(p.ws + OFF_H);
  const int lane = tid & 63, w = (int)p.wv;
  for (int row = blockIdx.x * 8 + w; row < T_TOK; row += gridDim.x * 8) {
    const float* xr = xrow(p, row);
    float4 v[4];
    float ss = 0.f;
#pragma unroll
    for (int i = 0; i < 4; ++i) {
      v[i] = *(const float4*)(xr + i * 256 + lane * 4);
      ss += v[i].x * v[i].x + v[i].y * v[i].y + v[i].z * v[i].z + v[i].w * v[i].w;
    }
    ss = wave_sum(ss);
    float rstd = rsqrtf(ss * (1.0f / 1024.0f) + 1e-6f);
#pragma unroll
    for (int i = 0; i < 4; ++i) {
      float4 gg = *(const float4*)(p.ret_norm + i * 256 + lane * 4);
      u32x2 o;
      o.x = pack2(v[i].x * rstd * gg.x, v[i].y * rstd * gg.y);
      o.y = pack2(v[i].z * rstd * gg.z, v[i].w * rstd * gg.w);
      *(u32x2*)(H + (size_t)row * 1024 + i * 256 + lane * 4) = o;
    }
  }
  }
}

__device__ void transpose_later_weights(const Params& p, unsigned char* smem, const int first_blk) {
  const int tid = (int)p.tidx;
  u16* Wt1 = (u16*)(p.ws + OFF_WT1);
  u16* Wt2 = (u16*)(p.ws + OFF_WT2);
  u16* Wt3 = (u16*)(p.ws + OFF_WT3);
  const int n1 = 512, n2 = 1568, n3 = 512;
  if ((int)blockIdx.x < first_blk) return;
  const int nb = (int)gridDim.x - first_blk;
  for (int t = (int)blockIdx.x - first_blk; t < n1 + n2 + n3; t += nb) {
    if (t < n1) {
      transpose_tile(p.ret_w_out, Wt1, 2048, 1024, 0, t >> 5, t & 31, smem, tid);
    } else if (t < n1 + n2) {
      int u = t - n1;
      transpose_tile(p.ssm_w_in, Wt2, 1024, 6176, 0, u >> 4, u & 15, smem, tid);
    } else {
      int u = t - n1 - n2;
      transpose_tile(p.ssm_w_out, Wt3, 2048, 1024, 0, u >> 5, u & 31, smem, tid);
    }
  }
}

template <int MODE>
__device__ void phase_norm(const Params& p, const float* __restrict__ X, const float* __restrict__ gain, const int rep) {
  const int tid = (int)p.tidx, lane = tid & 63, w = (int)p.wv;
  u16* H = (u16*)(p.ws + OFF_H);
  for (int row0 = blockIdx.x * 8 + w; row0 < T_TOK * rep; row0 += gridDim.x * 8) {
    const int row = row0 % T_TOK;
    const float* xr = X + (size_t)row * 1024;
    float4 v[4];
    float ss = 0.f;
#pragma unroll
    for (int i = 0; i < 4; ++i) {
      v[i] = *(const float4*)(xr + i * 256 + lane * 4);
      ss += v[i].x * v[i].x + v[i].y * v[i].y + v[i].z * v[i].z + v[i].w * v[i].w;
    }
    ss = wave_sum(ss);
    float rstd = rsqrtf(ss * (1.0f / 1024.0f) + 1e-6f);
#pragma unroll
    for (int i = 0; i < 4; ++i) {
      float4 gg = *(const float4*)(gain + i * 256 + lane * 4);
      if (MODE == 0) {
        u32x2 o;
        o.x = pack2(v[i].x * rstd * gg.x, v[i].y * rstd * gg.y);
        o.y = pack2(v[i].z * rstd * gg.z, v[i].w * rstd * gg.w);
        *(u32x2*)(H + (size_t)row * 1024 + i * 256 + lane * 4) = o;
      } else {
        float4 o = make_float4(v[i].x * rstd * gg.x, v[i].y * rstd * gg.y, v[i].z * rstd * gg.z, v[i].w * rstd * gg.w);
        *(float4*)(p.out + OUT_Y + (size_t)row * 1024 + i * 256 + lane * 4) = o;
      }
    }
  }
}

template <int EPI, int NH>
__device__ void gemm_phase(const Params& p, const u16* __restrict__ A, const u16* __restrict__ Bt, const int K, const int NT,
                           const float* __restrict__ resid, float* __restrict__ outf, unsigned char* smem, const int rep,
                           const int mtiles, const int nt0 = 0, const bool rev = false) {
  constexpr int BM = 256, BN = 128, BK = 64, LR = 144;
  constexpr int BUFB = (BM + BN) * LR;
  float* rstdS = (float*)(smem + 2 * BUFB);
  const int tid = (int)p.tidx, lane = tid & 63, w = (int)p.wv;
  const int wm = w >> 1, wn = w & 1, l15 = lane & 15, g = lane >> 4;
  const int KT = K / BK;
  const int ntiles = mtiles * NT;
  const float* parts = (const float*)(p.ws + OFF_PARTS);
  const int srow = tid >> 3, skc = tid & 7;

  for (int tile0 = rev ? (int)(gridDim.x - 1 - blockIdx.x) : (int)blockIdx.x; tile0 < ntiles * rep; tile0 += gridDim.x) {
    const int tile = tile0 % ntiles;
    int mt = tile / NT, nt = tile - mt * NT + nt0;
    if (EPI == 1 && NT == 8 && mtiles == 64 && gridDim.x == 256) {
      const int blk = tile & 255, rnd = tile >> 8;
      mt = rnd * 32 + (blk & 7) * 4 + (blk >> 6);
      nt = (blk >> 3) & 7;
    }
    const int m0 = mt * BM, n0 = nt * BN;
    const bool skip_mma = (EPI == 2) && (n0 >= 6144) && (wn == 1);
    u32x4 ra[2][4], rb[2][2];
    const u16* ap = A + (size_t)(m0 + srow) * K + skc * 8;
    const u16* bp = Bt + (size_t)(n0 + srow) * K + skc * 8;
#pragma unroll
    for (int i = 0; i < 4; ++i) ra[0][i] = *(const u32x4*)(ap + (size_t)(64 * i) * K);
#pragma unroll
    for (int i = 0; i < 2; ++i) rb[0][i] = *(const u32x4*)(bp + (size_t)(64 * i) * K);
#pragma unroll
    for (int i = 0; i < 4; ++i) ra[1][i] = *(const u32x4*)(ap + (size_t)(64 * i) * K + BK);
#pragma unroll
    for (int i = 0; i < 2; ++i) rb[1][i] = *(const u32x4*)(bp + (size_t)(64 * i) * K + BK);
    if (NH > 0) {
      for (int idx = tid; idx < BM * NH; idx += NTHR) {
        int row = idx / NH, h = idx % NH;
        const float* pp = parts + (size_t)(m0 + row) * 64 + h * (64 / NH);
        float s = 0.f;
#pragma unroll
        for (int q = 0; q < 64 / NH; ++q) s += pp[q];
        rstdS[idx] = rsqrtf(s / (float)(K / NH) + 1e-6f);
      }
    }
    {
      unsigned char* base = smem;
#pragma unroll
      for (int i = 0; i < 4; ++i) *(u32x4*)(base + (srow + 64 * i) * LR + skc * 16) = ra[0][i];
#pragma unroll
      for (int i = 0; i < 2; ++i) *(u32x4*)(base + BM * LR + (srow + 64 * i) * LR + skc * 16) = rb[0][i];
    }
    __syncthreads();

    f32x4 acc[4][4];
    f32x4 accT[4][4];
#pragma unroll
    for (int i = 0; i < 4; ++i)
#pragma unroll
      for (int j = 0; j < 4; ++j) {
        acc[i][j] = (f32x4){0.f, 0.f, 0.f, 0.f};
        accT[i][j] = (f32x4){0.f, 0.f, 0.f, 0.f};
      }

    for (int kt2 = 0; kt2 < KT; kt2 += 2) {
#pragma unroll
     for (int par = 0; par < 2; ++par) {
      const int kt = kt2 + par;
      if (kt + 2 < KT) {
#pragma unroll
        for (int i = 0; i < 4; ++i) ra[par][i] = *(const u32x4*)(ap + (size_t)(64 * i) * K + (kt + 2) * BK);
#pragma unroll
        for (int i = 0; i < 2; ++i) rb[par][i] = *(const u32x4*)(bp + (size_t)(64 * i) * K + (kt + 2) * BK);
      }
      const unsigned char* abase = smem + par * BUFB + (wm * 64 + l15) * LR + g * 16;
      const unsigned char* bbase = smem + par * BUFB + BM * LR + (wn * 64 + l15) * LR + g * 16;
      if (!skip_mma)
#pragma unroll
      for (int ks = 0; ks < 2; ++ks) {
        bf16x8 af[4], bfr[2];
#pragma unroll
        for (int mf = 0; mf < 4; ++mf) af[mf] = *(const bf16x8*)(abase + mf * 16 * LR + ks * 64);
#pragma unroll
        for (int nh = 0; nh < 2; ++nh) {
#pragma unroll
          for (int n2 = 0; n2 < 2; ++n2) bfr[n2] = *(const bf16x8*)(bbase + (nh * 2 + n2) * 16 * LR + ks * 64);
#pragma unroll
          for (int mf = 0; mf < 4; ++mf)
#pragma unroll
            for (int n2 = 0; n2 < 2; ++n2)
              acc[mf][nh * 2 + n2] = __builtin_amdgcn_mfma_f32_16x16x32_bf16(af[mf], bfr[n2], acc[mf][nh * 2 + n2], 0, 0, 0);
        }
      }
      if (NH > 0) {
        const int per = KT / NH;
        if (((kt + 1) % per) == 0) {
          const int h = (kt + 1) / per - 1;
#pragma unroll
          for (int mf = 0; mf < 4; ++mf)
#pragma unroll
            for (int r = 0; r < 4; ++r) {
              float s = rstdS[(wm * 64 + mf * 16 + 4 * g + r) * NH + h];
#pragma unroll
              for (int nf = 0; nf < 4; ++nf) {
                accT[mf][nf][r] += s * acc[mf][nf][r];
                acc[mf][nf][r] = 0.f;
              }
            }
        }
      }
      if (kt + 1 < KT) {
        unsigned char* base = smem + (par ^ 1) * BUFB;
#pragma unroll
        for (int i = 0; i < 4; ++i) *(u32x4*)(base + (srow + 64 * i) * LR + skc * 16) = ra[par ^ 1][i];
#pragma unroll
        for (int i = 0; i < 2; ++i) *(u32x4*)(base + BM * LR + (srow + 64 * i) * LR + skc * 16) = rb[par ^ 1][i];
      }
      __syncthreads();
     }
    }

#pragma unroll
    for (int mf = 0; mf < 4; ++mf) {
      __builtin_amdgcn_sched_barrier(0);
      float rvv[4][4];
      if (EPI == 1) {
#pragma unroll
        for (int r = 0; r < 4; ++r) {
          const int row = m0 + wm * 64 + mf * 16 + 4 * g + r;
#pragma unroll
          for (int nf = 0; nf < 4; ++nf) {
            const int col = n0 + wn * 64 + nf * 16 + l15;
            rvv[r][nf] = resid ? resid[(size_t)row * 1024 + col] : xrow(p, row)[col];
          }
        }
      }
#pragma unroll
      for (int r = 0; r < 4; ++r) {
        const int row = m0 + wm * 64 + mf * 16 + 4 * g + r;
        if (EPI == 0) {
          u16* proj = (u16*)(p.ws + OFF_PROJ) + (size_t)row * PROJ_LD;
          if (n0 < 2048) {
            const float2* rope = (const float2*)(p.ws + OFF_ROPE);
            const int pi = row < NPROMPT ? (row & 2047) : 2048 + ((row - NPROMPT) & 7);
#pragma unroll
            for (int np = 0; np < 2; ++np) {
              const int pc = n0 + wn * 64 + np * 32;
              const int i = ((pc & 255) >> 5) * 16 + l15;
              const float2 cs = rope[pi * 128 + i];
              const float x1 = acc[mf][2 * np][r], x2 = acc[mf][2 * np + 1][r];
              float y1 = x1 * cs.x - x2 * cs.y, y2 = x1 * cs.y + x2 * cs.x;
              if (pc >= 1024) { y1 *= 0.0625f; y2 *= 0.0625f; }
              const int f1 = (pc & ~255) + i;
              proj[f1] = f2bf(y1);
              proj[f1 + 128] = f2bf(y2);
            }
          } else {
#pragma unroll
            for (int nf = 0; nf < 4; ++nf) proj[n0 + wn * 64 + nf * 16 + l15] = f2bf(acc[mf][nf][r]);
          }
        } else if (EPI == 1) {
#pragma unroll
          for (int nf = 0; nf < 4; ++nf) {
            const int col = n0 + wn * 64 + nf * 16 + l15;
            const float a = (NH > 0) ? accT[mf][nf][r] : acc[mf][nf][r];
            outf[(size_t)row * 1024 + col] = rvv[r][nf] + a;
          }
        } else {
          u16* proj = (u16*)(p.ws + OFF_PROJ) + (size_t)row * PROJ_LD;
          float* dtraw = (float*)(p.ws + OFF_DTRAW) + (size_t)row * 32;
          float* cvo = nullptr;
          if (row < NPROMPT) {
            const int t = row & 2047;
            if (t >= 2045) cvo = p.out + OUT_CONVP + ((size_t)(row >> 11) * 3 + (t - 2045)) * 4096;
          } else {
            const int rs = row - NPROMPT, t = rs & 7;
            if (t >= 5) cvo = p.out + OUT_CONVS + ((size_t)(rs >> 3) * 3 + (t - 5)) * 4096;
          }
#pragma unroll
          for (int nf = 0; nf < 4; ++nf) {
            const int col = n0 + wn * 64 + nf * 16 + l15;
            const float a = acc[mf][nf][r];
            if (col < 6144) {
              proj[col] = f2bf(a);
              if (col >= 2048 && cvo) cvo[col - 2048] = a;
            } else if (col < 6176) {
              dtraw[col - 6144] = a;
            }
          }
        }
      }
    }
  }
}


template <int NH>
__device__ void gemm_sample_rows(const Params& p, const u16* __restrict__ A, const u16* __restrict__ Bt,
                                 const float* __restrict__ resid, float* __restrict__ outf, unsigned char* smem, const int rep) {
  constexpr int K = 2048, RS = 65;
  float* red = (float*)smem;
  float* rstdS = red + 8 * 64 * RS;
  const int tid = (int)p.tidx, lane = tid & 63, w = (int)p.wv, l15 = lane & 15, g = lane >> 4;
  const float* parts = (const float*)(p.ws + OFF_PARTS);
  for (int item0 = blockIdx.x; item0 < 256 * rep; item0 += gridDim.x) {
    const int item = item0 & 255;
    const int m0 = NPROMPT + (item >> 4) * 64, n0 = (item & 15) * 64;
    for (int idx = tid; idx < 64 * NH; idx += NTHR) {
      const int row = idx / NH, h = idx % NH;
      const float* pp = parts + (size_t)(m0 + row) * 64 + h * (64 / NH);
      float sm = 0.f;
#pragma unroll
      for (int q = 0; q < 64 / NH; ++q) sm += pp[q];
      rstdS[idx] = rsqrtf(sm / (float)(K / NH) + 1e-6f);
    }
    f32x4 acc[4][4];
#pragma unroll
    for (int i = 0; i < 4; ++i)
#pragma unroll
      for (int j = 0; j < 4; ++j) acc[i][j] = (f32x4){0.f, 0.f, 0.f, 0.f};
    const u16* ap = A + (size_t)(m0 + l15) * K + w * 256 + 8 * g;
    const u16* bp = Bt + (size_t)(n0 + l15) * K + w * 256 + 8 * g;
#pragma unroll 2
    for (int ks = 0; ks < 8; ++ks) {
      bf16x8 af[4], bfr[4];
#pragma unroll
      for (int mf = 0; mf < 4; ++mf) af[mf] = *(const bf16x8*)(ap + (size_t)(mf * 16) * K + ks * 32);
#pragma unroll
      for (int nf = 0; nf < 4; ++nf) bfr[nf] = *(const bf16x8*)(bp + (size_t)(nf * 16) * K + ks * 32);
#pragma unroll
      for (int mf = 0; mf < 4; ++mf)
#pragma unroll
        for (int nf = 0; nf < 4; ++nf)
          acc[mf][nf] = __builtin_amdgcn_mfma_f32_16x16x32_bf16(af[mf], bfr[nf], acc[mf][nf], 0, 0, 0);
    }
    __syncthreads();
    {
      const int h = (w * 256) / (K / NH);
#pragma unroll
      for (int mf = 0; mf < 4; ++mf)
#pragma unroll
        for (int r = 0; r < 4; ++r) {
          const int row = mf * 16 + 4 * g + r;
          const float sc = rstdS[row * NH + h];
#pragma unroll
          for (int nf = 0; nf < 4; ++nf) red[(w * 64 + row) * RS + nf * 16 + l15] = acc[mf][nf][r] * sc;
        }
    }
    __syncthreads();
    {
      const int row = tid >> 3, c0 = (tid & 7) * 8;
      float o[8];
      const size_t gidx = (size_t)(m0 + row) * 1024 + n0 + c0;
      const float* rp = resid ? resid + gidx : p.x_sample + (size_t)(m0 - NPROMPT + row) * 1024 + n0 + c0;
      const float4 r0 = *(const float4*)rp, r1 = *(const float4*)(rp + 4);
      o[0] = r0.x; o[1] = r0.y; o[2] = r0.z; o[3] = r0.w; o[4] = r1.x; o[5] = r1.y; o[6] = r1.z; o[7] = r1.w;
#pragma unroll
      for (int ww = 0; ww < 8; ++ww)
#pragma unroll
        for (int j = 0; j < 8; ++j) o[j] += red[(ww * 64 + row) * RS + c0 + j];
      *(float4*)(outf + gidx) = make_float4(o[0], o[1], o[2], o[3]);
      *(float4*)(outf + gidx + 4) = make_float4(o[4], o[5], o[6], o[7]);
    }
    __syncthreads();
  }
}

__device__ __forceinline__ int lds_byte(int r, int c) {
  int st = (r >> 4) * 2 + (c >> 5), rr = r & 15, cc = c & 31, ob = rr * 64 + cc * 2;
  return st * 1024 + (ob ^ (((ob >> 9) & 1) << 5));
}
__device__ __forceinline__ void stage_rc(int b, int& R, int& C) {
  int st = b / 1024, sb = b % 1024, swz = sb ^ (((sb >> 9) & 1) << 5);
  R = (st >> 1) * 16 + swz / 64;
  C = (st & 1) * 32 + (swz % 64) / 2;
}

template <int EPI>
__device__ void gemm8_phase(const Params& p, const u16* __restrict__ A, const u16* __restrict__ Bt, const int K, const int nN,
                            unsigned char* smem, const int rep) {
  constexpr int BM8 = 256, BK8 = 64, HALF = 128, NXCD = 8, WGM = 8, HT = HALF * BK8;
  u16* shm = (u16*)smem;
#define SA(b, h) (shm + ((b) * 2 + (h)) * HT)
#define SB(b, h) (shm + (4 + (b) * 2 + (h)) * HT)
#define STAGE(P, BASE, br, kt)                                                                            \
  do {                                                                                                    \
    const int _so = ((br) * K + (kt) * BK8) * 2;                                                          \
    __builtin_amdgcn_raw_ptr_buffer_load_lds(rsrc_##BASE, (__attribute__((address_space(3))) unsigned*)((char*)(P) + (int)p.tidx * 16), 16, voff0, _so, 0, 0); \
    __builtin_amdgcn_raw_ptr_buffer_load_lds(rsrc_##BASE, (__attribute__((address_space(3))) unsigned*)((char*)(P) + (int)p.tidx * 16 + 8192), 16, voff1, _so, 0, 0); \
  } while (0)
#define LDA(dst, b, h)                                                                                    \
  for (int m = 0; m < 4; ++m)                                                                             \
    for (int k = 0; k < 2; ++k)                                                                           \
      dst[m][k] = *reinterpret_cast<const bf16x8*>((char*)SA(b, h) + lds_byte(wr * 64 + m * 16 + fr, k * 32 + fq * 8))
#define LDB(dst, b, h)                                                                                    \
  for (int n = 0; n < 2; ++n)                                                                             \
    for (int k = 0; k < 2; ++k)                                                                           \
      dst[n][k] = *reinterpret_cast<const bf16x8*>((char*)SB(b, h) + lds_byte(wc * 32 + n * 16 + fr, k * 32 + fq * 8))
#define MMA(ai, bj, At, Bx)                                                                               \
  do {                                                                                                    \
    __builtin_amdgcn_s_setprio(1);                                                                        \
    for (int m = 0; m < 4; ++m)                                                                           \
      for (int n = 0; n < 2; ++n)                                                                         \
        for (int k = 0; k < 2; ++k)                                                                       \
          acc[ai][bj][m][n] = __builtin_amdgcn_mfma_f32_16x16x32_bf16(At[m][k], Bx[n][k], acc[ai][bj][m][n], 0, 0, 0); \
    __builtin_amdgcn_s_setprio(0);                                                                        \
  } while (0)
#define WAIT_V(n) asm volatile("s_waitcnt vmcnt(" #n ")" ::: "memory")
#define WAIT_L(n) asm volatile("s_waitcnt lgkmcnt(" #n ")" ::: "memory")
#define BAR __builtin_amdgcn_s_barrier()
#define SCHED __builtin_amdgcn_sched_barrier(0)

  const int nM = T_TOK / BM8, nwg = nM * nN;
  const int wid = (int)p.wv, lane = (int)p.tidx & 63, wr = wid >> 2, wc = wid & 3, fr = lane & 15, fq = lane >> 4;
  const int nt = K / BK8;
  const __amdgpu_buffer_rsrc_t rsrc_A = __builtin_amdgcn_make_buffer_rsrc((void*)A, (short)0, T_TOK * K * 2, 0x00020000);
  const __amdgpu_buffer_rsrc_t rsrc_Bt = __builtin_amdgcn_make_buffer_rsrc((void*)Bt, (short)0, nN * 256 * K * 2, 0x00020000);
  int voff0, voff1;
  {
    int r_, c_;
    stage_rc((int)p.tidx * 16, r_, c_);
    voff0 = (r_ * K + c_) * 2;
    stage_rc((int)p.tidx * 16 + 8192, r_, c_);
    voff1 = (r_ * K + c_) * 2;
  }

  for (int tile0 = blockIdx.x; tile0 < nwg * rep; tile0 += gridDim.x) {
    const int tile = tile0 % nwg;
    int wgid = tile;
    {
      int q = nwg / NXCD, r = nwg % NXCD, xcd = wgid % NXCD, off = wgid / NXCD;
      wgid = (xcd < r ? xcd * (q + 1) : r * (q + 1) + (xcd - r) * q) + off;
    }
    const int nig = WGM * nN, gid = wgid / nig, fm = gid * WGM, gsz = min(nM - fm, WGM);
    const int pm = fm + ((wgid % nig) % gsz), pn = (wgid % nig) / gsz, brow = pm * BM8, bcol = pn * BM8;

    f32x4 acc[2][2][4][2];
#pragma unroll
    for (int a = 0; a < 2; ++a)
#pragma unroll
      for (int b = 0; b < 2; ++b)
#pragma unroll
        for (int m = 0; m < 4; ++m)
#pragma unroll
          for (int n = 0; n < 2; ++n) acc[a][b][m][n] = (f32x4){0.f, 0.f, 0.f, 0.f};
    bf16x8 At[4][2], B0[2][2], B1[2][2];

    STAGE(SB(0, 0), Bt, bcol, 0); STAGE(SA(0, 0), A, brow, 0);
    STAGE(SB(0, 1), Bt, bcol + HALF, 0); STAGE(SA(0, 1), A, brow + HALF, 0);
    if (wr == 1) BAR;
    WAIT_V(4); BAR;
    STAGE(SB(1, 0), Bt, bcol, 1); STAGE(SA(1, 0), A, brow, 1); STAGE(SB(1, 1), Bt, bcol + HALF, 1);
    WAIT_V(6); BAR;
    for (int t = 0; t < nt - 2; t += 2) {
      LDB(B0, 0, 0); SCHED; LDA(At, 0, 0); STAGE(SA(1, 1), A, brow + HALF, t + 1);
      WAIT_L(8); BAR; WAIT_L(0); MMA(0, 0, At, B0); BAR; SCHED;
      LDB(B1, 0, 1); STAGE(SB(0, 0), Bt, bcol, t + 2);
      BAR; WAIT_L(0); MMA(0, 1, At, B1); BAR;
      LDA(At, 0, 1); STAGE(SA(0, 0), A, brow, t + 2);
      BAR; WAIT_L(0); MMA(1, 0, At, B0); BAR; SCHED;
      STAGE(SB(0, 1), Bt, bcol + HALF, t + 2);
      WAIT_V(6); BAR; MMA(1, 1, At, B1); BAR;
      LDB(B0, 1, 0); SCHED; LDA(At, 1, 0); STAGE(SA(0, 1), A, brow + HALF, t + 2);
      WAIT_L(8); BAR; WAIT_L(0); MMA(0, 0, At, B0); BAR; SCHED;
      LDB(B1, 1, 1); STAGE(SB(1, 0), Bt, bcol, t + 3);
      BAR; WAIT_L(0); MMA(0, 1, At, B1); BAR;
      LDA(At, 1, 1); STAGE(SA(1, 0), A, brow, t + 3);
      BAR; WAIT_L(0); MMA(1, 0, At, B0); BAR; SCHED;
      STAGE(SB(1, 1), Bt, bcol + HALF, t + 3);
      WAIT_V(6); BAR; MMA(1, 1, At, B1); BAR;
    }
    {
      LDB(B0, 0, 0); LDA(At, 0, 0); STAGE(SA(1, 1), A, brow + HALF, nt - 1);
      BAR; WAIT_L(0); MMA(0, 0, At, B0); BAR; SCHED;
      LDB(B1, 0, 1); BAR; WAIT_L(0); MMA(0, 1, At, B1); BAR; SCHED;
      LDA(At, 0, 1); WAIT_V(4); BAR; WAIT_L(0); MMA(1, 0, At, B0); MMA(1, 1, At, B1); BAR; SCHED;
    }
    {
      LDB(B0, 1, 0); LDA(At, 1, 0); WAIT_V(2); BAR; WAIT_L(0); MMA(0, 0, At, B0); BAR; SCHED;
      LDB(B1, 1, 1); WAIT_V(0); BAR; WAIT_L(0); MMA(0, 1, At, B1); BAR; SCHED;
      LDA(At, 1, 1); BAR; WAIT_L(0); MMA(1, 0, At, B0); MMA(1, 1, At, B1); BAR; SCHED;
    }
    if (wr == 0) BAR;

    u16* projb = (u16*)(p.ws + OFF_PROJ);
#pragma unroll
    for (int ai = 0; ai < 2; ++ai)
#pragma unroll
      for (int m = 0; m < 4; ++m) {
        if (EPI == 0 && bcol < 2048) {
          const float2* rope = (const float2*)(p.ws + OFF_ROPE);
#pragma unroll
          for (int bj = 0; bj < 2; ++bj) {
            __builtin_amdgcn_sched_barrier(0);
            const int pc = bcol + bj * HALF + wc * 32;
            const int i = ((pc & 255) >> 5) * 16 + fr;
            const int f1 = (pc & ~255) + i;
            float2 csv[4];
#pragma unroll
            for (int j = 0; j < 4; ++j) {
              const int row = brow + ai * HALF + wr * 64 + m * 16 + fq * 4 + j;
              const int pi = row < NPROMPT ? (row & 2047) : 2048 + ((row - NPROMPT) & 7);
              csv[j] = rope[pi * 128 + i];
            }
#pragma unroll
            for (int j = 0; j < 4; ++j) {
              const int row = brow + ai * HALF + wr * 64 + m * 16 + fq * 4 + j;
              u16* proj = projb + (size_t)row * PROJ_LD;
              const float2 cs = csv[j];
              const float x1 = acc[ai][bj][m][0][j], x2 = acc[ai][bj][m][1][j];
              float y1 = x1 * cs.x - x2 * cs.y, y2 = x1 * cs.y + x2 * cs.x;
              if (pc >= 1024) { y1 *= 0.0625f; y2 *= 0.0625f; }
              proj[f1] = f2bf(y1);
              proj[f1 + 128] = f2bf(y2);
            }
          }
        } else {
#pragma unroll
          for (int j = 0; j < 4; ++j) {
            __builtin_amdgcn_sched_barrier(0);
            const int row = brow + ai * HALF + wr * 64 + m * 16 + fq * 4 + j;
            u16* proj = projb + (size_t)row * PROJ_LD;
            float* cvo = nullptr;
            if (EPI == 2 && bcol >= 2048) {
              if (row < NPROMPT) {
                const int t = row & 2047;
                if (t >= 2045) cvo = p.out + OUT_CONVP + ((size_t)(row >> 11) * 3 + (t - 2045)) * 4096;
              } else {
                const int rs = row - NPROMPT, t = rs & 7;
                if (t >= 5) cvo = p.out + OUT_CONVS + ((size_t)(rs >> 3) * 3 + (t - 5)) * 4096;
              }
            }
#pragma unroll
            for (int bj = 0; bj < 2; ++bj)
#pragma unroll
              for (int n = 0; n < 2; ++n) {
                const int col = bcol + bj * HALF + wc * 32 + n * 16 + fr;
                const float a = acc[ai][bj][m][n][j];
                proj[col] = f2bf(a);
                if (EPI == 2 && cvo) cvo[col - 2048] = a;
              }
          }
        }
      }
  }
#undef SA
#undef SB
#undef STAGE
#undef LDA
#undef LDB
#undef MMA
#undef WAIT_V
#undef WAIT_L
#undef BAR
#undef SCHED
}

__device__ __forceinline__ void unpack8(const u32x4 u, float* xv) {
  xv[0] = bf2f((u16)(u.x & 0xffff)); xv[1] = bf2f((u16)(u.x >> 16));
  xv[2] = bf2f((u16)(u.y & 0xffff)); xv[3] = bf2f((u16)(u.y >> 16));
  xv[4] = bf2f((u16)(u.z & 0xffff)); xv[5] = bf2f((u16)(u.z >> 16));
  xv[6] = bf2f((u16)(u.w & 0xffff)); xv[7] = bf2f((u16)(u.w >> 16));
}

__device__ void phase_conv(const Params& p, unsigned char* smem, const int rep) {
  const int tid = (int)p.tidx;
  const float* dtraw = (const float*)(p.ws + OFF_DTRAW);
  float* dtv = (float*)(p.ws + OFF_DT);
  float* cumv = (float*)(p.ws + OFF_CUM);
  {
    float* laS = (float*)smem;
    const int tok = tid >> 3, h0 = (tid & 7) * 4;
    const float4 bias = *(const float4*)(p.ssm_dt_bias + h0);
    const float4 al = *(const float4*)(p.ssm_a_log + h0);
    const float4 an = make_float4(-expf(al.x), -expf(al.y), -expf(al.z), -expf(al.w));
    for (int sc = blockIdx.x; sc < 384; sc += gridDim.x) {
      int row0, len;
      if (sc < 256) { row0 = sc * 64; len = 64; } else { row0 = NPROMPT + (sc - 256) * 8; len = 8; }
      if (tok < len) {
        const float4 x = *(const float4*)(dtraw + (size_t)(row0 + tok) * 32 + h0);
        float4 dt;
        { float v = x.x + bias.x; dt.x = v > 20.f ? v : log1pf(expf(v)); }
        { float v = x.y + bias.y; dt.y = v > 20.f ? v : log1pf(expf(v)); }
        { float v = x.z + bias.z; dt.z = v > 20.f ? v : log1pf(expf(v)); }
        { float v = x.w + bias.w; dt.w = v > 20.f ? v : log1pf(expf(v)); }
        *(float4*)(dtv + (size_t)(row0 + tok) * 32 + h0) = dt;
        *(float4*)(laS + tok * 32 + h0) = make_float4(dt.x * an.x * 1.4426950408889634f, dt.y * an.y * 1.4426950408889634f,
                                                      dt.z * an.z * 1.4426950408889634f, dt.w * an.w * 1.4426950408889634f);
      }
      __syncthreads();
      if (tok < len) {
        float4 c = make_float4(0.f, 0.f, 0.f, 0.f);
        for (int t = 0; t <= tok; ++t) {
          const float4 v = *(const float4*)(laS + t * 32 + h0);
          c.x += v.x; c.y += v.y; c.z += v.z; c.w += v.w;
        }
        *(float4*)(cumv + (size_t)(row0 + tok) * 32 + h0) = c;
      }
      __syncthreads();
    }
  }
  const u16* proj = (const u16*)(p.ws + OFF_PROJ);
  u16* xbcc = (u16*)(p.ws + OFF_XBCC);
  const int gtid = blockIdx.x * NTHR + tid;
  const int ch0 = (gtid & 511) * 8, rb = gtid >> 9;
  float wgt[4][8], bs[8];
#pragma unroll
  for (int wv = 0; wv < 4; ++wv) {
    const float4 w0 = *(const float4*)(p.ssm_conv_w + (size_t)wv * 4096 + ch0);
    const float4 w1 = *(const float4*)(p.ssm_conv_w + (size_t)wv * 4096 + ch0 + 4);
    wgt[wv][0] = w0.x; wgt[wv][1] = w0.y; wgt[wv][2] = w0.z; wgt[wv][3] = w0.w;
    wgt[wv][4] = w1.x; wgt[wv][5] = w1.y; wgt[wv][6] = w1.z; wgt[wv][7] = w1.w;
  }
  {
    const float4 b0 = *(const float4*)(p.ssm_conv_b + ch0), b1 = *(const float4*)(p.ssm_conv_b + ch0 + 4);
    bs[0] = b0.x; bs[1] = b0.y; bs[2] = b0.z; bs[3] = b0.w; bs[4] = b1.x; bs[5] = b1.y; bs[6] = b1.z; bs[7] = b1.w;
  }
  const int rows_per = T_TOK / (int)(gridDim.x * NTHR / 512);
  for (int rr = 0; rr < rep; ++rr) {
    float hm3[8], hm2[8], hm1[8];
    const int rbeg = rb * rows_per;
    u32x4 cur[4], nxt[4];
#pragma unroll
    for (int q = 0; q < 4; ++q) cur[q] = *(const u32x4*)(proj + (size_t)(rbeg + q) * PROJ_LD + 2048 + ch0);
    for (int r4 = 0; r4 < rows_per; r4 += 4) {
#pragma unroll
      for (int q = 0; q < 4; ++q) {
        nxt[q] = cur[q];
        if (r4 + 4 + q < rows_per) nxt[q] = *(const u32x4*)(proj + (size_t)(rbeg + r4 + 4 + q) * PROJ_LD + 2048 + ch0);
      }
#pragma unroll
      for (int q4 = 0; q4 < 4; ++q4) {
        const int r = r4 + q4;
        const int row = rbeg + r;
        const bool samp = row >= NPROMPT;
        const int t = samp ? ((row - NPROMPT) & 7) : (row & 2047);
        const int b = samp ? ((row - NPROMPT) >> 3) : (row >> 11);
        if (r == 0 || t == 0) {
#pragma unroll
          for (int k = 1; k <= 3; ++k) {
            float hv[8];
            if (t - k >= 0) {
              unpack8(*(const u32x4*)(proj + (size_t)(row - k) * PROJ_LD + 2048 + ch0), hv);
            } else if (samp) {
              const float* sp = p.state_conv + ((size_t)b * 3 + (t - k + 3)) * 4096 + ch0;
              const float4 s0 = *(const float4*)sp, s1 = *(const float4*)(sp + 4);
              hv[0] = s0.x; hv[1] = s0.y; hv[2] = s0.z; hv[3] = s0.w; hv[4] = s1.x; hv[5] = s1.y; hv[6] = s1.z; hv[7] = s1.w;
            } else {
#pragma unroll
              for (int q = 0; q < 8; ++q) hv[q] = 0.f;
            }
#pragma unroll
            for (int q = 0; q < 8; ++q) {
              if (k == 1) hm1[q] = hv[q];
              if (k == 2) hm2[q] = hv[q];
              if (k == 3) hm3[q] = hv[q];
            }
          }
        }
        float xc[8], o[8];
        unpack8(cur[q4], xc);
#pragma unroll
        for (int q = 0; q < 8; ++q) {
          const float a = bs[q] + hm3[q] * wgt[0][q] + hm2[q] * wgt[1][q] + hm1[q] * wgt[2][q] + xc[q] * wgt[3][q];
          o[q] = silu(a);
          hm3[q] = hm2[q]; hm2[q] = hm1[q]; hm1[q] = xc[q];
        }
        u32x4 ov;
        ov.x = pack2(o[0], o[1]); ov.y = pack2(o[2], o[3]); ov.z = pack2(o[4], o[5]); ov.w = pack2(o[6], o[7]);
        *(u32x4*)(xbcc + (size_t)row * 4096 + ch0) = ov;
      }
#pragma unroll
      for (int q = 0; q < 4; ++q) cur[q] = nxt[q];
    }
  }
}

template <int DK, int MODE>
__device__ void rec_prompt_item(const Params& p, const int item, unsigned char* smem) {
  constexpr int QS = (DK + 16) * 2;
  constexpr int VS = 160, PS = 144;
  constexpr int MF = DK / 128;
  constexpr int KS = DK / 32;
  constexpr int KUNR = 4;
  constexpr int NQ = DK / 64;
  constexpr int CPR = DK / 8;
  unsigned char* Qs = smem;
  unsigned char* Ks = Qs + 64 * QS;
  unsigned char* STs = Ks + 64 * QS;
  unsigned char* Vs = STs + 64 * QS;
  unsigned char* Vts = Vs + 64 * VS;
  unsigned char* Ps = Vts + 64 * VS;
  float* cumS = (float*)(Ps + 64 * PS);
  float* uS = cumS + 64;

  const int tid = (int)p.tidx, lane = tid & 63, w = tid >> 6;
  const int l15 = lane & 15, g = lane >> 4;
  const int b = item >> 5;
  const int h = (MODE == 0) ? ((item >> 3) & 3) : (item & 31);
  const int s = (MODE == 0) ? (item & 7) : 0;
  const int row0 = b * 2048;

  const u16* src;
  int sstride, qcol, kcol, vcol;
  if (MODE == 0) {
    src = (const u16*)(p.ws + OFF_PROJ); sstride = PROJ_LD;
    qcol = h * 256; kcol = 1024 + h * 256; vcol = 2048 + h * 512 + s * 64;
  } else {
    src = (const u16*)(p.ws + OFF_XBCC); sstride = 4096;
    qcol = 3072 + (h >> 2) * 128; kcol = 2048 + (h >> 2) * 128; vcol = h * 64;
  }
  const float* dtv = (const float*)(p.ws + OFF_DT);
  const float* cumv = (const float*)(p.ws + OFF_CUM);
  const float lg = (MODE == 0) ? log2f(1.0f - exp2f(-5.0f - (float)h)) : 0.f;

  const int vrow = tid >> 3, vkc = tid & 7;
  const int jt = tid & 63;

  constexpr int NSET = (MODE == 1) ? 2 : 1;
  u32x4 rq[2][NQ], rk[2][NQ], rv[2];
  float pcj[2] = {0.f, 0.f}, puj[2] = {1.f, 1.f}, pclast[2] = {0.f, 0.f}, pct[2] = {0.f, 0.f}, put[2] = {1.f, 1.f};
  u16 gz[2][2][4];
  const u16* gsrc = (const u16*)(p.ws + OFF_PROJ);
  const int gcol = (MODE == 0) ? (4096 + h * 512 + s * 64) : (h * 64);
  const int fi = w >> 1, fe0 = 2 * (w & 1);
  const int fis = (int)p.wv >> 1, fe0s = 2 * ((int)p.wv & 1);
  const int dw = w * (DK / 8);

  unsigned qoff[NQ], goff[4], aoff[4];
#pragma unroll
  for (int i = 0; i < NQ; ++i) {
    const int c_ = tid + NTHR * i;
    qoff[i] = (unsigned)(((c_ / CPR) * sstride + qcol + (c_ % CPR) * 8) * 2);
  }
  const unsigned voffv = (unsigned)((vrow * sstride + vcol + vkc * 8) * 2);
#pragma unroll
  for (int r = 0; r < 4; ++r) {
    goff[r] = (unsigned)(((16 * fi + 4 * g + r) * PROJ_LD + gcol + 16 * fe0 + l15) * 2);
    aoff[r] = (unsigned)(((16 * fi + 4 * g + r) * 2048 + ((MODE == 0) ? (h * 512 + s * 64) : (h * 64)) + 16 * fe0 + l15) * 2);
  }
  const int kdelta = (kcol - qcol) * 2;

#define PF_ISSUE(SET, RBASE)                                                                       \
  {                                                                                                \
    const int rb_ = (RBASE);                                                                       \
    if (true) {                                                                                    \
      const char* sb_ = (const char*)src + (size_t)rb_ * (size_t)(sstride * 2);                    \
      const char* gb_ = (const char*)gsrc + (size_t)rb_ * (size_t)(PROJ_LD * 2);                   \
      _Pragma("unroll") for (int i = 0; i < NQ; ++i) {                                             \
        rq[SET][i] = *(const u32x4*)(sb_ + qoff[i]);                                               \
        rk[SET][i] = *(const u32x4*)(sb_ + kdelta + qoff[i]);                                      \
      }                                                                                            \
      rv[SET] = *(const u32x4*)(sb_ + voffv);                                                      \
      if (MODE == 1) {                                                                             \
        pcj[SET] = cumv[(size_t)(rb_ + vrow) * 32 + h]; puj[SET] = dtv[(size_t)(rb_ + vrow) * 32 + h]; \
        pclast[SET] = cumv[(size_t)(rb_ + 63) * 32 + h];                                           \
        pct[SET] = cumv[(size_t)(rb_ + jt) * 32 + h]; put[SET] = dtv[(size_t)(rb_ + jt) * 32 + h]; \
      }                                                                                            \
      _Pragma("unroll") for (int x = 0; x < 2; ++x)                                                \
        _Pragma("unroll") for (int r = 0; r < 4; ++r)                                              \
          gz[SET][x][r] = *(const u16*)(gb_ + 32 * x + goff[r]);                                   \
    } else {                                                                                       \
      _Pragma("unroll") for (int i = 0; i < NQ; ++i) {                                             \
        int c_ = tid + NTHR * i, rr_ = c_ / CPR, kc_ = c_ % CPR;                                   \
        rq[SET][i] = *(const u32x4*)(src + (size_t)(rb_ + rr_) * sstride + qcol + kc_ * 8);        \
        rk[SET][i] = *(const u32x4*)(src + (size_t)(rb_ + rr_) * sstride + kcol + kc_ * 8);        \
      }                                                                                            \
      rv[SET] = *(const u32x4*)(src + (size_t)(rb_ + vrow) * sstride + vcol + vkc * 8);            \
      _Pragma("unroll") for (int x = 0; x < 2; ++x)                                                \
        _Pragma("unroll") for (int r = 0; r < 4; ++r)                                              \
          gz[SET][x][r] = gsrc[(size_t)(rb_ + 16 * fi + 4 * g + r) * PROJ_LD + gcol + 16 * (fe0 + x) + l15]; \
    }                                                                                              \
  }

  f32x4 S[MF][4];
#pragma unroll
  for (int i = 0; i < MF; ++i)
#pragma unroll
    for (int j = 0; j < 4; ++j) S[i][j] = (f32x4){0.f, 0.f, 0.f, 0.f};

  float gnv[2];
  const float dsk = (MODE == 1) ? p.ssm_d[h] : 0.f;
#pragma unroll
  for (int x = 0; x < 2; ++x) {
    const int e = 16 * (fe0 + x) + l15;
    gnv[x] = (MODE == 0) ? p.ret_head_norm[h * 512 + s * 64 + e] : p.ssm_gate_norm[h * 64 + e];
  }

  PF_ISSUE(0, row0)
  if (NSET == 2) PF_ISSUE(1, row0 + 64)

  for (int c2 = 0; c2 < 32; c2 += 2) {
#pragma unroll
   for (int par2 = 0; par2 < 2; ++par2) {
    const int par = par2 & (NSET - 1);
    const int c = c2 + par2;
    const int r0 = row0 + c * 64;
#pragma unroll
    for (int i = 0; i < NQ; ++i) {
      int cc = tid + NTHR * i, rr = cc / CPR, kc = cc % CPR;
      *(u32x4*)(Qs + rr * QS + kc * 16) = rq[par][i];
      *(u32x4*)(Ks + rr * QS + kc * 16) = rk[par][i];
    }
    {
      const u32x4 rvv = rv[par];
      *(u32x4*)(Vs + vrow * VS + vkc * 16) = rvv;
      float cj, uj, cl;
      if (MODE == 0) { cj = (float)(vrow + 1) * lg; uj = 1.f; cl = 64.f * lg; } else { cj = pcj[par]; uj = puj[par]; cl = pclast[par]; }
      const float wj = uj * ex2(cl - cj);
      u32x4 o;
      o.x = pack2(bf2f((u16)(rvv.x & 0xffff)) * wj, bf2f((u16)(rvv.x >> 16)) * wj);
      o.y = pack2(bf2f((u16)(rvv.y & 0xffff)) * wj, bf2f((u16)(rvv.y >> 16)) * wj);
      o.z = pack2(bf2f((u16)(rvv.z & 0xffff)) * wj, bf2f((u16)(rvv.z >> 16)) * wj);
      o.w = pack2(bf2f((u16)(rvv.w & 0xffff)) * wj, bf2f((u16)(rvv.w >> 16)) * wj);
      *(u32x4*)(Vts + vrow * VS + vkc * 16) = o;
    }
    if (tid < 64) {
      if (MODE == 0) { cumS[tid] = (float)(tid + 1) * lg; uS[tid] = 1.f; } else { cumS[tid] = pct[par]; uS[tid] = put[par]; }
    }
#pragma unroll
    for (int mf = 0; mf < MF; ++mf)
#pragma unroll
      for (int nf = 0; nf < 4; ++nf) {
        u32x2 o;
        o.x = pack2(S[mf][nf][0], S[mf][nf][1]);
        o.y = pack2(S[mf][nf][2], S[mf][nf][3]);
        *(u32x2*)(STs + (16 * nf + l15) * QS + (dw + 16 * mf + 4 * g) * 2) = o;
      }
    u16 gzc[2][4];
#pragma unroll
    for (int x = 0; x < 2; ++x)
#pragma unroll
      for (int r = 0; r < 4; ++r) gzc[x][r] = gz[par][x][r];
    __syncthreads();
    if (c + NSET < 32) PF_ISSUE(par, r0 + 64 * NSET)
    f32x4 sc[2], cr[2];
#pragma unroll
    for (int x = 0; x < 2; ++x) { sc[x] = (f32x4){0.f, 0.f, 0.f, 0.f}; cr[x] = (f32x4){0.f, 0.f, 0.f, 0.f}; }
#pragma unroll KUNR
    for (int ks = 0; ks < KS; ++ks) {
      const bf16x8 a = *(const bf16x8*)(Qs + (16 * fi + l15) * QS + ks * 64 + g * 16);
      bf16x8 bk[2], bs[2];
#pragma unroll
      for (int x = 0; x < 2; ++x) {
        bk[x] = *(const bf16x8*)(Ks + (16 * (fe0 + x) + l15) * QS + ks * 64 + g * 16);
        bs[x] = *(const bf16x8*)(STs + (16 * (fe0 + x) + l15) * QS + ks * 64 + g * 16);
      }
#pragma unroll
      for (int x = 0; x < 2; ++x) {
        sc[x] = __builtin_amdgcn_mfma_f32_16x16x32_bf16(a, bk[x], sc[x], 0, 0, 0);
        cr[x] = __builtin_amdgcn_mfma_f32_16x16x32_bf16(a, bs[x], cr[x], 0, 0, 0);
      }
    }
    float ci[4];
#pragma unroll
    for (int r = 0; r < 4; ++r) ci[r] = cumS[16 * fi + 4 * g + r];
#pragma unroll
    for (int x = 0; x < 2; ++x) {
      const int fj = fe0 + x;
      const int j = 16 * fj + l15;
      const float cj = cumS[j], uj = uS[j];
#pragma unroll
      for (int r = 0; r < 4; ++r) {
        const int i = 16 * fi + 4 * g + r;
        float v = 0.f;
        if (j <= i) v = sc[x][r] * ex2(ci[r] - cj) * uj;
        *(u16*)(Ps + i * PS + j * 2) = f2bf(v);
      }
    }
    {
      const float atot = ex2(cumS[63]);
#pragma unroll
      for (int mf = 0; mf < MF; ++mf)
#pragma unroll
        for (int nf = 0; nf < 4; ++nf)
#pragma unroll
          for (int r = 0; r < 4; ++r) S[mf][nf][r] *= atot;
#pragma unroll
      for (int ks = 0; ks < 2; ++ks) {
        bf16x8 af[MF], bfv[4];
#pragma unroll
        for (int mf = 0; mf < MF; ++mf) af[mf] = trfrag(Ks, QS, 32 * ks, dw + 16 * mf, lane);
#pragma unroll
        for (int nf = 0; nf < 4; ++nf) bfv[nf] = trfrag(Vts, VS, 32 * ks, 16 * nf, lane);
#pragma unroll
        for (int mf = 0; mf < MF; ++mf)
#pragma unroll
          for (int nf = 0; nf < 4; ++nf)
            S[mf][nf] = __builtin_amdgcn_mfma_f32_16x16x32_bf16(af[mf], bfv[nf], S[mf][nf], 0, 0, 0);
      }
    }
    __syncthreads();
    f32x4 in[2];
#pragma unroll
    for (int x = 0; x < 2; ++x) in[x] = (f32x4){0.f, 0.f, 0.f, 0.f};
#pragma unroll
    for (int ks = 0; ks < 2; ++ks) {
      const bf16x8 a = *(const bf16x8*)(Ps + (16 * fi + l15) * PS + ks * 64 + g * 16);
      bf16x8 bv[2];
#pragma unroll
      for (int x = 0; x < 2; ++x) bv[x] = trfrag(Vs, VS, 32 * ks, 16 * (fe0 + x), lane);
#pragma unroll
      for (int x = 0; x < 2; ++x) in[x] = __builtin_amdgcn_mfma_f32_16x16x32_bf16(a, bv[x], in[x], 0, 0, 0);
    }
    {
      float ss[4] = {0.f, 0.f, 0.f, 0.f};
      u16* aout = (u16*)(p.ws + OFF_A2);
      float* parts = (float*)(p.ws + OFF_PARTS);
#pragma unroll
      for (int x = 0; x < 2; ++x) {
        const int e = 16 * (fe0 + x) + l15;
        const float gn = gnv[x];
        const int ocol = (MODE == 0) ? (h * 512 + s * 64 + e) : (h * 64 + e);
#pragma unroll
        for (int r = 0; r < 4; ++r) {
          const int i = 16 * fi + 4 * g + r;
          float o = in[x][r] + cr[x][r] * ex2(ci[r]);
          const float gv = bf2f(gzc[x][r]);
          float val;
          if (MODE == 0) {
            ss[r] += o * o;
            val = o * gn * silu(gv);
          } else {
            const float xs = bf2f(*(const u16*)(Vs + i * VS + e * 2));
            const float y = o + xs * dsk;
            const float gg = y * silu(gv);
            ss[r] += gg * gg;
            val = gg * gn;
          }
          *(u16*)((char*)aout + (size_t)r0 * 4096 + 32 * x + aoff[r]) = f2bf(val);
        }
      }
#pragma unroll
      for (int r = 0; r < 4; ++r) {
        const float v = row16_sum(ss[r]);
        if (l15 == 0) {
          const int i = 16 * fi + 4 * g + r;
          const int slot = (MODE == 0) ? (h * 16 + s * 2 + (w & 1)) : ((h >> 2) * 8 + (h & 3) * 2 + (w & 1));
          parts[(size_t)(r0 + i) * 64 + slot] = v;
        }
      }
    }
    __syncthreads();
   }
  }
#undef PF_ISSUE
  {
    float* so;
    int pitch;
    if (MODE == 0) { so = p.out + OUT_RETP + ((size_t)(b * 4 + h) * 256) * 512 + s * 64; pitch = 512; }
    else { so = p.out + OUT_SSMP + ((size_t)(b * 32 + h) * 128) * 64; pitch = 64; }
#pragma unroll
    for (int mf = 0; mf < MF; ++mf)
#pragma unroll
      for (int nf = 0; nf < 4; ++nf)
#pragma unroll
        for (int r = 0; r < 4; ++r)
          so[(size_t)(dw + 16 * mf + 4 * g + r) * pitch + 16 * nf + l15] = S[mf][nf][r];
  }
}

#define SAMPLE_DECODE(ITEM, B_, H_, S_)                              \
  const int B_ = (ITEM) >> 5;                                        \
  const int H_ = (MODE == 0) ? (((ITEM) >> 3) & 3) : ((ITEM) & 31);  \
  const int S_ = (MODE == 0) ? ((ITEM) & 7) : 0;

#define SAMPLE_ISSUE(SET, ITEM)                                                                                     \
  {                                                                                                                \
    SAMPLE_DECODE(ITEM, b_, h_, s_)                                                                                \
    const int row0_ = NPROMPT + b_ * 8;                                                                            \
    int qcol_, kcol_, vcol_;                                                                                       \
    if (MODE == 0) { qcol_ = h_ * 256; kcol_ = 1024 + h_ * 256; vcol_ = 2048 + h_ * 512 + s_ * 64; }               \
    else { qcol_ = 3072 + (h_ >> 2) * 128; kcol_ = 2048 + (h_ >> 2) * 128; vcol_ = h_ * 64; }                      \
    const float* s0_ = (MODE == 0) ? p.state_ret + ((size_t)(b_ * 4 + h_) * 256) * 512 + s_ * 64                   \
                                   : p.state_ssm + ((size_t)(b_ * 32 + h_) * 128) * 64;                            \
    _Pragma("unroll") for (int db = 0; db < NB; ++db)                                                              \
      _Pragma("unroll") for (int eb = 0; eb < 4; ++eb)                                                             \
        _Pragma("unroll") for (int r = 0; r < 4; ++r)                                                              \
          sv[SET][db][eb][r] = s0_[(size_t)(dbase + 16 * db + 4 * g + r) * pitch + 16 * eb + l15];                \
    if (tid < 2 * DK) {                                                                                            \
      const int which_ = tid / DK, c_ = tid % DK;                                                                  \
      rqk[SET] = *(const u32x4*)(src + (size_t)(row0_ + c_ / CPR) * sstride + (which_ ? kcol_ : qcol_) + (c_ % CPR) * 8); \
    }                                                                                                              \
    if (tid < 64) {                                                                                                \
      rv[SET] = *(const u32x4*)(src + (size_t)(row0_ + (tid >> 3)) * sstride + vcol_ + (tid & 7) * 8);             \
      if (MODE == 1) {                                                                                             \
        pvc[SET] = cumv[(size_t)(row0_ + (tid >> 3)) * 32 + h_];                                                   \
        pvu[SET] = dtv[(size_t)(row0_ + (tid >> 3)) * 32 + h_];                                                    \
        pvl[SET] = cumv[(size_t)(row0_ + 7) * 32 + h_];                                                            \
      }                                                                                                            \
    }                                                                                                              \
    gzs[SET] = gsrc[(size_t)(row0_ + w) * PROJ_LD + ((MODE == 0) ? (4096 + h_ * 512 + s_ * 64) : (h_ * 64)) + lane]; \
    if (MODE == 1 && tid < 16)                                                                                     \
      pcu[SET] = (tid < 8) ? cumv[(size_t)(row0_ + tid) * 32 + h_] : dtv[(size_t)(row0_ + tid - 8) * 32 + h_];     \
  }

#define SAMPLE_REMAP(I0)                                                                                   \
  ((((I0) & 4095) & ~255) |                                                                                \
   ((MODE == 0) ? ((((I0) & 7) * 4 + (((I0) & 255) >> 6)) * 8 + ((((I0) & 255) >> 3) & 7))                 \
                : ((((I0) & 7) * 8 + (((I0) & 255) >> 5)) * 4 + ((((I0) & 255) >> 3) & 3))))

template <int DK, int MODE>
__device__ void rec_sample_loop(const Params& p, unsigned char* smem, const int rep) {
  constexpr int SET_FLOATS = 8 * DK + 8 * DK + 512 + 64 + 4096 + 64 + (DK * 8 + 64 * 8) / 2;
  const int tid = (int)p.tidx, lane = tid & 63, w = tid >> 6;
  const int l15 = lane & 15, g = lane >> 4;
  constexpr int CPR = DK / 8;
  constexpr int DPW = DK / 8;
  constexpr int NB = DPW / 16;
  const int dbase = w * DPW;
  const int pitch = (MODE == 0) ? 512 : 64;
  int vz;
  asm volatile("v_mov_b32 %0, 0" : "=v"(vz));
  const u16* src = ((MODE == 0) ? (const u16*)(p.ws + OFF_PROJ) : (const u16*)(p.ws + OFF_XBCC)) + vz;
  const int sstride = (MODE == 0) ? PROJ_LD : 4096;
  const u16* gsrc = (const u16*)(p.ws + OFF_PROJ) + vz;
  const float* dtv = (const float*)(p.ws + OFF_DT) + vz;
  const float* cumv = (const float*)(p.ws + OFF_CUM) + vz;
  u16* aout = (u16*)(p.ws + OFF_A2);
  float* parts = (float*)(p.ws + OFF_PARTS);

  u32x4 rqk[2] = {(u32x4){0u, 0u, 0u, 0u}, (u32x4){0u, 0u, 0u, 0u}}, rv[2] = {(u32x4){0u, 0u, 0u, 0u}, (u32x4){0u, 0u, 0u, 0u}};
  f32x4 sv[2][NB][4];
  u16 gzs[2] = {0, 0};
  float pcu[2] = {0.f, 0.f}, pvc[2] = {0.f, 0.f}, pvu[2] = {1.f, 1.f}, pvl[2] = {0.f, 0.f};
  const int nitems = 4096 * rep;
  const int G = (int)gridDim.x;
  if ((int)blockIdx.x < nitems) SAMPLE_ISSUE(0, SAMPLE_REMAP((int)blockIdx.x) + vz)
  for (int itb = blockIdx.x; itb < nitems; itb += 2 * G) {
#pragma unroll
   for (int par = 0; par < 2; ++par) {
    const int item0 = itb + par * G;
    if (item0 < nitems) {
    if (item0 + G < nitems) SAMPLE_ISSUE(par ^ 1, SAMPLE_REMAP(item0 + G) + vz)
    __builtin_amdgcn_sched_barrier(0);
    const int item = SAMPLE_REMAP(item0) + vz;
    SAMPLE_DECODE(item, b, h, s)
    const int row0 = NPROMPT + b * 8;
    const u16 gzv = gzs[par];
    const u32x4 rqkc = rqk[par], rvc = rv[par];
    float* qS = (float*)smem + par * SET_FLOATS;
    float* kS = qS + 8 * DK;
    float* vS = kS + 8 * DK;
    float* scS = vS + 512;
    float* redS = scS + 64;
    float* cuS = redS + 4096;
    u16* kTb = (u16*)(cuS + 64);
    u16* vwTb = kTb + DK * 8;
    const float lgh = (MODE == 0) ? log2f(1.0f - exp2f(-5.0f - (float)h)) : 0.f;
    if (tid < 2 * DK) {
      const int which = tid / DK, c = tid % DK;
      float* dst = (which ? kS : qS) + (c / CPR) * DK + (c % CPR) * 8;
      dst[0] = bf2f((u16)(rqkc.x & 0xffff)); dst[1] = bf2f((u16)(rqkc.x >> 16));
      dst[2] = bf2f((u16)(rqkc.y & 0xffff)); dst[3] = bf2f((u16)(rqkc.y >> 16));
      dst[4] = bf2f((u16)(rqkc.z & 0xffff)); dst[5] = bf2f((u16)(rqkc.z >> 16));
      dst[6] = bf2f((u16)(rqkc.w & 0xffff)); dst[7] = bf2f((u16)(rqkc.w >> 16));
      if (which) {
        u16* dT = kTb + ((c % CPR) * 8) * 8 + (c / CPR);
        dT[0 * 8] = (u16)(rqkc.x & 0xffff); dT[1 * 8] = (u16)(rqkc.x >> 16);
        dT[2 * 8] = (u16)(rqkc.y & 0xffff); dT[3 * 8] = (u16)(rqkc.y >> 16);
        dT[4 * 8] = (u16)(rqkc.z & 0xffff); dT[5 * 8] = (u16)(rqkc.z >> 16);
        dT[6 * 8] = (u16)(rqkc.w & 0xffff); dT[7 * 8] = (u16)(rqkc.w >> 16);
      }
    }
    if (tid < 64) {
      const int t = tid >> 3, kc = tid & 7;
      float vv[8];
      vv[0] = bf2f((u16)(rvc.x & 0xffff)); vv[1] = bf2f((u16)(rvc.x >> 16));
      vv[2] = bf2f((u16)(rvc.y & 0xffff)); vv[3] = bf2f((u16)(rvc.y >> 16));
      vv[4] = bf2f((u16)(rvc.z & 0xffff)); vv[5] = bf2f((u16)(rvc.z >> 16));
      vv[6] = bf2f((u16)(rvc.w & 0xffff)); vv[7] = bf2f((u16)(rvc.w >> 16));
      float* dst = vS + t * 64 + kc * 8;
      const float wt = (MODE == 0) ? ex2((float)(7 - t) * lgh) : pvu[par] * ex2(pvl[par] - pvc[par]);
      u16* dT = vwTb + (kc * 8) * 8 + t;
#pragma unroll
      for (int x = 0; x < 8; ++x) { dst[x] = vv[x]; dT[x * 8] = f2bf(vv[x] * wt); }
    }
    if (MODE == 1 && tid < 16) cuS[tid] = pcu[par];
    __syncthreads();
    float cum[8], u[8];
    if (MODE == 0) {
#pragma unroll
      for (int t = 0; t < 8; ++t) { cum[t] = (float)(t + 1) * lgh; u[t] = 1.f; }
    } else {
#pragma unroll
      for (int t = 0; t < 8; ++t) { cum[t] = cuS[t]; u[t] = cuS[8 + t]; }
    }
    if (w == 0) {
      f32x4 sacc = (f32x4){0.f, 0.f, 0.f, 0.f};
#pragma unroll
      for (int ks = 0; ks < DK / 32; ++ks) {
        const float* qp = qS + (l15 & 7) * DK + ks * 32 + 8 * g;
        const float* kp = kS + (l15 & 7) * DK + ks * 32 + 8 * g;
        const float4 a0 = *(const float4*)qp, a1 = *(const float4*)(qp + 4);
        const float4 b0 = *(const float4*)kp, b1 = *(const float4*)(kp + 4);
        u32x4 qa_, kb_;
        qa_.x = pack2(a0.x, a0.y); qa_.y = pack2(a0.z, a0.w); qa_.z = pack2(a1.x, a1.y); qa_.w = pack2(a1.z, a1.w);
        kb_.x = pack2(b0.x, b0.y); kb_.y = pack2(b0.z, b0.w); kb_.z = pack2(b1.x, b1.y); kb_.w = pack2(b1.z, b1.w);
        sacc = __builtin_amdgcn_mfma_f32_16x16x32_bf16(__builtin_bit_cast(bf16x8, qa_), __builtin_bit_cast(bf16x8, kb_), sacc, 0, 0, 0);
      }
      if (g < 2 && l15 < 8) {
        float cj = 0.f, uj = 0.f;
#pragma unroll
        for (int t = 0; t < 8; ++t) if (t == l15) { cj = cum[t]; uj = u[t]; }
#pragma unroll
        for (int r = 0; r < 4; ++r) {
          const int i = 4 * g + r;
          float ci = 0.f;
#pragma unroll
          for (int t = 0; t < 8; ++t) if (t == i) ci = cum[t];
          scS[i * 8 + l15] = (l15 <= i) ? sacc[r] * ex2(ci - cj) * uj : 0.f;
        }
      }
    }
    {
      float* s1 = (MODE == 0) ? p.out + OUT_RETS + ((size_t)(b * 4 + h) * 256) * 512 + s * 64
                              : p.out + OUT_SSMS + ((size_t)(b * 32 + h) * 128) * 64;
      const float atot = ex2(cum[7]);
      const bf16x8 zero8 = (bf16x8){0, 0, 0, 0, 0, 0, 0, 0};
      bf16x8 kA[NB], vB[4], qa;
#pragma unroll
      for (int db = 0; db < NB; ++db) {
        const bf16x8 t8 = *(const bf16x8*)(kTb + (dbase + 16 * db + l15) * 8);
        kA[db] = (g == 0) ? t8 : zero8;
      }
#pragma unroll
      for (int eb = 0; eb < 4; ++eb) {
        const bf16x8 t8 = *(const bf16x8*)(vwTb + (16 * eb + l15) * 8);
        vB[eb] = (g == 0) ? t8 : zero8;
      }
      {
        const float* qrow = qS + (l15 & 7) * DK + dbase + 4 * g;
        const float4 q0 = *(const float4*)qrow;
        float4 q1 = make_float4(0.f, 0.f, 0.f, 0.f);
        if (NB == 2) q1 = *(const float4*)(qrow + 16);
        u32x4 qq;
        qq.x = pack2(q0.x, q0.y); qq.y = pack2(q0.z, q0.w); qq.z = pack2(q1.x, q1.y); qq.w = pack2(q1.z, q1.w);
        if (l15 >= 8) qq = (u32x4){0u, 0u, 0u, 0u};
        qa = __builtin_bit_cast(bf16x8, qq);
      }
#pragma unroll
      for (int eb = 0; eb < 4; ++eb) {
        u32x4 sb;
        sb.x = pack2(sv[par][0][eb][0], sv[par][0][eb][1]);
        sb.y = pack2(sv[par][0][eb][2], sv[par][0][eb][3]);
        if (NB == 2) {
          sb.z = pack2(sv[par][NB - 1][eb][0], sv[par][NB - 1][eb][1]);
          sb.w = pack2(sv[par][NB - 1][eb][2], sv[par][NB - 1][eb][3]);
        } else { sb.z = 0u; sb.w = 0u; }
        const f32x4 o3 = __builtin_amdgcn_mfma_f32_16x16x32_bf16(qa, __builtin_bit_cast(bf16x8, sb),
                                                                 (f32x4){0.f, 0.f, 0.f, 0.f}, 0, 0, 0);
        if (g < 2) {
#pragma unroll
          for (int r = 0; r < 4; ++r) redS[(w * 8 + 4 * g + r) * 64 + 16 * eb + l15] = o3[r];
        }
#pragma unroll
        for (int db = 0; db < NB; ++db) {
          f32x4 c = sv[par][db][eb];
          c[0] *= atot; c[1] *= atot; c[2] *= atot; c[3] *= atot;
          const f32x4 dn = __builtin_amdgcn_mfma_f32_16x16x32_bf16(kA[db], vB[eb], c, 0, 0, 0);
#pragma unroll
          for (int r = 0; r < 4; ++r) s1[(size_t)(dbase + 16 * db + 4 * g + r) * pitch + 16 * eb + l15] = dn[r];
        }
      }
    }
    __syncthreads();
    {
      const int i = w, e = lane;
      float o = 0.f;
#pragma unroll
      for (int ww = 0; ww < 8; ++ww) o += redS[(ww * 8 + i) * 64 + e];
      float ci = 0.f;
#pragma unroll
      for (int t = 0; t < 8; ++t) if (t == i) ci = cum[t];
      o *= ex2(ci);
#pragma unroll
      for (int jj = 0; jj < 8; ++jj) if (jj <= i) o += scS[i * 8 + jj] * vS[jj * 64 + e];
      const int row = row0 + i;
      const float gv = bf2f(gzv);
      if (MODE == 0) {
        const float ssq = wave_sum(o * o);
        const float val = o * p.ret_head_norm[h * 512 + s * 64 + e] * silu(gv);
        aout[(size_t)row * 2048 + h * 512 + s * 64 + e] = f2bf(val);
        if (lane < 2) parts[(size_t)row * 64 + h * 16 + s * 2 + lane] = lane == 0 ? ssq : 0.f;
      } else {
        const float y = o + vS[i * 64 + e] * p.ssm_d[h];
        const float gg = y * silu(gv);
        const float ssq = wave_sum(gg * gg);
        aout[(size_t)row * 2048 + h * 64 + e] = f2bf(gg * p.ssm_gate_norm[h * 64 + e]);
        if (lane < 2) parts[(size_t)row * 64 + (h >> 2) * 8 + (h & 3) * 2 + lane] = lane == 0 ? ssq : 0.f;
      }
    }
    }
   }
  }
  __syncthreads();
}

template <int DK, int MODE>
__device__ void phase_rec(const Params& p, unsigned char* smem, const int rep_p, const int rep_s) {
  for (int it0 = blockIdx.x; it0 < 256 * rep_p; it0 += gridDim.x) {
    const int blk = it0 & 255;
    const int item = (MODE == 0) ? (((blk & 7) * 4 + (blk >> 6)) * 8 + ((blk >> 3) & 7))
                                 : (((blk & 7) * 8 + (blk >> 5)) * 4 + ((blk >> 3) & 3));
    rec_prompt_item<DK, MODE>(p, item, smem);
  }
  rec_sample_loop<DK, MODE>(p, smem, rep_s);
}

#ifndef PHASE_MASK
#define PHASE_MASK 0x3ff
#endif
#ifndef DUP_MASK
#define DUP_MASK 0x000
#endif
#define XB_TMO      128
#define XB_XCNT(j)  (256  + 64 * (j))
#define XB_XSUB(j)  (1280 + 64 * (j))
#define XB_XGEN(j)  (2304 + 64 * (j))
#define XB_TOP      3328
#define XB_TOPGEN   3392
#define XCD_BAR_WORDS 3456
#define XB_SPIN_CAP (1u << 20)
#define LAS __attribute__((address_space(3)))
__device__ __forceinline__ unsigned xb_ld(unsigned* p) { return __hip_atomic_load(p, __ATOMIC_RELAXED, __HIP_MEMORY_SCOPE_AGENT); }
__device__ __forceinline__ unsigned xb_add(unsigned* p, unsigned v) { return __hip_atomic_fetch_add(p, v, __ATOMIC_RELAXED, __HIP_MEMORY_SCOPE_AGENT); }
__device__ __forceinline__ unsigned xb_xcc_id() { return (unsigned)__builtin_amdgcn_s_getreg((3 << 11) | 20) & 0xFu; }
#define XB_SPIN(cond, bar) do { unsigned _sp = 0; while (cond) { __builtin_amdgcn_s_sleep(1); \
    if ((++_sp & 255u) == 0u) { if (xb_ld(&(bar)[XB_TMO])) break; if (_sp > XB_SPIN_CAP) { atomicAdd(&(bar)[XB_TMO], 1u); break; } } } } while (0)
struct XcdBarrier {
  unsigned* bar; unsigned x;
  volatile LAS unsigned* st;
};
__device__ __forceinline__ XcdBarrier xcd_barrier_post(unsigned* bar, volatile LAS unsigned* st, const int tid) {
  XcdBarrier b; b.bar = bar; b.x = xb_xcc_id(); b.st = st;
  if (tid == 0) (void)xb_add(&bar[XB_XCNT(b.x)], 1u);
  return b;
}
__device__ __forceinline__ void xcd_barrier_complete(unsigned* bar, unsigned x, unsigned& nloc, unsigned& nx) {
  const unsigned G = gridDim.x * gridDim.y * gridDim.z;
  unsigned sum, cnt, mine, sp = 0u;
  for (;;) {
    sum = 0u; cnt = 0u; mine = 0u;
#pragma unroll
    for (unsigned j = 0; j < 16; ++j) { const unsigned c = xb_ld(&bar[XB_XCNT(j)]); sum += c; cnt += (c > 0u) ? 1u : 0u; mine = (j == x) ? c : mine; }
    if (sum == G) break;
    __builtin_amdgcn_s_sleep(1);
    if ((++sp & 255u) == 0u) { if (xb_ld(&bar[XB_TMO])) break; if (sp > XB_SPIN_CAP) { atomicAdd(&bar[XB_TMO], 1u); break; } }
  }
  nloc = mine > 0u ? mine : 1u; nx = cnt > 0u ? cnt : 1u;
}
__device__ __forceinline__ void xcd_barrier(const XcdBarrier& b, const int wvs) {
  int wvl_ = wvs;
  asm volatile("" : "+s"(wvl_));
  const int tid = wvl_ * 64 + (int)__builtin_amdgcn_mbcnt_hi(~0u, __builtin_amdgcn_mbcnt_lo(~0u, 0u));
  asm volatile("s_waitcnt vmcnt(0)" ::: "memory");
  __syncthreads();
  if (tid == 0) {
    unsigned* bar = b.bar;
    __builtin_amdgcn_s_waitcnt(0);
    unsigned nloc = b.st[0], nx = b.st[1];
    if (nloc == 0u) { xcd_barrier_complete(bar, b.x, nloc, nx); b.st[0] = nloc; b.st[1] = nx; }
    const unsigned old = xb_add(&bar[XB_XSUB(b.x)], 1u);
    const unsigned gen = old / nloc;
    if (old + 1u == (gen + 1u) * nloc) {
      __builtin_amdgcn_fence(__ATOMIC_RELEASE, "agent");
      asm volatile("s_waitcnt vmcnt(0)" ::: "memory");
      const unsigned og = xb_add(&bar[XB_TOP], 1u);
      const unsigned tg = og / nx;
      if (og + 1u == (tg + 1u) * nx) xb_add(&bar[XB_TOPGEN], 1u);
      else XB_SPIN(xb_ld(&bar[XB_TOPGEN]) == tg, bar);
      __builtin_amdgcn_fence(__ATOMIC_ACQUIRE, "agent");
      xb_add(&bar[XB_XGEN(b.x)], 1u);
      asm volatile("s_waitcnt vmcnt(0)" ::: "memory");
    } else {
      XB_SPIN(xb_ld(&bar[XB_XGEN(b.x)]) == gen, bar);
      __builtin_amdgcn_fence(__ATOMIC_ACQUIRE, "agent");
      asm volatile("s_waitcnt vmcnt(0)" ::: "memory");
    }
  }
  __syncthreads();
}

template <typename T>
__device__ __forceinline__ T* as_global(T* q) {
  return (T*)(__attribute__((address_space(1))) T*)q;
}

template <int PH>
__device__ __forceinline__ void run_phase(Params p, unsigned char* smem, const int wvs) {
  {
    long long z_ = 0;
    asm volatile("" : "+s"(z_));
    p.ws += z_; p.out += z_;
  }
  {
    int wvl_ = wvs;
    asm volatile("" : "+s"(wvl_));
    p.tidx = wvl_ * 64 + (int)__builtin_amdgcn_mbcnt_hi(~0u, __builtin_amdgcn_mbcnt_lo(~0u, 0u));
    p.wv = wvl_;
  }
  const int rep = 1 + (int)((p.dup >> PH) & 1);
  if (PH == 0) phase_prep(p, smem, rep);
  if (PH == 1) {
    gemm8_phase<0>(p, (const u16*)(p.ws + OFF_H), (const u16*)(p.ws + OFF_WT0), 1024, 24, smem, rep);
    __syncthreads();
    transpose_later_weights(p, smem, (68 * 24) % (int)gridDim.x);
  }
  if (PH == 2) phase_rec<256, 0>(p, smem, rep, 1 + (int)((p.dup >> (PH + 16)) & 1));
  if (PH == 3)
  {
    gemm_phase<1, 4>(p, (const u16*)(p.ws + OFF_A2), (const u16*)(p.ws + OFF_WT1), 2048, 8, nullptr,
                     (float*)(p.ws + OFF_X1), smem, rep, 64);
    __syncthreads();
    gemm_sample_rows<4>(p, (const u16*)(p.ws + OFF_A2), (const u16*)(p.ws + OFF_WT1), nullptr, (float*)(p.ws + OFF_X1), smem, rep);
  }
  if (PH == 4) phase_norm<0>(p, (const float*)(p.ws + OFF_X1), p.ssm_norm, rep);
  if (PH == 5) {
    gemm8_phase<2>(p, (const u16*)(p.ws + OFF_H), (const u16*)(p.ws + OFF_WT2), 1024, 24, smem, rep);
    __syncthreads();
    gemm_phase<2, 0>(p, (const u16*)(p.ws + OFF_H), (const u16*)(p.ws + OFF_WT2), 1024, 1, nullptr, nullptr, smem, 1, 68, 48, true);
  }
  if (PH == 6) phase_conv(p, smem, rep);
  if (PH == 7) phase_rec<128, 1>(p, smem, rep, 1 + (int)((p.dup >> (PH + 16)) & 1));
  if (PH == 8)
  {
    gemm_phase<1, 8>(p, (const u16*)(p.ws + OFF_A2), (const u16*)(p.ws + OFF_WT3), 2048, 8,
                     (const float*)(p.ws + OFF_X1), (float*)(p.ws + OFF_X2), smem, rep, 64);
    __syncthreads();
    gemm_sample_rows<8>(p, (const u16*)(p.ws + OFF_A2), (const u16*)(p.ws + OFF_WT3), (const float*)(p.ws + OFF_X1),
                        (float*)(p.ws + OFF_X2), smem, rep);
  }
  if (PH == 9) phase_norm<1>(p, (const float*)(p.ws + OFF_X2), p.final_norm, rep);
}

#define RUN_PHASE(k)                                   \
  if ((PHASE_MASK >> k) & 1) {                         \
    if (lo <= k && k <= hi) {                          \
      run_phase<k>(p, smem, wvs);                      \
      if (k < hi) { xcd_barrier(xb, wvs); if ((p.dup >> 30) & 1) { xcd_barrier(xb, wvs); xcd_barrier(xb, wvs); } } \
    }                                                  \
  }

__global__ void __launch_bounds__(NTHR) fwd_megakernel(Params p) {
  __shared__ __attribute__((aligned(16))) unsigned char smem[LDS_BYTES];
  cg::grid_group grid = cg::this_grid();
  const int lo = (int)p.phase_lo, hi = (int)p.phase_hi;
  if (lo > 1000) grid.sync();
  volatile LAS unsigned* xst = (volatile LAS unsigned*)(smem + LDS_BYTES - 16);
  const int wvs = __builtin_amdgcn_readfirstlane((int)(threadIdx.x >> 6));
  if (threadIdx.x == 0) { xst[0] = 0u; xst[1] = 0u; }
  __syncthreads();
  const XcdBarrier xb = xcd_barrier_post((unsigned*)(p.ws + OFF_BAR), xst, (int)threadIdx.x);
  RUN_PHASE(0)
  RUN_PHASE(1)
  RUN_PHASE(2)
  RUN_PHASE(3)
  RUN_PHASE(4)
  RUN_PHASE(5)
  RUN_PHASE(6)
  RUN_PHASE(7)
  RUN_PHASE(8)
  RUN_PHASE(9)
}

#ifndef ONE_LAUNCH
#define ONE_LAUNCH 1
#endif

extern "C" void kernel_launch(void* const* d_in, const int* in_sizes, int n_in, void* d_out, int out_size, void* d_ws,
                              size_t ws_size, hipStream_t stream) {
  static int grid_blocks = 0;
  if (!grid_blocks) {
    int dev = 0, cus = 0, per_cu = 0;
    hipGetDevice(&dev);
    hipDeviceGetAttribute(&cus, hipDeviceAttributeMultiprocessorCount, dev);
    hipOccupancyMaxActiveBlocksPerMultiprocessor(&per_cu, fwd_megakernel, NTHR, 0);
    if (per_cu < 1) per_cu = 1;
    if (per_cu > 1) per_cu = 1;
    grid_blocks = cus * per_cu;
  }
  Params p{};
  const float** pf = (const float**)&p;
  for (int i = 0; i < 19; ++i) pf[i] = (const float*)d_in[i];
  p.out = (float*)d_out;
  p.ws = (unsigned char*)d_ws;
#if ONE_LAUNCH
  hipMemsetAsync((unsigned char*)d_ws + OFF_BAR, 0, XCD_BAR_WORDS * 4, stream);
  p.phase_lo = 0; p.phase_hi = 9; p.dup = DUP_MASK;
  void* args[] = {&p};
  hipError_t e = hipLaunchCooperativeKernel((void*)fwd_megakernel, dim3(grid_blocks), dim3(NTHR), args, 0, stream);
  if (e != hipSuccess) fprintf(stderr, "cooperative launch failed: %s (grid %d)\n", hipGetErrorString(e), grid_blocks);
#else
  for (int ph = 0; ph <= 9; ++ph) {
    p.phase_lo = ph; p.phase_hi = ph;
    void* args[] = {&p};
    hipLaunchCooperativeKernel((void*)fwd_megakernel, dim3(grid_blocks), dim3(NTHR), args, 0, stream);
  }
#endif
}
```
